# Optimizing an MI355X kernel written in HIP

```python
import math
import jax, jax.numpy as jnp
from jax import lax
import numpy as np

D_MODEL = 2048
BATCH = 4
SEQ = 2048
DEPTH = 4

GRID_W = 64
CTX_LEN = 256
HEAD_DIM = 64
D_MIX = D_MODEL
N_GROUPS = 4
GROUP_W = D_MIX // N_GROUPS
LRU_HEADS = GROUP_W // HEAD_DIM
LRU_BLOCK = GROUP_W // LRU_HEADS
LRU_CONV = 4
LRU_C = 8.0
MLA_HEADS = 8
MLA_NOPE = 64
MLA_ROPE = 32
MLA_V = GROUP_W // MLA_HEADS
MLA_Q_RANK = 384
MLA_KV_RANK = 256
DIFF_HEADS = 4
DIFF_D = 64
DIFF_V = GROUP_W // DIFF_HEADS
GQA_Q_HEADS = GROUP_W // HEAD_DIM
GQA_KV_HEADS = 2
GQA_GROUP = GQA_Q_HEADS // GQA_KV_HEADS
WINDOW = 128
D_FF = 5632
MACARON_WEIGHT = 0.5
ROPE_BASE = 10000.0
Q_BLOCK = 128
RMS_EPS = 1e-6
NEG_INF = -1e30
N_MOD = 9

COLS_LRU = 2 * GROUP_W
COLS_MLA = MLA_Q_RANK + MLA_KV_RANK + MLA_ROPE
COLS_DIFF = 2 * DIFF_HEADS * 2 * DIFF_D + DIFF_HEADS * DIFF_V
COLS_GQA = (GQA_Q_HEADS + 2 * GQA_KV_HEADS) * HEAD_DIM
N_IN = COLS_LRU + COLS_MLA + COLS_DIFF + COLS_GQA
IN_SPLITS = (COLS_LRU, COLS_LRU + COLS_MLA, COLS_LRU + COLS_MLA + COLS_DIFF)

kernel_name = "hymba_parallel_mixer_diffusion_trunk"

F32 = jnp.float32


def rmsnorm(x, g):
    xf = x.astype(F32)
    y = xf * lax.rsqrt(jnp.mean(xf * xf, axis=-1, keepdims=True) + RMS_EPS)
    return (y * g.astype(F32)).astype(x.dtype)


def axial_rope_tables(rows, rot_dim):
    row = jnp.repeat(jnp.arange(rows, dtype=F32), GRID_W)
    col = jnp.tile(jnp.arange(GRID_W, dtype=F32), rows)
    per_axis = rot_dim // 2
    inv = ROPE_BASE ** (-jnp.arange(0, per_axis, 2, dtype=F32) / per_axis)
    ang = jnp.concatenate([row[:, None] * inv, col[:, None] * inv], axis=-1)
    return jnp.cos(ang), jnp.sin(ang)


def apply_rope(x, cos, sin):
    half = x.shape[-1] // 2
    xf = x.astype(F32)
    x1, x2 = xf[..., :half], xf[..., half:]
    c = cos[None, :, None, :]
    s = sin[None, :, None, :]
    return jnp.concatenate([x1 * c - x2 * s, x1 * s + x2 * c], axis=-1).astype(x.dtype)


def modulation(cvec, w_mod, b_mod):
    m = jax.nn.silu(cvec) @ w_mod + b_mod
    return jnp.split(m, N_MOD, axis=-1)


def sublayer_in(x, g_pre, shift, scale):
    return rmsnorm(x, g_pre) * (1 + scale) + shift


def sublayer_out(x, y, g_post, gate, weight):
    return x + weight * gate * rmsnorm(y, g_post)


def swiglu(h, w_in, w_out):
    g, u = jnp.split(h @ w_in, 2, axis=-1)
    return (jax.nn.silu(g) * u) @ w_out


def ffn_sublayer(x, mods, g_pre, g_post, w_in, w_out):
    shift, scale, gate = mods
    h = sublayer_in(x, g_pre, shift, scale)
    return sublayer_out(x, swiglu(h, w_in, w_out), g_post, gate, MACARON_WEIGHT)


def merge_heads(y):
    return y.reshape(y.shape[:2] + (GROUP_W,))


def blockwise(fn, q):
    bsz, n = q.shape[:2]
    nb = n // Q_BLOCK
    qb = jnp.moveaxis(q.reshape((bsz, nb, Q_BLOCK) + q.shape[2:]), 1, 0)
    out = jnp.moveaxis(lax.map(fn, qb), 0, 1)
    return out.reshape((bsz, n) + out.shape[3:])


def softmax_attend(q, k, v, scale):
    s = jnp.einsum('bqhd,bkhd->bhqk', q, k).astype(F32) * scale
    p = jax.nn.softmax(s, axis=-1).astype(v.dtype)
    return jnp.einsum('bhqk,bkhe->bqhe', p, v)


def diff_attend(q, k, v, lam, scale):
    s = jnp.einsum('bqhjd,bkhjd->bhjqk', q, k).astype(F32) * scale
    p = jax.nn.softmax(s, axis=-1)
    w = (p[:, :, 0] - lam * p[:, :, 1]).astype(v.dtype)
    return jnp.einsum('bhqk,bkhe->bqhe', w, v)


def sink_softmax(s, sink):
    col = jnp.broadcast_to(sink, s.shape[:-1] + (1,))
    return jax.nn.softmax(jnp.concatenate([col, s], axis=-1), axis=-1)[..., 1:]


def depthwise_conv_centred(u, w, b):
    y = lax.conv_general_dilated(
        u, w[:, None, :].astype(u.dtype), window_strides=(1,),
        padding=[(LRU_CONV // 2, LRU_CONV - 1 - LRU_CONV // 2)],
        dimension_numbers=('NWC', 'WIO', 'NWC'), feature_group_count=u.shape[-1])
    return y + b.astype(u.dtype)


def rglru_coeffs(u, w_g, b_g, lam):
    bsz, n, ch = u.shape
    ub = u.reshape(bsz, n, LRU_HEADS, LRU_BLOCK)
    g = jnp.einsum('bnhi,ghij->gbnhj', ub, w_g.astype(F32)).reshape(2, bsz, n, ch)
    g = g + b_g.astype(F32)[:, None, None, :]
    r = jax.nn.sigmoid(g[0])
    i = jax.nn.sigmoid(g[1])
    log_a = -LRU_C * r * jax.nn.softplus(-lam.astype(F32))
    a = jnp.exp(log_a)
    return a, jnp.sqrt(-jnp.expm1(2.0 * log_a)) * (i * u)


def linear_scan(a, b, reverse):
    def combine(p, q):
        return p[0] * q[0], q[0] * p[1] + q[1]
    return lax.associative_scan(combine, (a, b), reverse=reverse, axis=1)[1]


def rglru_mixer(cols_lat, cols_ctx, conv_w, conv_b, w_gates, b_gates, lam, ctx_out):
    xb_l, gate_l = jnp.split(cols_lat, 2, axis=-1)
    xb_c, gate_c = jnp.split(cols_ctx, 2, axis=-1)
    u_l = depthwise_conv_centred(xb_l, conv_w, conv_b).astype(F32)
    u_c = depthwise_conv_centred(xb_c, conv_w, conv_b).astype(F32)
    h_lat, h_ctx = [], []
    for d, rev in enumerate((False, True)):
        a_c, b_c = rglru_coeffs(u_c, w_gates[d], b_gates[d], lam[d])
        hc = linear_scan(a_c, b_c, rev)
        h0 = hc[:, 0] if rev else hc[:, -1]
        a_l, b_l = rglru_coeffs(u_l, w_gates[d], b_gates[d], lam[d])
        first = -1 if rev else 0
        b_l = b_l.at[:, first].add(a_l[:, first] * h0)
        h_lat.append(linear_scan(a_l, b_l, rev))
        h_ctx.append(hc)
    y_lat = ((h_lat[0] + h_lat[1]) * jax.nn.gelu(gate_l.astype(F32))).astype(cols_lat.dtype)
    y_ctx = None
    if ctx_out:
        y_ctx = ((h_ctx[0] + h_ctx[1]) * jax.nn.gelu(gate_c.astype(F32))).astype(cols_ctx.dtype)
    return y_lat, y_ctx


def mla_queries(cols, q_norm, w_qb, rope):
    bsz, n, _ = cols.shape
    q = (rmsnorm(cols[..., :MLA_Q_RANK], q_norm) @ w_qb).reshape(bsz, n, MLA_HEADS, MLA_NOPE + MLA_ROPE)
    if rope is None:
        return q
    return jnp.concatenate([q[..., :MLA_NOPE], apply_rope(q[..., MLA_NOPE:], *rope)], axis=-1)


def mla_keys_values(cols, kv_norm, w_kvb, rope):
    bsz, n, _ = cols.shape
    ckv = cols[..., MLA_Q_RANK:MLA_Q_RANK + MLA_KV_RANK]
    k_rope = cols[..., MLA_Q_RANK + MLA_KV_RANK:][:, :, None, :]
    if rope is not None:
        k_rope = apply_rope(k_rope, *rope)
    kv = (rmsnorm(ckv, kv_norm) @ w_kvb).reshape(bsz, n, MLA_HEADS, MLA_NOPE + MLA_V)
    k = jnp.concatenate([kv[..., :MLA_NOPE],
                         jnp.broadcast_to(k_rope, (bsz, n, MLA_HEADS, MLA_ROPE))], axis=-1)
    return k, kv[..., MLA_NOPE:]


def mla_mixer(cols_lat, cols_ctx, q_norm, w_qb, kv_norm, w_kvb, rope, ctx_out):
    scale = (MLA_NOPE + MLA_ROPE) ** -0.5
    k_c, v_c = mla_keys_values(cols_ctx, kv_norm, w_kvb, None)
    k_l, v_l = mla_keys_values(cols_lat, kv_norm, w_kvb, rope)
    k_all = jnp.concatenate([k_c, k_l], axis=1)
    v_all = jnp.concatenate([v_c, v_l], axis=1)
    q_l = mla_queries(cols_lat, q_norm, w_qb, rope)
    y_lat = merge_heads(blockwise(lambda qi: softmax_attend(qi, k_all, v_all, scale), q_l))
    y_ctx = None
    if ctx_out:
        q_c = mla_queries(cols_ctx, q_norm, w_qb, None)
        y_ctx = merge_heads(softmax_attend(q_c, k_c, v_c, scale))
    return y_lat, y_ctx


def diff_project(cols, rope):
    bsz, n, _ = cols.shape
    qk = DIFF_HEADS * 2 * DIFF_D
    q = cols[..., :qk].reshape(bsz, n, 2 * DIFF_HEADS, DIFF_D)
    k = cols[..., qk:2 * qk].reshape(bsz, n, 2 * DIFF_HEADS, DIFF_D)
    v = cols[..., 2 * qk:].reshape(bsz, n, DIFF_HEADS, DIFF_V)
    if rope is not None:
        q = apply_rope(q, *rope)
        k = apply_rope(k, *rope)
    shape5 = (bsz, n, DIFF_HEADS, 2, DIFF_D)
    return q.reshape(shape5), k.reshape(shape5), v


def diff_mixer(cols_lat, cols_ctx, lam_vecs, norm_g, lam_init, rope, ctx_out):
    lv = lam_vecs.astype(F32)
    lam = jnp.exp(jnp.sum(lv[0] * lv[1])) - jnp.exp(jnp.sum(lv[2] * lv[3])) + lam_init
    scale = DIFF_D ** -0.5
    q_l, k_l, v_l = diff_project(cols_lat, rope)
    q_c, k_c, v_c = diff_project(cols_ctx, None)
    k_all = jnp.concatenate([k_c, k_l], axis=1)
    v_all = jnp.concatenate([v_c, v_l], axis=1)

    def finish(o):
        return merge_heads(rmsnorm(o, norm_g) * (1.0 - lam_init))

    y_lat = finish(blockwise(lambda qi: diff_attend(qi, k_all, v_all, lam, scale), q_l))
    y_ctx = finish(diff_attend(q_c, k_c, v_c, lam, scale)) if ctx_out else None
    return y_lat, y_ctx


def gqa_project(cols, rope):
    bsz, n, _ = cols.shape
    nq = GQA_Q_HEADS * HEAD_DIM
    nk = GQA_KV_HEADS * HEAD_DIM
    q = cols[..., :nq].reshape(bsz, n, GQA_Q_HEADS, HEAD_DIM)
    k = cols[..., nq:nq + nk].reshape(bsz, n, GQA_KV_HEADS, HEAD_DIM)
    v = cols[..., nq + nk:].reshape(bsz, n, GQA_KV_HEADS, HEAD_DIM)
    if rope is not None:
        q = apply_rope(q, *rope)
        k = apply_rope(k, *rope)
    return q.reshape(bsz, n, GQA_KV_HEADS, GQA_GROUP, HEAD_DIM), k, v


def gqa_window_attend(q, k, v, kc, vc, sink, scale):
    bsz, n, hk, grp, d = q.shape
    nb = n // WINDOW
    qb = q.reshape(bsz, nb, WINDOW, hk, grp, d)

    def band(t):
        tp = jnp.pad(t, ((0, 0), (WINDOW, WINDOW), (0, 0), (0, 0)))
        tp = tp.reshape(bsz, nb + 2, WINDOW, hk, t.shape[-1])
        return jnp.concatenate([tp[:, :-2], tp[:, 1:-1], tp[:, 2:]], axis=2)

    kb, vb = band(k), band(v)
    s_loc = jnp.einsum('bnqhgd,bnkhd->bnhgqk', qb, kb).astype(F32) * scale
    qpos = jnp.arange(nb)[:, None] * WINDOW + jnp.arange(WINDOW)[None, :]
    kpos = (jnp.arange(nb)[:, None] - 1) * WINDOW + jnp.arange(3 * WINDOW)[None, :]
    rel = kpos[:, None, :] - qpos[:, :, None]
    valid = (jnp.abs(rel) <= WINDOW) & (kpos[:, None, :] >= 0) & (kpos[:, None, :] < n)
    s_loc = jnp.where(valid[None, :, None, None], s_loc, NEG_INF)
    s_ctx = jnp.einsum('bnqhgd,bkhd->bnhgqk', qb, kc).astype(F32) * scale
    m = kc.shape[1]
    p = sink_softmax(jnp.concatenate([s_ctx, s_loc], axis=-1), sink)
    p_ctx = p[..., :m].astype(v.dtype)
    p_loc = p[..., m:].astype(v.dtype)
    o = (jnp.einsum('bnhgqk,bkhd->bnqhgd', p_ctx, vc)
         + jnp.einsum('bnhgqk,bnkhd->bnqhgd', p_loc, vb))
    return o.reshape(bsz, n, GROUP_W)


def gqa_mixer(cols_lat, cols_ctx, sink_logits, rope, ctx_out):
    scale = HEAD_DIM ** -0.5
    sink = sink_logits.astype(F32).reshape(GQA_KV_HEADS, GQA_GROUP)[:, :, None, None]
    q_l, k_l, v_l = gqa_project(cols_lat, rope)
    q_c, k_c, v_c = gqa_project(cols_ctx, None)
    y_lat = gqa_window_attend(q_l, k_l, v_l, k_c, v_c, sink, scale)
    y_ctx = None
    if ctx_out:
        s = jnp.einsum('bqhgd,bkhd->bhgqk', q_c, k_c).astype(F32) * scale
        p = sink_softmax(s, sink).astype(v_c.dtype)
        o = jnp.einsum('bhgqk,bkhd->bqhgd', p, v_c)
        y_ctx = o.reshape(o.shape[0], o.shape[1], GROUP_W)
    return y_lat, y_ctx


def parallel_mixers(h_lat, h_ctx, w_in, w_out, lru_conv_w, lru_conv_b, lru_w_gates, lru_b_gates,
                    lru_lambda, mla_q_norm, mla_w_qb, mla_kv_norm, mla_w_kvb, diff_lambda, diff_norm,
                    diff_lambda_init, gqa_sink, rope_hd, rope_mla, ctx_out):
    a_l, b_l, c_l, d_l = jnp.split(h_lat @ w_in, list(IN_SPLITS), axis=-1)
    a_c, b_c, c_c, d_c = jnp.split(h_ctx @ w_in, list(IN_SPLITS), axis=-1)
    ya = rglru_mixer(a_l, a_c, lru_conv_w, lru_conv_b, lru_w_gates, lru_b_gates, lru_lambda, ctx_out)
    yb = mla_mixer(b_l, b_c, mla_q_norm, mla_w_qb, mla_kv_norm, mla_w_kvb, rope_mla, ctx_out)
    yc = diff_mixer(c_l, c_c, diff_lambda, diff_norm, diff_lambda_init, rope_hd, ctx_out)
    yd = gqa_mixer(d_l, d_c, gqa_sink, rope_hd, ctx_out)
    y_lat = jnp.concatenate([ya[0], yb[0], yc[0], yd[0]], axis=-1) @ w_out
    y_ctx = None
    if ctx_out:
        y_ctx = jnp.concatenate([ya[1], yb[1], yc[1], yd[1]], axis=-1) @ w_out
    return y_lat, y_ctx


def setup_inputs(seed: int = 0) -> dict:
    key = jax.random.key(seed)
    ks = jax.random.split(key, 24)
    L, D = DEPTH, D_MODEL

    def nrm(k, shape, fan_in, gain=1.0):
        return jax.random.normal(k, shape, F32) * (gain * fan_in ** -0.5)

    def gain(k, shape):
        return 1.0 + 0.05 * jax.random.normal(k, shape, F32)

    u = jax.random.uniform(ks[14], (L, 2, GROUP_W), F32, 0.9, 0.999)
    s = u ** (1.0 / LRU_C)
    lru_lambda = jnp.log(s) - jnp.log1p(-s)
    return {
        "x": jax.random.normal(ks[0], (BATCH, SEQ, D), F32),
        "c": jax.random.normal(ks[1], (BATCH, D), F32),
        "ctx": jax.random.normal(ks[2], (BATCH, CTX_LEN, D), F32),
        "c_ctx": jax.random.normal(ks[3], (D,), F32),
        "w_mod": nrm(ks[4], (L, D, N_MOD * D), D, 0.5),
        "b_mod": 0.02 * jax.random.normal(ks[5], (L, N_MOD * D), F32),
        "norm_g": gain(ks[6], (L, 6, D)),
        "ffn_w_in": nrm(ks[7], (L, 2, D, 2 * D_FF), D),
        "ffn_w_out": nrm(ks[8], (L, 2, D_FF, D), D_FF),
        "w_in": nrm(ks[9], (L, D, N_IN), D),
        "w_out": nrm(ks[10], (L, D_MIX, D), D_MIX),
        "lru_conv_w": nrm(ks[11], (L, LRU_CONV, GROUP_W), LRU_CONV),
        "lru_conv_b": 0.02 * jax.random.normal(ks[12], (L, GROUP_W), F32),
        "lru_w_gates": nrm(ks[13], (L, 2, 2, LRU_HEADS, LRU_BLOCK, LRU_BLOCK), LRU_BLOCK),
        "lru_b_gates": 0.02 * jax.random.normal(ks[15], (L, 2, 2, GROUP_W), F32),
        "lru_lambda": lru_lambda,
        "mla_q_norm": gain(ks[16], (L, MLA_Q_RANK)),
        "mla_w_qb": nrm(ks[17], (L, MLA_Q_RANK, MLA_HEADS * (MLA_NOPE + MLA_ROPE)), MLA_Q_RANK),
        "mla_kv_norm": gain(ks[18], (L, MLA_KV_RANK)),
        "mla_w_kvb": nrm(ks[19], (L, MLA_KV_RANK, MLA_HEADS * (MLA_NOPE + MLA_V)), MLA_KV_RANK),
        "diff_lambda": 0.1 * jax.random.normal(ks[20], (L, 4, DIFF_D), F32),
        "diff_norm": gain(ks[21], (L, DIFF_V)),
        "gqa_sink": 0.5 * jax.random.normal(ks[22], (L, GQA_Q_HEADS), F32),
    }


def reference(x, c, ctx, c_ctx, w_mod, b_mod, norm_g, ffn_w_in, ffn_w_out, w_in, w_out,
              lru_conv_w, lru_conv_b, lru_w_gates, lru_b_gates, lru_lambda,
              mla_q_norm, mla_w_qb, mla_kv_norm, mla_w_kvb, diff_lambda, diff_norm, gqa_sink):
    n = x.shape[1]
    rows = n // GRID_W
    rope_hd = axial_rope_tables(rows, HEAD_DIM)
    rope_mla = axial_rope_tables(rows, MLA_ROPE)
    x_lat, x_ctx = x, ctx
    for layer in range(DEPTH):
        last = layer == DEPTH - 1
        mod_l = modulation(c[:, None, :], w_mod[layer], b_mod[layer])
        mod_c = modulation(c_ctx[None, None, :], w_mod[layer], b_mod[layer])
        g = norm_g[layer]
        lam_init = 0.8 - 0.6 * math.exp(-0.3 * layer)
        x_lat = ffn_sublayer(x_lat, mod_l[0:3], g[0], g[1], ffn_w_in[layer, 0], ffn_w_out[layer, 0])
        x_ctx = ffn_sublayer(x_ctx, mod_c[0:3], g[0], g[1], ffn_w_in[layer, 0], ffn_w_out[layer, 0])
        h_lat = sublayer_in(x_lat, g[2], mod_l[3], mod_l[4])
        h_ctx = sublayer_in(x_ctx, g[2], mod_c[3], mod_c[4])
        y_lat, y_ctx = parallel_mixers(
            h_lat, h_ctx, w_in[layer], w_out[layer], lru_conv_w[layer], lru_conv_b[layer],
            lru_w_gates[layer], lru_b_gates[layer], lru_lambda[layer], mla_q_norm[layer],
            mla_w_qb[layer], mla_kv_norm[layer], mla_w_kvb[layer], diff_lambda[layer],
            diff_norm[layer], lam_init, gqa_sink[layer], rope_hd, rope_mla, not last)
        x_lat = sublayer_out(x_lat, y_lat, g[3], mod_l[5], 1.0)
        if not last:
            x_ctx = sublayer_out(x_ctx, y_ctx, g[3], mod_c[5], 1.0)
            x_ctx = ffn_sublayer(x_ctx, mod_c[6:9], g[4], g[5], ffn_w_in[layer, 1], ffn_w_out[layer, 1])
        x_lat = ffn_sublayer(x_lat, mod_l[6:9], g[4], g[5], ffn_w_in[layer, 1], ffn_w_out[layer, 1])
    return x_lat
```

```cpp
#include <hip/hip_runtime.h>
#include <cstdio>
#include <cstdint>
namespace pg8 {
#define PG8_LAS __attribute__((address_space(3)))
typedef unsigned short bf16_t;
typedef short bf16x8 __attribute__((ext_vector_type(8)));
typedef float f32x4 __attribute__((ext_vector_type(4)));
typedef unsigned u32x4 __attribute__((ext_vector_type(4)));
constexpr int BM = 256, BK = 64, HALF = 128, HTB = HALF * BK * 2  , STAGE_BYTES = 8 * HTB, NXCD = 8, WGM = 8;

__host__ __device__ __forceinline__ int lds_byte(int r, int c) { const int st = (r >> 4) * 2 + (c >> 5), rr = r & 15, cc = c & 31, ob = rr * 64 + cc * 2; return st * 1024 + (ob ^ (((ob >> 9) & 1) << 5)); }
__host__ __device__ __forceinline__ void stage_rc(int b, int& R, int& C) { const int st = b / 1024, sb = b % 1024, swz = sb ^ (((sb >> 9) & 1) << 5); R = (st >> 1) * 16 + swz / 64; C = (st & 1) * 32 + (swz % 64) / 2; }
__host__ __device__ __forceinline__ int perm32(int rho) { const int n = rho >> 4, i = rho & 15; return 8 * (i >> 2) + 4 * n + (i & 3); }

struct Unit { int pm, pn; };
struct Gemm { const bf16_t* A; const bf16_t* Bt; int M, N, K; };

struct StaticOrder {
    int nM, nN, nwg, G, c;
    __host__ __device__ void init(int M, int N, int G_, int c_) { nM = M / BM; nN = N / BM; nwg = nM * nN; G = G_; c = c_; }
    __host__ __device__ bool next(int i, Unit& u) const {
        const long L = (long)i * G + c; if (L >= nwg) return false;
        int wgid = (int)L; { const int q = nwg / NXCD, r = nwg % NXCD, xcd = wgid % NXCD, off = wgid / NXCD; wgid = (xcd < r ? xcd * (q + 1) : r * (q + 1) + (xcd - r) * q) + off; }
        const int nig = WGM * nN, gid = wgid / nig, fm = gid * WGM, gsz = (nM - fm) < WGM ? (nM - fm) : WGM;
        u.pm = fm + ((wgid % nig) % gsz); u.pn = (wgid % nig) / gsz; return true;
    }
    __device__ __forceinline__ void a_ready(const Unit&) const {}
    __device__ __forceinline__ void done(const Unit&) const {}
};

__device__ __forceinline__ unsigned cvt_pk_bf16(float lo, float hi) { unsigned r; asm volatile("v_cvt_pk_bf16_f32 %0, %1, %2" : "=v"(r) : "v"(lo), "v"(hi)); return r; }
typedef float f32x2 __attribute__((ext_vector_type(2)));
}
namespace pg8 {
template <class Epi, class Sched, bool ALIGN_EPI = false, bool SP2 = false>
__device__ __forceinline__ void gemm_phase(PG8_LAS unsigned char* lds, const Gemm g, const Sched& S, const Epi& E) {
    const int tid = threadIdx.x, wid = __builtin_amdgcn_readfirstlane(tid >> 6), lane = tid & 63, wr = wid >> 2, wc = wid & 3, fr = lane & 15, fq = lane >> 4;
    const int K = g.K, nt = K / BK;
    unsigned voffA[2], voffB[2];
#pragma unroll
    for (int i = 0; i < 2; ++i) { int R, C; stage_rc(tid * 16 + i * 8192, R, C); const int Rb = Epi::PERM ? ((R & ~31) + perm32(R & 31)) : R;
        voffA[i] = (unsigned)(R * K + C) * 2u; voffB[i] = (unsigned)(Rb * K + C) * 2u; }
    const size_t kstep = (size_t)(BK * 2);
    const size_t hstep = (size_t)HALF * K * 2;
    const size_t tstep = 2 * hstep;
    const unsigned ldsw = (unsigned)wid * 1024u;
    const int aoff = lds_byte(wr * 64 + fr, fq * 8), boff = lds_byte(wc * 32 + fr, fq * 8);
#define PG8_SA(b, h) (((b) * 2 + (h)) * HTB)
#define PG8_SB(b, h) ((4 + (b) * 2 + (h)) * HTB)
#define PG8_STAGE(bufoff, gbase, voff) do { _Pragma("unroll") for (int _i = 0; _i < 2; ++_i) \
        __builtin_amdgcn_global_load_lds((const unsigned*)((const char*)(gbase) + (voff)[_i]), (PG8_LAS unsigned*)(lds + (bufoff) + ldsw + _i * 8192), 16, 0, 0); } while (0)
#define PG8_LDA(dst, b, h) do { _Pragma("unroll") for (int m = 0; m < 4; ++m) _Pragma("unroll") for (int k = 0; k < 2; ++k) dst[m][k] = *(const PG8_LAS bf16x8*)(lds + PG8_SA(b, h) + aoff + m * 2048 + k * 1024); } while (0)
#define PG8_LDB(dst, b, h) do { _Pragma("unroll") for (int n = 0; n < 2; ++n) _Pragma("unroll") for (int k = 0; k < 2; ++k) dst[n][k] = *(const PG8_LAS bf16x8*)(lds + PG8_SB(b, h) + boff + n * 2048 + k * 1024); } while (0)
#define PG8_MMA(ai, bj, At, Bt) do { __builtin_amdgcn_s_setprio(1); _Pragma("unroll") for (int m = 0; m < 4; ++m) _Pragma("unroll") for (int n = 0; n < 2; ++n) _Pragma("unroll") for (int k = 0; k < 2; ++k) \
        acc[ai][bj][m][n] = __builtin_amdgcn_mfma_f32_16x16x32_bf16(Bt[n][k], At[m][k], acc[ai][bj][m][n], 0, 0, 0); __builtin_amdgcn_s_setprio(0); } while (0)
#define PG8_WAIT_V(n) asm volatile("s_waitcnt vmcnt(" #n ")" ::: "memory")
#define PG8_WAIT_L(n) asm volatile("s_waitcnt lgkmcnt(" #n ")" ::: "memory")
#define PG8_BAR __builtin_amdgcn_s_barrier()
#define PG8_SCHED __builtin_amdgcn_sched_barrier(0)
    Unit cur, nxt; int ui = 0;
    if (!S.next(0, cur)) return;
    f32x4 acc[2][2][4][2];
#pragma unroll
    for (int a = 0; a < 2; ++a)
#pragma unroll
        for (int b = 0; b < 2; ++b)
#pragma unroll
            for (int m = 0; m < 4; ++m)
#pragma unroll
                for (int n = 0; n < 2; ++n) acc[a][b][m][n] = (f32x4){0.f, 0.f, 0.f, 0.f};
    bf16x8 At[4][2], B0[2][2], B1[2][2];
    const char* cA = (const char*)g.A + (size_t)cur.pm * tstep; const char* cB = (const char*)g.Bt + (size_t)cur.pn * tstep;
    S.a_ready(cur);
    if constexpr (SP2) {
        PG8_STAGE(PG8_SB(0, 0), cB, voffB); PG8_STAGE(PG8_SB(0, 1), cB + hstep, voffB); PG8_STAGE(PG8_SA(0, 0), cA, voffA); PG8_STAGE(PG8_SA(0, 1), cA + hstep, voffA);
        if (wr == 1) PG8_BAR;
        PG8_WAIT_V(2); PG8_BAR;
        PG8_STAGE(PG8_SB(1, 0), cB + kstep, voffB); PG8_STAGE(PG8_SA(1, 0), cA + kstep, voffA); PG8_STAGE(PG8_SB(1, 1), cB + hstep + kstep, voffB);
        PG8_WAIT_V(6); PG8_BAR;
    } else {
        PG8_STAGE(PG8_SB(0, 0), cB, voffB); PG8_STAGE(PG8_SA(0, 0), cA, voffA); PG8_STAGE(PG8_SB(0, 1), cB + hstep, voffB); PG8_STAGE(PG8_SA(0, 1), cA + hstep, voffA);
        if (wr == 1) PG8_BAR;
        PG8_WAIT_V(4); PG8_BAR;
        PG8_STAGE(PG8_SB(1, 0), cB + kstep, voffB); PG8_STAGE(PG8_SA(1, 0), cA + kstep, voffA); PG8_STAGE(PG8_SB(1, 1), cB + hstep + kstep, voffB);
        PG8_WAIT_V(6); PG8_BAR;
    }
    for (;;) {
        const bool has_next = S.next(ui + 1, nxt);
        const char* nA = has_next ? (const char*)g.A + (size_t)nxt.pm * tstep : cA; const char* nB = has_next ? (const char*)g.Bt + (size_t)nxt.pn * tstep : cB;
        for (int t = 0; t < nt; t += 2) {
            const bool last = (t == nt - 2);
            const char* a1 = cA + (size_t)(t + 1) * kstep;
            const char* a2 = last ? nA : cA + (size_t)(t + 2) * kstep; const char* b2 = last ? nB : cB + (size_t)(t + 2) * kstep;
            const char* a3 = a2 + kstep; const char* b3 = b2 + kstep;
            if (last && has_next) S.a_ready(nxt);
            if constexpr (SP2) {
            PG8_LDB(B0, 0, 0); PG8_LDB(B1, 0, 1); PG8_SCHED; PG8_LDA(At, 0, 0); PG8_STAGE(PG8_SA(1, 1), a1 + hstep, voffA);
            PG8_WAIT_V(8); PG8_WAIT_L(0); PG8_BAR; PG8_MMA(0, 0, At, B0); PG8_MMA(0, 1, At, B1); PG8_BAR; PG8_SCHED;
            PG8_LDA(At, 0, 1); PG8_STAGE(PG8_SB(0, 0), b2, voffB); PG8_STAGE(PG8_SB(0, 1), b2 + hstep, voffB); PG8_STAGE(PG8_SA(0, 0), a2, voffA);
            PG8_WAIT_V(8); PG8_WAIT_L(0); PG8_BAR; PG8_MMA(1, 0, At, B0); PG8_MMA(1, 1, At, B1); PG8_BAR; PG8_SCHED;
            PG8_LDB(B0, 1, 0); PG8_LDB(B1, 1, 1); PG8_SCHED; PG8_LDA(At, 1, 0); PG8_STAGE(PG8_SA(0, 1), a2 + hstep, voffA);
            PG8_WAIT_V(8); PG8_WAIT_L(0); PG8_BAR; PG8_MMA(0, 0, At, B0); PG8_MMA(0, 1, At, B1); PG8_BAR; PG8_SCHED;
            PG8_LDA(At, 1, 1); PG8_STAGE(PG8_SB(1, 0), b3, voffB); PG8_STAGE(PG8_SB(1, 1), b3 + hstep, voffB); PG8_STAGE(PG8_SA(1, 0), a3, voffA);
            PG8_WAIT_V(8); PG8_WAIT_L(0); PG8_BAR; PG8_MMA(1, 0, At, B0); PG8_MMA(1, 1, At, B1); PG8_BAR; PG8_SCHED;
            } else {
            PG8_LDB(B0, 0, 0); PG8_SCHED; PG8_LDA(At, 0, 0); PG8_STAGE(PG8_SA(1, 1), a1 + hstep, voffA);
            PG8_WAIT_L(8); PG8_BAR; PG8_WAIT_L(0); PG8_MMA(0, 0, At, B0); PG8_BAR; PG8_SCHED;
            PG8_LDB(B1, 0, 1); PG8_STAGE(PG8_SB(0, 0), b2, voffB);
            PG8_BAR; PG8_WAIT_L(0); PG8_MMA(0, 1, At, B1); PG8_BAR;
            PG8_LDA(At, 0, 1); PG8_STAGE(PG8_SA(0, 0), a2, voffA);
            PG8_BAR; PG8_WAIT_L(0); PG8_MMA(1, 0, At, B0); PG8_BAR; PG8_SCHED;
            PG8_STAGE(PG8_SB(0, 1), b2 + hstep, voffB);
            PG8_WAIT_V(6); PG8_BAR; PG8_MMA(1, 1, At, B1); PG8_BAR;
            PG8_LDB(B0, 1, 0); PG8_SCHED; PG8_LDA(At, 1, 0); PG8_STAGE(PG8_SA(0, 1), a2 + hstep, voffA);
            PG8_WAIT_L(8); PG8_BAR; PG8_WAIT_L(0); PG8_MMA(0, 0, At, B0); PG8_BAR; PG8_SCHED;
            PG8_LDB(B1, 1, 1); PG8_STAGE(PG8_SB(1, 0), b3, voffB);
            PG8_BAR; PG8_WAIT_L(0); PG8_MMA(0, 1, At, B1); PG8_BAR;
            PG8_LDA(At, 1, 1); PG8_STAGE(PG8_SA(1, 0), a3, voffA);
            PG8_BAR; PG8_WAIT_L(0); PG8_MMA(1, 0, At, B0); PG8_BAR; PG8_SCHED;
            PG8_STAGE(PG8_SB(1, 1), b3 + hstep, voffB);
            PG8_WAIT_V(6); PG8_BAR; PG8_MMA(1, 1, At, B1); PG8_BAR;
            }
        }
        if constexpr (ALIGN_EPI) { if (wr == 0) PG8_BAR; }
        if constexpr (!Epi::AFTER_DRAIN) { E(acc, cur, wr, wc, fr, fq); S.done(cur); }
        if (!has_next) break;
#pragma unroll
        for (int a = 0; a < 2; ++a)
#pragma unroll
            for (int b = 0; b < 2; ++b)
#pragma unroll
                for (int m = 0; m < 4; ++m)
#pragma unroll
                    for (int n = 0; n < 2; ++n) acc[a][b][m][n] = (f32x4){0.f, 0.f, 0.f, 0.f};
        cur = nxt; cA = nA; cB = nB; ++ui;
        if constexpr (ALIGN_EPI) { if (wr == 1) PG8_BAR; }
    }
    PG8_WAIT_V(0);
    if constexpr (!ALIGN_EPI) { if (wr == 0) PG8_BAR; }
    PG8_BAR;
    if constexpr (Epi::AFTER_DRAIN) { E.fused(acc, cur, wr, wc, fr, fq, lds, wid, lane); S.done(cur); }
#undef PG8_SA
#undef PG8_SB
#undef PG8_STAGE
#undef PG8_LDA
#undef PG8_LDB
#undef PG8_MMA
#undef PG8_WAIT_V
#undef PG8_WAIT_L
#undef PG8_BAR
#undef PG8_SCHED
}
}

#define GAS __attribute__((address_space(1)))
#define LAS __attribute__((address_space(3)))
typedef unsigned short bf16;
typedef unsigned v4u __attribute__((ext_vector_type(4)));
typedef unsigned v2u __attribute__((ext_vector_type(2)));
typedef float f32x4 __attribute__((ext_vector_type(4)));
typedef float f32x2 __attribute__((ext_vector_type(2)));

constexpr int D = 2048, NB = 4, SEQ = 2048, CTX = 256, PB = 2304, M = NB * PB, DEPTH = 4, DFF = 5632, NIN = 4000, NINP = 4096, NMODC = 9 * D;
constexpr int NT = 512, NW = 8;
constexpr int C_XB = 0, C_GATE = 512, C_MQ = 1024, C_MKV = 1408, C_MKR = 1664, C_DQ = 1696, C_DK = 2208, C_DV = 2720, C_GQ = 3232, C_GK = 3744, C_GV = 3872;

constexpr size_t MiB = 1u << 20;
constexpr size_t WS_CTL = 0;
constexpr size_t WS_MOD = 1 * MiB;
constexpr size_t WS_ROPE = 3 * MiB;
constexpr size_t WS_WFFI = 4 * MiB;
constexpr size_t WS_WFFO = WS_WFFI + 352 * MiB;
constexpr size_t WS_WIN = WS_WFFO + 176 * MiB;
constexpr size_t WS_WOUT = WS_WIN + 64 * MiB;
constexpr size_t WS_WQB = WS_WOUT + 32 * MiB;
constexpr size_t WS_WKVB = WS_WQB + 3 * MiB;
constexpr size_t WS_WG = WS_WKVB + 2 * MiB;
constexpr size_t WS_X = WS_WG + 8 * MiB;
constexpr size_t WS_H = WS_X + 72 * MiB;
constexpr size_t WS_ACT = WS_H + 36 * MiB;
constexpr size_t WS_Y = WS_ACT + 99 * MiB;
constexpr size_t WS_COLS = WS_Y + 72 * MiB;
constexpr size_t WS_U = WS_COLS + 72 * MiB;
constexpr size_t WS_GATES = WS_U + 9 * MiB;
constexpr size_t WS_QN = WS_GATES + 72 * MiB;
constexpr size_t WS_KVN = WS_QN + 7 * MiB;
constexpr size_t WS_QUP = WS_KVN + 5 * MiB;
constexpr size_t WS_KVUP = WS_QUP + 14 * MiB;
constexpr size_t WS_QM = WS_KVUP + 18 * MiB;
constexpr size_t WS_KM = WS_QM + 14 * MiB;
constexpr size_t WS_AB = WS_KM + 14 * MiB;
constexpr size_t WS_HS = WS_AB + 72 * MiB;
constexpr size_t WS_DIFFO = WS_HS + 36 * MiB;
constexpr size_t WS_YMIX = WS_DIFFO + 36 * MiB;
constexpr size_t WS_END = WS_YMIX + 36 * MiB;

constexpr int LDS_BYTES = 147456;

struct P { const float* in[23]; float* out; unsigned char* ws; };

#define LDS_WAIT() asm volatile("s_waitcnt lgkmcnt(0)" ::: "memory")
__device__ __forceinline__ unsigned f2bf(float f) { unsigned u = __builtin_bit_cast(unsigned, f); return (u + 0x7fffu + ((u >> 16) & 1u)) >> 16; }
__device__ __forceinline__ unsigned pk2(float lo, float hi) { return f2bf(lo) | (f2bf(hi) << 16); }
__device__ __forceinline__ float bf2f(unsigned v) { return __builtin_bit_cast(float, v << 16); }
__device__ __forceinline__ float bflo(unsigned w) { return __builtin_bit_cast(float, w << 16); }
__device__ __forceinline__ float bfhi(unsigned w) { return __builtin_bit_cast(float, w & 0xffff0000u); }
__device__ __forceinline__ float wave_sum(float v) {
#pragma unroll
    for (int o = 1; o < 64; o <<= 1) v += __shfl_xor(v, o);
    return v;
}
__device__ __forceinline__ float sigmoidf_(float x) { return 1.f / (1.f + __expf(-x)); }
__device__ __forceinline__ float siluf_(float x) { return x / (1.f + __expf(-x)); }
__device__ __forceinline__ float gelu_tanh(float x) { const float u = 0.7978845608028654f * (x + 0.044715f * x * x * x); return 0.5f * x * (1.f + tanhf(u)); }

struct TileOrder {
    pg8::StaticOrder so; int latonly;
    __device__ __forceinline__ void init(int nMt, int N, int G, int c, int lat) { so.nM = nMt; so.nN = N / 256; so.nwg = so.nM * so.nN; so.G = G; so.c = c; latonly = lat; }
    __device__ __forceinline__ bool next(int i, pg8::Unit& u) const { if (!so.next(i, u)) return false; if (latonly) u.pm = (u.pm >> 3) * 9 + 1 + (u.pm & 7); return true; }
    __device__ __forceinline__ void a_ready(const pg8::Unit&) const {}
    __device__ __forceinline__ void done(const pg8::Unit&) const {}
};
struct EpiF32 {
    static constexpr bool PERM = false, AFTER_DRAIN = false;
    float* C; int ldc;
    __device__ __forceinline__ void operator()(const f32x4 (&acc)[2][2][4][2], const pg8::Unit& u, int wr, int wc, int fr, int fq) const {
        const int row0 = u.pm * 256 + wr * 64 + fr, col0 = u.pn * 256 + wc * 32 + 4 * fq;
#pragma unroll
        for (int ai = 0; ai < 2; ++ai)
#pragma unroll
            for (int m = 0; m < 4; ++m) { float* rowp = C + (size_t)(row0 + ai * 128 + m * 16) * ldc + col0;
#pragma unroll
                for (int bj = 0; bj < 2; ++bj)
#pragma unroll
                    for (int n = 0; n < 2; ++n) *(f32x4*)(rowp + bj * 128 + n * 16) = acc[ai][bj][m][n]; }
    }
};
struct EpiB16 {
    static constexpr bool PERM = true, AFTER_DRAIN = false;
    bf16* O; int ldc;
    __device__ __forceinline__ void operator()(const f32x4 (&acc)[2][2][4][2], const pg8::Unit& u, int wr, int wc, int fr, int fq) const {
        const int row0 = u.pm * 256 + wr * 64 + fr, col0 = u.pn * 256 + wc * 32 + 8 * fq;
#pragma unroll
        for (int ai = 0; ai < 2; ++ai)
#pragma unroll
            for (int m = 0; m < 4; ++m) { bf16* rowp = O + (size_t)(row0 + ai * 128 + m * 16) * ldc + col0;
#pragma unroll
                for (int bj = 0; bj < 2; ++bj) { const f32x4 v0 = acc[ai][bj][m][0], v1 = acc[ai][bj][m][1];
                    v4u w; w.x = pg8::cvt_pk_bf16(v0[0], v0[1]); w.y = pg8::cvt_pk_bf16(v0[2], v0[3]); w.z = pg8::cvt_pk_bf16(v1[0], v1[1]); w.w = pg8::cvt_pk_bf16(v1[2], v1[3]);
                    *(v4u*)(rowp + bj * 128) = w; } }
    }
};
struct EpiSwiglu {
    static constexpr bool PERM = true, AFTER_DRAIN = false;
    bf16* O; int ldc;
    __device__ __forceinline__ void operator()(const f32x4 (&acc)[2][2][4][2], const pg8::Unit& u, int wr, int wc, int fr, int fq) const {
        const int row0 = u.pm * 256 + wr * 64 + fr, col0 = u.pn * 128 + wc * 32 + 8 * fq;
#pragma unroll
        for (int ai = 0; ai < 2; ++ai)
#pragma unroll
            for (int m = 0; m < 4; ++m) { bf16* rowp = O + (size_t)(row0 + ai * 128 + m * 16) * ldc + col0;
                float r[8];
#pragma unroll
                for (int n = 0; n < 2; ++n)
#pragma unroll
                    for (int e = 0; e < 4; ++e) { const float g = acc[ai][0][m][n][e], uu = acc[ai][1][m][n][e]; r[n * 4 + e] = siluf_(g) * uu; }
                v4u w; w.x = pg8::cvt_pk_bf16(r[0], r[1]); w.y = pg8::cvt_pk_bf16(r[2], r[3]); w.z = pg8::cvt_pk_bf16(r[4], r[5]); w.w = pg8::cvt_pk_bf16(r[6], r[7]);
                *(v4u*)rowp = w; }
    }
};

__device__ __forceinline__ void transpose_item(const float* W, int N, int K, bf16* WT, int k0, int n0, int drow0, LAS float* scr, int lane) {
#pragma unroll 8
    for (int i = 0; i < 32; ++i) { const int kk = 2 * i + (lane >> 5); scr[kk * 33 + (lane & 31)] = W[(size_t)(k0 + kk) * N + n0 + (lane & 31)]; }
    LDS_WAIT(); asm volatile("" ::: "memory");
    const int c = lane & 7;
#pragma unroll
    for (int j = 0; j < 4; ++j) { const int n = (lane >> 3) + 8 * j; const LAS float* s = scr + (8 * c) * 33 + n;
        v4u o; o.x = pk2(s[0 * 33], s[1 * 33]); o.y = pk2(s[2 * 33], s[3 * 33]); o.z = pk2(s[4 * 33], s[5 * 33]); o.w = pk2(s[6 * 33], s[7 * 33]);
        *(v4u*)(WT + (size_t)(drow0 + n) * K + k0 + 8 * c) = o; }
    LDS_WAIT(); asm volatile("" ::: "memory");
}

__device__ __forceinline__ void phase_pro1(const P& p, LAS unsigned char* lds) {
    const int tid = threadIdx.x, lane = tid & 63, wave = __builtin_amdgcn_readfirstlane(tid >> 6);
    const int G = gridDim.x, blk = blockIdx.x;
    {
        LAS float* sc = (LAS float*)lds;
        LAS float* red = (LAS float*)(lds + 40960);
        const float* c = p.in[1]; const float* cc = p.in[3];
        for (int i = tid; i < 5 * D; i += NT) { const int v = i / D, k = i % D; const float x = v < 4 ? c[v * D + k] : cc[k]; sc[i] = x / (1.f + expf(-x)); }
        __syncthreads();
        const float* wmod = p.in[4]; const float* bmod = p.in[5];
        float* MOD = (float*)(p.ws + WS_MOD);
        for (int unit = blk; unit < DEPTH * 288; unit += G) {
            const int l = unit / 288, n0 = (unit % 288) * 64, kq = lane >> 4;
            const float* W = wmod + (size_t)l * D * NMODC + n0 + 4 * (lane & 15);
            float acc[5][4];
#pragma unroll
            for (int v = 0; v < 5; ++v)
#pragma unroll
                for (int e = 0; e < 4; ++e) acc[v][e] = 0.f;
            const int kbase = wave * 256 + kq;
#pragma unroll 4
            for (int i = 0; i < 64; ++i) { const int k = kbase + 4 * i; const f32x4 w = *(const f32x4*)(W + (size_t)k * NMODC);
#pragma unroll
                for (int v = 0; v < 5; ++v) { const float s = sc[v * D + k];
#pragma unroll
                    for (int e = 0; e < 4; ++e) acc[v][e] += s * w[e]; } }
#pragma unroll
            for (int v = 0; v < 5; ++v)
#pragma unroll
                for (int e = 0; e < 4; ++e) { float a = acc[v][e]; a += __shfl_xor(a, 16); a += __shfl_xor(a, 32); acc[v][e] = a; }
            if (kq == 0) {
#pragma unroll
                for (int v = 0; v < 5; ++v)
#pragma unroll
                    for (int e = 0; e < 4; ++e) red[(wave * 5 + v) * 64 + 4 * (lane & 15) + e] = acc[v][e]; }
            __syncthreads();
            if (tid < 320) { const int v = tid / 64, col = tid % 64; float s = 0.f;
#pragma unroll
                for (int w = 0; w < 8; ++w) s += red[(w * 5 + v) * 64 + col];
                MOD[((size_t)l * 5 + v) * NMODC + n0 + col] = s + bmod[l * NMODC + n0 + col]; }
            __syncthreads();
        }
    }
    __syncthreads();
    {
        LAS float* scr = (LAS float*)(lds + wave * 16384);
        const int gw = wave * G + blk, NGW = NW * G;
        constexpr int I_FI = 32 * 352, I_FO = 88 * 64, I_IN = 32 * 125, I_OUT = 32 * 64, I_QB = 6 * 24, I_KVB = 4 * 32;
        constexpr int T_FI = 8 * I_FI, T_FO = 8 * I_FO, T_IN = 4 * I_IN, T_OUT = 4 * I_OUT, T_QB = 4 * I_QB, T_KVB = 4 * I_KVB;
        constexpr int NITEMS = T_FI + T_FO + T_IN + T_OUT + T_QB + T_KVB;
        for (int it = gw; it < NITEMS; it += NGW) {
            int r = it;
            if (r < T_FI) { const int mat = r / I_FI; r %= I_FI; const int kb = r / 352, nb = r % 352, n0 = nb * 32;
                const int half = n0 / DFF, cc = n0 % DFF, drow0 = (cc / 128) * 256 + half * 128 + (cc % 128);
                transpose_item(p.in[7] + (size_t)mat * D * (2 * DFF), 2 * DFF, D, (bf16*)(p.ws + WS_WFFI) + (size_t)mat * (2 * DFF) * D, kb * 64, n0, drow0, scr, lane); continue; }
            r -= T_FI;
            if (r < T_FO) { const int mat = r / I_FO; r %= I_FO; const int kb = r / 64, nb = r % 64;
                transpose_item(p.in[8] + (size_t)mat * DFF * D, D, DFF, (bf16*)(p.ws + WS_WFFO) + (size_t)mat * D * DFF, kb * 64, nb * 32, nb * 32, scr, lane); continue; }
            r -= T_FO;
            if (r < T_IN) { const int mat = r / I_IN; r %= I_IN; const int kb = r / 125, nb = r % 125;
                transpose_item(p.in[9] + (size_t)mat * D * NIN, NIN, D, (bf16*)(p.ws + WS_WIN) + (size_t)mat * NINP * D, kb * 64, nb * 32, nb * 32, scr, lane); continue; }
            r -= T_IN;
            if (r < T_OUT) { const int mat = r / I_OUT; r %= I_OUT; const int kb = r / 64, nb = r % 64;
                transpose_item(p.in[10] + (size_t)mat * D * D, D, D, (bf16*)(p.ws + WS_WOUT) + (size_t)mat * D * D, kb * 64, nb * 32, nb * 32, scr, lane); continue; }
            r -= T_OUT;
            if (r < T_QB) { const int mat = r / I_QB; r %= I_QB; const int kb = r / 24, nb = r % 24;
                transpose_item(p.in[17] + (size_t)mat * 384 * 768, 768, 384, (bf16*)(p.ws + WS_WQB) + (size_t)mat * 768 * 384, kb * 64, nb * 32, nb * 32, scr, lane); continue; }
            r -= T_QB;
            { const int mat = r / I_KVB; r %= I_KVB; const int kb = r / 32, nb = r % 32;
                transpose_item(p.in[19] + (size_t)mat * 256 * 1024, 1024, 256, (bf16*)(p.ws + WS_WKVB) + (size_t)mat * 1024 * 256, kb * 64, nb * 32, nb * 32, scr, lane); }
        }
    }
    {
        const int gt = blk * NT + tid, NGT = G * NT;
        for (int i = gt; i < DEPTH * 96 * (D / 8); i += NGT) { const int l = i / (96 * (D / 8)), r = i % (96 * (D / 8));
            *(v4u*)((bf16*)(p.ws + WS_WIN) + ((size_t)l * NINP + NIN) * D + (size_t)r * 8) = (v4u){0u, 0u, 0u, 0u}; }
        const float* wg = p.in[13];
        for (int i = gt; i < DEPTH * 2048 * 64; i += NGT) { const int l = i / (2048 * 64), r = i % (2048 * 64), np = r / 64, k0 = (r % 64) * 8;
            const int c7 = np & 127, gate = (np >> 7) & 1, chunk = (np >> 8) & 3, dir = np >> 10, ch = chunk * 128 + c7, head = ch >> 6, j = ch & 63;
            v4u o = (v4u){0u, 0u, 0u, 0u};
            if ((k0 >> 6) == head) { const float* src = wg + ((((size_t)l * 2 + dir) * 2 + gate) * 8 + head) * 4096 + (size_t)(k0 & 63) * 64 + j;
                o.x = pk2(src[0], src[64]); o.y = pk2(src[128], src[192]); o.z = pk2(src[256], src[320]); o.w = pk2(src[384], src[448]); }
            *(v4u*)((bf16*)(p.ws + WS_WG) + ((size_t)l * 2048 + np) * 512 + k0) = o; }
        float* rope = (float*)(p.ws + WS_ROPE);
        for (int i = gt; i < SEQ * 32; i += NGT) { const int t = i / 32, k = i % 32; const float inv = powf(10000.f, -(float)(k & 15) / 16.f);
            const float ang = (k < 16 ? (float)(t / 64) : (float)(t % 64)) * inv; rope[i] = cosf(ang); rope[SEQ * 32 + i] = sinf(ang); }
        for (int i = gt; i < SEQ * 16; i += NGT) { const int t = i / 16, k = i % 16; const float inv = powf(10000.f, -(float)(k & 7) / 8.f);
            const float ang = (k < 8 ? (float)(t / 64) : (float)(t % 64)) * inv; rope[SEQ * 64 + i] = cosf(ang); rope[SEQ * 64 + SEQ * 16 + i] = sinf(ang); }
    }
}

__device__ __forceinline__ float row_rstd(const f32x4 (&v)[8]) {
    float s = 0.f;
#pragma unroll
    for (int j = 0; j < 8; ++j) s += (v[j][0] * v[j][0] + v[j][1] * v[j][1]) + (v[j][2] * v[j][2] + v[j][3] * v[j][3]);
    s = wave_sum(s);
    return 1.0f / sqrtf(s * (1.0f / D) + 1e-6f);
}
__device__ __forceinline__ void store_prenorm(bf16* hrow, int lane, const f32x4 (&v)[8], const float* g, const float* shift, const float* scale) {
    const float rstd = row_rstd(v);
#pragma unroll
    for (int j = 0; j < 8; ++j) { const int idx = lane + 64 * j;
        const f32x4 gg = ((const f32x4*)g)[idx], sh = ((const f32x4*)shift)[idx], sc = ((const f32x4*)scale)[idx];
        const f32x4 o = (v[j] * rstd) * gg * (sc + 1.0f) + sh;
        v2u w; w.x = pk2(o[0], o[1]); w.y = pk2(o[2], o[3]);
        *(v2u*)(hrow + 4 * idx) = w; }
}

__device__ __forceinline__ void phase_pro2(const P& p) {
    const int tid = threadIdx.x, lane = tid & 63, wave = tid >> 6, G = gridDim.x, blk = blockIdx.x;
    const int gw = wave * G + blk, NGW = NW * G;
    float* X = (float*)(p.ws + WS_X); bf16* H = (bf16*)(p.ws + WS_H); const float* MOD = (const float*)(p.ws + WS_MOD);
    for (int row = gw; row < M; row += NGW) {
        const int b = row / PB, pp = row % PB; const bool isctx = pp < CTX; const int v = isctx ? 4 : b;
        const float* src = isctx ? p.in[2] + ((size_t)b * CTX + pp) * D : p.in[0] + ((size_t)b * SEQ + (pp - CTX)) * D;
        f32x4 xv[8];
#pragma unroll
        for (int j = 0; j < 8; ++j) xv[j] = ((const f32x4*)src)[lane + 64 * j];
#pragma unroll
        for (int j = 0; j < 8; ++j) ((f32x4*)(X + (size_t)row * D))[lane + 64 * j] = xv[j];
        const float* mod = MOD + ((size_t)0 * 5 + v) * NMODC;
        store_prenorm(H + (size_t)row * D, lane, xv, p.in[6] + (size_t)(0 * 6 + 0) * D, mod + 0 * D, mod + 1 * D);
    }
}

__device__ __forceinline__ void phase_post(const P& p, int layer, int s) {
    const int tid = threadIdx.x, lane = tid & 63, wave = tid >> 6, G = gridDim.x, blk = blockIdx.x;
    const int gw = wave * G + blk, NGW = NW * G;
    float* X = (float*)(p.ws + WS_X); bf16* H = (bf16*)(p.ws + WS_H); const float* Y = (const float*)(p.ws + WS_Y); const float* MOD = (const float*)(p.ws + WS_MOD);
    const bool last = layer == DEPTH - 1, final = last && s == 2;
    const float wgt = (s == 1) ? 1.0f : 0.5f;
    const int l2 = (s < 2) ? layer : layer + 1, s2 = (s < 2) ? s + 1 : 0;
    for (int row = gw; row < M; row += NGW) {
        const int b = row / PB, pp = row % PB; const bool isctx = pp < CTX; const int v = isctx ? 4 : b;
        if (last && s >= 1 && isctx) continue;
        f32x4 yv[8], xv[8];
#pragma unroll
        for (int j = 0; j < 8; ++j) yv[j] = ((const f32x4*)(Y + (size_t)row * D))[lane + 64 * j];
#pragma unroll
        for (int j = 0; j < 8; ++j) xv[j] = ((const f32x4*)(X + (size_t)row * D))[lane + 64 * j];
        const float rstd = row_rstd(yv);
        const float* gate = MOD + ((size_t)layer * 5 + v) * NMODC + (size_t)(3 * s + 2) * D;
        const float* gpost = p.in[6] + (size_t)(layer * 6 + 2 * s + 1) * D;
        float* dst = final ? p.out + ((size_t)b * SEQ + (pp - CTX)) * D : X + (size_t)row * D;
#pragma unroll
        for (int j = 0; j < 8; ++j) { const int idx = lane + 64 * j; const f32x4 ga = ((const f32x4*)gate)[idx], gp = ((const f32x4*)gpost)[idx];
            xv[j] = xv[j] + (ga * wgt) * ((yv[j] * rstd) * gp);
            ((f32x4*)dst)[idx] = xv[j]; }
        if (!final) { const float* mod = MOD + ((size_t)l2 * 5 + v) * NMODC;
            store_prenorm(H + (size_t)row * D, lane, xv, p.in[6] + (size_t)(l2 * 6 + 2 * s2) * D, mod + (size_t)(3 * s2) * D, mod + (size_t)(3 * s2 + 1) * D); }
    }
}

template <class Epi>
__device__ __forceinline__ void run_gemm(LAS unsigned char* lds, const bf16* A, const bf16* Bt, int nMt, int N, int K, int latonly, int coff, const Epi& E) {
    pg8::Gemm g{A, Bt, M, N, K};
    TileOrder S; S.init(nMt, N, (int)gridDim.x, (int)((blockIdx.x + coff) % gridDim.x), latonly);
    pg8::gemm_phase<Epi, TileOrder, true, true>(lds, g, S, E);
}
__device__ __forceinline__ void phase_ffn_in(const P& p, LAS unsigned char* lds, int layer, int which) {
    const bool lat = (layer == DEPTH - 1) && which == 1;
    EpiSwiglu E{(bf16*)(p.ws + WS_ACT), DFF};
    run_gemm(lds, (const bf16*)(p.ws + WS_H), (const bf16*)(p.ws + WS_WFFI) + (size_t)(layer * 2 + which) * (2 * DFF) * D, lat ? 32 : 36, 2 * DFF, D, lat, 0, E);
}
__device__ __forceinline__ void phase_ffn_out(const P& p, LAS unsigned char* lds, int layer, int which) {
    const bool lat = (layer == DEPTH - 1) && which == 1;
    EpiF32 E{(float*)(p.ws + WS_Y), D};
    run_gemm(lds, (const bf16*)(p.ws + WS_ACT), (const bf16*)(p.ws + WS_WFFO) + (size_t)(layer * 2 + which) * D * DFF, lat ? 32 : 36, D, DFF, lat, 0, E);
}
__device__ __forceinline__ void phase_inproj(const P& p, LAS unsigned char* lds, int layer) {
    EpiB16 E{(bf16*)(p.ws + WS_COLS), NINP};
    run_gemm(lds, (const bf16*)(p.ws + WS_H), (const bf16*)(p.ws + WS_WIN) + (size_t)layer * NINP * D, 36, NINP, D, 0, 0, E);
}
__device__ __forceinline__ void phase_outproj(const P& p, LAS unsigned char* lds, int layer) {
    const bool lat = (layer == DEPTH - 1);
    EpiF32 E{(float*)(p.ws + WS_Y), D};
    run_gemm(lds, (const bf16*)(p.ws + WS_YMIX), (const bf16*)(p.ws + WS_WOUT) + (size_t)layer * D * D, lat ? 32 : 36, D, D, lat, 0, E);
}
__device__ __forceinline__ void phase_mgemm(const P& p, LAS unsigned char* lds, int layer) {
    { EpiB16 E{(bf16*)(p.ws + WS_QUP), 768};
      run_gemm(lds, (const bf16*)(p.ws + WS_QN), (const bf16*)(p.ws + WS_WQB) + (size_t)layer * 768 * 384, 36, 768, 384, 0, 0, E); }
    __syncthreads();
    { EpiB16 E{(bf16*)(p.ws + WS_KVUP), 1024};
      run_gemm(lds, (const bf16*)(p.ws + WS_KVN), (const bf16*)(p.ws + WS_WKVB) + (size_t)layer * 1024 * 256, 36, 1024, 256, 0, 148, E); }
    __syncthreads();
    { EpiF32 E{(float*)(p.ws + WS_GATES), 2048};
      run_gemm(lds, (const bf16*)(p.ws + WS_U), (const bf16*)(p.ws + WS_WG) + (size_t)layer * 2048 * 512, 36, 2048, 512, 0, 0, E); }
}

__device__ __forceinline__ void phase_prep(const P& p, int layer) {
    const int tid = threadIdx.x, lane = tid & 63, wave = tid >> 6, G = gridDim.x, blk = blockIdx.x;
    const int gw = wave * G + blk, NGW = NW * G;
    bf16* COLS = (bf16*)(p.ws + WS_COLS); bf16* U = (bf16*)(p.ws + WS_U); bf16* QN = (bf16*)(p.ws + WS_QN); bf16* KVN = (bf16*)(p.ws + WS_KVN);
    const float* rope = (const float*)(p.ws + WS_ROPE);
    const float* cw = p.in[11] + (size_t)layer * 4 * 512; const float* cb = p.in[12] + (size_t)layer * 512;
    const float* qg = p.in[16] + (size_t)layer * 384; const float* kvg = p.in[18] + (size_t)layer * 256;
    for (int row = gw; row < M; row += NGW) {
        const int pp = row % PB; const bool isctx = pp < CTX;
        const int lo = isctx ? 0 : CTX, hi = isctx ? CTX : PB;
        bf16* crow = COLS + (size_t)row * NINP;
#pragma unroll
        for (int cblk = 0; cblk < 8; ++cblk) { const int ch = cblk * 64 + lane; float acc = cb[ch];
#pragma unroll
            for (int j = 0; j < 4; ++j) { const int q = pp + j - 2; if (q >= lo && q < hi) acc += cw[j * 512 + ch] * bf2f(crow[(ptrdiff_t)(j - 2) * NINP + C_XB + ch]); }
            U[(size_t)row * 512 + ch] = (bf16)f2bf(acc); }
        { float v[6]; float s = 0.f;
#pragma unroll
            for (int j = 0; j < 6; ++j) { v[j] = bf2f(crow[C_MQ + lane + 64 * j]); s += v[j] * v[j]; }
            s = wave_sum(s); const float rstd = 1.0f / sqrtf(s * (1.0f / 384.f) + 1e-6f);
#pragma unroll
            for (int j = 0; j < 6; ++j) QN[(size_t)row * 384 + lane + 64 * j] = (bf16)f2bf(v[j] * rstd * qg[lane + 64 * j]); }
        { float v[4]; float s = 0.f;
#pragma unroll
            for (int j = 0; j < 4; ++j) { v[j] = bf2f(crow[C_MKV + lane + 64 * j]); s += v[j] * v[j]; }
            s = wave_sum(s); const float rstd = 1.0f / sqrtf(s * (1.0f / 256.f) + 1e-6f);
#pragma unroll
            for (int j = 0; j < 4; ++j) KVN[(size_t)row * 256 + lane + 64 * j] = (bf16)f2bf(v[j] * rstd * kvg[lane + 64 * j]); }
        if (!isctx) { const int t = pp - CTX; const int i = lane & 31, hsel = lane >> 5;
            const float c = rope[t * 32 + i], sn = rope[SEQ * 32 + t * 32 + i];
#pragma unroll
            for (int hp = 0; hp < 13; ++hp) { const int hd = hp * 2 + hsel; const int base = hd < 16 ? C_DQ + hd * 64 : C_GQ + (hd - 16) * 64;
                const float x1 = bf2f(crow[base + i]), x2 = bf2f(crow[base + 32 + i]);
                crow[base + i] = (bf16)f2bf(x1 * c - x2 * sn); crow[base + 32 + i] = (bf16)f2bf(x1 * sn + x2 * c); }
            if (lane < 16) { const float c2 = rope[SEQ * 64 + t * 16 + lane], s2 = rope[SEQ * 64 + SEQ * 16 + t * 16 + lane];
                const float x1 = bf2f(crow[C_MKR + lane]), x2 = bf2f(crow[C_MKR + 16 + lane]);
                crow[C_MKR + lane] = (bf16)f2bf(x1 * c2 - x2 * s2); crow[C_MKR + 16 + lane] = (bf16)f2bf(x1 * s2 + x2 * c2); }
        }
    }
}

__device__ __forceinline__ void phase_prep2(const P& p, int layer) {
    const int tid = threadIdx.x, lane = tid & 63, wave = tid >> 6, G = gridDim.x, blk = blockIdx.x;
    const int gw = wave * G + blk, NGW = NW * G;
    const bf16* COLS = (const bf16*)(p.ws + WS_COLS); const bf16* U = (const bf16*)(p.ws + WS_U);
    const bf16* QUP = (const bf16*)(p.ws + WS_QUP); const bf16* KVUP = (const bf16*)(p.ws + WS_KVUP);
    bf16* QM = (bf16*)(p.ws + WS_QM); bf16* KM = (bf16*)(p.ws + WS_KM);
    const float* GATES = (const float*)(p.ws + WS_GATES); f32x2* AB = (f32x2*)(p.ws + WS_AB);
    const float* rope = (const float*)(p.ws + WS_ROPE);
    const float* bg = p.in[14] + (size_t)layer * 2 * 2 * 512; const float* lam = p.in[15] + (size_t)layer * 2 * 512;
    for (int row = gw; row < M; row += NGW) {
        const int pp = row % PB; const bool isctx = pp < CTX; const int t = pp - CTX;
#pragma unroll
        for (int j = 0; j < 12; ++j) { const int e = lane + 64 * j, h = e / 96, d = e % 96;
            float qv = bf2f(QUP[(size_t)row * 768 + e]);
            if (d >= 64 && !isctx) { const int i = (d - 64) & 15; const bool second = (d - 64) >= 16;
                const float c = rope[SEQ * 64 + t * 16 + i], sn = rope[SEQ * 64 + SEQ * 16 + t * 16 + i];
                const float x1 = bf2f(QUP[(size_t)row * 768 + h * 96 + 64 + i]), x2 = bf2f(QUP[(size_t)row * 768 + h * 96 + 80 + i]);
                qv = second ? (x1 * sn + x2 * c) : (x1 * c - x2 * sn); }
            QM[(size_t)row * 768 + e] = (bf16)f2bf(qv);
            KM[(size_t)row * 768 + e] = d < 64 ? KVUP[(size_t)row * 1024 + h * 128 + d] : COLS[(size_t)row * NINP + C_MKR + (d - 64)]; }
#pragma unroll
        for (int dir = 0; dir < 2; ++dir)
#pragma unroll
            for (int cblk = 0; cblk < 8; ++cblk) { const int ch = cblk * 64 + lane;
                const float* gp = GATES + (size_t)row * 2048 + ((dir * 4 + (ch >> 7)) * 2) * 128 + (ch & 127);
                const float gr = gp[0] + bg[(dir * 2 + 0) * 512 + ch], gi = gp[128] + bg[(dir * 2 + 1) * 512 + ch];
                const float r = 1.f / (1.f + expf(-gr)), ig = 1.f / (1.f + expf(-gi));
                const float sp = log1pf(expf(-lam[dir * 512 + ch]));
                const float log_a = -8.0f * r * sp, a = expf(log_a);
                const float u = bf2f(U[(size_t)row * 512 + ch]);
                const float bco = sqrtf(-expm1f(2.0f * log_a)) * (ig * u);
                AB[((size_t)dir * M + row) * 512 + ch] = (f32x2){a, bco}; }
    }
}

template <int DQK, int DV, int MODE, bool OUTF32>
__device__ __forceinline__ void naive_attn(const bf16* Q, int qs, const bf16* K, int ks, const bf16* V, int vs, void* O, int os,
                                           int b, int pp0, int lane, float scale, float sink) {
    const size_t rowbase = (size_t)b * PB; const int pp = pp0 + lane;
    float q[DQK], o[DV];
    { const bf16* qr = Q + (rowbase + pp) * qs;
#pragma unroll
      for (int c = 0; c < DQK / 8; ++c) { const v4u w = *(const v4u*)(qr + 8 * c);
          q[8 * c + 0] = bflo(w.x); q[8 * c + 1] = bfhi(w.x); q[8 * c + 2] = bflo(w.y); q[8 * c + 3] = bfhi(w.y);
          q[8 * c + 4] = bflo(w.z); q[8 * c + 5] = bfhi(w.z); q[8 * c + 6] = bflo(w.w); q[8 * c + 7] = bfhi(w.w); } }
    const float sl2 = scale * 1.4426950408889634f;
#pragma unroll
    for (int d = 0; d < DQK; ++d) q[d] *= sl2;
#pragma unroll
    for (int e = 0; e < DV; ++e) o[e] = 0.f;
    float m = (MODE == 1) ? sink * 1.4426950408889634f : -1e30f, l = (MODE == 1) ? 1.f : 0.f;
    const bool isctx = pp0 < CTX; const int t = pp - CTX, t0 = pp0 - CTX;
    for (int seg = 0; seg < 2; ++seg) {
        int k0, k1;
        if (seg == 0) { k0 = 0; k1 = CTX; }
        else { if (isctx) break;
            if (MODE == 0) { k0 = CTX; k1 = PB; }
            else { const int a0 = t0 - 128 < 0 ? 0 : t0 - 128, a1 = t0 + 63 + 128 > SEQ - 1 ? SEQ - 1 : t0 + 63 + 128; k0 = CTX + a0; k1 = CTX + a1 + 1; } }
        for (int key = k0; key < k1; ++key) {
            const bf16* kr = K + (rowbase + key) * ks; const bf16* vr = V + (rowbase + key) * vs;
            asm volatile("" : "+v"(kr)); asm volatile("" : "+v"(vr));
            float s = 0.f;
#pragma unroll
            for (int c = 0; c < DQK / 8; ++c) { const v4u w = *(const v4u*)(kr + 8 * c);
                s += q[8 * c + 0] * bflo(w.x); s += q[8 * c + 1] * bfhi(w.x); s += q[8 * c + 2] * bflo(w.y); s += q[8 * c + 3] * bfhi(w.y);
                s += q[8 * c + 4] * bflo(w.z); s += q[8 * c + 5] * bfhi(w.z); s += q[8 * c + 6] * bflo(w.w); s += q[8 * c + 7] * bfhi(w.w); }
            bool valid = true;
            if (MODE == 1 && seg == 1) { const int rel = (key - CTX) - t; valid = (rel <= 128) && (rel >= -128); }
            if (valid) {
                const float mn = fmaxf(m, s), alpha = exp2f(m - mn), pr = exp2f(s - mn);
                l = l * alpha + pr; m = mn;
#pragma unroll
                for (int c = 0; c < DV / 8; ++c) { const v4u w = *(const v4u*)(vr + 8 * c);
                    o[8 * c + 0] = o[8 * c + 0] * alpha + pr * bflo(w.x); o[8 * c + 1] = o[8 * c + 1] * alpha + pr * bfhi(w.x);
                    o[8 * c + 2] = o[8 * c + 2] * alpha + pr * bflo(w.y); o[8 * c + 3] = o[8 * c + 3] * alpha + pr * bfhi(w.y);
                    o[8 * c + 4] = o[8 * c + 4] * alpha + pr * bflo(w.z); o[8 * c + 5] = o[8 * c + 5] * alpha + pr * bfhi(w.z);
                    o[8 * c + 6] = o[8 * c + 6] * alpha + pr * bflo(w.w); o[8 * c + 7] = o[8 * c + 7] * alpha + pr * bfhi(w.w); }
            }
        }
    }
    const float il = 1.f / l;
    if (OUTF32) { float* orow = (float*)O + (rowbase + pp) * os;
#pragma unroll
        for (int e = 0; e < DV; e += 4) *(f32x4*)(orow + e) = (f32x4){o[e] * il, o[e + 1] * il, o[e + 2] * il, o[e + 3] * il}; }
    else { bf16* orow = (bf16*)O + (rowbase + pp) * os;
#pragma unroll
        for (int e = 0; e < DV; e += 8) { v4u w; w.x = pk2(o[e] * il, o[e + 1] * il); w.y = pk2(o[e + 2] * il, o[e + 3] * il); w.z = pk2(o[e + 4] * il, o[e + 5] * il); w.w = pk2(o[e + 6] * il, o[e + 7] * il);
            *(v4u*)(orow + e) = w; } }
}

__device__ __forceinline__ void phase_att(const P& p, int layer) {
    const int tid = threadIdx.x, lane = tid & 63, wave = __builtin_amdgcn_readfirstlane(tid >> 6), G = gridDim.x, blk = blockIdx.x;
    const int gw = wave * G + blk, NGW = NW * G;
    const bool last = layer == DEPTH - 1;
    const bf16* COLS = (const bf16*)(p.ws + WS_COLS); const bf16* KVUP = (const bf16*)(p.ws + WS_KVUP);
    const bf16* QM = (const bf16*)(p.ws + WS_QM); const bf16* KM = (const bf16*)(p.ws + WS_KM);
    bf16* YMIX = (bf16*)(p.ws + WS_YMIX); float* DIFFO = (float*)(p.ws + WS_DIFFO);
    const f32x2* AB = (const f32x2*)(p.ws + WS_AB); float* HS = (float*)(p.ws + WS_HS);
    constexpr int N_SCAN = 64, N_MLA = NB * 8 * 36, N_DIFF = NB * 8 * 2 * 36, N_GQA = NB * 8 * 36;
    for (int it = gw; it < N_SCAN + N_MLA + N_DIFF + N_GQA; it += NGW) {
        int r = it;
        if (r < N_SCAN) {
            const int b = r >> 4, dir = (r >> 3) & 1, ch = (r & 7) * 64 + lane;
            const f32x2* ab = AB + ((size_t)dir * M + (size_t)b * PB) * 512 + ch; float* hs = HS + ((size_t)dir * M + (size_t)b * PB) * 512 + ch;
            float h = 0.f;
            if (dir == 0) {
#pragma unroll 8
                for (int q = 0; q < PB; ++q) { const f32x2 c = ab[(size_t)q * 512]; h = c.x * h + c.y; hs[(size_t)q * 512] = h; }
            } else {
#pragma unroll 8
                for (int q = CTX - 1; q >= 0; --q) { const f32x2 c = ab[(size_t)q * 512]; h = c.x * h + c.y; hs[(size_t)q * 512] = h; }
#pragma unroll 8
                for (int q = PB - 1; q >= CTX; --q) { const f32x2 c = ab[(size_t)q * 512]; h = c.x * h + c.y; hs[(size_t)q * 512] = h; }
            }
            continue; }
        r -= N_SCAN;
        if (r < N_MLA) { const int b = r / 288, hh = (r / 36) % 8, pp0 = (r % 36) * 64;
            if (last && pp0 < CTX) continue;
            naive_attn<96, 64, 0, false>(QM + hh * 96, 768, KM + hh * 96, 768, KVUP + hh * 128 + 64, 1024, YMIX + 512 + hh * 64, 2048, b, pp0, lane, 0.10206207261596575f, 0.f);
            continue; }
        r -= N_MLA;
        if (r < N_DIFF) { const int b = r / 576, ph = (r / 72) % 8, vh = (r / 36) % 2, pp0 = (r % 36) * 64;
            if (last && pp0 < CTX) continue;
            naive_attn<64, 64, 0, true>(COLS + C_DQ + ph * 64, NINP, COLS + C_DK + ph * 64, NINP, COLS + C_DV + (ph >> 1) * 128 + vh * 64, NINP, DIFFO + ph * 128 + vh * 64, 1024, b, pp0, lane, 0.125f, 0.f);
            continue; }
        r -= N_DIFF;
        { const int b = r / 288, hq = (r / 36) % 8, pp0 = (r % 36) * 64;
            if (last && pp0 < CTX) continue;
            const float sink = p.in[22][layer * 8 + hq];
            naive_attn<64, 64, 1, false>(COLS + C_GQ + hq * 64, NINP, COLS + C_GK + (hq >> 2) * 64, NINP, COLS + C_GV + (hq >> 2) * 64, NINP, YMIX + 1536 + hq * 64, 2048, b, pp0, lane, 0.125f, sink); }
    }
}

__device__ __forceinline__ void phase_mixfin(const P& p, int layer) {
    const int tid = threadIdx.x, lane = tid & 63, wave = tid >> 6, G = gridDim.x, blk = blockIdx.x;
    const int gw = wave * G + blk, NGW = NW * G;
    const bool last = layer == DEPTH - 1;
    const bf16* COLS = (const bf16*)(p.ws + WS_COLS); bf16* YMIX = (bf16*)(p.ws + WS_YMIX); const float* DIFFO = (const float*)(p.ws + WS_DIFFO); const float* HS = (const float*)(p.ws + WS_HS);
    const float* lv = p.in[20] + (size_t)layer * 4 * 64; const float* dg = p.in[21] + (size_t)layer * 128;
    const float lam_init = 0.8f - 0.6f * expf(-0.3f * (float)layer);
    const float lam = expf(wave_sum(lv[lane] * lv[64 + lane])) - expf(wave_sum(lv[128 + lane] * lv[192 + lane])) + lam_init;
    for (int row = gw; row < M; row += NGW) {
        const int pp = row % PB; if (last && pp < CTX) continue;
#pragma unroll
        for (int cblk = 0; cblk < 8; ++cblk) { const int ch = cblk * 64 + lane;
            const float hsum = HS[(size_t)row * 512 + ch] + HS[((size_t)M + row) * 512 + ch];
            const float gt = bf2f(COLS[(size_t)row * NINP + C_GATE + ch]);
            YMIX[(size_t)row * 2048 + ch] = (bf16)f2bf(hsum * gelu_tanh(gt)); }
#pragma unroll
        for (int hh = 0; hh < 4; ++hh) { float o[2]; float s = 0.f;
#pragma unroll
            for (int j = 0; j < 2; ++j) { const int e = lane + 64 * j;
                o[j] = DIFFO[(size_t)row * 1024 + (2 * hh) * 128 + e] - lam * DIFFO[(size_t)row * 1024 + (2 * hh + 1) * 128 + e]; s += o[j] * o[j]; }
            s = wave_sum(s); const float rstd = 1.0f / sqrtf(s * (1.0f / 128.f) + 1e-6f);
#pragma unroll
            for (int j = 0; j < 2; ++j) { const int e = lane + 64 * j; YMIX[(size_t)row * 2048 + 1024 + hh * 128 + e] = (bf16)f2bf(o[j] * rstd * dg[e] * (1.0f - lam_init)); } }
    }
}

enum { PH_PRO1 = 0, PH_PRO2, PH_FFN_IN, PH_FFN_OUT, PH_POST, PH_INPROJ, PH_PREP, PH_MGEMM, PH_PREP2, PH_ATT, PH_MIXFIN, PH_OUTPROJ, PH_COUNT };

template <int PH> __global__ void __launch_bounds__(NT, 2) k_phase(P p, int layer, int sub) {
    extern __shared__ __attribute__((aligned(16))) unsigned char lds_raw[];
    LAS unsigned char* lds = (LAS unsigned char*)lds_raw;
    if constexpr (PH == PH_PRO1) phase_pro1(p, lds);
    if constexpr (PH == PH_PRO2) phase_pro2(p);
    if constexpr (PH == PH_FFN_IN) phase_ffn_in(p, lds, layer, sub);
    if constexpr (PH == PH_FFN_OUT) phase_ffn_out(p, lds, layer, sub);
    if constexpr (PH == PH_POST) phase_post(p, layer, sub);
    if constexpr (PH == PH_INPROJ) phase_inproj(p, lds, layer);
    if constexpr (PH == PH_PREP) phase_prep(p, layer);
    if constexpr (PH == PH_MGEMM) phase_mgemm(p, lds, layer);
    if constexpr (PH == PH_PREP2) phase_prep2(p, layer);
    if constexpr (PH == PH_ATT) phase_att(p, layer);
    if constexpr (PH == PH_MIXFIN) phase_mixfin(p, layer);
    if constexpr (PH == PH_OUTPROJ) phase_outproj(p, lds, layer);
}

template <int PH> static void launch_phase(const P& p, int layer, int sub, int grid, hipStream_t stream) {
    static bool attr = false;
    if (!attr) { (void)hipFuncSetAttribute((const void*)k_phase<PH>, hipFuncAttributeMaxDynamicSharedMemorySize, LDS_BYTES); attr = true; }
    hipLaunchKernelGGL(k_phase<PH>, dim3(grid), dim3(NT), LDS_BYTES, stream, p, layer, sub);
}

extern "C" void kernel_launch(void* const* d_in, const int* in_sizes, int n_in, void* d_out, int out_size, void* d_ws, size_t ws_size, hipStream_t stream) {
    static int grid = 0;
    if (grid == 0) {
        if (n_in != 23 || out_size != NB * SEQ * D || ws_size < WS_END) { fprintf(stderr, "kernel_launch: unexpected shapes (n_in %d out %d ws %zu need %zu)\n", n_in, out_size, ws_size, (size_t)WS_END); grid = -1; return; }
        int dev = 0, cus = 0;
        if (hipGetDevice(&dev) != hipSuccess || hipDeviceGetAttribute(&cus, hipDeviceAttributeMultiprocessorCount, dev) != hipSuccess) { grid = -1; return; }
        grid = cus;
    }
    if (grid < 0) return;
    P p{};
    for (int i = 0; i < 23; ++i) p.in[i] = (const float*)d_in[i];
    p.out = (float*)d_out; p.ws = (unsigned char*)d_ws;
    launch_phase<PH_PRO1>(p, 0, 0, grid, stream);
    launch_phase<PH_PRO2>(p, 0, 0, grid, stream);
    for (int l = 0; l < DEPTH; ++l) {
        launch_phase<PH_FFN_IN>(p, l, 0, grid, stream);
        launch_phase<PH_FFN_OUT>(p, l, 0, grid, stream);
        launch_phase<PH_POST>(p, l, 0, grid, stream);
        launch_phase<PH_INPROJ>(p, l, 0, grid, stream);
        launch_phase<PH_PREP>(p, l, 0, grid, stream);
        launch_phase<PH_MGEMM>(p, l, 0, grid, stream);
        launch_phase<PH_PREP2>(p, l, 0, grid, stream);
        launch_phase<PH_ATT>(p, l, 0, grid, stream);
        launch_phase<PH_MIXFIN>(p, l, 0, grid, stream);
        launch_phase<PH_OUTPROJ>(p, l, 0, grid, stream);
        launch_phase<PH_POST>(p, l, 1, grid, stream);
        launch_phase<PH_FFN_IN>(p, l, 1, grid, stream);
        launch_phase<PH_FFN_OUT>(p, l, 1, grid, stream);
        launch_phase<PH_POST>(p, l, 2, grid, stream);
    }
}
```

```cpp
#include <hip/hip_runtime.h>
#include <cstdio>
#include <cstdint>
__device__ __forceinline__ int tid_opaque() { int t = (int)threadIdx.x; asm volatile("" : "+v"(t)); return t; }
namespace pg8 {
#define PG8_LAS __attribute__((address_space(3)))
typedef unsigned short bf16_t;
typedef short bf16x8 __attribute__((ext_vector_type(8)));
typedef float f32x4 __attribute__((ext_vector_type(4)));
typedef unsigned u32x4 __attribute__((ext_vector_type(4)));
constexpr int BM = 256, BK = 64, HALF = 128, HTB = HALF * BK * 2  , STAGE_BYTES = 8 * HTB, NXCD = 8, WGM = 8;

__host__ __device__ __forceinline__ int lds_byte(int r, int c) { const int st = (r >> 4) * 2 + (c >> 5), rr = r & 15, cc = c & 31, ob = rr * 64 + cc * 2; return st * 1024 + (ob ^ (((ob >> 9) & 1) << 5)); }
__host__ __device__ __forceinline__ void stage_rc(int b, int& R, int& C) { const int st = b / 1024, sb = b % 1024, swz = sb ^ (((sb >> 9) & 1) << 5); R = (st >> 1) * 16 + swz / 64; C = (st & 1) * 32 + (swz % 64) / 2; }
__host__ __device__ __forceinline__ int perm32(int rho) { const int n = rho >> 4, i = rho & 15; return 8 * (i >> 2) + 4 * n + (i & 3); }

struct Unit { int pm, pn; };
struct Gemm { const bf16_t* A; const bf16_t* Bt; int M, N, K; };

struct StaticOrder {
    int nM, nN, nwg, G, c;
    __host__ __device__ void init(int M, int N, int G_, int c_) { nM = M / BM; nN = N / BM; nwg = nM * nN; G = G_; c = c_; }
    __host__ __device__ bool next(int i, Unit& u) const {
        const long L = (long)i * G + c; if (L >= nwg) return false;
        int wgid = (int)L; { const int q = nwg / NXCD, r = nwg % NXCD, xcd = wgid % NXCD, off = wgid / NXCD; wgid = (xcd < r ? xcd * (q + 1) : r * (q + 1) + (xcd - r) * q) + off; }
        const int nig = WGM * nN, gid = wgid / nig, fm = gid * WGM, gsz = (nM - fm) < WGM ? (nM - fm) : WGM;
        u.pm = fm + ((wgid % nig) % gsz); u.pn = (wgid % nig) / gsz; return true;
    }
    __device__ __forceinline__ void a_ready(const Unit&) const {}
    __device__ __forceinline__ void done(const Unit&) const {}
};

__device__ __forceinline__ unsigned cvt_pk_bf16(float lo, float hi) { unsigned r; asm volatile("v_cvt_pk_bf16_f32 %0, %1, %2" : "=v"(r) : "v"(lo), "v"(hi)); return r; }
typedef float f32x2 __attribute__((ext_vector_type(2)));
}
namespace pg8 {
template <class Epi, class Sched, bool ALIGN_EPI = false, bool SP2 = false>
__device__ __forceinline__ void gemm_phase(PG8_LAS unsigned char* lds, const Gemm g, const Sched& S, const Epi& E) {
    const int tid = tid_opaque(), wid = __builtin_amdgcn_readfirstlane(tid >> 6), lane = tid & 63, wr = wid >> 2, wc = wid & 3, fr = lane & 15, fq = lane >> 4;
    const int K = g.K, nt = K / BK;
    unsigned voffA[2], voffB[2];
#pragma unroll
    for (int i = 0; i < 2; ++i) { int R, C; stage_rc(tid * 16 + i * 8192, R, C); const int Rb = Epi::PERM ? ((R & ~31) + perm32(R & 31)) : R;
        voffA[i] = (unsigned)(R * K + C) * 2u; voffB[i] = (unsigned)(Rb * K + C) * 2u; }
    const size_t kstep = (size_t)(BK * 2);
    const size_t hstep = (size_t)HALF * K * 2;
    const size_t tstep = 2 * hstep;
    const unsigned ldsw = (unsigned)wid * 1024u;
    const int aoff = lds_byte(wr * 64 + fr, fq * 8), boff = lds_byte(wc * 32 + fr, fq * 8);
#define PG8_SA(b, h) (((b) * 2 + (h)) * HTB)
#define PG8_SB(b, h) ((4 + (b) * 2 + (h)) * HTB)
#define PG8_STAGE(bufoff, gbase, voff) do { _Pragma("unroll") for (int _i = 0; _i < 2; ++_i) \
        __builtin_amdgcn_global_load_lds((const unsigned*)((const char*)(gbase) + (voff)[_i]), (PG8_LAS unsigned*)(lds + (bufoff) + ldsw + _i * 8192), 16, 0, 0); } while (0)
#define PG8_LDA(dst, b, h) do { _Pragma("unroll") for (int m = 0; m < 4; ++m) _Pragma("unroll") for (int k = 0; k < 2; ++k) dst[m][k] = *(const PG8_LAS bf16x8*)(lds + PG8_SA(b, h) + aoff + m * 2048 + k * 1024); } while (0)
#define PG8_LDB(dst, b, h) do { _Pragma("unroll") for (int n = 0; n < 2; ++n) _Pragma("unroll") for (int k = 0; k < 2; ++k) dst[n][k] = *(const PG8_LAS bf16x8*)(lds + PG8_SB(b, h) + boff + n * 2048 + k * 1024); } while (0)
#define PG8_MMA(ai, bj, At, Bt) do { __builtin_amdgcn_s_setprio(1); _Pragma("unroll") for (int m = 0; m < 4; ++m) _Pragma("unroll") for (int n = 0; n < 2; ++n) _Pragma("unroll") for (int k = 0; k < 2; ++k) \
        acc[ai][bj][m][n] = __builtin_amdgcn_mfma_f32_16x16x32_bf16(Bt[n][k], At[m][k], acc[ai][bj][m][n], 0, 0, 0); __builtin_amdgcn_s_setprio(0); } while (0)
#define PG8_WAIT_V(n) asm volatile("s_waitcnt vmcnt(" #n ")" ::: "memory")
#define PG8_WAIT_L(n) asm volatile("s_waitcnt lgkmcnt(" #n ")" ::: "memory")
#define PG8_BAR __builtin_amdgcn_s_barrier()
#define PG8_SCHED __builtin_amdgcn_sched_barrier(0)
    Unit cur, nxt; int ui = 0;
    if (!S.next(0, cur)) return;
    f32x4 acc[2][2][4][2];
#pragma unroll
    for (int a = 0; a < 2; ++a)
#pragma unroll
        for (int b = 0; b < 2; ++b)
#pragma unroll
            for (int m = 0; m < 4; ++m)
#pragma unroll
                for (int n = 0; n < 2; ++n) acc[a][b][m][n] = (f32x4){0.f, 0.f, 0.f, 0.f};
    bf16x8 At[4][2], B0[2][2], B1[2][2];
    const char* cA = (const char*)g.A + (size_t)cur.pm * tstep; const char* cB = (const char*)g.Bt + (size_t)cur.pn * tstep;
    S.a_ready(cur);
    if constexpr (SP2) {
        PG8_STAGE(PG8_SB(0, 0), cB, voffB); PG8_STAGE(PG8_SB(0, 1), cB + hstep, voffB); PG8_STAGE(PG8_SA(0, 0), cA, voffA); PG8_STAGE(PG8_SA(0, 1), cA + hstep, voffA);
        if (wr == 1) PG8_BAR;
        PG8_WAIT_V(2); PG8_BAR;
        PG8_STAGE(PG8_SB(1, 0), cB + kstep, voffB); PG8_STAGE(PG8_SA(1, 0), cA + kstep, voffA); PG8_STAGE(PG8_SB(1, 1), cB + hstep + kstep, voffB);
        PG8_WAIT_V(6); PG8_BAR;
    } else {
        PG8_STAGE(PG8_SB(0, 0), cB, voffB); PG8_STAGE(PG8_SA(0, 0), cA, voffA); PG8_STAGE(PG8_SB(0, 1), cB + hstep, voffB); PG8_STAGE(PG8_SA(0, 1), cA + hstep, voffA);
        if (wr == 1) PG8_BAR;
        PG8_WAIT_V(4); PG8_BAR;
        PG8_STAGE(PG8_SB(1, 0), cB + kstep, voffB); PG8_STAGE(PG8_SA(1, 0), cA + kstep, voffA); PG8_STAGE(PG8_SB(1, 1), cB + hstep + kstep, voffB);
        PG8_WAIT_V(6); PG8_BAR;
    }
    for (;;) {
        const bool has_next = S.next(ui + 1, nxt);
        const char* nA = has_next ? (const char*)g.A + (size_t)nxt.pm * tstep : cA; const char* nB = has_next ? (const char*)g.Bt + (size_t)nxt.pn * tstep : cB;
        for (int t = 0; t < nt; t += 2) {
            const bool last = (t == nt - 2);
            const char* a1 = cA + (size_t)(t + 1) * kstep;
            const char* a2 = last ? nA : cA + (size_t)(t + 2) * kstep; const char* b2 = last ? nB : cB + (size_t)(t + 2) * kstep;
            const char* a3 = a2 + kstep; const char* b3 = b2 + kstep;
            if (last && has_next) S.a_ready(nxt);
            if constexpr (SP2) {
            PG8_LDB(B0, 0, 0); PG8_LDB(B1, 0, 1); PG8_SCHED; PG8_LDA(At, 0, 0); PG8_STAGE(PG8_SA(1, 1), a1 + hstep, voffA);
            PG8_WAIT_V(8); PG8_WAIT_L(0); PG8_BAR; PG8_MMA(0, 0, At, B0); PG8_MMA(0, 1, At, B1); PG8_BAR; PG8_SCHED;
            PG8_LDA(At, 0, 1); PG8_STAGE(PG8_SB(0, 0), b2, voffB); PG8_STAGE(PG8_SB(0, 1), b2 + hstep, voffB); PG8_STAGE(PG8_SA(0, 0), a2, voffA);
            PG8_WAIT_V(8); PG8_WAIT_L(0); PG8_BAR; PG8_MMA(1, 0, At, B0); PG8_MMA(1, 1, At, B1); PG8_BAR; PG8_SCHED;
            PG8_LDB(B0, 1, 0); PG8_LDB(B1, 1, 1); PG8_SCHED; PG8_LDA(At, 1, 0); PG8_STAGE(PG8_SA(0, 1), a2 + hstep, voffA);
            PG8_WAIT_V(8); PG8_WAIT_L(0); PG8_BAR; PG8_MMA(0, 0, At, B0); PG8_MMA(0, 1, At, B1); PG8_BAR; PG8_SCHED;
            PG8_LDA(At, 1, 1); PG8_STAGE(PG8_SB(1, 0), b3, voffB); PG8_STAGE(PG8_SB(1, 1), b3 + hstep, voffB); PG8_STAGE(PG8_SA(1, 0), a3, voffA);
            PG8_WAIT_V(8); PG8_WAIT_L(0); PG8_BAR; PG8_MMA(1, 0, At, B0); PG8_MMA(1, 1, At, B1); PG8_BAR; PG8_SCHED;
            } else {
            PG8_LDB(B0, 0, 0); PG8_SCHED; PG8_LDA(At, 0, 0); PG8_STAGE(PG8_SA(1, 1), a1 + hstep, voffA);
            PG8_WAIT_L(8); PG8_BAR; PG8_WAIT_L(0); PG8_MMA(0, 0, At, B0); PG8_BAR; PG8_SCHED;
            PG8_LDB(B1, 0, 1); PG8_STAGE(PG8_SB(0, 0), b2, voffB);
            PG8_BAR; PG8_WAIT_L(0); PG8_MMA(0, 1, At, B1); PG8_BAR;
            PG8_LDA(At, 0, 1); PG8_STAGE(PG8_SA(0, 0), a2, voffA);
            PG8_BAR; PG8_WAIT_L(0); PG8_MMA(1, 0, At, B0); PG8_BAR; PG8_SCHED;
            PG8_STAGE(PG8_SB(0, 1), b2 + hstep, voffB);
            PG8_WAIT_V(6); PG8_BAR; PG8_MMA(1, 1, At, B1); PG8_BAR;
            PG8_LDB(B0, 1, 0); PG8_SCHED; PG8_LDA(At, 1, 0); PG8_STAGE(PG8_SA(0, 1), a2 + hstep, voffA);
            PG8_WAIT_L(8); PG8_BAR; PG8_WAIT_L(0); PG8_MMA(0, 0, At, B0); PG8_BAR; PG8_SCHED;
            PG8_LDB(B1, 1, 1); PG8_STAGE(PG8_SB(1, 0), b3, voffB);
            PG8_BAR; PG8_WAIT_L(0); PG8_MMA(0, 1, At, B1); PG8_BAR;
            PG8_LDA(At, 1, 1); PG8_STAGE(PG8_SA(1, 0), a3, voffA);
            PG8_BAR; PG8_WAIT_L(0); PG8_MMA(1, 0, At, B0); PG8_BAR; PG8_SCHED;
            PG8_STAGE(PG8_SB(1, 1), b3 + hstep, voffB);
            PG8_WAIT_V(6); PG8_BAR; PG8_MMA(1, 1, At, B1); PG8_BAR;
            }
        }
        if constexpr (ALIGN_EPI) { if (wr == 0) PG8_BAR; }
        if constexpr (!Epi::AFTER_DRAIN) { E(acc, cur, wr, wc, fr, fq); S.done(cur); }
        if (!has_next) break;
#pragma unroll
        for (int a = 0; a < 2; ++a)
#pragma unroll
            for (int b = 0; b < 2; ++b)
#pragma unroll
                for (int m = 0; m < 4; ++m)
#pragma unroll
                    for (int n = 0; n < 2; ++n) acc[a][b][m][n] = (f32x4){0.f, 0.f, 0.f, 0.f};
        cur = nxt; cA = nA; cB = nB; ++ui;
        if constexpr (ALIGN_EPI) { if (wr == 1) PG8_BAR; }
    }
    PG8_WAIT_V(0);
    if constexpr (!ALIGN_EPI) { if (wr == 0) PG8_BAR; }
    PG8_BAR;
    if constexpr (Epi::AFTER_DRAIN) { E.fused(acc, cur, wr, wc, fr, fq, lds, wid, lane); S.done(cur); }
#undef PG8_SA
#undef PG8_SB
#undef PG8_STAGE
#undef PG8_LDA
#undef PG8_LDB
#undef PG8_MMA
#undef PG8_WAIT_V
#undef PG8_WAIT_L
#undef PG8_BAR
#undef PG8_SCHED
}
}

#define GAS __attribute__((address_space(1)))
#define LAS __attribute__((address_space(3)))
typedef unsigned short bf16;
typedef unsigned v4u __attribute__((ext_vector_type(4)));
typedef unsigned v2u __attribute__((ext_vector_type(2)));
typedef float f32x4 __attribute__((ext_vector_type(4)));
typedef float f32x2 __attribute__((ext_vector_type(2)));

constexpr int D = 2048, NB = 4, SEQ = 2048, CTX = 256, PB = 2304, M = NB * PB, DEPTH = 4, DFF = 5632, NIN = 4000, NINP = 4096, NMODC = 9 * D;
constexpr int NT = 512, NW = 8;
constexpr int C_XB = 0, C_GATE = 512, C_MQ = 1024, C_MKV = 1408, C_MKR = 1664, C_DQ = 1696, C_DK = 2208, C_DV = 2720, C_GQ = 3232, C_GK = 3744, C_GV = 3872;

constexpr size_t MiB = 1u << 20;
constexpr size_t WS_CTL = 0;
constexpr size_t WS_MOD = 1 * MiB;
constexpr size_t WS_ROPE = 3 * MiB;
constexpr size_t WS_WFFI = 4 * MiB;
constexpr size_t WS_WFFO = WS_WFFI + 352 * MiB;
constexpr size_t WS_WIN = WS_WFFO + 176 * MiB;
constexpr size_t WS_WOUT = WS_WIN + 64 * MiB;
constexpr size_t WS_WQB = WS_WOUT + 32 * MiB;
constexpr size_t WS_WKVB = WS_WQB + 3 * MiB;
constexpr size_t WS_WG = WS_WKVB + 2 * MiB;
constexpr size_t WS_X = WS_WG + 8 * MiB;
constexpr size_t WS_H = WS_X + 72 * MiB;
constexpr size_t WS_ACT = WS_H + 36 * MiB;
constexpr size_t WS_Y = WS_ACT + 99 * MiB;
constexpr size_t WS_COLS = WS_Y + 72 * MiB;
constexpr size_t WS_U = WS_COLS + 72 * MiB;
constexpr size_t WS_GATES = WS_U + 9 * MiB;
constexpr size_t WS_QN = WS_GATES + 72 * MiB;
constexpr size_t WS_KVN = WS_QN + 7 * MiB;
constexpr size_t WS_QUP = WS_KVN + 5 * MiB;
constexpr size_t WS_KVUP = WS_QUP + 14 * MiB;
constexpr size_t WS_QM = WS_KVUP + 18 * MiB;
constexpr size_t WS_KM = WS_QM + 14 * MiB;
constexpr size_t WS_AB = WS_KM + 14 * MiB;
constexpr size_t WS_HS = WS_AB + 72 * MiB;
constexpr size_t WS_DIFFO = WS_HS + 36 * MiB;
constexpr size_t WS_YMIX = WS_DIFFO + 36 * MiB;
constexpr size_t WS_END = WS_YMIX + 36 * MiB;

constexpr int LDS_BYTES = 147456;

struct P { const float* in[23]; float* out; unsigned char* ws; };

#define LDS_WAIT() asm volatile("s_waitcnt lgkmcnt(0)" ::: "memory")
__device__ __forceinline__ unsigned f2bf(float f) { unsigned u = __builtin_bit_cast(unsigned, f); return (u + 0x7fffu + ((u >> 16) & 1u)) >> 16; }
__device__ __forceinline__ unsigned pk2(float lo, float hi) { return f2bf(lo) | (f2bf(hi) << 16); }
__device__ __forceinline__ float bf2f(unsigned v) { return __builtin_bit_cast(float, v << 16); }
__device__ __forceinline__ float bflo(unsigned w) { return __builtin_bit_cast(float, w << 16); }
__device__ __forceinline__ float bfhi(unsigned w) { return __builtin_bit_cast(float, w & 0xffff0000u); }
__device__ __forceinline__ float wave_sum(float v) {
#pragma unroll
    for (int o = 1; o < 64; o <<= 1) v += __shfl_xor(v, o);
    return v;
}
__device__ __forceinline__ float sigmoidf_(float x) { return 1.f / (1.f + __expf(-x)); }
__device__ __forceinline__ float siluf_(float x) { return x / (1.f + __expf(-x)); }
__device__ __forceinline__ float gelu_tanh(float x) { const float u = 0.7978845608028654f * (x + 0.044715f * x * x * x); return 0.5f * x * (1.f + tanhf(u)); }

struct TileOrder {
    pg8::StaticOrder so; int latonly;
    __device__ __forceinline__ void init(int nMt, int N, int G, int c, int lat) { so.nM = nMt; so.nN = N / 256; so.nwg = so.nM * so.nN; so.G = G; so.c = c; latonly = lat; }
    __device__ __forceinline__ bool next(int i, pg8::Unit& u) const { if (!so.next(i, u)) return false; if (latonly) u.pm = (u.pm >> 3) * 9 + 1 + (u.pm & 7); return true; }
    __device__ __forceinline__ void a_ready(const pg8::Unit&) const {}
    __device__ __forceinline__ void done(const pg8::Unit&) const {}
};
struct EpiF32 {
    static constexpr bool PERM = false, AFTER_DRAIN = false;
    float* C; int ldc;
    __device__ __forceinline__ void operator()(const f32x4 (&acc)[2][2][4][2], const pg8::Unit& u, int wr, int wc, int fr, int fq) const {
        const int row0 = u.pm * 256 + wr * 64 + fr, col0 = u.pn * 256 + wc * 32 + 4 * fq;
#pragma unroll
        for (int ai = 0; ai < 2; ++ai)
#pragma unroll
            for (int m = 0; m < 4; ++m) { float* rowp = C + (size_t)(row0 + ai * 128 + m * 16) * ldc + col0;
#pragma unroll
                for (int bj = 0; bj < 2; ++bj)
#pragma unroll
                    for (int n = 0; n < 2; ++n) *(f32x4*)(rowp + bj * 128 + n * 16) = acc[ai][bj][m][n]; }
    }
};
struct EpiB16 {
    static constexpr bool PERM = true, AFTER_DRAIN = false;
    bf16* O; int ldc;
    __device__ __forceinline__ void operator()(const f32x4 (&acc)[2][2][4][2], const pg8::Unit& u, int wr, int wc, int fr, int fq) const {
        const int row0 = u.pm * 256 + wr * 64 + fr, col0 = u.pn * 256 + wc * 32 + 8 * fq;
#pragma unroll
        for (int ai = 0; ai < 2; ++ai)
#pragma unroll
            for (int m = 0; m < 4; ++m) { bf16* rowp = O + (size_t)(row0 + ai * 128 + m * 16) * ldc + col0;
#pragma unroll
                for (int bj = 0; bj < 2; ++bj) { const f32x4 v0 = acc[ai][bj][m][0], v1 = acc[ai][bj][m][1];
                    v4u w; w.x = pg8::cvt_pk_bf16(v0[0], v0[1]); w.y = pg8::cvt_pk_bf16(v0[2], v0[3]); w.z = pg8::cvt_pk_bf16(v1[0], v1[1]); w.w = pg8::cvt_pk_bf16(v1[2], v1[3]);
                    *(v4u*)(rowp + bj * 128) = w; } }
    }
};
struct EpiSwiglu {
    static constexpr bool PERM = true, AFTER_DRAIN = false;
    bf16* O; int ldc;
    __device__ __forceinline__ void operator()(const f32x4 (&acc)[2][2][4][2], const pg8::Unit& u, int wr, int wc, int fr, int fq) const {
        const int row0 = u.pm * 256 + wr * 64 + fr, col0 = u.pn * 128 + wc * 32 + 8 * fq;
#pragma unroll
        for (int ai = 0; ai < 2; ++ai)
#pragma unroll
            for (int m = 0; m < 4; ++m) { bf16* rowp = O + (size_t)(row0 + ai * 128 + m * 16) * ldc + col0;
                float r[8];
#pragma unroll
                for (int n = 0; n < 2; ++n)
#pragma unroll
                    for (int e = 0; e < 4; ++e) { const float g = acc[ai][0][m][n][e], uu = acc[ai][1][m][n][e]; r[n * 4 + e] = siluf_(g) * uu; }
                v4u w; w.x = pg8::cvt_pk_bf16(r[0], r[1]); w.y = pg8::cvt_pk_bf16(r[2], r[3]); w.z = pg8::cvt_pk_bf16(r[4], r[5]); w.w = pg8::cvt_pk_bf16(r[6], r[7]);
                *(v4u*)rowp = w; }
    }
};

__device__ __forceinline__ void transpose_item(const float* W, int N, int K, bf16* WT, int k0, int n0, int drow0, LAS float* scr, int lane) {
#pragma unroll 8
    for (int i = 0; i < 32; ++i) { const int kk = 2 * i + (lane >> 5); scr[kk * 33 + (lane & 31)] = W[(size_t)(k0 + kk) * N + n0 + (lane & 31)]; }
    LDS_WAIT(); asm volatile("" ::: "memory");
    const int c = lane & 7;
#pragma unroll
    for (int j = 0; j < 4; ++j) { const int n = (lane >> 3) + 8 * j; const LAS float* s = scr + (8 * c) * 33 + n;
        v4u o; o.x = pk2(s[0 * 33], s[1 * 33]); o.y = pk2(s[2 * 33], s[3 * 33]); o.z = pk2(s[4 * 33], s[5 * 33]); o.w = pk2(s[6 * 33], s[7 * 33]);
        *(v4u*)(WT + (size_t)(drow0 + n) * K + k0 + 8 * c) = o; }
    LDS_WAIT(); asm volatile("" ::: "memory");
}

__device__ __forceinline__ void phase_pro1(const P& p, LAS unsigned char* lds) {
    const int tid = tid_opaque(), lane = tid & 63, wave = __builtin_amdgcn_readfirstlane(tid >> 6);
    const int G = gridDim.x, blk = blockIdx.x;
    {
        LAS float* sc = (LAS float*)lds;
        LAS float* red = (LAS float*)(lds + 40960);
        const float* c = p.in[1]; const float* cc = p.in[3];
        for (int i = tid; i < 5 * D; i += NT) { const int v = i / D, k = i % D; const float x = v < 4 ? c[v * D + k] : cc[k]; sc[i] = x / (1.f + expf(-x)); }
        __syncthreads();
        const float* wmod = p.in[4]; const float* bmod = p.in[5];
        float* MOD = (float*)(p.ws + WS_MOD);
        for (int unit = blk; unit < DEPTH * 288; unit += G) {
            const int l = unit / 288, n0 = (unit % 288) * 64, kq = lane >> 4;
            const float* W = wmod + (size_t)l * D * NMODC + n0 + 4 * (lane & 15);
            float acc[5][4];
#pragma unroll
            for (int v = 0; v < 5; ++v)
#pragma unroll
                for (int e = 0; e < 4; ++e) acc[v][e] = 0.f;
            const int kbase = wave * 256 + kq;
#pragma unroll 4
            for (int i = 0; i < 64; ++i) { const int k = kbase + 4 * i; const f32x4 w = *(const f32x4*)(W + (size_t)k * NMODC);
#pragma unroll
                for (int v = 0; v < 5; ++v) { const float s = sc[v * D + k];
#pragma unroll
                    for (int e = 0; e < 4; ++e) acc[v][e] += s * w[e]; } }
#pragma unroll
            for (int v = 0; v < 5; ++v)
#pragma unroll
                for (int e = 0; e < 4; ++e) { float a = acc[v][e]; a += __shfl_xor(a, 16); a += __shfl_xor(a, 32); acc[v][e] = a; }
            if (kq == 0) {
#pragma unroll
                for (int v = 0; v < 5; ++v)
#pragma unroll
                    for (int e = 0; e < 4; ++e) red[(wave * 5 + v) * 64 + 4 * (lane & 15) + e] = acc[v][e]; }
            __syncthreads();
            if (tid < 320) { const int v = tid / 64, col = tid % 64; float s = 0.f;
#pragma unroll
                for (int w = 0; w < 8; ++w) s += red[(w * 5 + v) * 64 + col];
                MOD[((size_t)l * 5 + v) * NMODC + n0 + col] = s + bmod[l * NMODC + n0 + col]; }
            __syncthreads();
        }
    }
    __syncthreads();
    {
        LAS float* scr = (LAS float*)(lds + wave * 16384);
        const int gw = wave * G + blk, NGW = NW * G;
        constexpr int I_FI = 32 * 352, I_FO = 88 * 64, I_IN = 32 * 125, I_OUT = 32 * 64, I_QB = 6 * 24, I_KVB = 4 * 32;
        constexpr int T_FI = 8 * I_FI, T_FO = 8 * I_FO, T_IN = 4 * I_IN, T_OUT = 4 * I_OUT, T_QB = 4 * I_QB, T_KVB = 4 * I_KVB;
        constexpr int NITEMS = T_FI + T_FO + T_IN + T_OUT + T_QB + T_KVB;
        for (int it = gw; it < NITEMS; it += NGW) {
            int r = it;
            if (r < T_FI) { const int mat = r / I_FI; r %= I_FI; const int kb = r / 352, nb = r % 352, n0 = nb * 32;
                const int half = n0 / DFF, cc = n0 % DFF, drow0 = (cc / 128) * 256 + half * 128 + (cc % 128);
                transpose_item(p.in[7] + (size_t)mat * D * (2 * DFF), 2 * DFF, D, (bf16*)(p.ws + WS_WFFI) + (size_t)mat * (2 * DFF) * D, kb * 64, n0, drow0, scr, lane); continue; }
            r -= T_FI;
            if (r < T_FO) { const int mat = r / I_FO; r %= I_FO; const int kb = r / 64, nb = r % 64;
                transpose_item(p.in[8] + (size_t)mat * DFF * D, D, DFF, (bf16*)(p.ws + WS_WFFO) + (size_t)mat * D * DFF, kb * 64, nb * 32, nb * 32, scr, lane); continue; }
            r -= T_FO;
            if (r < T_IN) { const int mat = r / I_IN; r %= I_IN; const int kb = r / 125, nb = r % 125;
                transpose_item(p.in[9] + (size_t)mat * D * NIN, NIN, D, (bf16*)(p.ws + WS_WIN) + (size_t)mat * NINP * D, kb * 64, nb * 32, nb * 32, scr, lane); continue; }
            r -= T_IN;
            if (r < T_OUT) { const int mat = r / I_OUT; r %= I_OUT; const int kb = r / 64, nb = r % 64;
                transpose_item(p.in[10] + (size_t)mat * D * D, D, D, (bf16*)(p.ws + WS_WOUT) + (size_t)mat * D * D, kb * 64, nb * 32, nb * 32, scr, lane); continue; }
            r -= T_OUT;
            if (r < T_QB) { const int mat = r / I_QB; r %= I_QB; const int kb = r / 24, nb = r % 24;
                transpose_item(p.in[17] + (size_t)mat * 384 * 768, 768, 384, (bf16*)(p.ws + WS_WQB) + (size_t)mat * 768 * 384, kb * 64, nb * 32, nb * 32, scr, lane); continue; }
            r -= T_QB;
            { const int mat = r / I_KVB; r %= I_KVB; const int kb = r / 32, nb = r % 32;
                transpose_item(p.in[19] + (size_t)mat * 256 * 1024, 1024, 256, (bf16*)(p.ws + WS_WKVB) + (size_t)mat * 1024 * 256, kb * 64, nb * 32, nb * 32, scr, lane); }
        }
    }
    {
        const int gt = blk * NT + tid, NGT = G * NT;
        for (int i = gt; i < DEPTH * 96 * (D / 8); i += NGT) { const int l = i / (96 * (D / 8)), r = i % (96 * (D / 8));
            *(v4u*)((bf16*)(p.ws + WS_WIN) + ((size_t)l * NINP + NIN) * D + (size_t)r * 8) = (v4u){0u, 0u, 0u, 0u}; }
        const float* wg = p.in[13];
        for (int i = gt; i < DEPTH * 2048 * 64; i += NGT) { const int l = i / (2048 * 64), r = i % (2048 * 64), np = r / 64, k0 = (r % 64) * 8;
            const int c7 = np & 127, gate = (np >> 7) & 1, chunk = (np >> 8) & 3, dir = np >> 10, ch = chunk * 128 + c7, head = ch >> 6, j = ch & 63;
            v4u o = (v4u){0u, 0u, 0u, 0u};
            if ((k0 >> 6) == head) { const float* src = wg + ((((size_t)l * 2 + dir) * 2 + gate) * 8 + head) * 4096 + (size_t)(k0 & 63) * 64 + j;
                o.x = pk2(src[0], src[64]); o.y = pk2(src[128], src[192]); o.z = pk2(src[256], src[320]); o.w = pk2(src[384], src[448]); }
            *(v4u*)((bf16*)(p.ws + WS_WG) + ((size_t)l * 2048 + np) * 512 + k0) = o; }
        float* rope = (float*)(p.ws + WS_ROPE);
        for (int i = gt; i < SEQ * 32; i += NGT) { const int t = i / 32, k = i % 32; const float inv = powf(10000.f, -(float)(k & 15) / 16.f);
            const float ang = (k < 16 ? (float)(t / 64) : (float)(t % 64)) * inv; rope[i] = cosf(ang); rope[SEQ * 32 + i] = sinf(ang); }
        for (int i = gt; i < SEQ * 16; i += NGT) { const int t = i / 16, k = i % 16; const float inv = powf(10000.f, -(float)(k & 7) / 8.f);
            const float ang = (k < 8 ? (float)(t / 64) : (float)(t % 64)) * inv; rope[SEQ * 64 + i] = cosf(ang); rope[SEQ * 64 + SEQ * 16 + i] = sinf(ang); }
    }
}

__device__ __forceinline__ float row_rstd(const f32x4 (&v)[8]) {
    float s = 0.f;
#pragma unroll
    for (int j = 0; j < 8; ++j) s += (v[j][0] * v[j][0] + v[j][1] * v[j][1]) + (v[j][2] * v[j][2] + v[j][3] * v[j][3]);
    s = wave_sum(s);
    return 1.0f / sqrtf(s * (1.0f / D) + 1e-6f);
}
__device__ __forceinline__ void store_prenorm(bf16* hrow, int lane, const f32x4 (&v)[8], const float* g, const float* shift, const float* scale) {
    const float rstd = row_rstd(v);
#pragma unroll
    for (int j = 0; j < 8; ++j) { const int idx = lane + 64 * j;
        const f32x4 gg = ((const f32x4*)g)[idx], sh = ((const f32x4*)shift)[idx], sc = ((const f32x4*)scale)[idx];
        const f32x4 o = (v[j] * rstd) * gg * (sc + 1.0f) + sh;
        v2u w; w.x = pk2(o[0], o[1]); w.y = pk2(o[2], o[3]);
        *(v2u*)(hrow + 4 * idx) = w; }
}

__device__ __forceinline__ void phase_pro2(const P& p) {
    const int tid = tid_opaque(), lane = tid & 63, wave = tid >> 6, G = gridDim.x, blk = blockIdx.x;
    const int gw = wave * G + blk, NGW = NW * G;
    float* X = (float*)(p.ws + WS_X); bf16* H = (bf16*)(p.ws + WS_H); const float* MOD = (const float*)(p.ws + WS_MOD);
    for (int row = gw; row < M; row += NGW) {
        const int b = row / PB, pp = row % PB; const bool isctx = pp < CTX; const int v = isctx ? 4 : b;
        const float* src = isctx ? p.in[2] + ((size_t)b * CTX + pp) * D : p.in[0] + ((size_t)b * SEQ + (pp - CTX)) * D;
        f32x4 xv[8];
#pragma unroll
        for (int j = 0; j < 8; ++j) xv[j] = ((const f32x4*)src)[lane + 64 * j];
#pragma unroll
        for (int j = 0; j < 8; ++j) ((f32x4*)(X + (size_t)row * D))[lane + 64 * j] = xv[j];
        const float* mod = MOD + ((size_t)0 * 5 + v) * NMODC;
        store_prenorm(H + (size_t)row * D, lane, xv, p.in[6] + (size_t)(0 * 6 + 0) * D, mod + 0 * D, mod + 1 * D);
    }
}

__device__ __forceinline__ void phase_post(const P& p, int layer, int s) {
    const int tid = tid_opaque(), lane = tid & 63, wave = tid >> 6, G = gridDim.x, blk = blockIdx.x;
    const int gw = wave * G + blk, NGW = NW * G;
    float* X = (float*)(p.ws + WS_X); bf16* H = (bf16*)(p.ws + WS_H); const float* Y = (const float*)(p.ws + WS_Y); const float* MOD = (const float*)(p.ws + WS_MOD);
    const bool last = layer == DEPTH - 1, final = last && s == 2;
    const float wgt = (s == 1) ? 1.0f : 0.5f;
    const int l2 = (s < 2) ? layer : layer + 1, s2 = (s < 2) ? s + 1 : 0;
    for (int row = gw; row < M; row += NGW) {
        const int b = row / PB, pp = row % PB; const bool isctx = pp < CTX; const int v = isctx ? 4 : b;
        if (last && s >= 1 && isctx) continue;
        f32x4 yv[8], xv[8];
#pragma unroll
        for (int j = 0; j < 8; ++j) yv[j] = ((const f32x4*)(Y + (size_t)row * D))[lane + 64 * j];
#pragma unroll
        for (int j = 0; j < 8; ++j) xv[j] = ((const f32x4*)(X + (size_t)row * D))[lane + 64 * j];
        const float rstd = row_rstd(yv);
        const float* gate = MOD + ((size_t)layer * 5 + v) * NMODC + (size_t)(3 * s + 2) * D;
        const float* gpost = p.in[6] + (size_t)(layer * 6 + 2 * s + 1) * D;
        float* dst = final ? p.out + ((size_t)b * SEQ + (pp - CTX)) * D : X + (size_t)row * D;
#pragma unroll
        for (int j = 0; j < 8; ++j) { const int idx = lane + 64 * j; const f32x4 ga = ((const f32x4*)gate)[idx], gp = ((const f32x4*)gpost)[idx];
            xv[j] = xv[j] + (ga * wgt) * ((yv[j] * rstd) * gp);
            ((f32x4*)dst)[idx] = xv[j]; }
        if (!final) { const float* mod = MOD + ((size_t)l2 * 5 + v) * NMODC;
            store_prenorm(H + (size_t)row * D, lane, xv, p.in[6] + (size_t)(l2 * 6 + 2 * s2) * D, mod + (size_t)(3 * s2) * D, mod + (size_t)(3 * s2 + 1) * D); }
    }
}

template <class Epi>
__device__ __forceinline__ void run_gemm(LAS unsigned char* lds, const bf16* A, const bf16* Bt, int nMt, int N, int K, int latonly, int coff, const Epi& E) {
    pg8::Gemm g{A, Bt, M, N, K};
    TileOrder S; S.init(nMt, N, (int)gridDim.x, (int)((blockIdx.x + coff) % gridDim.x), latonly);
    pg8::gemm_phase<Epi, TileOrder, true, true>(lds, g, S, E);
}
__device__ __forceinline__ void phase_ffn_in(const P& p, LAS unsigned char* lds, int layer, int which) {
    const bool lat = (layer == DEPTH - 1) && which == 1;
    EpiSwiglu E{(bf16*)(p.ws + WS_ACT), DFF};
    run_gemm(lds, (const bf16*)(p.ws + WS_H), (const bf16*)(p.ws + WS_WFFI) + (size_t)(layer * 2 + which) * (2 * DFF) * D, lat ? 32 : 36, 2 * DFF, D, lat, 0, E);
}
__device__ __forceinline__ void phase_ffn_out(const P& p, LAS unsigned char* lds, int layer, int which) {
    const bool lat = (layer == DEPTH - 1) && which == 1;
    EpiF32 E{(float*)(p.ws + WS_Y), D};
    run_gemm(lds, (const bf16*)(p.ws + WS_ACT), (const bf16*)(p.ws + WS_WFFO) + (size_t)(layer * 2 + which) * D * DFF, lat ? 32 : 36, D, DFF, lat, 0, E);
}
__device__ __forceinline__ void phase_inproj(const P& p, LAS unsigned char* lds, int layer) {
    EpiB16 E{(bf16*)(p.ws + WS_COLS), NINP};
    run_gemm(lds, (const bf16*)(p.ws + WS_H), (const bf16*)(p.ws + WS_WIN) + (size_t)layer * NINP * D, 36, NINP, D, 0, 0, E);
}
__device__ __forceinline__ void phase_outproj(const P& p, LAS unsigned char* lds, int layer) {
    const bool lat = (layer == DEPTH - 1);
    EpiF32 E{(float*)(p.ws + WS_Y), D};
    run_gemm(lds, (const bf16*)(p.ws + WS_YMIX), (const bf16*)(p.ws + WS_WOUT) + (size_t)layer * D * D, lat ? 32 : 36, D, D, lat, 0, E);
}
__device__ __forceinline__ void phase_mgemm(const P& p, LAS unsigned char* lds, int layer) {
    { EpiB16 E{(bf16*)(p.ws + WS_QUP), 768};
      run_gemm(lds, (const bf16*)(p.ws + WS_QN), (const bf16*)(p.ws + WS_WQB) + (size_t)layer * 768 * 384, 36, 768, 384, 0, 0, E); }
    __syncthreads();
    { EpiB16 E{(bf16*)(p.ws + WS_KVUP), 1024};
      run_gemm(lds, (const bf16*)(p.ws + WS_KVN), (const bf16*)(p.ws + WS_WKVB) + (size_t)layer * 1024 * 256, 36, 1024, 256, 0, 148, E); }
    __syncthreads();
    { EpiF32 E{(float*)(p.ws + WS_GATES), 2048};
      run_gemm(lds, (const bf16*)(p.ws + WS_U), (const bf16*)(p.ws + WS_WG) + (size_t)layer * 2048 * 512, 36, 2048, 512, 0, 0, E); }
}

__device__ __forceinline__ void phase_prep(const P& p, int layer) {
    const int tid = tid_opaque(), lane = tid & 63, wave = tid >> 6, G = gridDim.x, blk = blockIdx.x;
    const int gw = wave * G + blk, NGW = NW * G;
    bf16* COLS = (bf16*)(p.ws + WS_COLS); bf16* U = (bf16*)(p.ws + WS_U); bf16* QN = (bf16*)(p.ws + WS_QN); bf16* KVN = (bf16*)(p.ws + WS_KVN);
    const float* rope = (const float*)(p.ws + WS_ROPE);
    const float* cw = p.in[11] + (size_t)layer * 4 * 512; const float* cb = p.in[12] + (size_t)layer * 512;
    const float* qg = p.in[16] + (size_t)layer * 384; const float* kvg = p.in[18] + (size_t)layer * 256;
    for (int row = gw; row < M; row += NGW) {
        const int pp = row % PB; const bool isctx = pp < CTX;
        const int lo = isctx ? 0 : CTX, hi = isctx ? CTX : PB;
        bf16* crow = COLS + (size_t)row * NINP;
#pragma unroll
        for (int cblk = 0; cblk < 8; ++cblk) { const int ch = cblk * 64 + lane; float acc = cb[ch];
#pragma unroll
            for (int j = 0; j < 4; ++j) { const int q = pp + j - 2; if (q >= lo && q < hi) acc += cw[j * 512 + ch] * bf2f(crow[(ptrdiff_t)(j - 2) * NINP + C_XB + ch]); }
            U[(size_t)row * 512 + ch] = (bf16)f2bf(acc); }
        { float v[6]; float s = 0.f;
#pragma unroll
            for (int j = 0; j < 6; ++j) { v[j] = bf2f(crow[C_MQ + lane + 64 * j]); s += v[j] * v[j]; }
            s = wave_sum(s); const float rstd = 1.0f / sqrtf(s * (1.0f / 384.f) + 1e-6f);
#pragma unroll
            for (int j = 0; j < 6; ++j) QN[(size_t)row * 384 + lane + 64 * j] = (bf16)f2bf(v[j] * rstd * qg[lane + 64 * j]); }
        { float v[4]; float s = 0.f;
#pragma unroll
            for (int j = 0; j < 4; ++j) { v[j] = bf2f(crow[C_MKV + lane + 64 * j]); s += v[j] * v[j]; }
            s = wave_sum(s); const float rstd = 1.0f / sqrtf(s * (1.0f / 256.f) + 1e-6f);
#pragma unroll
            for (int j = 0; j < 4; ++j) KVN[(size_t)row * 256 + lane + 64 * j] = (bf16)f2bf(v[j] * rstd * kvg[lane + 64 * j]); }
        if (!isctx) { const int t = pp - CTX; const int i = lane & 31, hsel = lane >> 5;
            const float c = rope[t * 32 + i], sn = rope[SEQ * 32 + t * 32 + i];
#pragma unroll
            for (int hp = 0; hp < 13; ++hp) { const int hd = hp * 2 + hsel; const int base = hd < 16 ? C_DQ + hd * 64 : C_GQ + (hd - 16) * 64;
                const float x1 = bf2f(crow[base + i]), x2 = bf2f(crow[base + 32 + i]);
                crow[base + i] = (bf16)f2bf(x1 * c - x2 * sn); crow[base + 32 + i] = (bf16)f2bf(x1 * sn + x2 * c); }
            if (lane < 16) { const float c2 = rope[SEQ * 64 + t * 16 + lane], s2 = rope[SEQ * 64 + SEQ * 16 + t * 16 + lane];
                const float x1 = bf2f(crow[C_MKR + lane]), x2 = bf2f(crow[C_MKR + 16 + lane]);
                crow[C_MKR + lane] = (bf16)f2bf(x1 * c2 - x2 * s2); crow[C_MKR + 16 + lane] = (bf16)f2bf(x1 * s2 + x2 * c2); }
        }
    }
}

__device__ __forceinline__ void phase_prep2(const P& p, int layer) {
    const int tid = tid_opaque(), lane = tid & 63, wave = tid >> 6, G = gridDim.x, blk = blockIdx.x;
    const int gw = wave * G + blk, NGW = NW * G;
    const bf16* COLS = (const bf16*)(p.ws + WS_COLS); const bf16* U = (const bf16*)(p.ws + WS_U);
    const bf16* QUP = (const bf16*)(p.ws + WS_QUP); const bf16* KVUP = (const bf16*)(p.ws + WS_KVUP);
    bf16* QM = (bf16*)(p.ws + WS_QM); bf16* KM = (bf16*)(p.ws + WS_KM);
    const float* GATES = (const float*)(p.ws + WS_GATES); f32x2* AB = (f32x2*)(p.ws + WS_AB);
    const float* rope = (const float*)(p.ws + WS_ROPE);
    const float* bg = p.in[14] + (size_t)layer * 2 * 2 * 512; const float* lam = p.in[15] + (size_t)layer * 2 * 512;
    for (int row = gw; row < M; row += NGW) {
        const int pp = row % PB; const bool isctx = pp < CTX; const int t = pp - CTX;
#pragma unroll
        for (int j = 0; j < 12; ++j) { const int e = lane + 64 * j, h = e / 96, d = e % 96;
            float qv = bf2f(QUP[(size_t)row * 768 + e]);
            if (d >= 64 && !isctx) { const int i = (d - 64) & 15; const bool second = (d - 64) >= 16;
                const float c = rope[SEQ * 64 + t * 16 + i], sn = rope[SEQ * 64 + SEQ * 16 + t * 16 + i];
                const float x1 = bf2f(QUP[(size_t)row * 768 + h * 96 + 64 + i]), x2 = bf2f(QUP[(size_t)row * 768 + h * 96 + 80 + i]);
                qv = second ? (x1 * sn + x2 * c) : (x1 * c - x2 * sn); }
            QM[(size_t)row * 768 + e] = (bf16)f2bf(qv);
            KM[(size_t)row * 768 + e] = d < 64 ? KVUP[(size_t)row * 1024 + h * 128 + d] : COLS[(size_t)row * NINP + C_MKR + (d - 64)]; }
#pragma unroll
        for (int dir = 0; dir < 2; ++dir)
#pragma unroll
            for (int cblk = 0; cblk < 8; ++cblk) { const int ch = cblk * 64 + lane;
                const float* gp = GATES + (size_t)row * 2048 + ((dir * 4 + (ch >> 7)) * 2) * 128 + (ch & 127);
                const float gr = gp[0] + bg[(dir * 2 + 0) * 512 + ch], gi = gp[128] + bg[(dir * 2 + 1) * 512 + ch];
                const float r = 1.f / (1.f + expf(-gr)), ig = 1.f / (1.f + expf(-gi));
                const float sp = log1pf(expf(-lam[dir * 512 + ch]));
                const float log_a = -8.0f * r * sp, a = expf(log_a);
                const float u = bf2f(U[(size_t)row * 512 + ch]);
                const float bco = sqrtf(-expm1f(2.0f * log_a)) * (ig * u);
                AB[((size_t)dir * M + row) * 512 + ch] = (f32x2){a, bco}; }
    }
}

template <int DQK, int DV, int MODE, bool OUTF32>
__device__ __forceinline__ void naive_attn(const bf16* Q, int qs, const bf16* K, int ks, const bf16* V, int vs, void* O, int os,
                                           int b, int pp0, int lane, float scale, float sink) {
    const size_t rowbase = (size_t)b * PB; const int pp = pp0 + lane;
    float q[DQK], o[DV];
    { const bf16* qr = Q + (rowbase + pp) * qs;
#pragma unroll
      for (int c = 0; c < DQK / 8; ++c) { const v4u w = *(const v4u*)(qr + 8 * c);
          q[8 * c + 0] = bflo(w.x); q[8 * c + 1] = bfhi(w.x); q[8 * c + 2] = bflo(w.y); q[8 * c + 3] = bfhi(w.y);
          q[8 * c + 4] = bflo(w.z); q[8 * c + 5] = bfhi(w.z); q[8 * c + 6] = bflo(w.w); q[8 * c + 7] = bfhi(w.w); } }
    const float sl2 = scale * 1.4426950408889634f;
#pragma unroll
    for (int d = 0; d < DQK; ++d) q[d] *= sl2;
#pragma unroll
    for (int e = 0; e < DV; ++e) o[e] = 0.f;
    float m = (MODE == 1) ? sink * 1.4426950408889634f : -1e30f, l = (MODE == 1) ? 1.f : 0.f;
    const bool isctx = pp0 < CTX; const int t = pp - CTX, t0 = pp0 - CTX;
    for (int seg = 0; seg < 2; ++seg) {
        int k0, k1;
        if (seg == 0) { k0 = 0; k1 = CTX; }
        else { if (isctx) break;
            if (MODE == 0) { k0 = CTX; k1 = PB; }
            else { const int a0 = t0 - 128 < 0 ? 0 : t0 - 128, a1 = t0 + 63 + 128 > SEQ - 1 ? SEQ - 1 : t0 + 63 + 128; k0 = CTX + a0; k1 = CTX + a1 + 1; } }
        for (int key = k0; key < k1; ++key) {
            const bf16* kr = K + (rowbase + key) * ks; const bf16* vr = V + (rowbase + key) * vs;
            asm volatile("" : "+v"(kr)); asm volatile("" : "+v"(vr));
            float s = 0.f;
#pragma unroll
            for (int c = 0; c < DQK / 8; ++c) { const v4u w = *(const v4u*)(kr + 8 * c);
                s += q[8 * c + 0] * bflo(w.x); s += q[8 * c + 1] * bfhi(w.x); s += q[8 * c + 2] * bflo(w.y); s += q[8 * c + 3] * bfhi(w.y);
                s += q[8 * c + 4] * bflo(w.z); s += q[8 * c + 5] * bfhi(w.z); s += q[8 * c + 6] * bflo(w.w); s += q[8 * c + 7] * bfhi(w.w); }
            bool valid = true;
            if (MODE == 1 && seg == 1) { const int rel = (key - CTX) - t; valid = (rel <= 128) && (rel >= -128); }
            if (valid) {
                const float mn = fmaxf(m, s), alpha = exp2f(m - mn), pr = exp2f(s - mn);
                l = l * alpha + pr; m = mn;
#pragma unroll
                for (int c = 0; c < DV / 8; ++c) { const v4u w = *(const v4u*)(vr + 8 * c);
                    o[8 * c + 0] = o[8 * c + 0] * alpha + pr * bflo(w.x); o[8 * c + 1] = o[8 * c + 1] * alpha + pr * bfhi(w.x);
                    o[8 * c + 2] = o[8 * c + 2] * alpha + pr * bflo(w.y); o[8 * c + 3] = o[8 * c + 3] * alpha + pr * bfhi(w.y);
                    o[8 * c + 4] = o[8 * c + 4] * alpha + pr * bflo(w.z); o[8 * c + 5] = o[8 * c + 5] * alpha + pr * bfhi(w.z);
                    o[8 * c + 6] = o[8 * c + 6] * alpha + pr * bflo(w.w); o[8 * c + 7] = o[8 * c + 7] * alpha + pr * bfhi(w.w); }
            }
        }
    }
    const float il = 1.f / l;
    if (OUTF32) { float* orow = (float*)O + (rowbase + pp) * os;
#pragma unroll
        for (int e = 0; e < DV; e += 4) *(f32x4*)(orow + e) = (f32x4){o[e] * il, o[e + 1] * il, o[e + 2] * il, o[e + 3] * il}; }
    else { bf16* orow = (bf16*)O + (rowbase + pp) * os;
#pragma unroll
        for (int e = 0; e < DV; e += 8) { v4u w; w.x = pk2(o[e] * il, o[e + 1] * il); w.y = pk2(o[e + 2] * il, o[e + 3] * il); w.z = pk2(o[e + 4] * il, o[e + 5] * il); w.w = pk2(o[e + 6] * il, o[e + 7] * il);
            *(v4u*)(orow + e) = w; } }
}

__device__ __forceinline__ void phase_att(const P& p, int layer) {
    const int tid = tid_opaque(), lane = tid & 63, wave = __builtin_amdgcn_readfirstlane(tid >> 6), G = gridDim.x, blk = blockIdx.x;
    const int gw = wave * G + blk, NGW = NW * G;
    const bool last = layer == DEPTH - 1;
    const bf16* COLS = (const bf16*)(p.ws + WS_COLS); const bf16* KVUP = (const bf16*)(p.ws + WS_KVUP);
    const bf16* QM = (const bf16*)(p.ws + WS_QM); const bf16* KM = (const bf16*)(p.ws + WS_KM);
    bf16* YMIX = (bf16*)(p.ws + WS_YMIX); float* DIFFO = (float*)(p.ws + WS_DIFFO);
    const f32x2* AB = (const f32x2*)(p.ws + WS_AB); float* HS = (float*)(p.ws + WS_HS);
    constexpr int N_SCAN = 64, N_MLA = NB * 8 * 36, N_DIFF = NB * 8 * 2 * 36, N_GQA = NB * 8 * 36;
    for (int it = gw; it < N_SCAN + N_MLA + N_DIFF + N_GQA; it += NGW) {
        int r = it;
        if (r < N_SCAN) {
            const int b = r >> 4, dir = (r >> 3) & 1, ch = (r & 7) * 64 + lane;
            const f32x2* ab = AB + ((size_t)dir * M + (size_t)b * PB) * 512 + ch; float* hs = HS + ((size_t)dir * M + (size_t)b * PB) * 512 + ch;
            float h = 0.f;
            if (dir == 0) {
#pragma unroll 8
                for (int q = 0; q < PB; ++q) { const f32x2 c = ab[(size_t)q * 512]; h = c.x * h + c.y; hs[(size_t)q * 512] = h; }
            } else {
#pragma unroll 8
                for (int q = CTX - 1; q >= 0; --q) { const f32x2 c = ab[(size_t)q * 512]; h = c.x * h + c.y; hs[(size_t)q * 512] = h; }
#pragma unroll 8
                for (int q = PB - 1; q >= CTX; --q) { const f32x2 c = ab[(size_t)q * 512]; h = c.x * h + c.y; hs[(size_t)q * 512] = h; }
            }
            continue; }
        r -= N_SCAN;
        if (r < N_MLA) { const int b = r / 288, hh = (r / 36) % 8, pp0 = (r % 36) * 64;
            if (last && pp0 < CTX) continue;
            naive_attn<96, 64, 0, false>(QM + hh * 96, 768, KM + hh * 96, 768, KVUP + hh * 128 + 64, 1024, YMIX + 512 + hh * 64, 2048, b, pp0, lane, 0.10206207261596575f, 0.f);
            continue; }
        r -= N_MLA;
        if (r < N_DIFF) { const int b = r / 576, ph = (r / 72) % 8, vh = (r / 36) % 2, pp0 = (r % 36) * 64;
            if (last && pp0 < CTX) continue;
            naive_attn<64, 64, 0, true>(COLS + C_DQ + ph * 64, NINP, COLS + C_DK + ph * 64, NINP, COLS + C_DV + (ph >> 1) * 128 + vh * 64, NINP, DIFFO + ph * 128 + vh * 64, 1024, b, pp0, lane, 0.125f, 0.f);
            continue; }
        r -= N_DIFF;
        { const int b = r / 288, hq = (r / 36) % 8, pp0 = (r % 36) * 64;
            if (last && pp0 < CTX) continue;
            const float sink = p.in[22][layer * 8 + hq];
            naive_attn<64, 64, 1, false>(COLS + C_GQ + hq * 64, NINP, COLS + C_GK + (hq >> 2) * 64, NINP, COLS + C_GV + (hq >> 2) * 64, NINP, YMIX + 1536 + hq * 64, 2048, b, pp0, lane, 0.125f, sink); }
    }
}

__device__ __forceinline__ void phase_mixfin(const P& p, int layer) {
    const int tid = tid_opaque(), lane = tid & 63, wave = tid >> 6, G = gridDim.x, blk = blockIdx.x;
    const int gw = wave * G + blk, NGW = NW * G;
    const bool last = layer == DEPTH - 1;
    const bf16* COLS = (const bf16*)(p.ws + WS_COLS); bf16* YMIX = (bf16*)(p.ws + WS_YMIX); const float* DIFFO = (const float*)(p.ws + WS_DIFFO); const float* HS = (const float*)(p.ws + WS_HS);
    const float* lv = p.in[20] + (size_t)layer * 4 * 64; const float* dg = p.in[21] + (size_t)layer * 128;
    const float lam_init = 0.8f - 0.6f * expf(-0.3f * (float)layer);
    const float lam = expf(wave_sum(lv[lane] * lv[64 + lane])) - expf(wave_sum(lv[128 + lane] * lv[192 + lane])) + lam_init;
    for (int row = gw; row < M; row += NGW) {
        const int pp = row % PB; if (last && pp < CTX) continue;
#pragma unroll
        for (int cblk = 0; cblk < 8; ++cblk) { const int ch = cblk * 64 + lane;
            const float hsum = HS[(size_t)row * 512 + ch] + HS[((size_t)M + row) * 512 + ch];
            const float gt = bf2f(COLS[(size_t)row * NINP + C_GATE + ch]);
            YMIX[(size_t)row * 2048 + ch] = (bf16)f2bf(hsum * gelu_tanh(gt)); }
#pragma unroll
        for (int hh = 0; hh < 4; ++hh) { float o[2]; float s = 0.f;
#pragma unroll
            for (int j = 0; j < 2; ++j) { const int e = lane + 64 * j;
                o[j] = DIFFO[(size_t)row * 1024 + (2 * hh) * 128 + e] - lam * DIFFO[(size_t)row * 1024 + (2 * hh + 1) * 128 + e]; s += o[j] * o[j]; }
            s = wave_sum(s); const float rstd = 1.0f / sqrtf(s * (1.0f / 128.f) + 1e-6f);
#pragma unroll
            for (int j = 0; j < 2; ++j) { const int e = lane + 64 * j; YMIX[(size_t)row * 2048 + 1024 + hh * 128 + e] = (bf16)f2bf(o[j] * rstd * dg[e] * (1.0f - lam_init)); } }
    }
}


#define XB_TMO      128
#define XB_XCNT(j)  (256  + 64 * (j))
#define XB_XSUB(j)  (1280 + 64 * (j))
#define XB_XGEN(j)  (2304 + 64 * (j))
#define XB_TOP      3328
#define XB_TOPGEN   3392
#define XCD_BAR_WORDS 3456
#define XB_SPIN_CAP (1u << 18)

__device__ __forceinline__ unsigned xb_ld(unsigned* p)              { return __hip_atomic_load(p, __ATOMIC_RELAXED, __HIP_MEMORY_SCOPE_AGENT); }
__device__ __forceinline__ unsigned xb_add(unsigned* p, unsigned v) { return __hip_atomic_fetch_add(p, v, __ATOMIC_RELAXED, __HIP_MEMORY_SCOPE_AGENT); }
__device__ __forceinline__ unsigned xb_xcc_id() { return (unsigned)__builtin_amdgcn_s_getreg((3 << 11) | 20) & 0xFu; }
#define XB_SPIN(cond, bar) do { unsigned _sp = 0; while (cond) { __builtin_amdgcn_s_sleep(1); \
    if ((++_sp & 255u) == 0u) { if (xb_ld(&(bar)[XB_TMO])) break; if (_sp > XB_SPIN_CAP) { atomicAdd(&(bar)[XB_TMO], 1u); break; } } } } while (0)

struct XcdBarrier {
    unsigned* bar; unsigned x;
    volatile LAS unsigned* st;
};

__device__ __forceinline__ XcdBarrier xcd_barrier_post(unsigned* bar, volatile LAS unsigned* st) {
    XcdBarrier b; b.bar = bar; b.x = xb_xcc_id(); b.st = st;
    if (threadIdx.x == 0) (void)xb_add(&bar[XB_XCNT(b.x)], 1u);
    return b;
}
__device__ __forceinline__ void xcd_barrier_complete(unsigned* bar, unsigned x, unsigned& nloc, unsigned& nx) {
    const unsigned G = gridDim.x * gridDim.y * gridDim.z;
    unsigned sum, cnt, mine, sp = 0u;
    for (;;) {
        sum = 0u; cnt = 0u; mine = 0u;
#pragma unroll
        for (unsigned j = 0; j < 16; ++j) { const unsigned c = xb_ld(&bar[XB_XCNT(j)]); sum += c; cnt += (c > 0u) ? 1u : 0u; mine = (j == x) ? c : mine; }
        if (sum == G) break;
        __builtin_amdgcn_s_sleep(1);
        if ((++sp & 255u) == 0u) { if (xb_ld(&bar[XB_TMO])) break; if (sp > XB_SPIN_CAP) { atomicAdd(&bar[XB_TMO], 1u); break; } }
    }
    nloc = mine > 0u ? mine : 1u; nx = cnt > 0u ? cnt : 1u;
}

__device__ __forceinline__ void xcd_barrier(const XcdBarrier& b) {
    asm volatile("s_waitcnt vmcnt(0)" ::: "memory");
    __syncthreads();
    if (threadIdx.x == 0) {
        unsigned* bar = b.bar; const unsigned bx = xb_xcc_id();
        __builtin_amdgcn_s_waitcnt(0);
        unsigned nloc = b.st[0], nx = b.st[1];
        if (nloc == 0u) { xcd_barrier_complete(bar, bx, nloc, nx); b.st[0] = nloc; b.st[1] = nx; }
        const unsigned old = xb_add(&bar[XB_XSUB(bx)], 1u);
        const unsigned gen = old / nloc;
        if (old + 1u == (gen + 1u) * nloc) {
            __builtin_amdgcn_fence(__ATOMIC_RELEASE, "agent");
            asm volatile("s_waitcnt vmcnt(0)" ::: "memory");
            const unsigned og = xb_add(&bar[XB_TOP], 1u);
            const unsigned tg = og / nx;
            if (og + 1u == (tg + 1u) * nx) xb_add(&bar[XB_TOPGEN], 1u);
            else XB_SPIN(xb_ld(&bar[XB_TOPGEN]) == tg, bar);
            __builtin_amdgcn_fence(__ATOMIC_ACQUIRE, "agent");
            xb_add(&bar[XB_XGEN(bx)], 1u);
            asm volatile("s_waitcnt vmcnt(0)" ::: "memory");
        } else {
            XB_SPIN(xb_ld(&bar[XB_XGEN(bx)]) == gen, bar);
            __builtin_amdgcn_fence(__ATOMIC_ACQUIRE, "agent");
            asm volatile("s_waitcnt vmcnt(0)" ::: "memory");
        }
    }
    __syncthreads();
}

constexpr int CW_BAR = 4096;
constexpr size_t CTL_ZERO_BYTES = 1 * MiB;
constexpr int LDSCTL_OFF = 131072, MISC_OFF = LDSCTL_OFF + 320;

__global__ void __launch_bounds__(NT, 2) k_mega(P p) {
    extern __shared__ __attribute__((aligned(16))) unsigned char lds_raw[];
    LAS unsigned char* lds = (LAS unsigned char*)lds_raw;
    for (int u = threadIdx.x; u < (LDS_BYTES - LDSCTL_OFF) / 4; u += NT) ((LAS unsigned*)(lds + LDSCTL_OFF))[u] = 0u;
    __syncthreads();
    unsigned* barw = (unsigned*)(p.ws + WS_CTL) + CW_BAR;
    XcdBarrier bar = xcd_barrier_post(barw, (volatile LAS unsigned*)(lds + MISC_OFF) + 8);
#define GB() xcd_barrier(bar)
    phase_pro1(p, lds); GB();
    phase_pro2(p); GB();
    for (int l = 0; l < DEPTH; ++l) {
        for (int which = 0; which < 2; ++which) {
            phase_ffn_in(p, lds, l, which); GB();
            phase_ffn_out(p, lds, l, which); GB();
            phase_post(p, l, which == 0 ? 0 : 2); GB();
            if (which == 0) {
                phase_inproj(p, lds, l); GB();
                phase_prep(p, l); GB();
                phase_mgemm(p, lds, l); GB();
                phase_prep2(p, l); GB();
                phase_att(p, l); GB();
                phase_mixfin(p, l); GB();
                phase_outproj(p, lds, l); GB();
                phase_post(p, l, 1); GB();
            }
        }
    }
#undef GB
    if (__hip_atomic_load(barw + XB_TMO, __ATOMIC_RELAXED, __HIP_MEMORY_SCOPE_AGENT) != 0u) {
        const float q = __builtin_nanf("");
        for (size_t i = (size_t)blockIdx.x * NT + threadIdx.x; i < (size_t)NB * SEQ * D; i += (size_t)gridDim.x * NT) p.out[i] = q;
    }
}

extern "C" void kernel_launch(void* const* d_in, const int* in_sizes, int n_in, void* d_out, int out_size, void* d_ws, size_t ws_size, hipStream_t stream) {
    static int grid = 0;
    if (grid == 0) {
        if (n_in != 23 || out_size != NB * SEQ * D || ws_size < WS_END) { fprintf(stderr, "kernel_launch: unexpected shapes (n_in %d out %d ws %zu need %zu)\n", n_in, out_size, ws_size, (size_t)WS_END); grid = -1; return; }
        int dev = 0, cus = 0, per_cu = 0;
        if (hipGetDevice(&dev) != hipSuccess || hipDeviceGetAttribute(&cus, hipDeviceAttributeMultiprocessorCount, dev) != hipSuccess) { grid = -1; return; }
        if (hipFuncSetAttribute((const void*)k_mega, hipFuncAttributeMaxDynamicSharedMemorySize, LDS_BYTES) != hipSuccess) { fprintf(stderr, "kernel_launch: hipFuncSetAttribute failed\n"); grid = -1; return; }
        if (hipOccupancyMaxActiveBlocksPerMultiprocessor(&per_cu, (const void*)k_mega, NT, LDS_BYTES) != hipSuccess || per_cu < 1)
            fprintf(stderr, "kernel_launch: note: occupancy query reports %d workgroups per CU\n", per_cu);
        (void)hipGetLastError();
        grid = cus;
    }
    if (grid < 0) return;
    if (hipMemsetAsync((char*)d_ws + WS_CTL, 0, CTL_ZERO_BYTES, stream) != hipSuccess) { fprintf(stderr, "kernel_launch: memset failed\n"); return; }
    P p{};
    for (int i = 0; i < 23; ++i) p.in[i] = (const float*)d_in[i];
    p.out = (float*)d_out; p.ws = (unsigned char*)d_ws;
    hipLaunchKernelGGL(k_mega, dim3(grid), dim3(NT), LDS_BYTES, stream, p);
}
```

```cpp
#include <hip/hip_runtime.h>
#include <cstdio>
#include <cstdint>
__device__ __forceinline__ int opq_s(int x) { asm volatile("" : "+s"(x)); return x; }
__device__ __forceinline__ unsigned char* opq_p(unsigned char* x) { asm volatile("" : "+s"(x)); return x; }
__device__ __forceinline__ int tid_opaque() { int t = (int)threadIdx.x; asm volatile("" : "+v"(t)); return t; }
namespace pg8 {
#define PG8_LAS __attribute__((address_space(3)))
typedef unsigned short bf16_t;
typedef short bf16x8 __attribute__((ext_vector_type(8)));
typedef float f32x4 __attribute__((ext_vector_type(4)));
typedef unsigned u32x4 __attribute__((ext_vector_type(4)));
constexpr int BM = 256, BK = 64, HALF = 128, HTB = HALF * BK * 2  , STAGE_BYTES = 8 * HTB, NXCD = 8, WGM = 8;

__host__ __device__ __forceinline__ int lds_byte(int r, int c) { const int st = (r >> 4) * 2 + (c >> 5), rr = r & 15, cc = c & 31, ob = rr * 64 + cc * 2; return st * 1024 + (ob ^ (((ob >> 9) & 1) << 5)); }
__host__ __device__ __forceinline__ void stage_rc(int b, int& R, int& C) { const int st = b / 1024, sb = b % 1024, swz = sb ^ (((sb >> 9) & 1) << 5); R = (st >> 1) * 16 + swz / 64; C = (st & 1) * 32 + (swz % 64) / 2; }
__host__ __device__ __forceinline__ int perm32(int rho) { const int n = rho >> 4, i = rho & 15; return 8 * (i >> 2) + 4 * n + (i & 3); }

struct Unit { int pm, pn; };
struct Gemm { const bf16_t* A; const bf16_t* Bt; int M, N, K; };

struct StaticOrder {
    int nM, nN, nwg, G, c;
    __host__ __device__ void init(int M, int N, int G_, int c_) { nM = M / BM; nN = N / BM; nwg = nM * nN; G = G_; c = c_; }
    __host__ __device__ bool next(int i, Unit& u) const {
        const long L = (long)i * G + c; if (L >= nwg) return false;
        int wgid = (int)L; { const int q = nwg / NXCD, r = nwg % NXCD, xcd = wgid % NXCD, off = wgid / NXCD; wgid = (xcd < r ? xcd * (q + 1) : r * (q + 1) + (xcd - r) * q) + off; }
        const int nig = WGM * nN, gid = wgid / nig, fm = gid * WGM, gsz = (nM - fm) < WGM ? (nM - fm) : WGM;
        u.pm = fm + ((wgid % nig) % gsz); u.pn = (wgid % nig) / gsz; return true;
    }
    __device__ __forceinline__ void a_ready(const Unit&) const {}
    __device__ __forceinline__ void done(const Unit&) const {}
};

__device__ __forceinline__ unsigned cvt_pk_bf16(float lo, float hi) { unsigned r; asm volatile("v_cvt_pk_bf16_f32 %0, %1, %2" : "=v"(r) : "v"(lo), "v"(hi)); return r; }
typedef float f32x2 __attribute__((ext_vector_type(2)));
}
namespace pg8 {
template <class Epi, class Sched, bool ALIGN_EPI = false, bool SP2 = false>
__device__ __forceinline__ void gemm_phase(PG8_LAS unsigned char* lds, const Gemm g, const Sched& S, const Epi& E) {
    const int tid = tid_opaque(), wid = __builtin_amdgcn_readfirstlane(tid >> 6), lane = tid & 63, wr = wid >> 2, wc = wid & 3, fr = lane & 15, fq = lane >> 4;
    const int K = g.K, nt = K / BK;
    unsigned voffA[2], voffB[2];
#pragma unroll
    for (int i = 0; i < 2; ++i) { int R, C; stage_rc(tid * 16 + i * 8192, R, C); const int Rb = Epi::PERM ? ((R & ~31) + perm32(R & 31)) : R;
        voffA[i] = (unsigned)(R * K + C) * 2u; voffB[i] = (unsigned)(Rb * K + C) * 2u; }
    const size_t kstep = (size_t)(BK * 2);
    const size_t hstep = (size_t)HALF * K * 2;
    const size_t tstep = 2 * hstep;
    const unsigned ldsw = (unsigned)wid * 1024u;
    const int aoff = lds_byte(wr * 64 + fr, fq * 8), boff = lds_byte(wc * 32 + fr, fq * 8);
#define PG8_SA(b, h) (((b) * 2 + (h)) * HTB)
#define PG8_SB(b, h) ((4 + (b) * 2 + (h)) * HTB)
#define PG8_STAGE(bufoff, gbase, voff) do { _Pragma("unroll") for (int _i = 0; _i < 2; ++_i) \
        __builtin_amdgcn_global_load_lds((const unsigned*)((const char*)(gbase) + (voff)[_i]), (PG8_LAS unsigned*)(lds + (bufoff) + ldsw + _i * 8192), 16, 0, 0); } while (0)
#define PG8_LDA(dst, b, h) do { _Pragma("unroll") for (int m = 0; m < 4; ++m) _Pragma("unroll") for (int k = 0; k < 2; ++k) dst[m][k] = *(const PG8_LAS bf16x8*)(lds + PG8_SA(b, h) + aoff + m * 2048 + k * 1024); } while (0)
#define PG8_LDB(dst, b, h) do { _Pragma("unroll") for (int n = 0; n < 2; ++n) _Pragma("unroll") for (int k = 0; k < 2; ++k) dst[n][k] = *(const PG8_LAS bf16x8*)(lds + PG8_SB(b, h) + boff + n * 2048 + k * 1024); } while (0)
#define PG8_MMA(ai, bj, At, Bt) do { __builtin_amdgcn_s_setprio(1); _Pragma("unroll") for (int m = 0; m < 4; ++m) _Pragma("unroll") for (int n = 0; n < 2; ++n) _Pragma("unroll") for (int k = 0; k < 2; ++k) \
        acc[ai][bj][m][n] = __builtin_amdgcn_mfma_f32_16x16x32_bf16(Bt[n][k], At[m][k], acc[ai][bj][m][n], 0, 0, 0); __builtin_amdgcn_s_setprio(0); } while (0)
#define PG8_WAIT_V(n) asm volatile("s_waitcnt vmcnt(" #n ")" ::: "memory")
#define PG8_WAIT_L(n) asm volatile("s_waitcnt lgkmcnt(" #n ")" ::: "memory")
#define PG8_BAR __builtin_amdgcn_s_barrier()
#define PG8_SCHED __builtin_amdgcn_sched_barrier(0)
    Unit cur, nxt; int ui = 0;
    if (!S.next(0, cur)) return;
    f32x4 acc[2][2][4][2];
#pragma unroll
    for (int a = 0; a < 2; ++a)
#pragma unroll
        for (int b = 0; b < 2; ++b)
#pragma unroll
            for (int m = 0; m < 4; ++m)
#pragma unroll
                for (int n = 0; n < 2; ++n) acc[a][b][m][n] = (f32x4){0.f, 0.f, 0.f, 0.f};
    bf16x8 At[4][2], B0[2][2], B1[2][2];
    const char* cA = (const char*)g.A + (size_t)cur.pm * tstep; const char* cB = (const char*)g.Bt + (size_t)cur.pn * tstep;
    S.a_ready(cur);
    if constexpr (SP2) {
        PG8_STAGE(PG8_SB(0, 0), cB, voffB); PG8_STAGE(PG8_SB(0, 1), cB + hstep, voffB); PG8_STAGE(PG8_SA(0, 0), cA, voffA); PG8_STAGE(PG8_SA(0, 1), cA + hstep, voffA);
        if (wr == 1) PG8_BAR;
        PG8_WAIT_V(2); PG8_BAR;
        PG8_STAGE(PG8_SB(1, 0), cB + kstep, voffB); PG8_STAGE(PG8_SA(1, 0), cA + kstep, voffA); PG8_STAGE(PG8_SB(1, 1), cB + hstep + kstep, voffB);
        PG8_WAIT_V(6); PG8_BAR;
    } else {
        PG8_STAGE(PG8_SB(0, 0), cB, voffB); PG8_STAGE(PG8_SA(0, 0), cA, voffA); PG8_STAGE(PG8_SB(0, 1), cB + hstep, voffB); PG8_STAGE(PG8_SA(0, 1), cA + hstep, voffA);
        if (wr == 1) PG8_BAR;
        PG8_WAIT_V(4); PG8_BAR;
        PG8_STAGE(PG8_SB(1, 0), cB + kstep, voffB); PG8_STAGE(PG8_SA(1, 0), cA + kstep, voffA); PG8_STAGE(PG8_SB(1, 1), cB + hstep + kstep, voffB);
        PG8_WAIT_V(6); PG8_BAR;
    }
    for (;;) {
        const bool has_next = S.next(ui + 1, nxt);
        const char* nA = has_next ? (const char*)g.A + (size_t)nxt.pm * tstep : cA; const char* nB = has_next ? (const char*)g.Bt + (size_t)nxt.pn * tstep : cB;
        for (int t = 0; t < nt; t += 2) {
            const bool last = (t == nt - 2);
            const char* a1 = cA + (size_t)(t + 1) * kstep;
            const char* a2 = last ? nA : cA + (size_t)(t + 2) * kstep; const char* b2 = last ? nB : cB + (size_t)(t + 2) * kstep;
            const char* a3 = a2 + kstep; const char* b3 = b2 + kstep;
            if (last && has_next) S.a_ready(nxt);
            if constexpr (SP2) {
            PG8_LDB(B0, 0, 0); PG8_LDB(B1, 0, 1); PG8_SCHED; PG8_LDA(At, 0, 0); PG8_STAGE(PG8_SA(1, 1), a1 + hstep, voffA);
            PG8_WAIT_V(8); PG8_WAIT_L(0); PG8_BAR; PG8_MMA(0, 0, At, B0); PG8_MMA(0, 1, At, B1); PG8_BAR; PG8_SCHED;
            PG8_LDA(At, 0, 1); PG8_STAGE(PG8_SB(0, 0), b2, voffB); PG8_STAGE(PG8_SB(0, 1), b2 + hstep, voffB); PG8_STAGE(PG8_SA(0, 0), a2, voffA);
            PG8_WAIT_V(8); PG8_WAIT_L(0); PG8_BAR; PG8_MMA(1, 0, At, B0); PG8_MMA(1, 1, At, B1); PG8_BAR; PG8_SCHED;
            PG8_LDB(B0, 1, 0); PG8_LDB(B1, 1, 1); PG8_SCHED; PG8_LDA(At, 1, 0); PG8_STAGE(PG8_SA(0, 1), a2 + hstep, voffA);
            PG8_WAIT_V(8); PG8_WAIT_L(0); PG8_BAR; PG8_MMA(0, 0, At, B0); PG8_MMA(0, 1, At, B1); PG8_BAR; PG8_SCHED;
            PG8_LDA(At, 1, 1); PG8_STAGE(PG8_SB(1, 0), b3, voffB); PG8_STAGE(PG8_SB(1, 1), b3 + hstep, voffB); PG8_STAGE(PG8_SA(1, 0), a3, voffA);
            PG8_WAIT_V(8); PG8_WAIT_L(0); PG8_BAR; PG8_MMA(1, 0, At, B0); PG8_MMA(1, 1, At, B1); PG8_BAR; PG8_SCHED;
            } else {
            PG8_LDB(B0, 0, 0); PG8_SCHED; PG8_LDA(At, 0, 0); PG8_STAGE(PG8_SA(1, 1), a1 + hstep, voffA);
            PG8_WAIT_L(8); PG8_BAR; PG8_WAIT_L(0); PG8_MMA(0, 0, At, B0); PG8_BAR; PG8_SCHED;
            PG8_LDB(B1, 0, 1); PG8_STAGE(PG8_SB(0, 0), b2, voffB);
            PG8_BAR; PG8_WAIT_L(0); PG8_MMA(0, 1, At, B1); PG8_BAR;
            PG8_LDA(At, 0, 1); PG8_STAGE(PG8_SA(0, 0), a2, voffA);
            PG8_BAR; PG8_WAIT_L(0); PG8_MMA(1, 0, At, B0); PG8_BAR; PG8_SCHED;
            PG8_STAGE(PG8_SB(0, 1), b2 + hstep, voffB);
            PG8_WAIT_V(6); PG8_BAR; PG8_MMA(1, 1, At, B1); PG8_BAR;
            PG8_LDB(B0, 1, 0); PG8_SCHED; PG8_LDA(At, 1, 0); PG8_STAGE(PG8_SA(0, 1), a2 + hstep, voffA);
            PG8_WAIT_L(8); PG8_BAR; PG8_WAIT_L(0); PG8_MMA(0, 0, At, B0); PG8_BAR; PG8_SCHED;
            PG8_LDB(B1, 1, 1); PG8_STAGE(PG8_SB(1, 0), b3, voffB);
            PG8_BAR; PG8_WAIT_L(0); PG8_MMA(0, 1, At, B1); PG8_BAR;
            PG8_LDA(At, 1, 1); PG8_STAGE(PG8_SA(1, 0), a3, voffA);
            PG8_BAR; PG8_WAIT_L(0); PG8_MMA(1, 0, At, B0); PG8_BAR; PG8_SCHED;
            PG8_STAGE(PG8_SB(1, 1), b3 + hstep, voffB);
            PG8_WAIT_V(6); PG8_BAR; PG8_MMA(1, 1, At, B1); PG8_BAR;
            }
        }
        if constexpr (ALIGN_EPI) { if (wr == 0) PG8_BAR; }
        if constexpr (!Epi::AFTER_DRAIN) { E(acc, cur, wr, wc, fr, fq); S.done(cur); }
        if (!has_next) break;
#pragma unroll
        for (int a = 0; a < 2; ++a)
#pragma unroll
            for (int b = 0; b < 2; ++b)
#pragma unroll
                for (int m = 0; m < 4; ++m)
#pragma unroll
                    for (int n = 0; n < 2; ++n) acc[a][b][m][n] = (f32x4){0.f, 0.f, 0.f, 0.f};
        cur = nxt; cA = nA; cB = nB; ++ui;
        if constexpr (ALIGN_EPI) { if (wr == 1) PG8_BAR; }
    }
    PG8_WAIT_V(0);
    if constexpr (!ALIGN_EPI) { if (wr == 0) PG8_BAR; }
    PG8_BAR;
    if constexpr (Epi::AFTER_DRAIN) { E.fused(acc, cur, wr, wc, fr, fq, lds, wid, lane); S.done(cur); }
#undef PG8_SA
#undef PG8_SB
#undef PG8_STAGE
#undef PG8_LDA
#undef PG8_LDB
#undef PG8_MMA
#undef PG8_WAIT_V
#undef PG8_WAIT_L
#undef PG8_BAR
#undef PG8_SCHED
}
}

#define GAS __attribute__((address_space(1)))
#define LAS __attribute__((address_space(3)))
typedef unsigned short bf16;
typedef unsigned v4u __attribute__((ext_vector_type(4)));
typedef unsigned v2u __attribute__((ext_vector_type(2)));
typedef float f32x4 __attribute__((ext_vector_type(4)));
typedef float f32x2 __attribute__((ext_vector_type(2)));

constexpr int D = 2048, NB = 4, SEQ = 2048, CTX = 256, PB = 2304, M = NB * PB, DEPTH = 4, DFF = 5632, NIN = 4000, NINP = 4096, NMODC = 9 * D;
constexpr int NT = 512, NW = 8;
constexpr int C_XB = 0, C_GATE = 512, C_MQ = 1024, C_MKV = 1408, C_MKR = 1664, C_DQ = 1696, C_DK = 2208, C_DV = 2720, C_GQ = 3232, C_GK = 3744, C_GV = 3872;

constexpr size_t MiB = 1u << 20;
constexpr size_t WS_CTL = 0;
constexpr size_t WS_MOD = 1 * MiB;
constexpr size_t WS_ROPE = 3 * MiB;
constexpr size_t WS_WFFI = 4 * MiB;
constexpr size_t WS_WFFO = WS_WFFI + 352 * MiB;
constexpr size_t WS_WIN = WS_WFFO + 176 * MiB;
constexpr size_t WS_WOUT = WS_WIN + 64 * MiB;
constexpr size_t WS_WQB = WS_WOUT + 32 * MiB;
constexpr size_t WS_WKVB = WS_WQB + 3 * MiB;
constexpr size_t WS_WG = WS_WKVB + 2 * MiB;
constexpr size_t WS_X = WS_WG + 8 * MiB;
constexpr size_t WS_H = WS_X + 72 * MiB;
constexpr size_t WS_ACT = WS_H + 36 * MiB;
constexpr size_t WS_Y = WS_ACT + 99 * MiB;
constexpr size_t WS_COLS = WS_Y + 72 * MiB;
constexpr size_t WS_U = WS_COLS + 72 * MiB;
constexpr size_t WS_GATES = WS_U + 9 * MiB;
constexpr size_t WS_QN = WS_GATES + 72 * MiB;
constexpr size_t WS_KVN = WS_QN + 7 * MiB;
constexpr size_t WS_QUP = WS_KVN + 5 * MiB;
constexpr size_t WS_KVUP = WS_QUP + 14 * MiB;
constexpr size_t WS_QM = WS_KVUP + 18 * MiB;
constexpr size_t WS_KM = WS_QM + 14 * MiB;
constexpr size_t WS_AB = WS_KM + 14 * MiB;
constexpr size_t WS_HS = WS_AB + 72 * MiB;
constexpr size_t WS_DIFFO = WS_HS + 36 * MiB;
constexpr size_t WS_YMIX = WS_DIFFO + 36 * MiB;
constexpr size_t WS_VTD = WS_YMIX + 36 * MiB;
constexpr size_t WS_VTG = WS_VTD + 9 * MiB;
constexpr size_t WS_VTM = WS_VTG + 3 * MiB;
constexpr size_t WS_END = WS_VTM + 9 * MiB;

constexpr int LDS_BYTES = 147456;

struct P { const float* in[23]; float* out; unsigned char* ws; };
typedef const __attribute__((address_space(4))) P* KP;
__device__ __forceinline__ P load_P(KP kp) {
#if defined(__HIP_DEVICE_COMPILE__)
    asm volatile("" : "+s"(kp)); P r; for (int i = 0; i < 23; ++i) r.in[i] = kp->in[i]; r.out = kp->out; r.ws = kp->ws; return r;
#else
    (void)kp; return P{};
#endif
}

#define LDS_WAIT() asm volatile("s_waitcnt lgkmcnt(0)" ::: "memory")
__device__ __forceinline__ unsigned f2bf(float f) { unsigned u = __builtin_bit_cast(unsigned, f); return (u + 0x7fffu + ((u >> 16) & 1u)) >> 16; }
__device__ __forceinline__ unsigned pk2(float lo, float hi) { return f2bf(lo) | (f2bf(hi) << 16); }
__device__ __forceinline__ float bf2f(unsigned v) { return __builtin_bit_cast(float, v << 16); }
__device__ __forceinline__ float bflo(unsigned w) { return __builtin_bit_cast(float, w << 16); }
__device__ __forceinline__ float bfhi(unsigned w) { return __builtin_bit_cast(float, w & 0xffff0000u); }
template <int XM> __device__ __forceinline__ float swz_xor(float v) { return __builtin_bit_cast(float, __builtin_amdgcn_ds_swizzle(__builtin_bit_cast(int, v), (XM << 10) | 0x1f)); }
__device__ __forceinline__ void pl32swap(unsigned& a, unsigned& b) { asm volatile("s_nop 1\n\tv_permlane32_swap_b32 %0, %1\n\ts_nop 1" : "+v"(a), "+v"(b)); }
__device__ __forceinline__ float xhalf_sum(float v) { unsigned a = __builtin_bit_cast(unsigned, v), b = a; pl32swap(a, b); return __builtin_bit_cast(float, a) + __builtin_bit_cast(float, b); }
__device__ __forceinline__ float xhalf_max(float v) { unsigned a = __builtin_bit_cast(unsigned, v), b = a; pl32swap(a, b); return fmaxf(__builtin_bit_cast(float, a), __builtin_bit_cast(float, b)); }
__device__ __forceinline__ float wave_sum(float v) {
    v += swz_xor<1>(v); v += swz_xor<2>(v); v += swz_xor<4>(v); v += swz_xor<8>(v); v += swz_xor<16>(v);
    return xhalf_sum(v);
}
__device__ __forceinline__ float sigmoidf_(float x) { return 1.f / (1.f + __expf(-x)); }
__device__ __forceinline__ float siluf_(float x) { return x / (1.f + __expf(-x)); }
__device__ __forceinline__ float gelu_tanh(float x) { const float u = 0.7978845608028654f * (x + 0.044715f * x * x * x); return 0.5f * x * (1.f + tanhf(u)); }

struct TileOrder {
    pg8::StaticOrder so; int latonly;
    __device__ __forceinline__ void init(int nMt, int N, int G, int c, int lat) { so.nM = nMt; so.nN = N / 256; so.nwg = so.nM * so.nN; so.G = G; so.c = c; latonly = lat; }
    __device__ __forceinline__ bool next(int i, pg8::Unit& u) const { if (!so.next(i, u)) return false; if (latonly) u.pm = (u.pm >> 3) * 9 + 1 + (u.pm & 7); return true; }
    __device__ __forceinline__ void a_ready(const pg8::Unit&) const {}
    __device__ __forceinline__ void done(const pg8::Unit&) const {}
};
struct EpiF32 {
    static constexpr bool PERM = false, AFTER_DRAIN = false;
    float* C; int ldc;
    __device__ __forceinline__ void operator()(const f32x4 (&acc)[2][2][4][2], const pg8::Unit& u, int wr, int wc, int fr, int fq) const {
        const int row0 = u.pm * 256 + wr * 64 + fr, col0 = u.pn * 256 + wc * 32 + 4 * fq;
#pragma unroll
        for (int ai = 0; ai < 2; ++ai)
#pragma unroll
            for (int m = 0; m < 4; ++m) { float* rowp = C + (size_t)(row0 + ai * 128 + m * 16) * ldc + col0;
#pragma unroll
                for (int bj = 0; bj < 2; ++bj)
#pragma unroll
                    for (int n = 0; n < 2; ++n) *(f32x4*)(rowp + bj * 128 + n * 16) = acc[ai][bj][m][n]; }
    }
};
struct EpiB16 {
    static constexpr bool PERM = true, AFTER_DRAIN = false;
    bf16* O; int ldc;
    __device__ __forceinline__ void operator()(const f32x4 (&acc)[2][2][4][2], const pg8::Unit& u, int wr, int wc, int fr, int fq) const {
        const int row0 = u.pm * 256 + wr * 64 + fr, col0 = u.pn * 256 + wc * 32 + 8 * fq;
#pragma unroll
        for (int ai = 0; ai < 2; ++ai)
#pragma unroll
            for (int m = 0; m < 4; ++m) { bf16* rowp = O + (size_t)(row0 + ai * 128 + m * 16) * ldc + col0;
#pragma unroll
                for (int bj = 0; bj < 2; ++bj) { const f32x4 v0 = acc[ai][bj][m][0], v1 = acc[ai][bj][m][1];
                    v4u w; w.x = pg8::cvt_pk_bf16(v0[0], v0[1]); w.y = pg8::cvt_pk_bf16(v0[2], v0[3]); w.z = pg8::cvt_pk_bf16(v1[0], v1[1]); w.w = pg8::cvt_pk_bf16(v1[2], v1[3]);
                    *(v4u*)(rowp + bj * 128) = w; } }
    }
};
struct EpiSwiglu {
    static constexpr bool PERM = true, AFTER_DRAIN = false;
    bf16* O; int ldc;
    __device__ __forceinline__ void operator()(const f32x4 (&acc)[2][2][4][2], const pg8::Unit& u, int wr, int wc, int fr, int fq) const {
        const int row0 = u.pm * 256 + wr * 64 + fr, col0 = u.pn * 128 + wc * 32 + 8 * fq;
#pragma unroll
        for (int ai = 0; ai < 2; ++ai)
#pragma unroll
            for (int m = 0; m < 4; ++m) { bf16* rowp = O + (size_t)(row0 + ai * 128 + m * 16) * ldc + col0;
                float r[8];
#pragma unroll
                for (int n = 0; n < 2; ++n)
#pragma unroll
                    for (int e = 0; e < 4; ++e) { const float g = acc[ai][0][m][n][e], uu = acc[ai][1][m][n][e]; r[n * 4 + e] = siluf_(g) * uu; }
                v4u w; w.x = pg8::cvt_pk_bf16(r[0], r[1]); w.y = pg8::cvt_pk_bf16(r[2], r[3]); w.z = pg8::cvt_pk_bf16(r[4], r[5]); w.w = pg8::cvt_pk_bf16(r[6], r[7]);
                *(v4u*)rowp = w; }
    }
};

__device__ __forceinline__ void transpose_item(const float* W, int N, int K, bf16* WT, int k0, int n0, int drow0, LAS float* scr, int lane) {
#pragma unroll 8
    for (int i = 0; i < 32; ++i) { const int kk = 2 * i + (lane >> 5); scr[kk * 33 + (lane & 31)] = W[(size_t)(k0 + kk) * N + n0 + (lane & 31)]; }
    LDS_WAIT(); asm volatile("" ::: "memory");
    const int c = lane & 7;
#pragma unroll
    for (int j = 0; j < 4; ++j) { const int n = (lane >> 3) + 8 * j; const LAS float* s = scr + (8 * c) * 33 + n;
        v4u o; o.x = pk2(s[0 * 33], s[1 * 33]); o.y = pk2(s[2 * 33], s[3 * 33]); o.z = pk2(s[4 * 33], s[5 * 33]); o.w = pk2(s[6 * 33], s[7 * 33]);
        *(v4u*)(WT + (size_t)(drow0 + n) * K + k0 + 8 * c) = o; }
    LDS_WAIT(); asm volatile("" ::: "memory");
}

__device__ __forceinline__ void phase_pro1(const P& p, LAS unsigned char* lds) {
    unsigned char* wsb = opq_p(p.ws);
    const int tid = tid_opaque(), lane = tid & 63, wave = __builtin_amdgcn_readfirstlane(tid >> 6);
    const int G = gridDim.x, blk = blockIdx.x;
    {
        LAS float* sc = (LAS float*)lds;
        LAS float* red = (LAS float*)(lds + 40960);
        const float* c = p.in[1]; const float* cc = p.in[3];
        for (int i = tid; i < 5 * D; i += NT) { const int v = i / D, k = i % D; const float x = v < 4 ? c[v * D + k] : cc[k]; sc[i] = x / (1.f + expf(-x)); }
        __syncthreads();
        const float* wmod = p.in[4]; const float* bmod = p.in[5];
        float* MOD = (float*)(wsb + WS_MOD);
        for (int unit = blk; unit < DEPTH * 288; unit += G) {
            const int l = unit / 288, n0 = (unit % 288) * 64, kq = lane >> 4;
            const float* W = wmod + (size_t)l * D * NMODC + n0 + 4 * (lane & 15);
            float acc[5][4];
#pragma unroll
            for (int v = 0; v < 5; ++v)
#pragma unroll
                for (int e = 0; e < 4; ++e) acc[v][e] = 0.f;
            const int kbase = wave * 256 + kq;
#pragma unroll 4
            for (int i = 0; i < 64; ++i) { const int k = kbase + 4 * i; const f32x4 w = *(const f32x4*)(W + (size_t)k * NMODC);
#pragma unroll
                for (int v = 0; v < 5; ++v) { const float s = sc[v * D + k];
#pragma unroll
                    for (int e = 0; e < 4; ++e) acc[v][e] += s * w[e]; } }
#pragma unroll
            for (int v = 0; v < 5; ++v)
#pragma unroll
                for (int e = 0; e < 4; ++e) { float a = acc[v][e]; a += swz_xor<16>(a); a = xhalf_sum(a); acc[v][e] = a; }
            if (kq == 0) {
#pragma unroll
                for (int v = 0; v < 5; ++v)
#pragma unroll
                    for (int e = 0; e < 4; ++e) red[(wave * 5 + v) * 64 + 4 * (lane & 15) + e] = acc[v][e]; }
            __syncthreads();
            if (tid < 320) { const int v = tid / 64, col = tid % 64; float s = 0.f;
#pragma unroll
                for (int w = 0; w < 8; ++w) s += red[(w * 5 + v) * 64 + col];
                MOD[((size_t)l * 5 + v) * NMODC + n0 + col] = s + bmod[l * NMODC + n0 + col]; }
            __syncthreads();
        }
    }
    __syncthreads();
    {
        LAS float* scr = (LAS float*)(lds + wave * 16384);
        const int gw = wave * G + blk, NGW = NW * G;
        constexpr int I_FI = 32 * 352, I_FO = 88 * 64, I_IN = 32 * 125, I_OUT = 32 * 64, I_QB = 6 * 24, I_KVB = 4 * 32;
        constexpr int T_FI = 8 * I_FI, T_FO = 8 * I_FO, T_IN = 4 * I_IN, T_OUT = 4 * I_OUT, T_QB = 4 * I_QB, T_KVB = 4 * I_KVB;
        constexpr int NITEMS = T_FI + T_FO + T_IN + T_OUT + T_QB + T_KVB;
        for (int it = gw; it < NITEMS; it += NGW) {
            int r = it;
            if (r < T_FI) { const int mat = r / I_FI; r %= I_FI; const int kb = r / 352, nb = r % 352, n0 = nb * 32;
                const int half = n0 / DFF, cc = n0 % DFF, drow0 = (cc / 128) * 256 + half * 128 + (cc % 128);
                transpose_item(p.in[7] + (size_t)mat * D * (2 * DFF), 2 * DFF, D, (bf16*)(wsb + WS_WFFI) + (size_t)mat * (2 * DFF) * D, kb * 64, n0, drow0, scr, lane); continue; }
            r -= T_FI;
            if (r < T_FO) { const int mat = r / I_FO; r %= I_FO; const int kb = r / 64, nb = r % 64;
                transpose_item(p.in[8] + (size_t)mat * DFF * D, D, DFF, (bf16*)(wsb + WS_WFFO) + (size_t)mat * D * DFF, kb * 64, nb * 32, nb * 32, scr, lane); continue; }
            r -= T_FO;
            if (r < T_IN) { const int mat = r / I_IN; r %= I_IN; const int kb = r / 125, nb = r % 125;
                transpose_item(p.in[9] + (size_t)mat * D * NIN, NIN, D, (bf16*)(wsb + WS_WIN) + (size_t)mat * NINP * D, kb * 64, nb * 32, nb * 32, scr, lane); continue; }
            r -= T_IN;
            if (r < T_OUT) { const int mat = r / I_OUT; r %= I_OUT; const int kb = r / 64, nb = r % 64;
                transpose_item(p.in[10] + (size_t)mat * D * D, D, D, (bf16*)(wsb + WS_WOUT) + (size_t)mat * D * D, kb * 64, nb * 32, nb * 32, scr, lane); continue; }
            r -= T_OUT;
            if (r < T_QB) { const int mat = r / I_QB; r %= I_QB; const int kb = r / 24, nb = r % 24;
                transpose_item(p.in[17] + (size_t)mat * 384 * 768, 768, 384, (bf16*)(wsb + WS_WQB) + (size_t)mat * 768 * 384, kb * 64, nb * 32, nb * 32, scr, lane); continue; }
            r -= T_QB;
            { const int mat = r / I_KVB; r %= I_KVB; const int kb = r / 32, nb = r % 32;
                transpose_item(p.in[19] + (size_t)mat * 256 * 1024, 1024, 256, (bf16*)(wsb + WS_WKVB) + (size_t)mat * 1024 * 256, kb * 64, nb * 32, nb * 32, scr, lane); }
        }
    }
    {
        const int gt = blk * NT + tid, NGT = G * NT;
        for (int i = gt; i < DEPTH * 96 * (D / 8); i += NGT) { const int l = i / (96 * (D / 8)), r = i % (96 * (D / 8));
            *(v4u*)((bf16*)(wsb + WS_WIN) + ((size_t)l * NINP + NIN) * D + (size_t)r * 8) = (v4u){0u, 0u, 0u, 0u}; }
        const float* wg = p.in[13];
        for (int i = gt; i < DEPTH * 2048 * 64; i += NGT) { const int l = i / (2048 * 64), r = i % (2048 * 64), np = r / 64, k0 = (r % 64) * 8;
            const int c7 = np & 127, gate = (np >> 7) & 1, chunk = (np >> 8) & 3, dir = np >> 10, ch = chunk * 128 + c7, head = ch >> 6, j = ch & 63;
            v4u o = (v4u){0u, 0u, 0u, 0u};
            if ((k0 >> 6) == head) { const float* src = wg + ((((size_t)l * 2 + dir) * 2 + gate) * 8 + head) * 4096 + (size_t)(k0 & 63) * 64 + j;
                o.x = pk2(src[0], src[64]); o.y = pk2(src[128], src[192]); o.z = pk2(src[256], src[320]); o.w = pk2(src[384], src[448]); }
            *(v4u*)((bf16*)(wsb + WS_WG) + ((size_t)l * 2048 + np) * 512 + k0) = o; }
        float* rope = (float*)(wsb + WS_ROPE);
        for (int i = gt; i < SEQ * 32; i += NGT) { const int t = i / 32, k = i % 32; const float inv = powf(10000.f, -(float)(k & 15) / 16.f);
            const float ang = (k < 16 ? (float)(t / 64) : (float)(t % 64)) * inv; rope[i] = cosf(ang); rope[SEQ * 32 + i] = sinf(ang); }
        for (int i = gt; i < SEQ * 16; i += NGT) { const int t = i / 16, k = i % 16; const float inv = powf(10000.f, -(float)(k & 7) / 8.f);
            const float ang = (k < 8 ? (float)(t / 64) : (float)(t % 64)) * inv; rope[SEQ * 64 + i] = cosf(ang); rope[SEQ * 64 + SEQ * 16 + i] = sinf(ang); }
    }
}

__device__ __forceinline__ float row_rstd(const f32x4 (&v)[8]) {
    float s = 0.f;
#pragma unroll
    for (int j = 0; j < 8; ++j) s += (v[j][0] * v[j][0] + v[j][1] * v[j][1]) + (v[j][2] * v[j][2] + v[j][3] * v[j][3]);
    s = wave_sum(s);
    return 1.0f / sqrtf(s * (1.0f / D) + 1e-6f);
}
__device__ __forceinline__ void store_prenorm(bf16* hrow, int lane, const f32x4 (&v)[8], const float* g, const float* shift, const float* scale) {
    const float rstd = row_rstd(v);
#pragma unroll
    for (int j = 0; j < 8; ++j) { const int idx = lane + 64 * j;
        const f32x4 gg = ((const f32x4*)g)[idx], sh = ((const f32x4*)shift)[idx], sc = ((const f32x4*)scale)[idx];
        const f32x4 o = (v[j] * rstd) * gg * (sc + 1.0f) + sh;
        v2u w; w.x = pk2(o[0], o[1]); w.y = pk2(o[2], o[3]);
        *(v2u*)(hrow + 4 * idx) = w; }
}

__device__ __forceinline__ void phase_pro2(const P& p) {
    unsigned char* wsb = opq_p(p.ws);
    const int tid = tid_opaque(), lane = tid & 63, wave = tid >> 6, G = gridDim.x, blk = blockIdx.x;
    const int gw = wave * G + blk, NGW = NW * G;
    float* X = (float*)(wsb + WS_X); bf16* H = (bf16*)(wsb + WS_H); const float* MOD = (const float*)(wsb + WS_MOD);
    for (int row = gw; row < M; row += NGW) {
        const int b = row / PB, pp = row % PB; const bool isctx = pp < CTX; const int v = isctx ? 4 : b;
        const float* src = isctx ? p.in[2] + ((size_t)b * CTX + pp) * D : p.in[0] + ((size_t)b * SEQ + (pp - CTX)) * D;
        f32x4 xv[8];
#pragma unroll
        for (int j = 0; j < 8; ++j) xv[j] = ((const f32x4*)src)[lane + 64 * j];
#pragma unroll
        for (int j = 0; j < 8; ++j) ((f32x4*)(X + (size_t)row * D))[lane + 64 * j] = xv[j];
        const float* mod = MOD + ((size_t)0 * 5 + v) * NMODC;
        store_prenorm(H + (size_t)row * D, lane, xv, p.in[6] + (size_t)(0 * 6 + 0) * D, mod + 0 * D, mod + 1 * D);
    }
}

__device__ __forceinline__ void phase_post(const P& p, int layer, int s) {
    unsigned char* wsb = opq_p(p.ws);
    layer = opq_s(layer);
    const int tid = tid_opaque(), lane = tid & 63, wave = tid >> 6, G = gridDim.x, blk = blockIdx.x;
    const int gw = wave * G + blk, NGW = NW * G;
    float* X = (float*)(wsb + WS_X); bf16* H = (bf16*)(wsb + WS_H); const float* Y = (const float*)(wsb + WS_Y); const float* MOD = (const float*)(wsb + WS_MOD);
    const bool last = layer == DEPTH - 1, final = last && s == 2;
    const float wgt = (s == 1) ? 1.0f : 0.5f;
    const int l2 = (s < 2) ? layer : layer + 1, s2 = (s < 2) ? s + 1 : 0;
    for (int row = gw; row < M; row += NGW) {
        const int b = row / PB, pp = row % PB; const bool isctx = pp < CTX; const int v = isctx ? 4 : b;
        if (last && s >= 1 && isctx) continue;
        f32x4 yv[8], xv[8];
#pragma unroll
        for (int j = 0; j < 8; ++j) yv[j] = ((const f32x4*)(Y + (size_t)row * D))[lane + 64 * j];
#pragma unroll
        for (int j = 0; j < 8; ++j) xv[j] = ((const f32x4*)(X + (size_t)row * D))[lane + 64 * j];
        const float rstd = row_rstd(yv);
        const float* gate = MOD + ((size_t)layer * 5 + v) * NMODC + (size_t)(3 * s + 2) * D;
        const float* gpost = p.in[6] + (size_t)(layer * 6 + 2 * s + 1) * D;
        float* dst = final ? p.out + ((size_t)b * SEQ + (pp - CTX)) * D : X + (size_t)row * D;
#pragma unroll
        for (int j = 0; j < 8; ++j) { const int idx = lane + 64 * j; const f32x4 ga = ((const f32x4*)gate)[idx], gp = ((const f32x4*)gpost)[idx];
            xv[j] = xv[j] + (ga * wgt) * ((yv[j] * rstd) * gp);
            ((f32x4*)dst)[idx] = xv[j]; }
        if (!final) { const float* mod = MOD + ((size_t)l2 * 5 + v) * NMODC;
            store_prenorm(H + (size_t)row * D, lane, xv, p.in[6] + (size_t)(l2 * 6 + 2 * s2) * D, mod + (size_t)(3 * s2) * D, mod + (size_t)(3 * s2 + 1) * D); }
    }
}

template <class Epi>
__device__ __forceinline__ void run_gemm(LAS unsigned char* lds, const bf16* A, const bf16* Bt, int nMt, int N, int K, int latonly, int coff, const Epi& E) {
    pg8::Gemm g{A, Bt, M, N, K};
    TileOrder S; S.init(nMt, N, (int)gridDim.x, (int)((blockIdx.x + coff) % gridDim.x), latonly);
    pg8::gemm_phase<Epi, TileOrder, true, true>(lds, g, S, E);
}
__device__ __forceinline__ void phase_ffn_in(const P& p, LAS unsigned char* lds, int layer, int which) {
    unsigned char* wsb = opq_p(p.ws);
    layer = opq_s(layer);
    const bool lat = (layer == DEPTH - 1) && which == 1;
    EpiSwiglu E{(bf16*)(wsb + WS_ACT), DFF};
    run_gemm(lds, (const bf16*)(wsb + WS_H), (const bf16*)(wsb + WS_WFFI) + (size_t)(layer * 2 + which) * (2 * DFF) * D, lat ? 32 : 36, 2 * DFF, D, lat, 0, E);
}
__device__ __forceinline__ void phase_ffn_out(const P& p, LAS unsigned char* lds, int layer, int which) {
    unsigned char* wsb = opq_p(p.ws);
    layer = opq_s(layer);
    const bool lat = (layer == DEPTH - 1) && which == 1;
    EpiF32 E{(float*)(wsb + WS_Y), D};
    run_gemm(lds, (const bf16*)(wsb + WS_ACT), (const bf16*)(wsb + WS_WFFO) + (size_t)(layer * 2 + which) * D * DFF, lat ? 32 : 36, D, DFF, lat, 0, E);
}
__device__ __forceinline__ void phase_inproj(const P& p, LAS unsigned char* lds, int layer) {
    unsigned char* wsb = opq_p(p.ws);
    layer = opq_s(layer);
    EpiB16 E{(bf16*)(wsb + WS_COLS), NINP};
    run_gemm(lds, (const bf16*)(wsb + WS_H), (const bf16*)(wsb + WS_WIN) + (size_t)layer * NINP * D, 36, NINP, D, 0, 0, E);
}
__device__ __forceinline__ void phase_outproj(const P& p, LAS unsigned char* lds, int layer) {
    unsigned char* wsb = opq_p(p.ws);
    layer = opq_s(layer);
    const bool lat = (layer == DEPTH - 1);
    EpiF32 E{(float*)(wsb + WS_Y), D};
    run_gemm(lds, (const bf16*)(wsb + WS_YMIX), (const bf16*)(wsb + WS_WOUT) + (size_t)layer * D * D, lat ? 32 : 36, D, D, lat, 0, E);
}
__device__ __forceinline__ void phase_mgemm(const P& p, LAS unsigned char* lds, int layer) {
    unsigned char* wsb = opq_p(p.ws);
    layer = opq_s(layer);
    { EpiB16 E{(bf16*)(wsb + WS_QUP), 768};
      run_gemm(lds, (const bf16*)(wsb + WS_QN), (const bf16*)(wsb + WS_WQB) + (size_t)layer * 768 * 384, 36, 768, 384, 0, 0, E); }
    __syncthreads();
    { EpiB16 E{(bf16*)(wsb + WS_KVUP), 1024};
      run_gemm(lds, (const bf16*)(wsb + WS_KVN), (const bf16*)(wsb + WS_WKVB) + (size_t)layer * 1024 * 256, 36, 1024, 256, 0, 148, E); }
    __syncthreads();
    { EpiF32 E{(float*)(wsb + WS_GATES), 2048};
      run_gemm(lds, (const bf16*)(wsb + WS_U), (const bf16*)(wsb + WS_WG) + (size_t)layer * 2048 * 512, 36, 2048, 512, 0, 0, E); }
}


__device__ __forceinline__ void transpose_tok_item(const bf16* src, int ss, bf16* dst, LAS unsigned short* scr, int lane) {
#pragma unroll
    for (int i = 0; i < 8; ++i) { const int id = lane + 64 * i, row = id >> 3, ch = id & 7;
        const v4u w = *(const v4u*)(src + (size_t)row * ss + ch * 8);
        LAS unsigned* d = (LAS unsigned*)(scr + row * 66 + ch * 8);
        d[0] = w.x; d[1] = w.y; d[2] = w.z; d[3] = w.w; }
    LDS_WAIT(); asm volatile("" ::: "memory");
#pragma unroll
    for (int i = 0; i < 8; ++i) { const int id = lane + 64 * i, e = id >> 3, ch = id & 7;
        unsigned v[8];
#pragma unroll
        for (int k = 0; k < 8; ++k) v[k] = scr[(ch * 8 + k) * 66 + e];
        v4u w; w.x = v[0] | (v[1] << 16); w.y = v[2] | (v[3] << 16); w.z = v[4] | (v[5] << 16); w.w = v[6] | (v[7] << 16);
        *(v4u*)(dst + (size_t)e * PB + ch * 8) = w; }
    LDS_WAIT(); asm volatile("" ::: "memory");
}
__device__ __forceinline__ void phase_prep(const P& p, LAS unsigned char* lds, int layer) {
    unsigned char* wsb = opq_p(p.ws);
    layer = opq_s(layer);
    const int tid = tid_opaque(), lane = tid & 63, wave = tid >> 6, G = gridDim.x, blk = blockIdx.x;
    const int gw = wave * G + blk, NGW = NW * G;
    bf16* COLS = (bf16*)(wsb + WS_COLS); bf16* U = (bf16*)(wsb + WS_U); bf16* QN = (bf16*)(wsb + WS_QN); bf16* KVN = (bf16*)(wsb + WS_KVN);
    const float* rope = (const float*)(wsb + WS_ROPE);
    const float* cw = p.in[11] + (size_t)layer * 4 * 512; const float* cb = p.in[12] + (size_t)layer * 512;
    const float* qg = p.in[16] + (size_t)layer * 384; const float* kvg = p.in[18] + (size_t)layer * 256;
    for (int row = gw; row < M; row += NGW) {
        const int pp = row % PB; const bool isctx = pp < CTX;
        const int lo = isctx ? 0 : CTX, hi = isctx ? CTX : PB;
        bf16* crow = COLS + (size_t)row * NINP;
#pragma unroll
        for (int cblk = 0; cblk < 8; ++cblk) { const int ch = cblk * 64 + lane; float acc = cb[ch];
#pragma unroll
            for (int j = 0; j < 4; ++j) { const int q = pp + j - 2; if (q >= lo && q < hi) acc += cw[j * 512 + ch] * bf2f(crow[(ptrdiff_t)(j - 2) * NINP + C_XB + ch]); }
            U[(size_t)row * 512 + ch] = (bf16)f2bf(acc); }
        { float v[6]; float s = 0.f;
#pragma unroll
            for (int j = 0; j < 6; ++j) { v[j] = bf2f(crow[C_MQ + lane + 64 * j]); s += v[j] * v[j]; }
            s = wave_sum(s); const float rstd = 1.0f / sqrtf(s * (1.0f / 384.f) + 1e-6f);
#pragma unroll
            for (int j = 0; j < 6; ++j) QN[(size_t)row * 384 + lane + 64 * j] = (bf16)f2bf(v[j] * rstd * qg[lane + 64 * j]); }
        { float v[4]; float s = 0.f;
#pragma unroll
            for (int j = 0; j < 4; ++j) { v[j] = bf2f(crow[C_MKV + lane + 64 * j]); s += v[j] * v[j]; }
            s = wave_sum(s); const float rstd = 1.0f / sqrtf(s * (1.0f / 256.f) + 1e-6f);
#pragma unroll
            for (int j = 0; j < 4; ++j) KVN[(size_t)row * 256 + lane + 64 * j] = (bf16)f2bf(v[j] * rstd * kvg[lane + 64 * j]); }
        if (!isctx) { const int t = pp - CTX; const int i = lane & 31, hsel = lane >> 5;
            const float c = rope[t * 32 + i], sn = rope[SEQ * 32 + t * 32 + i];
#pragma unroll
            for (int hp = 0; hp < 13; ++hp) { const int hd = hp * 2 + hsel; const int base = hd < 16 ? C_DQ + hd * 64 : C_GQ + (hd - 16) * 64;
                const float x1 = bf2f(crow[base + i]), x2 = bf2f(crow[base + 32 + i]);
                crow[base + i] = (bf16)f2bf(x1 * c - x2 * sn); crow[base + 32 + i] = (bf16)f2bf(x1 * sn + x2 * c); }
            if (lane < 16) { const float c2 = rope[SEQ * 64 + t * 16 + lane], s2 = rope[SEQ * 64 + SEQ * 16 + t * 16 + lane];
                const float x1 = bf2f(crow[C_MKR + lane]), x2 = bf2f(crow[C_MKR + 16 + lane]);
                crow[C_MKR + lane] = (bf16)f2bf(x1 * c2 - x2 * s2); crow[C_MKR + 16 + lane] = (bf16)f2bf(x1 * s2 + x2 * c2); }
        }
    }
    { LAS unsigned short* scr = (LAS unsigned short*)(lds + wave * 16384);
      bf16* VTD = (bf16*)(wsb + WS_VTD); bf16* VTG = (bf16*)(wsb + WS_VTG);
      for (int it = gw; it < NB * 36 * 10; it += NGW) { const int b = it / 360, r = it % 360, tb = r / 10, cb = r % 10;
          const bf16* s = COLS + ((size_t)b * PB + tb * 64) * NINP + (cb < 8 ? C_DV + cb * 64 : C_GV + (cb - 8) * 64);
          bf16* d = cb < 8 ? VTD + ((size_t)b * 512 + cb * 64) * PB + tb * 64 : VTG + ((size_t)b * 128 + (cb - 8) * 64) * PB + tb * 64;
          transpose_tok_item(s, NINP, d, scr, lane); } }
}

__device__ __forceinline__ void phase_prep2(const P& p, LAS unsigned char* lds, int layer) {
    unsigned char* wsb = opq_p(p.ws);
    layer = opq_s(layer);
    const int tid = tid_opaque(), lane = tid & 63, wave = tid >> 6, G = gridDim.x, blk = blockIdx.x;
    const int gw = wave * G + blk, NGW = NW * G;
    const bf16* COLS = (const bf16*)(wsb + WS_COLS); const bf16* U = (const bf16*)(wsb + WS_U);
    const bf16* QUP = (const bf16*)(wsb + WS_QUP); const bf16* KVUP = (const bf16*)(wsb + WS_KVUP);
    bf16* QM = (bf16*)(wsb + WS_QM); bf16* KM = (bf16*)(wsb + WS_KM);
    const float* GATES = (const float*)(wsb + WS_GATES); f32x2* AB = (f32x2*)(wsb + WS_AB);
    const float* rope = (const float*)(wsb + WS_ROPE);
    const float* bg = p.in[14] + (size_t)layer * 2 * 2 * 512; const float* lam = p.in[15] + (size_t)layer * 2 * 512;
    for (int row = gw; row < M; row += NGW) {
        const int pp = row % PB; const bool isctx = pp < CTX; const int t = pp - CTX;
#pragma unroll
        for (int j = 0; j < 12; ++j) { const int e = lane + 64 * j, h = e / 96, d = e % 96;
            float qv = bf2f(QUP[(size_t)row * 768 + e]);
            if (d >= 64 && !isctx) { const int i = (d - 64) & 15; const bool second = (d - 64) >= 16;
                const float c = rope[SEQ * 64 + t * 16 + i], sn = rope[SEQ * 64 + SEQ * 16 + t * 16 + i];
                const float x1 = bf2f(QUP[(size_t)row * 768 + h * 96 + 64 + i]), x2 = bf2f(QUP[(size_t)row * 768 + h * 96 + 80 + i]);
                qv = second ? (x1 * sn + x2 * c) : (x1 * c - x2 * sn); }
            QM[(size_t)row * 768 + e] = (bf16)f2bf(qv);
            KM[(size_t)row * 768 + e] = d < 64 ? KVUP[(size_t)row * 1024 + h * 128 + d] : COLS[(size_t)row * NINP + C_MKR + (d - 64)]; }
#pragma unroll
        for (int dir = 0; dir < 2; ++dir)
#pragma unroll
            for (int cblk = 0; cblk < 8; ++cblk) { const int ch = cblk * 64 + lane;
                const float* gp = GATES + (size_t)row * 2048 + ((dir * 4 + (ch >> 7)) * 2) * 128 + (ch & 127);
                const float gr = gp[0] + bg[(dir * 2 + 0) * 512 + ch], gi = gp[128] + bg[(dir * 2 + 1) * 512 + ch];
                const float r = 1.f / (1.f + expf(-gr)), ig = 1.f / (1.f + expf(-gi));
                const float sp = log1pf(expf(-lam[dir * 512 + ch]));
                const float log_a = -8.0f * r * sp, a = expf(log_a);
                const float u = bf2f(U[(size_t)row * 512 + ch]);
                const float bco = sqrtf(-expm1f(2.0f * log_a)) * (ig * u);
                AB[((size_t)dir * M + row) * 512 + ch] = (f32x2){a, bco}; }
    }
    { LAS unsigned short* scr = (LAS unsigned short*)(lds + wave * 16384);
      bf16* VTM = (bf16*)(wsb + WS_VTM);
      for (int it = gw; it < NB * 36 * 8; it += NGW) { const int b = it / 288, r = it % 288, tb = r / 8, hh = r % 8;
          transpose_tok_item(KVUP + ((size_t)b * PB + tb * 64) * 1024 + hh * 128 + 64, 1024, VTM + ((size_t)b * 512 + hh * 64) * PB + tb * 64, scr, lane); } }
}

template <int DQK, int DV, int MODE, bool OUTF32>
__device__ __forceinline__ void naive_attn(const bf16* Q, int qs, const bf16* K, int ks, const bf16* V, int vs, void* O, int os,
                                           int b, int pp0, int lane, float scale, float sink) {
    const size_t rowbase = (size_t)b * PB; const int pp = pp0 + lane;
    float q[DQK], o[DV];
    { const bf16* qr = Q + (rowbase + pp) * qs;
#pragma unroll
      for (int c = 0; c < DQK / 8; ++c) { const v4u w = *(const v4u*)(qr + 8 * c);
          q[8 * c + 0] = bflo(w.x); q[8 * c + 1] = bfhi(w.x); q[8 * c + 2] = bflo(w.y); q[8 * c + 3] = bfhi(w.y);
          q[8 * c + 4] = bflo(w.z); q[8 * c + 5] = bfhi(w.z); q[8 * c + 6] = bflo(w.w); q[8 * c + 7] = bfhi(w.w); } }
    const float sl2 = scale * 1.4426950408889634f;
#pragma unroll
    for (int d = 0; d < DQK; ++d) q[d] *= sl2;
#pragma unroll
    for (int e = 0; e < DV; ++e) o[e] = 0.f;
    float m = (MODE == 1) ? sink * 1.4426950408889634f : -1e30f, l = (MODE == 1) ? 1.f : 0.f;
    const bool isctx = pp0 < CTX; const int t = pp - CTX, t0 = pp0 - CTX;
    for (int seg = 0; seg < 2; ++seg) {
        int k0, k1;
        if (seg == 0) { k0 = 0; k1 = CTX; }
        else { if (isctx) break;
            if (MODE == 0) { k0 = CTX; k1 = PB; }
            else { const int a0 = t0 - 128 < 0 ? 0 : t0 - 128, a1 = t0 + 63 + 128 > SEQ - 1 ? SEQ - 1 : t0 + 63 + 128; k0 = CTX + a0; k1 = CTX + a1 + 1; } }
        for (int key = k0; key < k1; ++key) {
            const bf16* kr = K + (rowbase + key) * ks; const bf16* vr = V + (rowbase + key) * vs;
            asm volatile("" : "+v"(kr)); asm volatile("" : "+v"(vr));
            float s = 0.f;
#pragma unroll
            for (int c = 0; c < DQK / 8; ++c) { const v4u w = *(const v4u*)(kr + 8 * c);
                s += q[8 * c + 0] * bflo(w.x); s += q[8 * c + 1] * bfhi(w.x); s += q[8 * c + 2] * bflo(w.y); s += q[8 * c + 3] * bfhi(w.y);
                s += q[8 * c + 4] * bflo(w.z); s += q[8 * c + 5] * bfhi(w.z); s += q[8 * c + 6] * bflo(w.w); s += q[8 * c + 7] * bfhi(w.w); }
            bool valid = true;
            if (MODE == 1 && seg == 1) { const int rel = (key - CTX) - t; valid = (rel <= 128) && (rel >= -128); }
            if (valid) {
                const float mn = fmaxf(m, s), alpha = exp2f(m - mn), pr = exp2f(s - mn);
                l = l * alpha + pr; m = mn;
#pragma unroll
                for (int c = 0; c < DV / 8; ++c) { const v4u w = *(const v4u*)(vr + 8 * c);
                    o[8 * c + 0] = o[8 * c + 0] * alpha + pr * bflo(w.x); o[8 * c + 1] = o[8 * c + 1] * alpha + pr * bfhi(w.x);
                    o[8 * c + 2] = o[8 * c + 2] * alpha + pr * bflo(w.y); o[8 * c + 3] = o[8 * c + 3] * alpha + pr * bfhi(w.y);
                    o[8 * c + 4] = o[8 * c + 4] * alpha + pr * bflo(w.z); o[8 * c + 5] = o[8 * c + 5] * alpha + pr * bfhi(w.z);
                    o[8 * c + 6] = o[8 * c + 6] * alpha + pr * bflo(w.w); o[8 * c + 7] = o[8 * c + 7] * alpha + pr * bfhi(w.w); }
            }
        }
    }
    const float il = 1.f / l;
    if (OUTF32) { float* orow = (float*)O + (rowbase + pp) * os;
#pragma unroll
        for (int e = 0; e < DV; e += 4) *(f32x4*)(orow + e) = (f32x4){o[e] * il, o[e + 1] * il, o[e + 2] * il, o[e + 3] * il}; }
    else { bf16* orow = (bf16*)O + (rowbase + pp) * os;
#pragma unroll
        for (int e = 0; e < DV; e += 8) { v4u w; w.x = pk2(o[e] * il, o[e + 1] * il); w.y = pk2(o[e + 2] * il, o[e + 3] * il); w.z = pk2(o[e + 4] * il, o[e + 5] * il); w.w = pk2(o[e + 6] * il, o[e + 7] * il);
            *(v4u*)(orow + e) = w; } }
}


typedef short bf16x8 __attribute__((ext_vector_type(8)));
typedef float f32x16 __attribute__((ext_vector_type(16)));
__device__ __forceinline__ int crow16(int r, int hi) { return (r & 3) + 8 * (r >> 2) + 4 * hi; }

typedef __bf16 bf16x2_t __attribute__((ext_vector_type(2)));
__device__ __forceinline__ unsigned cvtpk_s(float lo, float hi) { const f32x2 v = {lo, hi}; const bf16x2_t b = __builtin_convertvector(v, bf16x2_t); return __builtin_bit_cast(unsigned, b); }
template <int DQK, int DV, int MODE, bool OUTF32>
__device__ __forceinline__ void attn_unit(LAS unsigned char* lds, const bf16* Qb, int qs, const bf16* Kb, int ks, const bf16* VTb, void* Ob, int os,
                                          int q0, int ntd, float scale, float sink, int tid_in) {
    int tid = tid_in; asm volatile("" : "+v"(tid));
    constexpr int RSK = DQK * 2 + 16, RSV = 136, KBUF = 64 * RSK, VBUF = DV * RSV, CPR = DQK / 8, NKC = 64 * CPR, NVC = DV * 8;
    constexpr int NKI = (NKC + NT - 1) / NT, NVI = NVC / NT, ND0 = DQK / 16, NDB = DV / 32;
    const int lane = tid & 63, wave = __builtin_amdgcn_readfirstlane(tid >> 6), r32 = lane & 31, hi = lane >> 5;
    int ta = 4, ntiles = ntd;
    if (MODE == 1) { if (q0 < CTX) ntiles = 4; else { const int t0 = q0 - CTX; const int lo = t0 - 128 < 0 ? 0 : t0 - 128, hh = t0 + 383 > SEQ - 1 ? SEQ - 1 : t0 + 383; ta = 4 + (lo >> 6); ntiles = 4 + ((hh >> 6) - (lo >> 6) + 1); } }
#define TILE_OF(i) ((MODE == 1 && (i) >= 4) ? ta + (i) - 4 : (i))
    const int qrow = q0 + wave * 32 + r32;
    bf16x8 qf[ND0];
#pragma unroll
    for (int d0 = 0; d0 < ND0; ++d0) qf[d0] = *(const bf16x8*)(Qb + (size_t)qrow * qs + 16 * d0 + 8 * hi);
    f32x16 o[NDB];
#pragma unroll
    for (int db = 0; db < NDB; ++db)
#pragma unroll
        for (int r = 0; r < 16; ++r) o[db][r] = 0.f;
    const float c = scale * 1.4426950408889634f;
    float m = (MODE == 1) ? sink / scale : -1e30f, l = (MODE == 1 && hi == 0) ? 1.f : 0.f;
    v4u kreg[NKI], vreg[NVI];
#pragma unroll
    for (int i_ = 0; i_ < NKI; ++i_) kreg[i_] = (v4u){0u, 0u, 0u, 0u};
#pragma unroll
    for (int i_ = 0; i_ < NVI; ++i_) vreg[i_] = (v4u){0u, 0u, 0u, 0u};
#define LOAD_TILE(tile) do { const int kb_ = (tile) * 64; \
        _Pragma("unroll") for (int i_ = 0; i_ < NKI; ++i_) { const int id_ = tid + NT * i_; if (id_ < NKC) { const int row_ = id_ / CPR, ch_ = id_ % CPR; kreg[i_] = *(const v4u*)(Kb + (size_t)(kb_ + row_) * ks + ch_ * 8); } } \
        _Pragma("unroll") for (int i_ = 0; i_ < NVI; ++i_) { const int id_ = tid + NT * i_, d_ = id_ >> 3, ch_ = id_ & 7; vreg[i_] = *(const v4u*)(VTb + (size_t)d_ * PB + kb_ + ch_ * 8); } } while (0)
#define STORE_TILE(buf) do { \
        _Pragma("unroll") for (int i_ = 0; i_ < NKI; ++i_) { const int id_ = tid + NT * i_; if (id_ < NKC) { const int row_ = id_ / CPR, ch_ = id_ % CPR; *(LAS v4u*)(lds + (buf) * KBUF + row_ * RSK + ch_ * 16) = kreg[i_]; } } \
        _Pragma("unroll") for (int i_ = 0; i_ < NVI; ++i_) { const int id_ = tid + NT * i_, d_ = id_ >> 3, ch_ = id_ & 7; LAS v2u* w_ = (LAS v2u*)(lds + 2 * KBUF + (buf) * VBUF + d_ * RSV + ch_ * 16); \
            w_[0] = (v2u){vreg[i_].x, vreg[i_].y}; w_[1] = (v2u){vreg[i_].z, vreg[i_].w}; } } while (0)
    LOAD_TILE(TILE_OF(0)); STORE_TILE(0); __syncthreads();
    for (int i = 0; i < ntiles; ++i) {
        const int cur = i & 1, tile = TILE_OF(i);
        if (i + 1 < ntiles) LOAD_TILE(TILE_OF(i + 1));
        bool active = true;
        if (MODE == 1 && i >= 4) { const int kt0 = tile * 64 - CTX, qt0 = q0 - CTX + wave * 32; active = (kt0 + 63 >= qt0 - 128) && (kt0 <= qt0 + 31 + 128); }
        if (active) {
            f32x16 p0, p1;
#pragma unroll
            for (int r = 0; r < 16; ++r) { p0[r] = 0.f; p1[r] = 0.f; }
            const LAS unsigned char* kb = lds + cur * KBUF + r32 * RSK + hi * 16;
#pragma unroll
            for (int d0 = 0; d0 < ND0; ++d0) { const bf16x8 k0 = *(const LAS bf16x8*)(kb + d0 * 32), k1 = *(const LAS bf16x8*)(kb + 32 * RSK + d0 * 32);
                p0 = __builtin_amdgcn_mfma_f32_32x32x16_bf16(k0, qf[d0], p0, 0, 0, 0); p1 = __builtin_amdgcn_mfma_f32_32x32x16_bf16(k1, qf[d0], p1, 0, 0, 0); }
            if (MODE == 1 && i >= 4) { const int rel0 = (tile * 64 - CTX) - (qrow - CTX);
#pragma unroll
                for (int r = 0; r < 16; ++r) { const int ra = rel0 + crow16(r, hi), rb = ra + 32;
                    if (ra > 128 || ra < -128) p0[r] = -1e30f; if (rb > 128 || rb < -128) p1[r] = -1e30f; } }
            float mx = fmaxf(p0[0], p1[0]);
#pragma unroll
            for (int r = 1; r < 16; ++r) mx = fmaxf(mx, fmaxf(p0[r], p1[r]));
            mx = xhalf_max(mx);
            const float mn = fmaxf(m, mx), alpha = __builtin_amdgcn_exp2f((m - mn) * c), nmc = -mn * c; m = mn;
            float sum = 0.f;
#pragma unroll
            for (int r = 0; r < 16; ++r) { p0[r] = __builtin_amdgcn_exp2f(fmaf(p0[r], c, nmc)); p1[r] = __builtin_amdgcn_exp2f(fmaf(p1[r], c, nmc)); sum += p0[r] + p1[r]; }
            l = l * alpha + sum;
            if (!__all(alpha == 1.f)) {
#pragma unroll
                for (int db = 0; db < NDB; ++db)
#pragma unroll
                    for (int r = 0; r < 16; ++r) o[db][r] *= alpha; }
            const LAS unsigned char* vb = lds + 2 * KBUF + cur * VBUF + r32 * RSV + hi * 8;
#pragma unroll
            for (int s = 0; s < 4; ++s) { const int rb = (s & 1) * 8;
                v4u pw;
                if (s < 2) { pw.x = cvtpk_s(p0[rb + 0], p0[rb + 1]); pw.y = cvtpk_s(p0[rb + 2], p0[rb + 3]); pw.z = cvtpk_s(p0[rb + 4], p0[rb + 5]); pw.w = cvtpk_s(p0[rb + 6], p0[rb + 7]); }
                else       { pw.x = cvtpk_s(p1[rb + 0], p1[rb + 1]); pw.y = cvtpk_s(p1[rb + 2], p1[rb + 3]); pw.z = cvtpk_s(p1[rb + 4], p1[rb + 5]); pw.w = cvtpk_s(p1[rb + 6], p1[rb + 7]); }
                const bf16x8 pf = __builtin_bit_cast(bf16x8, pw);
#pragma unroll
                for (int db = 0; db < NDB; ++db) { const LAS unsigned char* vp = vb + db * 32 * RSV + s * 32;
                    const v2u a0 = *(const LAS v2u*)(vp), a1 = *(const LAS v2u*)(vp + 16);
                    const bf16x8 vf = __builtin_bit_cast(bf16x8, (v4u){a0.x, a0.y, a1.x, a1.y});
                    o[db] = __builtin_amdgcn_mfma_f32_32x32x16_bf16(vf, pf, o[db], 0, 0, 0); }
                __builtin_amdgcn_sched_barrier(0); }
        }
        if (i + 1 < ntiles) STORE_TILE(cur ^ 1);
        __syncthreads();
    }
#undef LOAD_TILE
#undef STORE_TILE
#undef TILE_OF
    l = xhalf_sum(l);
    const float il = 1.f / l;
#pragma unroll
    for (int db = 0; db < NDB; ++db)
#pragma unroll
        for (int rr = 0; rr < 4; ++rr) { const int d = 32 * db + 8 * rr + 4 * hi;
            const float a = o[db][4 * rr] * il, b = o[db][4 * rr + 1] * il, cc = o[db][4 * rr + 2] * il, dd = o[db][4 * rr + 3] * il;
            if (OUTF32) *(f32x4*)((float*)Ob + (size_t)qrow * os + d) = (f32x4){a, b, cc, dd};
            else *(v2u*)((bf16*)Ob + (size_t)qrow * os + d) = (v2u){cvtpk_s(a, b), cvtpk_s(cc, dd)}; }
}

__device__ __forceinline__ void phase_att(const P& p, LAS unsigned char* lds, int layer) {
    unsigned char* wsb = opq_p(p.ws);
    layer = opq_s(layer);
    const int tid = tid_opaque(), lane = tid & 63, wave = __builtin_amdgcn_readfirstlane(tid >> 6), G = gridDim.x, blk = blockIdx.x;
    const int gw = wave * G + blk;
    const bool last = layer == DEPTH - 1;
    const bf16* COLS = (const bf16*)(wsb + WS_COLS);
    const bf16* QM = (const bf16*)(wsb + WS_QM); const bf16* KM = (const bf16*)(wsb + WS_KM);
    const bf16* VTD = (const bf16*)(wsb + WS_VTD); const bf16* VTG = (const bf16*)(wsb + WS_VTG); const bf16* VTM = (const bf16*)(wsb + WS_VTM);
    bf16* YMIX = (bf16*)(wsb + WS_YMIX); float* DIFFO = (float*)(wsb + WS_DIFFO);
    const f32x2* AB = (const f32x2*)(wsb + WS_AB); float* HS = (float*)(wsb + WS_HS);
    if (gw < 64) { const int r = gw;
        const int b = r >> 4, dir = (r >> 3) & 1, ch = (r & 7) * 64 + lane;
        const f32x2* ab = AB + ((size_t)dir * M + (size_t)b * PB) * 512 + ch; float* hs = HS + ((size_t)dir * M + (size_t)b * PB) * 512 + ch;
        float h = 0.f;
        if (dir == 0) {
#pragma unroll 8
            for (int q = 0; q < PB; ++q) { const f32x2 c = ab[(size_t)q * 512]; h = c.x * h + c.y; hs[(size_t)q * 512] = h; }
        } else {
#pragma unroll 8
            for (int q = CTX - 1; q >= 0; --q) { const f32x2 c = ab[(size_t)q * 512]; h = c.x * h + c.y; hs[(size_t)q * 512] = h; }
#pragma unroll 8
            for (int q = PB - 1; q >= CTX; --q) { const f32x2 c = ab[(size_t)q * 512]; h = c.x * h + c.y; hs[(size_t)q * 512] = h; }
        } }
    for (int u = blk; u < 256; u += G) {
        const int xcd = u & 7, j = u >> 3, grp = xcd * 4 + (j >> 3), qb = j & 7, b = grp >> 3, hh = grp & 7, q0 = CTX + qb * 256;
        const size_t rb = (size_t)b * PB;
        attn_unit<96, 64, 0, false>(lds, QM + rb * 768 + hh * 96, 768, KM + rb * 768 + hh * 96, 768, VTM + ((size_t)b * 512 + hh * 64) * PB, YMIX + rb * 2048 + 512 + hh * 64, 2048, q0, 36, 0.10206207261596575f, 0.f, tid);
        for (int vh = 0; vh < 2; ++vh)
            attn_unit<64, 64, 0, true>(lds, COLS + rb * NINP + C_DQ + hh * 64, NINP, COLS + rb * NINP + C_DK + hh * 64, NINP, VTD + ((size_t)b * 512 + (hh >> 1) * 128 + vh * 64) * PB, DIFFO + rb * 1024 + hh * 128 + vh * 64, 1024, q0, 36, 0.125f, 0.f, tid);
        attn_unit<64, 64, 1, false>(lds, COLS + rb * NINP + C_GQ + hh * 64, NINP, COLS + rb * NINP + C_GK + (hh >> 2) * 64, NINP, VTG + ((size_t)b * 128 + (hh >> 2) * 64) * PB, YMIX + rb * 2048 + 1536 + hh * 64, 2048, q0, 0, 0.125f, p.in[22][layer * 8 + hh], tid);
    }
    if (!last) {
        for (int u = blk; u < 96; u += G) { const int kind = u >> 5, b = (u >> 3) & 3, hh = u & 7; const size_t rb = (size_t)b * PB;
            if (kind == 0) attn_unit<96, 64, 0, false>(lds, QM + rb * 768 + hh * 96, 768, KM + rb * 768 + hh * 96, 768, VTM + ((size_t)b * 512 + hh * 64) * PB, YMIX + rb * 2048 + 512 + hh * 64, 2048, 0, 4, 0.10206207261596575f, 0.f, tid);
            else if (kind == 1) { for (int vh = 0; vh < 2; ++vh) attn_unit<64, 64, 0, true>(lds, COLS + rb * NINP + C_DQ + hh * 64, NINP, COLS + rb * NINP + C_DK + hh * 64, NINP, VTD + ((size_t)b * 512 + (hh >> 1) * 128 + vh * 64) * PB, DIFFO + rb * 1024 + hh * 128 + vh * 64, 1024, 0, 4, 0.125f, 0.f, tid); }
            else attn_unit<64, 64, 1, false>(lds, COLS + rb * NINP + C_GQ + hh * 64, NINP, COLS + rb * NINP + C_GK + (hh >> 2) * 64, NINP, VTG + ((size_t)b * 128 + (hh >> 2) * 64) * PB, YMIX + rb * 2048 + 1536 + hh * 64, 2048, 0, 0, 0.125f, p.in[22][layer * 8 + hh], tid);
        }
    }
}

__device__ __forceinline__ void phase_mixfin(const P& p, int layer) {
    unsigned char* wsb = opq_p(p.ws);
    layer = opq_s(layer);
    const int tid = tid_opaque(), lane = tid & 63, wave = tid >> 6, G = gridDim.x, blk = blockIdx.x;
    const int gw = wave * G + blk, NGW = NW * G;
    const bool last = layer == DEPTH - 1;
    const bf16* COLS = (const bf16*)(wsb + WS_COLS); bf16* YMIX = (bf16*)(wsb + WS_YMIX); const float* DIFFO = (const float*)(wsb + WS_DIFFO); const float* HS = (const float*)(wsb + WS_HS);
    const float* lv = p.in[20] + (size_t)layer * 4 * 64; const float* dg = p.in[21] + (size_t)layer * 128;
    const float lam_init = 0.8f - 0.6f * expf(-0.3f * (float)layer);
    const float lam = expf(wave_sum(lv[lane] * lv[64 + lane])) - expf(wave_sum(lv[128 + lane] * lv[192 + lane])) + lam_init;
    for (int row = gw; row < M; row += NGW) {
        const int pp = row % PB; if (last && pp < CTX) continue;
#pragma unroll
        for (int cblk = 0; cblk < 8; ++cblk) { const int ch = cblk * 64 + lane;
            const float hsum = HS[(size_t)row * 512 + ch] + HS[((size_t)M + row) * 512 + ch];
            const float gt = bf2f(COLS[(size_t)row * NINP + C_GATE + ch]);
            YMIX[(size_t)row * 2048 + ch] = (bf16)f2bf(hsum * gelu_tanh(gt)); }
#pragma unroll
        for (int hh = 0; hh < 4; ++hh) { float o[2]; float s = 0.f;
#pragma unroll
            for (int j = 0; j < 2; ++j) { const int e = lane + 64 * j;
                o[j] = DIFFO[(size_t)row * 1024 + (2 * hh) * 128 + e] - lam * DIFFO[(size_t)row * 1024 + (2 * hh + 1) * 128 + e]; s += o[j] * o[j]; }
            s = wave_sum(s); const float rstd = 1.0f / sqrtf(s * (1.0f / 128.f) + 1e-6f);
#pragma unroll
            for (int j = 0; j < 2; ++j) { const int e = lane + 64 * j; YMIX[(size_t)row * 2048 + 1024 + hh * 128 + e] = (bf16)f2bf(o[j] * rstd * dg[e] * (1.0f - lam_init)); } }
    }
}


#define XB_TMO      128
#define XB_XCNT(j)  (256  + 64 * (j))
#define XB_XSUB(j)  (1280 + 64 * (j))
#define XB_XGEN(j)  (2304 + 64 * (j))
#define XB_TOP      3328
#define XB_TOPGEN   3392
#define XCD_BAR_WORDS 3456
#define XB_SPIN_CAP (1u << 18)

__device__ __forceinline__ unsigned xb_ld(unsigned* p)              { return __hip_atomic_load(p, __ATOMIC_RELAXED, __HIP_MEMORY_SCOPE_AGENT); }
__device__ __forceinline__ unsigned xb_add(unsigned* p, unsigned v) { return __hip_atomic_fetch_add(p, v, __ATOMIC_RELAXED, __HIP_MEMORY_SCOPE_AGENT); }
__device__ __forceinline__ unsigned xb_xcc_id() { return (unsigned)__builtin_amdgcn_s_getreg((3 << 11) | 20) & 0xFu; }
#define XB_SPIN(cond, bar) do { unsigned _sp = 0; while (cond) { __builtin_amdgcn_s_sleep(1); \
    if ((++_sp & 255u) == 0u) { if (xb_ld(&(bar)[XB_TMO])) break; if (_sp > XB_SPIN_CAP) { atomicAdd(&(bar)[XB_TMO], 1u); break; } } } } while (0)

struct XcdBarrier {
    unsigned* bar; unsigned x;
    volatile LAS unsigned* st;
};

__device__ __forceinline__ XcdBarrier xcd_barrier_post(unsigned* bar, volatile LAS unsigned* st) {
    XcdBarrier b; b.bar = bar; b.x = xb_xcc_id(); b.st = st;
    if (threadIdx.x == 0) (void)xb_add(&bar[XB_XCNT(b.x)], 1u);
    return b;
}
__device__ __forceinline__ void xcd_barrier_complete(unsigned* bar, unsigned x, unsigned& nloc, unsigned& nx) {
    const unsigned G = gridDim.x * gridDim.y * gridDim.z;
    unsigned sum, cnt, mine, sp = 0u;
    for (;;) {
        sum = 0u; cnt = 0u; mine = 0u;
#pragma unroll
        for (unsigned j = 0; j < 16; ++j) { const unsigned c = xb_ld(&bar[XB_XCNT(j)]); sum += c; cnt += (c > 0u) ? 1u : 0u; mine = (j == x) ? c : mine; }
        if (sum == G) break;
        __builtin_amdgcn_s_sleep(1);
        if ((++sp & 255u) == 0u) { if (xb_ld(&bar[XB_TMO])) break; if (sp > XB_SPIN_CAP) { atomicAdd(&bar[XB_TMO], 1u); break; } }
    }
    nloc = mine > 0u ? mine : 1u; nx = cnt > 0u ? cnt : 1u;
}

__device__ __forceinline__ void xcd_barrier(const XcdBarrier& b) {
    asm volatile("s_waitcnt vmcnt(0)" ::: "memory");
    __syncthreads();
    if (threadIdx.x == 0) {
        unsigned* bar = b.bar; const unsigned bx = xb_xcc_id();
        __builtin_amdgcn_s_waitcnt(0);
        unsigned nloc = b.st[0], nx = b.st[1];
        if (nloc == 0u) { xcd_barrier_complete(bar, bx, nloc, nx); b.st[0] = nloc; b.st[1] = nx; }
        const unsigned old = xb_add(&bar[XB_XSUB(bx)], 1u);
        const unsigned gen = old / nloc;
        if (old + 1u == (gen + 1u) * nloc) {
            __builtin_amdgcn_fence(__ATOMIC_RELEASE, "agent");
            asm volatile("s_waitcnt vmcnt(0)" ::: "memory");
            const unsigned og = xb_add(&bar[XB_TOP], 1u);
            const unsigned tg = og / nx;
            if (og + 1u == (tg + 1u) * nx) xb_add(&bar[XB_TOPGEN], 1u);
            else XB_SPIN(xb_ld(&bar[XB_TOPGEN]) == tg, bar);
            __builtin_amdgcn_fence(__ATOMIC_ACQUIRE, "agent");
            xb_add(&bar[XB_XGEN(bx)], 1u);
            asm volatile("s_waitcnt vmcnt(0)" ::: "memory");
        } else {
            XB_SPIN(xb_ld(&bar[XB_XGEN(bx)]) == gen, bar);
            __builtin_amdgcn_fence(__ATOMIC_ACQUIRE, "agent");
            asm volatile("s_waitcnt vmcnt(0)" ::: "memory");
        }
    }
    __syncthreads();
}

constexpr int CW_BAR = 4096;
constexpr size_t CTL_ZERO_BYTES = 1 * MiB;
constexpr int LDSCTL_OFF = 131072, MISC_OFF = LDSCTL_OFF + 320;

__global__ void __launch_bounds__(NT, 2) k_mega(P p) {
    extern __shared__ __attribute__((aligned(16))) unsigned char lds_raw[];
    LAS unsigned char* lds = (LAS unsigned char*)lds_raw;
    const KP kp = (KP)__builtin_amdgcn_kernarg_segment_ptr();
    for (int u = threadIdx.x; u < (LDS_BYTES - LDSCTL_OFF) / 4; u += NT) ((LAS unsigned*)(lds + LDSCTL_OFF))[u] = 0u;
    __syncthreads();
    unsigned* barw = (unsigned*)(p.ws + WS_CTL) + CW_BAR;
    XcdBarrier bar = xcd_barrier_post(barw, (volatile LAS unsigned*)(lds + MISC_OFF) + 8);
#define GB() xcd_barrier(bar)
    phase_pro1(load_P(kp), lds); GB();
    phase_pro2(load_P(kp)); GB();
    for (int l = 0; l < DEPTH; ++l) {
        for (int which = 0; which < 2; ++which) {
            phase_ffn_in(load_P(kp), lds, l, which); GB();
            phase_ffn_out(load_P(kp), lds, l, which); GB();
            phase_post(load_P(kp), l, which == 0 ? 0 : 2); GB();
            if (which == 0) {
                phase_inproj(load_P(kp), lds, l); GB();
                phase_prep(load_P(kp), lds, l); GB();
                phase_mgemm(load_P(kp), lds, l); GB();
                phase_prep2(load_P(kp), lds, l); GB();
                phase_att(load_P(kp), lds, l); GB();
                phase_mixfin(load_P(kp), l); GB();
                phase_outproj(load_P(kp), lds, l); GB();
                phase_post(load_P(kp), l, 1); GB();
            }
        }
    }
#undef GB
    if (__hip_atomic_load(barw + XB_TMO, __ATOMIC_RELAXED, __HIP_MEMORY_SCOPE_AGENT) != 0u) {
        const float q = __builtin_nanf("");
        for (size_t i = (size_t)blockIdx.x * NT + threadIdx.x; i < (size_t)NB * SEQ * D; i += (size_t)gridDim.x * NT) p.out[i] = q;
    }
}

extern "C" void kernel_launch(void* const* d_in, const int* in_sizes, int n_in, void* d_out, int out_size, void* d_ws, size_t ws_size, hipStream_t stream) {
    static int grid = 0;
    if (grid == 0) {
        if (n_in != 23 || out_size != NB * SEQ * D || ws_size < WS_END) { fprintf(stderr, "kernel_launch: unexpected shapes (n_in %d out %d ws %zu need %zu)\n", n_in, out_size, ws_size, (size_t)WS_END); grid = -1; return; }
        int dev = 0, cus = 0, per_cu = 0;
        if (hipGetDevice(&dev) != hipSuccess || hipDeviceGetAttribute(&cus, hipDeviceAttributeMultiprocessorCount, dev) != hipSuccess) { grid = -1; return; }
        if (hipFuncSetAttribute((const void*)k_mega, hipFuncAttributeMaxDynamicSharedMemorySize, LDS_BYTES) != hipSuccess) { fprintf(stderr, "kernel_launch: hipFuncSetAttribute failed\n"); grid = -1; return; }
        if (hipOccupancyMaxActiveBlocksPerMultiprocessor(&per_cu, (const void*)k_mega, NT, LDS_BYTES) != hipSuccess || per_cu < 1)
            fprintf(stderr, "kernel_launch: note: occupancy query reports %d workgroups per CU\n", per_cu);
        (void)hipGetLastError();
        grid = cus;
    }
    if (grid < 0) return;
    if (hipMemsetAsync((char*)d_ws + WS_CTL, 0, CTL_ZERO_BYTES, stream) != hipSuccess) { fprintf(stderr, "kernel_launch: memset failed\n"); return; }
    P p{};
    for (int i = 0; i < 23; ++i) p.in[i] = (const float*)d_in[i];
    p.out = (float*)d_out; p.ws = (unsigned char*)d_ws;
    hipLaunchKernelGGL(k_mega, dim3(grid), dim3(NT), LDS_BYTES, stream, p);
}
```

```cpp
#include <hip/hip_runtime.h>
#include <cstdio>
#include <cstdint>
__device__ __forceinline__ int opq_s(int x) { asm volatile("" : "+s"(x)); return x; }
__device__ __forceinline__ unsigned char* opq_p(unsigned char* x) { asm volatile("" : "+s"(x)); return x; }
__device__ __forceinline__ int tid_opaque() { int t = (int)threadIdx.x; asm volatile("" : "+v"(t)); return t; }
namespace pg8 {
#define PG8_LAS __attribute__((address_space(3)))
typedef unsigned short bf16_t;
typedef short bf16x8 __attribute__((ext_vector_type(8)));
typedef float f32x4 __attribute__((ext_vector_type(4)));
typedef unsigned u32x4 __attribute__((ext_vector_type(4)));
constexpr int BM = 256, BK = 64, HALF = 128, HTB = HALF * BK * 2  , STAGE_BYTES = 8 * HTB, NXCD = 8, WGM = 8;

__host__ __device__ __forceinline__ int lds_byte(int r, int c) { const int st = (r >> 4) * 2 + (c >> 5), rr = r & 15, cc = c & 31, ob = rr * 64 + cc * 2; return st * 1024 + (ob ^ (((ob >> 9) & 1) << 5)); }
__host__ __device__ __forceinline__ void stage_rc(int b, int& R, int& C) { const int st = b / 1024, sb = b % 1024, swz = sb ^ (((sb >> 9) & 1) << 5); R = (st >> 1) * 16 + swz / 64; C = (st & 1) * 32 + (swz % 64) / 2; }
__host__ __device__ __forceinline__ int perm32(int rho) { const int n = rho >> 4, i = rho & 15; return 8 * (i >> 2) + 4 * n + (i & 3); }

struct Unit { int pm, pn; };
struct Gemm { const bf16_t* A; const bf16_t* Bt; int M, N, K; };

struct StaticOrder {
    int nM, nN, nwg, G, c;
    __host__ __device__ void init(int M, int N, int G_, int c_) { nM = M / BM; nN = N / BM; nwg = nM * nN; G = G_; c = c_; }
    __host__ __device__ bool next(int i, Unit& u) const {
        const long L = (long)i * G + c; if (L >= nwg) return false;
        int wgid = (int)L; { const int q = nwg / NXCD, r = nwg % NXCD, xcd = wgid % NXCD, off = wgid / NXCD; wgid = (xcd < r ? xcd * (q + 1) : r * (q + 1) + (xcd - r) * q) + off; }
        const int nig = WGM * nN, gid = wgid / nig, fm = gid * WGM, gsz = (nM - fm) < WGM ? (nM - fm) : WGM;
        u.pm = fm + ((wgid % nig) % gsz); u.pn = (wgid % nig) / gsz; return true;
    }
    __device__ __forceinline__ void a_ready(const Unit&) const {}
    __device__ __forceinline__ void done(const Unit&) const {}
};

__device__ __forceinline__ unsigned cvt_pk_bf16(float lo, float hi) { unsigned r; asm volatile("v_cvt_pk_bf16_f32 %0, %1, %2" : "=v"(r) : "v"(lo), "v"(hi)); return r; }
typedef float f32x2 __attribute__((ext_vector_type(2)));
}
namespace pg8 {
template <class Epi, class Sched, bool ALIGN_EPI = false, bool SP2 = false>
__device__ __forceinline__ void gemm_phase(PG8_LAS unsigned char* lds, const Gemm g, const Sched& S, const Epi& E) {
    const int tid = tid_opaque(), wid = __builtin_amdgcn_readfirstlane(tid >> 6), lane = tid & 63, wr = wid >> 2, wc = wid & 3, fr = lane & 15, fq = lane >> 4;
    const int K = g.K, nt = K / BK;
    unsigned voffA[2], voffB[2];
#pragma unroll
    for (int i = 0; i < 2; ++i) { int R, C; stage_rc(tid * 16 + i * 8192, R, C); const int Rb = Epi::PERM ? ((R & ~31) + perm32(R & 31)) : R;
        voffA[i] = (unsigned)(R * K + C) * 2u; voffB[i] = (unsigned)(Rb * K + C) * 2u; }
    const size_t kstep = (size_t)(BK * 2);
    const size_t hstep = (size_t)HALF * K * 2;
    const size_t tstep = 2 * hstep;
    const unsigned ldsw = (unsigned)wid * 1024u;
    const int aoff = lds_byte(wr * 64 + fr, fq * 8), boff = lds_byte(wc * 32 + fr, fq * 8);
#define PG8_SA(b, h) (((b) * 2 + (h)) * HTB)
#define PG8_SB(b, h) ((4 + (b) * 2 + (h)) * HTB)
#define PG8_STAGE(bufoff, gbase, voff) do { _Pragma("unroll") for (int _i = 0; _i < 2; ++_i) \
        __builtin_amdgcn_global_load_lds((const unsigned*)((const char*)(gbase) + (voff)[_i]), (PG8_LAS unsigned*)(lds + (bufoff) + ldsw + _i * 8192), 16, 0, 0); } while (0)
#define PG8_LDA(dst, b, h) do { _Pragma("unroll") for (int m = 0; m < 4; ++m) _Pragma("unroll") for (int k = 0; k < 2; ++k) dst[m][k] = *(const PG8_LAS bf16x8*)(lds + PG8_SA(b, h) + aoff + m * 2048 + k * 1024); } while (0)
#define PG8_LDB(dst, b, h) do { _Pragma("unroll") for (int n = 0; n < 2; ++n) _Pragma("unroll") for (int k = 0; k < 2; ++k) dst[n][k] = *(const PG8_LAS bf16x8*)(lds + PG8_SB(b, h) + boff + n * 2048 + k * 1024); } while (0)
#define PG8_MMA(ai, bj, At, Bt) do { __builtin_amdgcn_s_setprio(1); _Pragma("unroll") for (int m = 0; m < 4; ++m) _Pragma("unroll") for (int n = 0; n < 2; ++n) _Pragma("unroll") for (int k = 0; k < 2; ++k) \
        acc[ai][bj][m][n] = __builtin_amdgcn_mfma_f32_16x16x32_bf16(Bt[n][k], At[m][k], acc[ai][bj][m][n], 0, 0, 0); __builtin_amdgcn_s_setprio(0); } while (0)
#define PG8_WAIT_V(n) asm volatile("s_waitcnt vmcnt(" #n ")" ::: "memory")
#define PG8_WAIT_L(n) asm volatile("s_waitcnt lgkmcnt(" #n ")" ::: "memory")
#define PG8_BAR __builtin_amdgcn_s_barrier()
#define PG8_SCHED __builtin_amdgcn_sched_barrier(0)
    Unit cur, nxt; int ui = 0;
    if (!S.next(0, cur)) return;
    f32x4 acc[2][2][4][2];
#pragma unroll
    for (int a = 0; a < 2; ++a)
#pragma unroll
        for (int b = 0; b < 2; ++b)
#pragma unroll
            for (int m = 0; m < 4; ++m)
#pragma unroll
                for (int n = 0; n < 2; ++n) acc[a][b][m][n] = (f32x4){0.f, 0.f, 0.f, 0.f};
    bf16x8 At[4][2], B0[2][2], B1[2][2];
    const char* cA = (const char*)g.A + (size_t)cur.pm * tstep; const char* cB = (const char*)g.Bt + (size_t)cur.pn * tstep;
    S.a_ready(cur);
    if constexpr (SP2) {
        PG8_STAGE(PG8_SB(0, 0), cB, voffB); PG8_STAGE(PG8_SB(0, 1), cB + hstep, voffB); PG8_STAGE(PG8_SA(0, 0), cA, voffA); PG8_STAGE(PG8_SA(0, 1), cA + hstep, voffA);
        if (wr == 1) PG8_BAR;
        PG8_WAIT_V(2); PG8_BAR;
        PG8_STAGE(PG8_SB(1, 0), cB + kstep, voffB); PG8_STAGE(PG8_SA(1, 0), cA + kstep, voffA); PG8_STAGE(PG8_SB(1, 1), cB + hstep + kstep, voffB);
        PG8_WAIT_V(6); PG8_BAR;
    } else {
        PG8_STAGE(PG8_SB(0, 0), cB, voffB); PG8_STAGE(PG8_SA(0, 0), cA, voffA); PG8_STAGE(PG8_SB(0, 1), cB + hstep, voffB); PG8_STAGE(PG8_SA(0, 1), cA + hstep, voffA);
        if (wr == 1) PG8_BAR;
        PG8_WAIT_V(4); PG8_BAR;
        PG8_STAGE(PG8_SB(1, 0), cB + kstep, voffB); PG8_STAGE(PG8_SA(1, 0), cA + kstep, voffA); PG8_STAGE(PG8_SB(1, 1), cB + hstep + kstep, voffB);
        PG8_WAIT_V(6); PG8_BAR;
    }
    for (;;) {
        const bool has_next = S.next(ui + 1, nxt);
        const char* nA = has_next ? (const char*)g.A + (size_t)nxt.pm * tstep : cA; const char* nB = has_next ? (const char*)g.Bt + (size_t)nxt.pn * tstep : cB;
        for (int t = 0; t < nt; t += 2) {
            const bool last = (t == nt - 2);
            const char* a1 = cA + (size_t)(t + 1) * kstep;
            const char* a2 = last ? nA : cA + (size_t)(t + 2) * kstep; const char* b2 = last ? nB : cB + (size_t)(t + 2) * kstep;
            const char* a3 = a2 + kstep; const char* b3 = b2 + kstep;
            if (last && has_next) S.a_ready(nxt);
            if constexpr (SP2) {
            PG8_LDB(B0, 0, 0); PG8_LDB(B1, 0, 1); PG8_SCHED; PG8_LDA(At, 0, 0); PG8_STAGE(PG8_SA(1, 1), a1 + hstep, voffA);
            PG8_WAIT_V(8); PG8_WAIT_L(0); PG8_BAR; PG8_MMA(0, 0, At, B0); PG8_MMA(0, 1, At, B1); PG8_BAR; PG8_SCHED;
            PG8_LDA(At, 0, 1); PG8_STAGE(PG8_SB(0, 0), b2, voffB); PG8_STAGE(PG8_SB(0, 1), b2 + hstep, voffB); PG8_STAGE(PG8_SA(0, 0), a2, voffA);
            PG8_WAIT_V(8); PG8_WAIT_L(0); PG8_BAR; PG8_MMA(1, 0, At, B0); PG8_MMA(1, 1, At, B1); PG8_BAR; PG8_SCHED;
            PG8_LDB(B0, 1, 0); PG8_LDB(B1, 1, 1); PG8_SCHED; PG8_LDA(At, 1, 0); PG8_STAGE(PG8_SA(0, 1), a2 + hstep, voffA);
            PG8_WAIT_V(8); PG8_WAIT_L(0); PG8_BAR; PG8_MMA(0, 0, At, B0); PG8_MMA(0, 1, At, B1); PG8_BAR; PG8_SCHED;
            PG8_LDA(At, 1, 1); PG8_STAGE(PG8_SB(1, 0), b3, voffB); PG8_STAGE(PG8_SB(1, 1), b3 + hstep, voffB); PG8_STAGE(PG8_SA(1, 0), a3, voffA);
            PG8_WAIT_V(8); PG8_WAIT_L(0); PG8_BAR; PG8_MMA(1, 0, At, B0); PG8_MMA(1, 1, At, B1); PG8_BAR; PG8_SCHED;
            } else {
            PG8_LDB(B0, 0, 0); PG8_SCHED; PG8_LDA(At, 0, 0); PG8_STAGE(PG8_SA(1, 1), a1 + hstep, voffA);
            PG8_WAIT_L(8); PG8_BAR; PG8_WAIT_L(0); PG8_MMA(0, 0, At, B0); PG8_BAR; PG8_SCHED;
            PG8_LDB(B1, 0, 1); PG8_STAGE(PG8_SB(0, 0), b2, voffB);
            PG8_BAR; PG8_WAIT_L(0); PG8_MMA(0, 1, At, B1); PG8_BAR;
            PG8_LDA(At, 0, 1); PG8_STAGE(PG8_SA(0, 0), a2, voffA);
            PG8_BAR; PG8_WAIT_L(0); PG8_MMA(1, 0, At, B0); PG8_BAR; PG8_SCHED;
            PG8_STAGE(PG8_SB(0, 1), b2 + hstep, voffB);
            PG8_WAIT_V(6); PG8_BAR; PG8_MMA(1, 1, At, B1); PG8_BAR;
            PG8_LDB(B0, 1, 0); PG8_SCHED; PG8_LDA(At, 1, 0); PG8_STAGE(PG8_SA(0, 1), a2 + hstep, voffA);
            PG8_WAIT_L(8); PG8_BAR; PG8_WAIT_L(0); PG8_MMA(0, 0, At, B0); PG8_BAR; PG8_SCHED;
            PG8_LDB(B1, 1, 1); PG8_STAGE(PG8_SB(1, 0), b3, voffB);
            PG8_BAR; PG8_WAIT_L(0); PG8_MMA(0, 1, At, B1); PG8_BAR;
            PG8_LDA(At, 1, 1); PG8_STAGE(PG8_SA(1, 0), a3, voffA);
            PG8_BAR; PG8_WAIT_L(0); PG8_MMA(1, 0, At, B0); PG8_BAR; PG8_SCHED;
            PG8_STAGE(PG8_SB(1, 1), b3 + hstep, voffB);
            PG8_WAIT_V(6); PG8_BAR; PG8_MMA(1, 1, At, B1); PG8_BAR;
            }
        }
        if constexpr (ALIGN_EPI) { if (wr == 0) PG8_BAR; }
        if constexpr (!Epi::AFTER_DRAIN) { E(acc, cur, wr, wc, fr, fq); S.done(cur); }
        if (!has_next) break;
#pragma unroll
        for (int a = 0; a < 2; ++a)
#pragma unroll
            for (int b = 0; b < 2; ++b)
#pragma unroll
                for (int m = 0; m < 4; ++m)
#pragma unroll
                    for (int n = 0; n < 2; ++n) acc[a][b][m][n] = (f32x4){0.f, 0.f, 0.f, 0.f};
        cur = nxt; cA = nA; cB = nB; ++ui;
        if constexpr (ALIGN_EPI) { if (wr == 1) PG8_BAR; }
    }
    PG8_WAIT_V(0);
    if constexpr (!ALIGN_EPI) { if (wr == 0) PG8_BAR; }
    PG8_BAR;
    if constexpr (Epi::AFTER_DRAIN) { E.fused(acc, cur, wr, wc, fr, fq, lds, wid, lane); S.done(cur); }
#undef PG8_SA
#undef PG8_SB
#undef PG8_STAGE
#undef PG8_LDA
#undef PG8_LDB
#undef PG8_MMA
#undef PG8_WAIT_V
#undef PG8_WAIT_L
#undef PG8_BAR
#undef PG8_SCHED
}
}

#define GAS __attribute__((address_space(1)))
#define LAS __attribute__((address_space(3)))
typedef unsigned short bf16;
typedef unsigned v4u __attribute__((ext_vector_type(4)));
typedef unsigned v2u __attribute__((ext_vector_type(2)));
typedef float f32x4 __attribute__((ext_vector_type(4)));
typedef float f32x2 __attribute__((ext_vector_type(2)));

constexpr int D = 2048, NB = 4, SEQ = 2048, CTX = 256, PB = 2304, M = NB * PB, DEPTH = 4, DFF = 5632, NIN = 4000, NINP = 4096, NMODC = 9 * D;
constexpr int NT = 512, NW = 8;
constexpr int C_XB = 0, C_GATE = 512, C_MQ = 1024, C_MKV = 1408, C_MKR = 1664, C_DQ = 1696, C_DK = 2208, C_DV = 2720, C_GQ = 3232, C_GK = 3744, C_GV = 3872;

constexpr size_t MiB = 1u << 20;
constexpr size_t WS_CTL = 0;
constexpr size_t WS_MOD = 1 * MiB;
constexpr size_t WS_ROPE = 3 * MiB;
constexpr size_t WS_WFFI = 4 * MiB;
constexpr size_t WS_WFFO = WS_WFFI + 352 * MiB;
constexpr size_t WS_WIN = WS_WFFO + 176 * MiB;
constexpr size_t WS_WOUT = WS_WIN + 64 * MiB;
constexpr size_t WS_WQB = WS_WOUT + 32 * MiB;
constexpr size_t WS_WKVB = WS_WQB + 3 * MiB;
constexpr size_t WS_WG = WS_WKVB + 2 * MiB;
constexpr size_t WS_X = WS_WG + 8 * MiB;
constexpr size_t WS_H = WS_X + 72 * MiB;
constexpr size_t WS_ACT = WS_H + 36 * MiB;
constexpr size_t WS_Y = WS_ACT + 99 * MiB;
constexpr size_t WS_COLS = WS_Y + 72 * MiB;
constexpr size_t WS_U = WS_COLS + 72 * MiB;
constexpr size_t WS_GATES = WS_U + 9 * MiB;
constexpr size_t WS_QN = WS_GATES + 72 * MiB;
constexpr size_t WS_KVN = WS_QN + 7 * MiB;
constexpr size_t WS_QUP = WS_KVN + 5 * MiB;
constexpr size_t WS_KVUP = WS_QUP + 14 * MiB;
constexpr size_t WS_QM = WS_KVUP + 18 * MiB;
constexpr size_t WS_KM = WS_QM + 14 * MiB;
constexpr size_t WS_AB = WS_KM + 14 * MiB;
constexpr size_t WS_HS = WS_AB + 72 * MiB;
constexpr size_t WS_DIFFO = WS_HS + 36 * MiB;
constexpr size_t WS_YMIX = WS_DIFFO + 36 * MiB;
constexpr size_t WS_VTD = WS_YMIX + 36 * MiB;
constexpr size_t WS_VTG = WS_VTD + 9 * MiB;
constexpr size_t WS_VTM = WS_VTG + 3 * MiB;
constexpr size_t WS_SUM = WS_VTM + 9 * MiB;
constexpr size_t WS_END = WS_SUM + 2 * MiB;

constexpr int LDS_BYTES = 147456;

struct P { const float* in[23]; float* out; unsigned char* ws; };
typedef const __attribute__((address_space(4))) P* KP;
__device__ __forceinline__ P load_P(KP kp) {
#if defined(__HIP_DEVICE_COMPILE__)
    asm volatile("" : "+s"(kp)); P r; for (int i = 0; i < 23; ++i) r.in[i] = kp->in[i]; r.out = kp->out; r.ws = kp->ws; return r;
#else
    (void)kp; return P{};
#endif
}

#define LDS_WAIT() asm volatile("s_waitcnt lgkmcnt(0)" ::: "memory")
__device__ __forceinline__ unsigned f2bf(float f) { unsigned u = __builtin_bit_cast(unsigned, f); return (u + 0x7fffu + ((u >> 16) & 1u)) >> 16; }
__device__ __forceinline__ unsigned pk2(float lo, float hi) { return f2bf(lo) | (f2bf(hi) << 16); }
__device__ __forceinline__ float bf2f(unsigned v) { return __builtin_bit_cast(float, v << 16); }
__device__ __forceinline__ float bflo(unsigned w) { return __builtin_bit_cast(float, w << 16); }
__device__ __forceinline__ float bfhi(unsigned w) { return __builtin_bit_cast(float, w & 0xffff0000u); }
template <int XM> __device__ __forceinline__ float swz_xor(float v) { return __builtin_bit_cast(float, __builtin_amdgcn_ds_swizzle(__builtin_bit_cast(int, v), (XM << 10) | 0x1f)); }
__device__ __forceinline__ void pl32swap(unsigned& a, unsigned& b) { asm volatile("s_nop 1\n\tv_permlane32_swap_b32 %0, %1\n\ts_nop 1" : "+v"(a), "+v"(b)); }
__device__ __forceinline__ float xhalf_sum(float v) { unsigned a = __builtin_bit_cast(unsigned, v), b = a; pl32swap(a, b); return __builtin_bit_cast(float, a) + __builtin_bit_cast(float, b); }
__device__ __forceinline__ float xhalf_max(float v) { unsigned a = __builtin_bit_cast(unsigned, v), b = a; pl32swap(a, b); return fmaxf(__builtin_bit_cast(float, a), __builtin_bit_cast(float, b)); }
__device__ __forceinline__ float wave_sum(float v) {
    v += swz_xor<1>(v); v += swz_xor<2>(v); v += swz_xor<4>(v); v += swz_xor<8>(v); v += swz_xor<16>(v);
    return xhalf_sum(v);
}
__device__ __forceinline__ float sigmoidf_(float x) { return 1.f / (1.f + __expf(-x)); }
__device__ __forceinline__ float siluf_(float x) { return x / (1.f + __expf(-x)); }
__device__ __forceinline__ float gelu_tanh(float x) { const float u = 0.7978845608028654f * (x + 0.044715f * x * x * x); return 0.5f * x * (1.f + tanhf(u)); }

struct TileOrder {
    pg8::StaticOrder so; int latonly;
    __device__ __forceinline__ void init(int nMt, int N, int G, int c, int lat) { so.nM = nMt; so.nN = N / 256; so.nwg = so.nM * so.nN; so.G = G; so.c = c; latonly = lat; }
    __device__ __forceinline__ bool next(int i, pg8::Unit& u) const { if (!so.next(i, u)) return false; if (latonly) u.pm = (u.pm >> 3) * 9 + 1 + (u.pm & 7); return true; }
    __device__ __forceinline__ void a_ready(const pg8::Unit&) const {}
    __device__ __forceinline__ void done(const pg8::Unit&) const {}
};
struct EpiF32 {
    static constexpr bool PERM = false, AFTER_DRAIN = false;
    float* C; int ldc;
    __device__ __forceinline__ void operator()(const f32x4 (&acc)[2][2][4][2], const pg8::Unit& u, int wr, int wc, int fr, int fq) const {
        const int row0 = u.pm * 256 + wr * 64 + fr, col0 = u.pn * 256 + wc * 32 + 4 * fq;
#pragma unroll
        for (int ai = 0; ai < 2; ++ai)
#pragma unroll
            for (int m = 0; m < 4; ++m) { float* rowp = C + (size_t)(row0 + ai * 128 + m * 16) * ldc + col0;
#pragma unroll
                for (int bj = 0; bj < 2; ++bj)
#pragma unroll
                    for (int n = 0; n < 2; ++n) *(f32x4*)(rowp + bj * 128 + n * 16) = acc[ai][bj][m][n]; }
    }
};
struct EpiB16 {
    static constexpr bool PERM = true, AFTER_DRAIN = false;
    bf16* O; int ldc;
    __device__ __forceinline__ void operator()(const f32x4 (&acc)[2][2][4][2], const pg8::Unit& u, int wr, int wc, int fr, int fq) const {
        const int row0 = u.pm * 256 + wr * 64 + fr, col0 = u.pn * 256 + wc * 32 + 8 * fq;
#pragma unroll
        for (int ai = 0; ai < 2; ++ai)
#pragma unroll
            for (int m = 0; m < 4; ++m) { bf16* rowp = O + (size_t)(row0 + ai * 128 + m * 16) * ldc + col0;
#pragma unroll
                for (int bj = 0; bj < 2; ++bj) { const f32x4 v0 = acc[ai][bj][m][0], v1 = acc[ai][bj][m][1];
                    v4u w; w.x = pg8::cvt_pk_bf16(v0[0], v0[1]); w.y = pg8::cvt_pk_bf16(v0[2], v0[3]); w.z = pg8::cvt_pk_bf16(v1[0], v1[1]); w.w = pg8::cvt_pk_bf16(v1[2], v1[3]);
                    *(v4u*)(rowp + bj * 128) = w; } }
    }
};
struct EpiSwiglu {
    static constexpr bool PERM = true, AFTER_DRAIN = false;
    bf16* O; int ldc;
    __device__ __forceinline__ void operator()(const f32x4 (&acc)[2][2][4][2], const pg8::Unit& u, int wr, int wc, int fr, int fq) const {
        const int row0 = u.pm * 256 + wr * 64 + fr, col0 = u.pn * 128 + wc * 32 + 8 * fq;
#pragma unroll
        for (int ai = 0; ai < 2; ++ai)
#pragma unroll
            for (int m = 0; m < 4; ++m) { bf16* rowp = O + (size_t)(row0 + ai * 128 + m * 16) * ldc + col0;
                float r[8];
#pragma unroll
                for (int n = 0; n < 2; ++n)
#pragma unroll
                    for (int e = 0; e < 4; ++e) { const float g = acc[ai][0][m][n][e], uu = acc[ai][1][m][n][e]; r[n * 4 + e] = siluf_(g) * uu; }
                v4u w; w.x = pg8::cvt_pk_bf16(r[0], r[1]); w.y = pg8::cvt_pk_bf16(r[2], r[3]); w.z = pg8::cvt_pk_bf16(r[4], r[5]); w.w = pg8::cvt_pk_bf16(r[6], r[7]);
                *(v4u*)rowp = w; }
    }
};

__device__ __forceinline__ void transpose_item(const float* W, int N, int K, bf16* WT, int k0, int n0, int drow0, LAS float* scr, int lane) {
#pragma unroll 8
    for (int i = 0; i < 32; ++i) { const int kk = 2 * i + (lane >> 5); scr[kk * 33 + (lane & 31)] = W[(size_t)(k0 + kk) * N + n0 + (lane & 31)]; }
    LDS_WAIT(); asm volatile("" ::: "memory");
    const int c = lane & 7;
#pragma unroll
    for (int j = 0; j < 4; ++j) { const int n = (lane >> 3) + 8 * j; const LAS float* s = scr + (8 * c) * 33 + n;
        v4u o; o.x = pk2(s[0 * 33], s[1 * 33]); o.y = pk2(s[2 * 33], s[3 * 33]); o.z = pk2(s[4 * 33], s[5 * 33]); o.w = pk2(s[6 * 33], s[7 * 33]);
        *(v4u*)(WT + (size_t)(drow0 + n) * K + k0 + 8 * c) = o; }
    LDS_WAIT(); asm volatile("" ::: "memory");
}

__device__ __forceinline__ void phase_pro1(const P& p, LAS unsigned char* lds) {
    unsigned char* wsb = opq_p(p.ws);
    const int tid = tid_opaque(), lane = tid & 63, wave = __builtin_amdgcn_readfirstlane(tid >> 6);
    const int G = gridDim.x, blk = blockIdx.x;
    {
        LAS float* sc = (LAS float*)lds;
        LAS float* red = (LAS float*)(lds + 40960);
        const float* c = p.in[1]; const float* cc = p.in[3];
        for (int i = tid; i < 5 * D; i += NT) { const int v = i / D, k = i % D; const float x = v < 4 ? c[v * D + k] : cc[k]; sc[i] = x / (1.f + expf(-x)); }
        __syncthreads();
        const float* wmod = p.in[4]; const float* bmod = p.in[5];
        float* MOD = (float*)(wsb + WS_MOD);
        for (int unit = blk; unit < DEPTH * 288; unit += G) {
            const int l = unit / 288, n0 = (unit % 288) * 64, kq = lane >> 4;
            const float* W = wmod + (size_t)l * D * NMODC + n0 + 4 * (lane & 15);
            float acc[5][4];
#pragma unroll
            for (int v = 0; v < 5; ++v)
#pragma unroll
                for (int e = 0; e < 4; ++e) acc[v][e] = 0.f;
            const int kbase = wave * 256 + kq;
#pragma unroll 4
            for (int i = 0; i < 64; ++i) { const int k = kbase + 4 * i; const f32x4 w = *(const f32x4*)(W + (size_t)k * NMODC);
#pragma unroll
                for (int v = 0; v < 5; ++v) { const float s = sc[v * D + k];
#pragma unroll
                    for (int e = 0; e < 4; ++e) acc[v][e] += s * w[e]; } }
#pragma unroll
            for (int v = 0; v < 5; ++v)
#pragma unroll
                for (int e = 0; e < 4; ++e) { float a = acc[v][e]; a += swz_xor<16>(a); a = xhalf_sum(a); acc[v][e] = a; }
            if (kq == 0) {
#pragma unroll
                for (int v = 0; v < 5; ++v)
#pragma unroll
                    for (int e = 0; e < 4; ++e) red[(wave * 5 + v) * 64 + 4 * (lane & 15) + e] = acc[v][e]; }
            __syncthreads();
            if (tid < 320) { const int v = tid / 64, col = tid % 64; float s = 0.f;
#pragma unroll
                for (int w = 0; w < 8; ++w) s += red[(w * 5 + v) * 64 + col];
                MOD[((size_t)l * 5 + v) * NMODC + n0 + col] = s + bmod[l * NMODC + n0 + col]; }
            __syncthreads();
        }
    }
    __syncthreads();
    {
        LAS float* scr = (LAS float*)(lds + wave * 16384);
        const int gw = wave * G + blk, NGW = NW * G;
        constexpr int I_FI = 32 * 352, I_FO = 88 * 64, I_IN = 32 * 125, I_OUT = 32 * 64, I_QB = 6 * 24, I_KVB = 4 * 32;
        constexpr int T_FI = 8 * I_FI, T_FO = 8 * I_FO, T_IN = 4 * I_IN, T_OUT = 4 * I_OUT, T_QB = 4 * I_QB, T_KVB = 4 * I_KVB;
        constexpr int NITEMS = T_FI + T_FO + T_IN + T_OUT + T_QB + T_KVB;
        for (int it = gw; it < NITEMS; it += NGW) {
            int r = it;
            if (r < T_FI) { const int mat = r / I_FI; r %= I_FI; const int kb = r / 352, nb = r % 352, n0 = nb * 32;
                const int half = n0 / DFF, cc = n0 % DFF, drow0 = (cc / 128) * 256 + half * 128 + (cc % 128);
                transpose_item(p.in[7] + (size_t)mat * D * (2 * DFF), 2 * DFF, D, (bf16*)(wsb + WS_WFFI) + (size_t)mat * (2 * DFF) * D, kb * 64, n0, drow0, scr, lane); continue; }
            r -= T_FI;
            if (r < T_FO) { const int mat = r / I_FO; r %= I_FO; const int kb = r / 64, nb = r % 64;
                transpose_item(p.in[8] + (size_t)mat * DFF * D, D, DFF, (bf16*)(wsb + WS_WFFO) + (size_t)mat * D * DFF, kb * 64, nb * 32, nb * 32, scr, lane); continue; }
            r -= T_FO;
            if (r < T_IN) { const int mat = r / I_IN; r %= I_IN; const int kb = r / 125, nb = r % 125;
                transpose_item(p.in[9] + (size_t)mat * D * NIN, NIN, D, (bf16*)(wsb + WS_WIN) + (size_t)mat * NINP * D, kb * 64, nb * 32, nb * 32, scr, lane); continue; }
            r -= T_IN;
            if (r < T_OUT) { const int mat = r / I_OUT; r %= I_OUT; const int kb = r / 64, nb = r % 64;
                transpose_item(p.in[10] + (size_t)mat * D * D, D, D, (bf16*)(wsb + WS_WOUT) + (size_t)mat * D * D, kb * 64, nb * 32, nb * 32, scr, lane); continue; }
            r -= T_OUT;
            if (r < T_QB) { const int mat = r / I_QB; r %= I_QB; const int kb = r / 24, nb = r % 24;
                transpose_item(p.in[17] + (size_t)mat * 384 * 768, 768, 384, (bf16*)(wsb + WS_WQB) + (size_t)mat * 768 * 384, kb * 64, nb * 32, nb * 32, scr, lane); continue; }
            r -= T_QB;
            { const int mat = r / I_KVB; r %= I_KVB; const int kb = r / 32, nb = r % 32;
                transpose_item(p.in[19] + (size_t)mat * 256 * 1024, 1024, 256, (bf16*)(wsb + WS_WKVB) + (size_t)mat * 1024 * 256, kb * 64, nb * 32, nb * 32, scr, lane); }
        }
    }
    {
        const int gt = blk * NT + tid, NGT = G * NT;
        for (int i = gt; i < DEPTH * 96 * (D / 8); i += NGT) { const int l = i / (96 * (D / 8)), r = i % (96 * (D / 8));
            *(v4u*)((bf16*)(wsb + WS_WIN) + ((size_t)l * NINP + NIN) * D + (size_t)r * 8) = (v4u){0u, 0u, 0u, 0u}; }
        const float* wg = p.in[13];
        for (int i = gt; i < DEPTH * 2048 * 64; i += NGT) { const int l = i / (2048 * 64), r = i % (2048 * 64), np = r / 64, k0 = (r % 64) * 8;
            const int c7 = np & 127, gate = (np >> 7) & 1, chunk = (np >> 8) & 3, dir = np >> 10, ch = chunk * 128 + c7, head = ch >> 6, j = ch & 63;
            v4u o = (v4u){0u, 0u, 0u, 0u};
            if ((k0 >> 6) == head) { const float* src = wg + ((((size_t)l * 2 + dir) * 2 + gate) * 8 + head) * 4096 + (size_t)(k0 & 63) * 64 + j;
                o.x = pk2(src[0], src[64]); o.y = pk2(src[128], src[192]); o.z = pk2(src[256], src[320]); o.w = pk2(src[384], src[448]); }
            *(v4u*)((bf16*)(wsb + WS_WG) + ((size_t)l * 2048 + np) * 512 + k0) = o; }
        float* rope = (float*)(wsb + WS_ROPE);
        for (int i = gt; i < SEQ * 32; i += NGT) { const int t = i / 32, k = i % 32; const float inv = powf(10000.f, -(float)(k & 15) / 16.f);
            const float ang = (k < 16 ? (float)(t / 64) : (float)(t % 64)) * inv; rope[i] = cosf(ang); rope[SEQ * 32 + i] = sinf(ang); }
        for (int i = gt; i < SEQ * 16; i += NGT) { const int t = i / 16, k = i % 16; const float inv = powf(10000.f, -(float)(k & 7) / 8.f);
            const float ang = (k < 8 ? (float)(t / 64) : (float)(t % 64)) * inv; rope[SEQ * 64 + i] = cosf(ang); rope[SEQ * 64 + SEQ * 16 + i] = sinf(ang); }
    }
}

__device__ __forceinline__ float row_rstd(const f32x4 (&v)[8]) {
    float s = 0.f;
#pragma unroll
    for (int j = 0; j < 8; ++j) s += (v[j][0] * v[j][0] + v[j][1] * v[j][1]) + (v[j][2] * v[j][2] + v[j][3] * v[j][3]);
    s = wave_sum(s);
    return 1.0f / sqrtf(s * (1.0f / D) + 1e-6f);
}
__device__ __forceinline__ void store_prenorm(bf16* hrow, int lane, const f32x4 (&v)[8], const float* g, const float* shift, const float* scale) {
    const float rstd = row_rstd(v);
#pragma unroll
    for (int j = 0; j < 8; ++j) { const int idx = lane + 64 * j;
        const f32x4 gg = ((const f32x4*)g)[idx], sh = ((const f32x4*)shift)[idx], sc = ((const f32x4*)scale)[idx];
        const f32x4 o = (v[j] * rstd) * gg * (sc + 1.0f) + sh;
        v2u w; w.x = pk2(o[0], o[1]); w.y = pk2(o[2], o[3]);
        *(v2u*)(hrow + 4 * idx) = w; }
}

__device__ __forceinline__ void phase_pro2(const P& p) {
    unsigned char* wsb = opq_p(p.ws);
    const int tid = tid_opaque(), lane = tid & 63, wave = tid >> 6, G = gridDim.x, blk = blockIdx.x;
    const int gw = wave * G + blk, NGW = NW * G;
    float* X = (float*)(wsb + WS_X); bf16* H = (bf16*)(wsb + WS_H); const float* MOD = (const float*)(wsb + WS_MOD);
    for (int row = gw; row < M; row += NGW) {
        const int b = row / PB, pp = row % PB; const bool isctx = pp < CTX; const int v = isctx ? 4 : b;
        const float* src = isctx ? p.in[2] + ((size_t)b * CTX + pp) * D : p.in[0] + ((size_t)b * SEQ + (pp - CTX)) * D;
        f32x4 xv[8];
#pragma unroll
        for (int j = 0; j < 8; ++j) xv[j] = ((const f32x4*)src)[lane + 64 * j];
#pragma unroll
        for (int j = 0; j < 8; ++j) ((f32x4*)(X + (size_t)row * D))[lane + 64 * j] = xv[j];
        const float* mod = MOD + ((size_t)0 * 5 + v) * NMODC;
        store_prenorm(H + (size_t)row * D, lane, xv, p.in[6] + (size_t)(0 * 6 + 0) * D, mod + 0 * D, mod + 1 * D);
    }
}

__device__ __forceinline__ void phase_post(const P& p, int layer, int s) {
    unsigned char* wsb = opq_p(p.ws);
    layer = opq_s(layer);
    const int tid = tid_opaque(), lane = tid & 63, wave = tid >> 6, G = gridDim.x, blk = blockIdx.x;
    const int gw = wave * G + blk, NGW = NW * G;
    float* X = (float*)(wsb + WS_X); bf16* H = (bf16*)(wsb + WS_H); const float* Y = (const float*)(wsb + WS_Y); const float* MOD = (const float*)(wsb + WS_MOD);
    const bool last = layer == DEPTH - 1, final = last && s == 2;
    const float wgt = (s == 1) ? 1.0f : 0.5f;
    const int l2 = (s < 2) ? layer : layer + 1, s2 = (s < 2) ? s + 1 : 0;
    for (int row = gw; row < M; row += NGW) {
        const int b = row / PB, pp = row % PB; const bool isctx = pp < CTX; const int v = isctx ? 4 : b;
        if (last && s >= 1 && isctx) continue;
        f32x4 yv[8], xv[8];
#pragma unroll
        for (int j = 0; j < 8; ++j) yv[j] = ((const f32x4*)(Y + (size_t)row * D))[lane + 64 * j];
#pragma unroll
        for (int j = 0; j < 8; ++j) xv[j] = ((const f32x4*)(X + (size_t)row * D))[lane + 64 * j];
        const float rstd = row_rstd(yv);
        const float* gate = MOD + ((size_t)layer * 5 + v) * NMODC + (size_t)(3 * s + 2) * D;
        const float* gpost = p.in[6] + (size_t)(layer * 6 + 2 * s + 1) * D;
        float* dst = final ? p.out + ((size_t)b * SEQ + (pp - CTX)) * D : X + (size_t)row * D;
#pragma unroll
        for (int j = 0; j < 8; ++j) { const int idx = lane + 64 * j; const f32x4 ga = ((const f32x4*)gate)[idx], gp = ((const f32x4*)gpost)[idx];
            xv[j] = xv[j] + (ga * wgt) * ((yv[j] * rstd) * gp);
            ((f32x4*)dst)[idx] = xv[j]; }
        if (!final) { const float* mod = MOD + ((size_t)l2 * 5 + v) * NMODC;
            store_prenorm(H + (size_t)row * D, lane, xv, p.in[6] + (size_t)(l2 * 6 + 2 * s2) * D, mod + (size_t)(3 * s2) * D, mod + (size_t)(3 * s2 + 1) * D); }
    }
}

template <class Epi>
__device__ __forceinline__ void run_gemm(LAS unsigned char* lds, const bf16* A, const bf16* Bt, int nMt, int N, int K, int latonly, int coff, const Epi& E) {
    pg8::Gemm g{A, Bt, M, N, K};
    TileOrder S; S.init(nMt, N, (int)gridDim.x, (int)((blockIdx.x + coff) % gridDim.x), latonly);
    pg8::gemm_phase<Epi, TileOrder, true, true>(lds, g, S, E);
}
__device__ __forceinline__ void phase_ffn_in(const P& p, LAS unsigned char* lds, int layer, int which) {
    unsigned char* wsb = opq_p(p.ws);
    layer = opq_s(layer);
    const bool lat = (layer == DEPTH - 1) && which == 1;
    EpiSwiglu E{(bf16*)(wsb + WS_ACT), DFF};
    run_gemm(lds, (const bf16*)(wsb + WS_H), (const bf16*)(wsb + WS_WFFI) + (size_t)(layer * 2 + which) * (2 * DFF) * D, lat ? 32 : 36, 2 * DFF, D, lat, 0, E);
}
__device__ __forceinline__ void phase_ffn_out(const P& p, LAS unsigned char* lds, int layer, int which) {
    unsigned char* wsb = opq_p(p.ws);
    layer = opq_s(layer);
    const bool lat = (layer == DEPTH - 1) && which == 1;
    EpiF32 E{(float*)(wsb + WS_Y), D};
    run_gemm(lds, (const bf16*)(wsb + WS_ACT), (const bf16*)(wsb + WS_WFFO) + (size_t)(layer * 2 + which) * D * DFF, lat ? 32 : 36, D, DFF, lat, 0, E);
}
__device__ __forceinline__ void phase_inproj(const P& p, LAS unsigned char* lds, int layer) {
    unsigned char* wsb = opq_p(p.ws);
    layer = opq_s(layer);
    EpiB16 E{(bf16*)(wsb + WS_COLS), NINP};
    run_gemm(lds, (const bf16*)(wsb + WS_H), (const bf16*)(wsb + WS_WIN) + (size_t)layer * NINP * D, 36, NINP, D, 0, 0, E);
}
__device__ __forceinline__ void phase_outproj(const P& p, LAS unsigned char* lds, int layer) {
    unsigned char* wsb = opq_p(p.ws);
    layer = opq_s(layer);
    const bool lat = (layer == DEPTH - 1);
    EpiF32 E{(float*)(wsb + WS_Y), D};
    run_gemm(lds, (const bf16*)(wsb + WS_YMIX), (const bf16*)(wsb + WS_WOUT) + (size_t)layer * D * D, lat ? 32 : 36, D, D, lat, 0, E);
}
__device__ __forceinline__ void phase_mgemm(const P& p, LAS unsigned char* lds, int layer) {
    unsigned char* wsb = opq_p(p.ws);
    layer = opq_s(layer);
    { EpiB16 E{(bf16*)(wsb + WS_QUP), 768};
      run_gemm(lds, (const bf16*)(wsb + WS_QN), (const bf16*)(wsb + WS_WQB) + (size_t)layer * 768 * 384, 36, 768, 384, 0, 0, E); }
    __syncthreads();
    { EpiB16 E{(bf16*)(wsb + WS_KVUP), 1024};
      run_gemm(lds, (const bf16*)(wsb + WS_KVN), (const bf16*)(wsb + WS_WKVB) + (size_t)layer * 1024 * 256, 36, 1024, 256, 0, 148, E); }
    __syncthreads();
    { EpiF32 E{(float*)(wsb + WS_GATES), 2048};
      run_gemm(lds, (const bf16*)(wsb + WS_U), (const bf16*)(wsb + WS_WG) + (size_t)layer * 2048 * 512, 36, 2048, 512, 0, 0, E); }
}


__device__ __forceinline__ void transpose_tok_item(const bf16* src, int ss, bf16* dst, LAS unsigned short* scr, int lane) {
#pragma unroll
    for (int i = 0; i < 8; ++i) { const int id = lane + 64 * i, row = id >> 3, ch = id & 7;
        const v4u w = *(const v4u*)(src + (size_t)row * ss + ch * 8);
        LAS unsigned* d = (LAS unsigned*)(scr + row * 66 + ch * 8);
        d[0] = w.x; d[1] = w.y; d[2] = w.z; d[3] = w.w; }
    LDS_WAIT(); asm volatile("" ::: "memory");
#pragma unroll
    for (int i = 0; i < 8; ++i) { const int id = lane + 64 * i, e = id >> 3, ch = id & 7;
        unsigned v[8];
#pragma unroll
        for (int k = 0; k < 8; ++k) v[k] = scr[(ch * 8 + k) * 66 + e];
        v4u w; w.x = v[0] | (v[1] << 16); w.y = v[2] | (v[3] << 16); w.z = v[4] | (v[5] << 16); w.w = v[6] | (v[7] << 16);
        *(v4u*)(dst + (size_t)e * PB + ch * 8) = w; }
    LDS_WAIT(); asm volatile("" ::: "memory");
}
__device__ __forceinline__ void phase_prep(const P& p, LAS unsigned char* lds, int layer) {
    unsigned char* wsb = opq_p(p.ws);
    layer = opq_s(layer);
    const int tid = tid_opaque(), lane = tid & 63, wave = tid >> 6, G = gridDim.x, blk = blockIdx.x;
    const int gw = wave * G + blk, NGW = NW * G;
    bf16* COLS = (bf16*)(wsb + WS_COLS); bf16* U = (bf16*)(wsb + WS_U); bf16* QN = (bf16*)(wsb + WS_QN); bf16* KVN = (bf16*)(wsb + WS_KVN);
    const float* rope = (const float*)(wsb + WS_ROPE);
    const float* cw = p.in[11] + (size_t)layer * 4 * 512; const float* cb = p.in[12] + (size_t)layer * 512;
    const float* qg = p.in[16] + (size_t)layer * 384; const float* kvg = p.in[18] + (size_t)layer * 256;
    for (int row = gw; row < M; row += NGW) {
        const int pp = row % PB; const bool isctx = pp < CTX;
        const int lo = isctx ? 0 : CTX, hi = isctx ? CTX : PB;
        bf16* crow = COLS + (size_t)row * NINP;
#pragma unroll
        for (int cblk = 0; cblk < 8; ++cblk) { const int ch = cblk * 64 + lane; float acc = cb[ch];
#pragma unroll
            for (int j = 0; j < 4; ++j) { const int q = pp + j - 2; if (q >= lo && q < hi) acc += cw[j * 512 + ch] * bf2f(crow[(ptrdiff_t)(j - 2) * NINP + C_XB + ch]); }
            U[(size_t)row * 512 + ch] = (bf16)f2bf(acc); }
        { float v[6]; float s = 0.f;
#pragma unroll
            for (int j = 0; j < 6; ++j) { v[j] = bf2f(crow[C_MQ + lane + 64 * j]); s += v[j] * v[j]; }
            s = wave_sum(s); const float rstd = 1.0f / sqrtf(s * (1.0f / 384.f) + 1e-6f);
#pragma unroll
            for (int j = 0; j < 6; ++j) QN[(size_t)row * 384 + lane + 64 * j] = (bf16)f2bf(v[j] * rstd * qg[lane + 64 * j]); }
        { float v[4]; float s = 0.f;
#pragma unroll
            for (int j = 0; j < 4; ++j) { v[j] = bf2f(crow[C_MKV + lane + 64 * j]); s += v[j] * v[j]; }
            s = wave_sum(s); const float rstd = 1.0f / sqrtf(s * (1.0f / 256.f) + 1e-6f);
#pragma unroll
            for (int j = 0; j < 4; ++j) KVN[(size_t)row * 256 + lane + 64 * j] = (bf16)f2bf(v[j] * rstd * kvg[lane + 64 * j]); }
        if (!isctx) { const int t = pp - CTX; const int i = lane & 31, hsel = lane >> 5;
            const float c = rope[t * 32 + i], sn = rope[SEQ * 32 + t * 32 + i];
#pragma unroll
            for (int hp = 0; hp < 13; ++hp) { const int hd = hp * 2 + hsel; const int base = hd < 16 ? C_DQ + hd * 64 : C_GQ + (hd - 16) * 64;
                const float x1 = bf2f(crow[base + i]), x2 = bf2f(crow[base + 32 + i]);
                crow[base + i] = (bf16)f2bf(x1 * c - x2 * sn); crow[base + 32 + i] = (bf16)f2bf(x1 * sn + x2 * c); }
            if (lane < 16) { const float c2 = rope[SEQ * 64 + t * 16 + lane], s2 = rope[SEQ * 64 + SEQ * 16 + t * 16 + lane];
                const float x1 = bf2f(crow[C_MKR + lane]), x2 = bf2f(crow[C_MKR + 16 + lane]);
                crow[C_MKR + lane] = (bf16)f2bf(x1 * c2 - x2 * s2); crow[C_MKR + 16 + lane] = (bf16)f2bf(x1 * s2 + x2 * c2); }
        }
    }
    { LAS unsigned short* scr = (LAS unsigned short*)(lds + wave * 16384);
      bf16* VTD = (bf16*)(wsb + WS_VTD); bf16* VTG = (bf16*)(wsb + WS_VTG);
      for (int it = gw; it < NB * 36 * 10; it += NGW) { const int b = it / 360, r = it % 360, tb = r / 10, cb = r % 10;
          const bf16* s = COLS + ((size_t)b * PB + tb * 64) * NINP + (cb < 8 ? C_DV + cb * 64 : C_GV + (cb - 8) * 64);
          bf16* d = cb < 8 ? VTD + ((size_t)b * 512 + cb * 64) * PB + tb * 64 : VTG + ((size_t)b * 128 + (cb - 8) * 64) * PB + tb * 64;
          transpose_tok_item(s, NINP, d, scr, lane); } }
}

__device__ __forceinline__ void phase_prep2(const P& p, LAS unsigned char* lds, int layer) {
    unsigned char* wsb = opq_p(p.ws);
    layer = opq_s(layer);
    const int tid = tid_opaque(), lane = tid & 63, wave = tid >> 6, G = gridDim.x, blk = blockIdx.x;
    const int gw = wave * G + blk, NGW = NW * G;
    const bf16* COLS = (const bf16*)(wsb + WS_COLS); const bf16* U = (const bf16*)(wsb + WS_U);
    const bf16* QUP = (const bf16*)(wsb + WS_QUP); const bf16* KVUP = (const bf16*)(wsb + WS_KVUP);
    bf16* QM = (bf16*)(wsb + WS_QM); bf16* KM = (bf16*)(wsb + WS_KM);
    const float* GATES = (const float*)(wsb + WS_GATES); f32x2* AB = (f32x2*)(wsb + WS_AB);
    const float* rope = (const float*)(wsb + WS_ROPE);
    const float* bg = p.in[14] + (size_t)layer * 2 * 2 * 512; const float* lam = p.in[15] + (size_t)layer * 2 * 512;
    for (int row = gw; row < M; row += NGW) {
        const int pp = row % PB; const bool isctx = pp < CTX; const int t = pp - CTX;
#pragma unroll
        for (int j = 0; j < 12; ++j) { const int e = lane + 64 * j, h = e / 96, d = e % 96;
            float qv = bf2f(QUP[(size_t)row * 768 + e]);
            if (d >= 64 && !isctx) { const int i = (d - 64) & 15; const bool second = (d - 64) >= 16;
                const float c = rope[SEQ * 64 + t * 16 + i], sn = rope[SEQ * 64 + SEQ * 16 + t * 16 + i];
                const float x1 = bf2f(QUP[(size_t)row * 768 + h * 96 + 64 + i]), x2 = bf2f(QUP[(size_t)row * 768 + h * 96 + 80 + i]);
                qv = second ? (x1 * sn + x2 * c) : (x1 * c - x2 * sn); }
            QM[(size_t)row * 768 + e] = (bf16)f2bf(qv);
            KM[(size_t)row * 768 + e] = d < 64 ? KVUP[(size_t)row * 1024 + h * 128 + d] : COLS[(size_t)row * NINP + C_MKR + (d - 64)]; }
#pragma unroll
        for (int dir = 0; dir < 2; ++dir)
#pragma unroll
            for (int cblk = 0; cblk < 8; ++cblk) { const int ch = cblk * 64 + lane;
                const float* gp = GATES + (size_t)row * 2048 + ((dir * 4 + (ch >> 7)) * 2) * 128 + (ch & 127);
                const float gr = gp[0] + bg[(dir * 2 + 0) * 512 + ch], gi = gp[128] + bg[(dir * 2 + 1) * 512 + ch];
                const float r = 1.f / (1.f + expf(-gr)), ig = 1.f / (1.f + expf(-gi));
                const float sp = log1pf(expf(-lam[dir * 512 + ch]));
                const float log_a = -8.0f * r * sp, a = expf(log_a);
                const float u = bf2f(U[(size_t)row * 512 + ch]);
                const float bco = sqrtf(-expm1f(2.0f * log_a)) * (ig * u);
                AB[((size_t)dir * M + row) * 512 + ch] = (f32x2){a, bco}; }
    }
    { LAS unsigned short* scr = (LAS unsigned short*)(lds + wave * 16384);
      bf16* VTM = (bf16*)(wsb + WS_VTM);
      for (int it = gw; it < NB * 36 * 8; it += NGW) { const int b = it / 288, r = it % 288, tb = r / 8, hh = r % 8;
          transpose_tok_item(KVUP + ((size_t)b * PB + tb * 64) * 1024 + hh * 128 + 64, 1024, VTM + ((size_t)b * 512 + hh * 64) * PB + tb * 64, scr, lane); } }
}

template <int DQK, int DV, int MODE, bool OUTF32>
__device__ __forceinline__ void naive_attn(const bf16* Q, int qs, const bf16* K, int ks, const bf16* V, int vs, void* O, int os,
                                           int b, int pp0, int lane, float scale, float sink) {
    const size_t rowbase = (size_t)b * PB; const int pp = pp0 + lane;
    float q[DQK], o[DV];
    { const bf16* qr = Q + (rowbase + pp) * qs;
#pragma unroll
      for (int c = 0; c < DQK / 8; ++c) { const v4u w = *(const v4u*)(qr + 8 * c);
          q[8 * c + 0] = bflo(w.x); q[8 * c + 1] = bfhi(w.x); q[8 * c + 2] = bflo(w.y); q[8 * c + 3] = bfhi(w.y);
          q[8 * c + 4] = bflo(w.z); q[8 * c + 5] = bfhi(w.z); q[8 * c + 6] = bflo(w.w); q[8 * c + 7] = bfhi(w.w); } }
    const float sl2 = scale * 1.4426950408889634f;
#pragma unroll
    for (int d = 0; d < DQK; ++d) q[d] *= sl2;
#pragma unroll
    for (int e = 0; e < DV; ++e) o[e] = 0.f;
    float m = (MODE == 1) ? sink * 1.4426950408889634f : -1e30f, l = (MODE == 1) ? 1.f : 0.f;
    const bool isctx = pp0 < CTX; const int t = pp - CTX, t0 = pp0 - CTX;
    for (int seg = 0; seg < 2; ++seg) {
        int k0, k1;
        if (seg == 0) { k0 = 0; k1 = CTX; }
        else { if (isctx) break;
            if (MODE == 0) { k0 = CTX; k1 = PB; }
            else { const int a0 = t0 - 128 < 0 ? 0 : t0 - 128, a1 = t0 + 63 + 128 > SEQ - 1 ? SEQ - 1 : t0 + 63 + 128; k0 = CTX + a0; k1 = CTX + a1 + 1; } }
        for (int key = k0; key < k1; ++key) {
            const bf16* kr = K + (rowbase + key) * ks; const bf16* vr = V + (rowbase + key) * vs;
            asm volatile("" : "+v"(kr)); asm volatile("" : "+v"(vr));
            float s = 0.f;
#pragma unroll
            for (int c = 0; c < DQK / 8; ++c) { const v4u w = *(const v4u*)(kr + 8 * c);
                s += q[8 * c + 0] * bflo(w.x); s += q[8 * c + 1] * bfhi(w.x); s += q[8 * c + 2] * bflo(w.y); s += q[8 * c + 3] * bfhi(w.y);
                s += q[8 * c + 4] * bflo(w.z); s += q[8 * c + 5] * bfhi(w.z); s += q[8 * c + 6] * bflo(w.w); s += q[8 * c + 7] * bfhi(w.w); }
            bool valid = true;
            if (MODE == 1 && seg == 1) { const int rel = (key - CTX) - t; valid = (rel <= 128) && (rel >= -128); }
            if (valid) {
                const float mn = fmaxf(m, s), alpha = exp2f(m - mn), pr = exp2f(s - mn);
                l = l * alpha + pr; m = mn;
#pragma unroll
                for (int c = 0; c < DV / 8; ++c) { const v4u w = *(const v4u*)(vr + 8 * c);
                    o[8 * c + 0] = o[8 * c + 0] * alpha + pr * bflo(w.x); o[8 * c + 1] = o[8 * c + 1] * alpha + pr * bfhi(w.x);
                    o[8 * c + 2] = o[8 * c + 2] * alpha + pr * bflo(w.y); o[8 * c + 3] = o[8 * c + 3] * alpha + pr * bfhi(w.y);
                    o[8 * c + 4] = o[8 * c + 4] * alpha + pr * bflo(w.z); o[8 * c + 5] = o[8 * c + 5] * alpha + pr * bfhi(w.z);
                    o[8 * c + 6] = o[8 * c + 6] * alpha + pr * bflo(w.w); o[8 * c + 7] = o[8 * c + 7] * alpha + pr * bfhi(w.w); }
            }
        }
    }
    const float il = 1.f / l;
    if (OUTF32) { float* orow = (float*)O + (rowbase + pp) * os;
#pragma unroll
        for (int e = 0; e < DV; e += 4) *(f32x4*)(orow + e) = (f32x4){o[e] * il, o[e + 1] * il, o[e + 2] * il, o[e + 3] * il}; }
    else { bf16* orow = (bf16*)O + (rowbase + pp) * os;
#pragma unroll
        for (int e = 0; e < DV; e += 8) { v4u w; w.x = pk2(o[e] * il, o[e + 1] * il); w.y = pk2(o[e + 2] * il, o[e + 3] * il); w.z = pk2(o[e + 4] * il, o[e + 5] * il); w.w = pk2(o[e + 6] * il, o[e + 7] * il);
            *(v4u*)(orow + e) = w; } }
}


typedef short bf16x8 __attribute__((ext_vector_type(8)));
typedef float f32x16 __attribute__((ext_vector_type(16)));
__device__ __forceinline__ int crow16(int r, int hi) { return (r & 3) + 8 * (r >> 2) + 4 * hi; }

typedef __bf16 bf16x2_t __attribute__((ext_vector_type(2)));
__device__ __forceinline__ unsigned cvtpk_s(float lo, float hi) { const f32x2 v = {lo, hi}; const bf16x2_t b = __builtin_convertvector(v, bf16x2_t); return __builtin_bit_cast(unsigned, b); }
template <int DQK, int DV, int MODE, bool OUTF32>
__device__ __forceinline__ void attn_unit(LAS unsigned char* lds, const bf16* Qb, int qs, const bf16* Kb, int ks, const bf16* VTb, void* Ob, int os,
                                          int q0, int ntd, float scale, float sink, int tid_in) {
    int tid = tid_in; asm volatile("" : "+v"(tid));
    constexpr int RSK = DQK * 2 + 16, RSV = 136, KBUF = 64 * RSK, VBUF = DV * RSV, CPR = DQK / 8, NKC = 64 * CPR, NVC = DV * 8;
    constexpr int NKI = (NKC + NT - 1) / NT, NVI = NVC / NT, ND0 = DQK / 16, NDB = DV / 32;
    const int lane = tid & 63, wave = __builtin_amdgcn_readfirstlane(tid >> 6), r32 = lane & 31, hi = lane >> 5;
    int ta = 4, ntiles = ntd;
    if (MODE == 1) { if (q0 < CTX) ntiles = 4; else { const int t0 = q0 - CTX; const int lo = t0 - 128 < 0 ? 0 : t0 - 128, hh = t0 + 383 > SEQ - 1 ? SEQ - 1 : t0 + 383; ta = 4 + (lo >> 6); ntiles = 4 + ((hh >> 6) - (lo >> 6) + 1); } }
#define TILE_OF(i) ((MODE == 1 && (i) >= 4) ? ta + (i) - 4 : (i))
    const int qrow = q0 + wave * 32 + r32;
    bf16x8 qf[ND0];
#pragma unroll
    for (int d0 = 0; d0 < ND0; ++d0) qf[d0] = *(const bf16x8*)(Qb + (size_t)qrow * qs + 16 * d0 + 8 * hi);
    f32x16 o[NDB];
#pragma unroll
    for (int db = 0; db < NDB; ++db)
#pragma unroll
        for (int r = 0; r < 16; ++r) o[db][r] = 0.f;
    const float c = scale * 1.4426950408889634f;
    float m = (MODE == 1) ? sink / scale : -1e30f, l = (MODE == 1 && hi == 0) ? 1.f : 0.f;
    v4u kreg[NKI], vreg[NVI];
#pragma unroll
    for (int i_ = 0; i_ < NKI; ++i_) kreg[i_] = (v4u){0u, 0u, 0u, 0u};
#pragma unroll
    for (int i_ = 0; i_ < NVI; ++i_) vreg[i_] = (v4u){0u, 0u, 0u, 0u};
#define LOAD_TILE(tile) do { const int kb_ = (tile) * 64; \
        _Pragma("unroll") for (int i_ = 0; i_ < NKI; ++i_) { const int id_ = tid + NT * i_; if (id_ < NKC) { const int row_ = id_ / CPR, ch_ = id_ % CPR; kreg[i_] = *(const v4u*)(Kb + (size_t)(kb_ + row_) * ks + ch_ * 8); } } \
        _Pragma("unroll") for (int i_ = 0; i_ < NVI; ++i_) { const int id_ = tid + NT * i_, d_ = id_ >> 3, ch_ = id_ & 7; vreg[i_] = *(const v4u*)(VTb + (size_t)d_ * PB + kb_ + ch_ * 8); } } while (0)
#define STORE_TILE(buf) do { \
        _Pragma("unroll") for (int i_ = 0; i_ < NKI; ++i_) { const int id_ = tid + NT * i_; if (id_ < NKC) { const int row_ = id_ / CPR, ch_ = id_ % CPR; *(LAS v4u*)(lds + (buf) * KBUF + row_ * RSK + ch_ * 16) = kreg[i_]; } } \
        _Pragma("unroll") for (int i_ = 0; i_ < NVI; ++i_) { const int id_ = tid + NT * i_, d_ = id_ >> 3, ch_ = id_ & 7; LAS v2u* w_ = (LAS v2u*)(lds + 2 * KBUF + (buf) * VBUF + d_ * RSV + ch_ * 16); \
            w_[0] = (v2u){vreg[i_].x, vreg[i_].y}; w_[1] = (v2u){vreg[i_].z, vreg[i_].w}; } } while (0)
    LOAD_TILE(TILE_OF(0)); STORE_TILE(0); __syncthreads();
    for (int i = 0; i < ntiles; ++i) {
        const int cur = i & 1, tile = TILE_OF(i);
        if (i + 1 < ntiles) LOAD_TILE(TILE_OF(i + 1));
        bool active = true;
        if (MODE == 1 && i >= 4) { const int kt0 = tile * 64 - CTX, qt0 = q0 - CTX + wave * 32; active = (kt0 + 63 >= qt0 - 128) && (kt0 <= qt0 + 31 + 128); }
        if (active) {
            f32x16 p0, p1;
#pragma unroll
            for (int r = 0; r < 16; ++r) { p0[r] = 0.f; p1[r] = 0.f; }
            const LAS unsigned char* kb = lds + cur * KBUF + r32 * RSK + hi * 16;
#pragma unroll
            for (int d0 = 0; d0 < ND0; ++d0) { const bf16x8 k0 = *(const LAS bf16x8*)(kb + d0 * 32), k1 = *(const LAS bf16x8*)(kb + 32 * RSK + d0 * 32);
                p0 = __builtin_amdgcn_mfma_f32_32x32x16_bf16(k0, qf[d0], p0, 0, 0, 0); p1 = __builtin_amdgcn_mfma_f32_32x32x16_bf16(k1, qf[d0], p1, 0, 0, 0); }
            if (MODE == 1 && i >= 4) { const int rel0 = (tile * 64 - CTX) - (qrow - CTX);
#pragma unroll
                for (int r = 0; r < 16; ++r) { const int ra = rel0 + crow16(r, hi), rb = ra + 32;
                    if (ra > 128 || ra < -128) p0[r] = -1e30f; if (rb > 128 || rb < -128) p1[r] = -1e30f; } }
            float mx = fmaxf(p0[0], p1[0]);
#pragma unroll
            for (int r = 1; r < 16; ++r) mx = fmaxf(mx, fmaxf(p0[r], p1[r]));
            mx = xhalf_max(mx);
            const float mn = fmaxf(m, mx), alpha = __builtin_amdgcn_exp2f((m - mn) * c), nmc = -mn * c; m = mn;
            float sum = 0.f;
#pragma unroll
            for (int r = 0; r < 16; ++r) { p0[r] = __builtin_amdgcn_exp2f(fmaf(p0[r], c, nmc)); p1[r] = __builtin_amdgcn_exp2f(fmaf(p1[r], c, nmc)); sum += p0[r] + p1[r]; }
            l = l * alpha + sum;
            if (!__all(alpha == 1.f)) {
#pragma unroll
                for (int db = 0; db < NDB; ++db)
#pragma unroll
                    for (int r = 0; r < 16; ++r) o[db][r] *= alpha; }
            const LAS unsigned char* vb = lds + 2 * KBUF + cur * VBUF + r32 * RSV + hi * 8;
#pragma unroll
            for (int s = 0; s < 4; ++s) { const int rb = (s & 1) * 8;
                v4u pw;
                if (s < 2) { pw.x = cvtpk_s(p0[rb + 0], p0[rb + 1]); pw.y = cvtpk_s(p0[rb + 2], p0[rb + 3]); pw.z = cvtpk_s(p0[rb + 4], p0[rb + 5]); pw.w = cvtpk_s(p0[rb + 6], p0[rb + 7]); }
                else       { pw.x = cvtpk_s(p1[rb + 0], p1[rb + 1]); pw.y = cvtpk_s(p1[rb + 2], p1[rb + 3]); pw.z = cvtpk_s(p1[rb + 4], p1[rb + 5]); pw.w = cvtpk_s(p1[rb + 6], p1[rb + 7]); }
                const bf16x8 pf = __builtin_bit_cast(bf16x8, pw);
#pragma unroll
                for (int db = 0; db < NDB; ++db) { const LAS unsigned char* vp = vb + db * 32 * RSV + s * 32;
                    const v2u a0 = *(const LAS v2u*)(vp), a1 = *(const LAS v2u*)(vp + 16);
                    const bf16x8 vf = __builtin_bit_cast(bf16x8, (v4u){a0.x, a0.y, a1.x, a1.y});
                    o[db] = __builtin_amdgcn_mfma_f32_32x32x16_bf16(vf, pf, o[db], 0, 0, 0); }
                __builtin_amdgcn_sched_barrier(0); }
        }
        if (i + 1 < ntiles) STORE_TILE(cur ^ 1);
        __syncthreads();
    }
#undef LOAD_TILE
#undef STORE_TILE
#undef TILE_OF
    l = xhalf_sum(l);
    const float il = 1.f / l;
#pragma unroll
    for (int db = 0; db < NDB; ++db)
#pragma unroll
        for (int rr = 0; rr < 4; ++rr) { const int d = 32 * db + 8 * rr + 4 * hi;
            const float a = o[db][4 * rr] * il, b = o[db][4 * rr + 1] * il, cc = o[db][4 * rr + 2] * il, dd = o[db][4 * rr + 3] * il;
            if (OUTF32) *(f32x4*)((float*)Ob + (size_t)qrow * os + d) = (f32x4){a, b, cc, dd};
            else *(v2u*)((bf16*)Ob + (size_t)qrow * os + d) = (v2u){cvtpk_s(a, b), cvtpk_s(cc, dd)}; }
}

__device__ __forceinline__ void phase_att(const P& p, LAS unsigned char* lds, int layer) {
    unsigned char* wsb = opq_p(p.ws);
    layer = opq_s(layer);
    const int tid = tid_opaque(), lane = tid & 63, wave = __builtin_amdgcn_readfirstlane(tid >> 6), G = gridDim.x, blk = blockIdx.x;
    const int gw = wave * G + blk;
    const bool last = layer == DEPTH - 1;
    const bf16* COLS = (const bf16*)(wsb + WS_COLS);
    const bf16* QM = (const bf16*)(wsb + WS_QM); const bf16* KM = (const bf16*)(wsb + WS_KM);
    const bf16* VTD = (const bf16*)(wsb + WS_VTD); const bf16* VTG = (const bf16*)(wsb + WS_VTG); const bf16* VTM = (const bf16*)(wsb + WS_VTM);
    bf16* YMIX = (bf16*)(wsb + WS_YMIX); float* DIFFO = (float*)(wsb + WS_DIFFO);
    const f32x2* AB = (const f32x2*)(wsb + WS_AB);
    { f32x2* SUM = (f32x2*)(wsb + WS_SUM);
      for (int it = gw; it < NB * 2 * 36 * 8; it += NW * G) { const int g = it & 7, c = (it >> 3) % 36, dir = (it / 288) & 1, b = it / 576, ch = g * 64 + lane;
          const f32x2* ab = AB + ((size_t)dir * M + (size_t)b * PB + c * 64) * 512 + ch;
          float A = 1.f, H = 0.f;
          if (dir == 0) {
#pragma unroll 16
              for (int q = 0; q < 64; ++q) { const f32x2 cf = ab[(size_t)q * 512]; H = cf.x * H + cf.y; A *= cf.x; }
          } else {
#pragma unroll 16
              for (int q = 63; q >= 0; --q) { const f32x2 cf = ab[(size_t)q * 512]; H = cf.x * H + cf.y; A *= cf.x; }
          }
          const int ord = dir == 0 ? c : (c <= 3 ? 3 - c : 39 - c);
          SUM[(((size_t)dir * NB + b) * 40 + ord) * 512 + ch] = (f32x2){A, H}; } }
    for (int u = blk; u < 256; u += G) {
        const int xcd = u & 7, j = u >> 3, grp = xcd * 4 + (j >> 3), qb = j & 7, b = grp >> 3, hh = grp & 7, q0 = CTX + qb * 256;
        const size_t rb = (size_t)b * PB;
        attn_unit<96, 64, 0, false>(lds, QM + rb * 768 + hh * 96, 768, KM + rb * 768 + hh * 96, 768, VTM + ((size_t)b * 512 + hh * 64) * PB, YMIX + rb * 2048 + 512 + hh * 64, 2048, q0, 36, 0.10206207261596575f, 0.f, tid);
        for (int vh = 0; vh < 2; ++vh)
            attn_unit<64, 64, 0, true>(lds, COLS + rb * NINP + C_DQ + hh * 64, NINP, COLS + rb * NINP + C_DK + hh * 64, NINP, VTD + ((size_t)b * 512 + (hh >> 1) * 128 + vh * 64) * PB, DIFFO + rb * 1024 + hh * 128 + vh * 64, 1024, q0, 36, 0.125f, 0.f, tid);
        attn_unit<64, 64, 1, false>(lds, COLS + rb * NINP + C_GQ + hh * 64, NINP, COLS + rb * NINP + C_GK + (hh >> 2) * 64, NINP, VTG + ((size_t)b * 128 + (hh >> 2) * 64) * PB, YMIX + rb * 2048 + 1536 + hh * 64, 2048, q0, 0, 0.125f, p.in[22][layer * 8 + hh], tid);
    }
    if (!last) {
        for (int u = blk; u < 96; u += G) { const int kind = u >> 5, b = (u >> 3) & 3, hh = u & 7; const size_t rb = (size_t)b * PB;
            if (kind == 0) attn_unit<96, 64, 0, false>(lds, QM + rb * 768 + hh * 96, 768, KM + rb * 768 + hh * 96, 768, VTM + ((size_t)b * 512 + hh * 64) * PB, YMIX + rb * 2048 + 512 + hh * 64, 2048, 0, 4, 0.10206207261596575f, 0.f, tid);
            else if (kind == 1) { for (int vh = 0; vh < 2; ++vh) attn_unit<64, 64, 0, true>(lds, COLS + rb * NINP + C_DQ + hh * 64, NINP, COLS + rb * NINP + C_DK + hh * 64, NINP, VTD + ((size_t)b * 512 + (hh >> 1) * 128 + vh * 64) * PB, DIFFO + rb * 1024 + hh * 128 + vh * 64, 1024, 0, 4, 0.125f, 0.f, tid); }
            else attn_unit<64, 64, 1, false>(lds, COLS + rb * NINP + C_GQ + hh * 64, NINP, COLS + rb * NINP + C_GK + (hh >> 2) * 64, NINP, VTG + ((size_t)b * 128 + (hh >> 2) * 64) * PB, YMIX + rb * 2048 + 1536 + hh * 64, 2048, 0, 0, 0.125f, p.in[22][layer * 8 + hh], tid);
        }
    }
}

__device__ __forceinline__ void phase_mixfin(const P& p, LAS unsigned char* lds, int layer) {
    layer = opq_s(layer);
    unsigned char* wsb = opq_p(p.ws);
    const int tid = tid_opaque(), lane = tid & 63, wave = tid >> 6, G = gridDim.x, blk = blockIdx.x;
    const int gw = wave * G + blk, NGW = NW * G;
    const bool last = layer == DEPTH - 1;
    const bf16* COLS = (const bf16*)(wsb + WS_COLS); bf16* YMIX = (bf16*)(wsb + WS_YMIX); const float* DIFFO = (const float*)(wsb + WS_DIFFO);
    { const f32x2* AB = (const f32x2*)(wsb + WS_AB); const f32x2* SUM = (const f32x2*)(wsb + WS_SUM);
      LAS float* hf = (LAS float*)(lds + wave * 16384);
      for (int it = gw; it < NB * 36 * 8; it += NGW) { const int g = it & 7, c = (it >> 3) % 36, b = it / 288, ch = g * 64 + lane;
          if (last && c < 4) continue;
          { const f32x2* sm = SUM + (((size_t)0 * NB + b) * 40) * 512 + ch; float h = 0.f;
            for (int o = 0; o < c; ++o) { const f32x2 s = sm[(size_t)o * 512]; h = s.x * h + s.y; }
            const f32x2* ab = AB + ((size_t)0 * M + (size_t)b * PB + c * 64) * 512 + ch;
#pragma unroll 16
            for (int q = 0; q < 64; ++q) { const f32x2 cf = ab[(size_t)q * 512]; h = cf.x * h + cf.y; hf[q * 64 + lane] = h; } }
          { const int ord = c <= 3 ? 3 - c : 39 - c;
            const f32x2* sm = SUM + (((size_t)1 * NB + b) * 40) * 512 + ch; float h = 0.f;
            for (int o = 0; o < ord; ++o) { const f32x2 s = sm[(size_t)o * 512]; h = s.x * h + s.y; }
            const f32x2* ab = AB + ((size_t)1 * M + (size_t)b * PB + c * 64) * 512 + ch;
            LDS_WAIT();
#pragma unroll 8
            for (int q = 63; q >= 0; --q) { const f32x2 cf = ab[(size_t)q * 512]; h = cf.x * h + cf.y; const size_t row = (size_t)b * PB + c * 64 + q;
                const float gt = bf2f(COLS[row * NINP + C_GATE + ch]);
                YMIX[row * 2048 + ch] = (bf16)f2bf((hf[q * 64 + lane] + h) * gelu_tanh(gt)); } }
          LDS_WAIT(); } }
    const float* lv = p.in[20] + (size_t)layer * 4 * 64; const float* dg = p.in[21] + (size_t)layer * 128;
    const float lam_init = 0.8f - 0.6f * expf(-0.3f * (float)layer);
    const float lam = expf(wave_sum(lv[lane] * lv[64 + lane])) - expf(wave_sum(lv[128 + lane] * lv[192 + lane])) + lam_init;
    for (int row = gw; row < M; row += NGW) {
        const int pp = row % PB; if (last && pp < CTX) continue;
#pragma unroll
        for (int hh = 0; hh < 4; ++hh) { float o[2]; float s = 0.f;
#pragma unroll
            for (int j = 0; j < 2; ++j) { const int e = lane + 64 * j;
                o[j] = DIFFO[(size_t)row * 1024 + (2 * hh) * 128 + e] - lam * DIFFO[(size_t)row * 1024 + (2 * hh + 1) * 128 + e]; s += o[j] * o[j]; }
            s = wave_sum(s); const float rstd = 1.0f / sqrtf(s * (1.0f / 128.f) + 1e-6f);
#pragma unroll
            for (int j = 0; j < 2; ++j) { const int e = lane + 64 * j; YMIX[(size_t)row * 2048 + 1024 + hh * 128 + e] = (bf16)f2bf(o[j] * rstd * dg[e] * (1.0f - lam_init)); } }
    }
}

#define XB_TMO      128
#define XB_XCNT(j)  (256  + 64 * (j))
#define XB_XSUB(j)  (1280 + 64 * (j))
#define XB_XGEN(j)  (2304 + 64 * (j))
#define XB_TOP      3328
#define XB_TOPGEN   3392
#define XCD_BAR_WORDS 3456
#define XB_SPIN_CAP (1u << 18)

__device__ __forceinline__ unsigned xb_ld(unsigned* p)              { return __hip_atomic_load(p, __ATOMIC_RELAXED, __HIP_MEMORY_SCOPE_AGENT); }
__device__ __forceinline__ unsigned xb_add(unsigned* p, unsigned v) { return __hip_atomic_fetch_add(p, v, __ATOMIC_RELAXED, __HIP_MEMORY_SCOPE_AGENT); }
__device__ __forceinline__ unsigned xb_xcc_id() { return (unsigned)__builtin_amdgcn_s_getreg((3 << 11) | 20) & 0xFu; }
#define XB_SPIN(cond, bar) do { unsigned _sp = 0; while (cond) { __builtin_amdgcn_s_sleep(1); \
    if ((++_sp & 255u) == 0u) { if (xb_ld(&(bar)[XB_TMO])) break; if (_sp > XB_SPIN_CAP) { atomicAdd(&(bar)[XB_TMO], 1u); break; } } } } while (0)

struct XcdBarrier {
    unsigned* bar; unsigned x;
    volatile LAS unsigned* st;
};

__device__ __forceinline__ XcdBarrier xcd_barrier_post(unsigned* bar, volatile LAS unsigned* st) {
    XcdBarrier b; b.bar = bar; b.x = xb_xcc_id(); b.st = st;
    if (threadIdx.x == 0) (void)xb_add(&bar[XB_XCNT(b.x)], 1u);
    return b;
}
__device__ __forceinline__ void xcd_barrier_complete(unsigned* bar, unsigned x, unsigned& nloc, unsigned& nx) {
    const unsigned G = gridDim.x * gridDim.y * gridDim.z;
    unsigned sum, cnt, mine, sp = 0u;
    for (;;) {
        sum = 0u; cnt = 0u; mine = 0u;
#pragma unroll
        for (unsigned j = 0; j < 16; ++j) { const unsigned c = xb_ld(&bar[XB_XCNT(j)]); sum += c; cnt += (c > 0u) ? 1u : 0u; mine = (j == x) ? c : mine; }
        if (sum == G) break;
        __builtin_amdgcn_s_sleep(1);
        if ((++sp & 255u) == 0u) { if (xb_ld(&bar[XB_TMO])) break; if (sp > XB_SPIN_CAP) { atomicAdd(&bar[XB_TMO], 1u); break; } }
    }
    nloc = mine > 0u ? mine : 1u; nx = cnt > 0u ? cnt : 1u;
}

__device__ __forceinline__ void xcd_barrier(const XcdBarrier& b) {
    asm volatile("s_waitcnt vmcnt(0)" ::: "memory");
    __syncthreads();
    if (threadIdx.x == 0) {
        unsigned* bar = b.bar; const unsigned bx = xb_xcc_id();
        __builtin_amdgcn_s_waitcnt(0);
        unsigned nloc = b.st[0], nx = b.st[1];
        if (nloc == 0u) { xcd_barrier_complete(bar, bx, nloc, nx); b.st[0] = nloc; b.st[1] = nx; }
        const unsigned old = xb_add(&bar[XB_XSUB(bx)], 1u);
        const unsigned gen = old / nloc;
        if (old + 1u == (gen + 1u) * nloc) {
            __builtin_amdgcn_fence(__ATOMIC_RELEASE, "agent");
            asm volatile("s_waitcnt vmcnt(0)" ::: "memory");
            const unsigned og = xb_add(&bar[XB_TOP], 1u);
            const unsigned tg = og / nx;
            if (og + 1u == (tg + 1u) * nx) xb_add(&bar[XB_TOPGEN], 1u);
            else XB_SPIN(xb_ld(&bar[XB_TOPGEN]) == tg, bar);
            __builtin_amdgcn_fence(__ATOMIC_ACQUIRE, "agent");
            xb_add(&bar[XB_XGEN(bx)], 1u);
            asm volatile("s_waitcnt vmcnt(0)" ::: "memory");
        } else {
            XB_SPIN(xb_ld(&bar[XB_XGEN(bx)]) == gen, bar);
            __builtin_amdgcn_fence(__ATOMIC_ACQUIRE, "agent");
            asm volatile("s_waitcnt vmcnt(0)" ::: "memory");
        }
    }
    __syncthreads();
}

constexpr int CW_BAR = 4096;
constexpr size_t CTL_ZERO_BYTES = 1 * MiB;
constexpr int LDSCTL_OFF = 131072, MISC_OFF = LDSCTL_OFF + 320;

__global__ void __launch_bounds__(NT, 2) k_mega(P p) {
    extern __shared__ __attribute__((aligned(16))) unsigned char lds_raw[];
    LAS unsigned char* lds = (LAS unsigned char*)lds_raw;
    const KP kp = (KP)__builtin_amdgcn_kernarg_segment_ptr();
    for (int u = threadIdx.x; u < (LDS_BYTES - LDSCTL_OFF) / 4; u += NT) ((LAS unsigned*)(lds + LDSCTL_OFF))[u] = 0u;
    __syncthreads();
    unsigned* barw = (unsigned*)(p.ws + WS_CTL) + CW_BAR;
    XcdBarrier bar = xcd_barrier_post(barw, (volatile LAS unsigned*)(lds + MISC_OFF) + 8);
#define GB() xcd_barrier(bar)
    phase_pro1(load_P(kp), lds); GB();
    phase_pro2(load_P(kp)); GB();
    for (int l = 0; l < DEPTH; ++l) {
        for (int which = 0; which < 2; ++which) {
            phase_ffn_in(load_P(kp), lds, l, which); GB();
            phase_ffn_out(load_P(kp), lds, l, which); GB();
            phase_post(load_P(kp), l, which == 0 ? 0 : 2); GB();
            if (which == 0) {
                phase_inproj(load_P(kp), lds, l); GB();
                phase_prep(load_P(kp), lds, l); GB();
                phase_mgemm(load_P(kp), lds, l); GB();
                phase_prep2(load_P(kp), lds, l); GB();
                phase_att(load_P(kp), lds, l); GB();
                phase_mixfin(load_P(kp), lds, l); GB();
                phase_outproj(load_P(kp), lds, l); GB();
                phase_post(load_P(kp), l, 1); GB();
            }
        }
    }
#undef GB
    if (__hip_atomic_load(barw + XB_TMO, __ATOMIC_RELAXED, __HIP_MEMORY_SCOPE_AGENT) != 0u) {
        const float q = __builtin_nanf("");
        for (size_t i = (size_t)blockIdx.x * NT + threadIdx.x; i < (size_t)NB * SEQ * D; i += (size_t)gridDim.x * NT) p.out[i] = q;
    }
}

extern "C" void kernel_launch(void* const* d_in, const int* in_sizes, int n_in, void* d_out, int out_size, void* d_ws, size_t ws_size, hipStream_t stream) {
    static int grid = 0;
    if (grid == 0) {
        if (n_in != 23 || out_size != NB * SEQ * D || ws_size < WS_END) { fprintf(stderr, "kernel_launch: unexpected shapes (n_in %d out %d ws %zu need %zu)\n", n_in, out_size, ws_size, (size_t)WS_END); grid = -1; return; }
        int dev = 0, cus = 0, per_cu = 0;
        if (hipGetDevice(&dev) != hipSuccess || hipDeviceGetAttribute(&cus, hipDeviceAttributeMultiprocessorCount, dev) != hipSuccess) { grid = -1; return; }
        if (hipFuncSetAttribute((const void*)k_mega, hipFuncAttributeMaxDynamicSharedMemorySize, LDS_BYTES) != hipSuccess) { fprintf(stderr, "kernel_launch: hipFuncSetAttribute failed\n"); grid = -1; return; }
        if (hipOccupancyMaxActiveBlocksPerMultiprocessor(&per_cu, (const void*)k_mega, NT, LDS_BYTES) != hipSuccess || per_cu < 1)
            fprintf(stderr, "kernel_launch: note: occupancy query reports %d workgroups per CU\n", per_cu);
        (void)hipGetLastError();
        grid = cus;
    }
    if (grid < 0) return;
    if (hipMemsetAsync((char*)d_ws + WS_CTL, 0, CTL_ZERO_BYTES, stream) != hipSuccess) { fprintf(stderr, "kernel_launch: memset failed\n"); return; }
    P p{};
    for (int i = 0; i < 23; ++i) p.in[i] = (const float*)d_in[i];
    p.out = (float*)d_out; p.ws = (unsigned char*)d_ws;
    hipLaunchKernelGGL(k_mega, dim3(grid), dim3(NT), LDS_BYTES, stream, p);
}
```

```cpp
#include <hip/hip_runtime.h>
#include <cstdio>
#include <cstdint>
__device__ __forceinline__ int opq_s(int x) { asm volatile("" : "+s"(x)); return x; }
__device__ __forceinline__ unsigned char* opq_p(unsigned char* x) { asm volatile("" : "+s"(x)); return x; }
__device__ __forceinline__ int tid_opaque() { int t = (int)threadIdx.x; asm volatile("" : "+v"(t)); return t; }
namespace pg8 {
#define PG8_LAS __attribute__((address_space(3)))
typedef unsigned short bf16_t;
typedef short bf16x8 __attribute__((ext_vector_type(8)));
typedef float f32x4 __attribute__((ext_vector_type(4)));
typedef unsigned u32x4 __attribute__((ext_vector_type(4)));
constexpr int BM = 256, BK = 64, HALF = 128, HTB = HALF * BK * 2  , STAGE_BYTES = 8 * HTB, NXCD = 8, WGM = 8;

__host__ __device__ __forceinline__ int lds_byte(int r, int c) { const int st = (r >> 4) * 2 + (c >> 5), rr = r & 15, cc = c & 31, ob = rr * 64 + cc * 2; return st * 1024 + (ob ^ (((ob >> 9) & 1) << 5)); }
__host__ __device__ __forceinline__ void stage_rc(int b, int& R, int& C) { const int st = b / 1024, sb = b % 1024, swz = sb ^ (((sb >> 9) & 1) << 5); R = (st >> 1) * 16 + swz / 64; C = (st & 1) * 32 + (swz % 64) / 2; }
__host__ __device__ __forceinline__ int perm32(int rho) { const int n = rho >> 4, i = rho & 15; return 8 * (i >> 2) + 4 * n + (i & 3); }

struct Unit { int pm, pn; };
struct Gemm { const bf16_t* A; const bf16_t* Bt; int M, N, K, ld; };

struct StaticOrder {
    int nM, nN, nwg, G, c;
    __host__ __device__ void init(int M, int N, int G_, int c_) { nM = M / BM; nN = N / BM; nwg = nM * nN; G = G_; c = c_; }
    __host__ __device__ bool next(int i, Unit& u) const {
        const long L = (long)i * G + c; if (L >= nwg) return false;
        int wgid = (int)L; { const int q = nwg / NXCD, r = nwg % NXCD, xcd = wgid % NXCD, off = wgid / NXCD; wgid = (xcd < r ? xcd * (q + 1) : r * (q + 1) + (xcd - r) * q) + off; }
        const int nig = WGM * nN, gid = wgid / nig, fm = gid * WGM, gsz = (nM - fm) < WGM ? (nM - fm) : WGM;
        u.pm = fm + ((wgid % nig) % gsz); u.pn = (wgid % nig) / gsz; return true;
    }
    __device__ __forceinline__ void a_ready(const Unit&) const {}
    __device__ __forceinline__ void done(const Unit&) const {}
};

__device__ __forceinline__ unsigned cvt_pk_bf16(float lo, float hi) { unsigned r; asm volatile("v_cvt_pk_bf16_f32 %0, %1, %2" : "=v"(r) : "v"(lo), "v"(hi)); return r; }
typedef float f32x2 __attribute__((ext_vector_type(2)));
}
namespace pg8 {
template <class Epi, class Sched, bool ALIGN_EPI = false, bool SP2 = false>
__device__ __forceinline__ void gemm_phase(PG8_LAS unsigned char* lds, const Gemm g, const Sched& S, const Epi& E) {
    const int tid = tid_opaque(), wid = __builtin_amdgcn_readfirstlane(tid >> 6), lane = tid & 63, wr = wid >> 2, wc = wid & 3, fr = lane & 15, fq = lane >> 4;
    const int K = g.ld, nt = g.K / BK;
    unsigned voffA[2], voffB[2];
#pragma unroll
    for (int i = 0; i < 2; ++i) { int R, C; stage_rc(tid * 16 + i * 8192, R, C); const int Rb = Epi::PERM ? ((R & ~31) + perm32(R & 31)) : R;
        voffA[i] = (unsigned)(R * K + C) * 2u; voffB[i] = (unsigned)(Rb * K + C) * 2u; }
    const size_t kstep = (size_t)(BK * 2);
    const size_t hstep = (size_t)HALF * K * 2;
    const size_t tstep = 2 * hstep;
    const unsigned ldsw = (unsigned)wid * 1024u;
    const int aoff = lds_byte(wr * 64 + fr, fq * 8), boff = lds_byte(wc * 32 + fr, fq * 8);
#define PG8_SA(b, h) (((b) * 2 + (h)) * HTB)
#define PG8_SB(b, h) ((4 + (b) * 2 + (h)) * HTB)
#define PG8_STAGE(bufoff, gbase, voff) do { _Pragma("unroll") for (int _i = 0; _i < 2; ++_i) \
        __builtin_amdgcn_global_load_lds((const unsigned*)((const char*)(gbase) + (voff)[_i]), (PG8_LAS unsigned*)(lds + (bufoff) + ldsw + _i * 8192), 16, 0, 0); } while (0)
#define PG8_LDA(dst, b, h) do { _Pragma("unroll") for (int m = 0; m < 4; ++m) _Pragma("unroll") for (int k = 0; k < 2; ++k) dst[m][k] = *(const PG8_LAS bf16x8*)(lds + PG8_SA(b, h) + aoff + m * 2048 + k * 1024); } while (0)
#define PG8_LDB(dst, b, h) do { _Pragma("unroll") for (int n = 0; n < 2; ++n) _Pragma("unroll") for (int k = 0; k < 2; ++k) dst[n][k] = *(const PG8_LAS bf16x8*)(lds + PG8_SB(b, h) + boff + n * 2048 + k * 1024); } while (0)
#define PG8_MMA(ai, bj, At, Bt) do { __builtin_amdgcn_s_setprio(1); _Pragma("unroll") for (int m = 0; m < 4; ++m) _Pragma("unroll") for (int n = 0; n < 2; ++n) _Pragma("unroll") for (int k = 0; k < 2; ++k) \
        acc[ai][bj][m][n] = __builtin_amdgcn_mfma_f32_16x16x32_bf16(Bt[n][k], At[m][k], acc[ai][bj][m][n], 0, 0, 0); __builtin_amdgcn_s_setprio(0); } while (0)
#define PG8_WAIT_V(n) asm volatile("s_waitcnt vmcnt(" #n ")" ::: "memory")
#define PG8_WAIT_L(n) asm volatile("s_waitcnt lgkmcnt(" #n ")" ::: "memory")
#define PG8_BAR __builtin_amdgcn_s_barrier()
#define PG8_SCHED __builtin_amdgcn_sched_barrier(0)
    Unit cur, nxt; int ui = 0;
    if (!S.next(0, cur)) return;
    f32x4 acc[2][2][4][2];
#pragma unroll
    for (int a = 0; a < 2; ++a)
#pragma unroll
        for (int b = 0; b < 2; ++b)
#pragma unroll
            for (int m = 0; m < 4; ++m)
#pragma unroll
                for (int n = 0; n < 2; ++n) acc[a][b][m][n] = (f32x4){0.f, 0.f, 0.f, 0.f};
    bf16x8 At[4][2], B0[2][2], B1[2][2];
    const char* cA = (const char*)g.A + (size_t)cur.pm * tstep; const char* cB = (const char*)g.Bt + (size_t)cur.pn * tstep;
    S.a_ready(cur);
    if constexpr (SP2) {
        PG8_STAGE(PG8_SB(0, 0), cB, voffB); PG8_STAGE(PG8_SB(0, 1), cB + hstep, voffB); PG8_STAGE(PG8_SA(0, 0), cA, voffA); PG8_STAGE(PG8_SA(0, 1), cA + hstep, voffA);
        if (wr == 1) PG8_BAR;
        PG8_WAIT_V(2); PG8_BAR;
        PG8_STAGE(PG8_SB(1, 0), cB + kstep, voffB); PG8_STAGE(PG8_SA(1, 0), cA + kstep, voffA); PG8_STAGE(PG8_SB(1, 1), cB + hstep + kstep, voffB);
        PG8_WAIT_V(6); PG8_BAR;
    } else {
        PG8_STAGE(PG8_SB(0, 0), cB, voffB); PG8_STAGE(PG8_SA(0, 0), cA, voffA); PG8_STAGE(PG8_SB(0, 1), cB + hstep, voffB); PG8_STAGE(PG8_SA(0, 1), cA + hstep, voffA);
        if (wr == 1) PG8_BAR;
        PG8_WAIT_V(4); PG8_BAR;
        PG8_STAGE(PG8_SB(1, 0), cB + kstep, voffB); PG8_STAGE(PG8_SA(1, 0), cA + kstep, voffA); PG8_STAGE(PG8_SB(1, 1), cB + hstep + kstep, voffB);
        PG8_WAIT_V(6); PG8_BAR;
    }
    for (;;) {
        const bool has_next = S.next(ui + 1, nxt);
        const char* nA = has_next ? (const char*)g.A + (size_t)nxt.pm * tstep : cA; const char* nB = has_next ? (const char*)g.Bt + (size_t)nxt.pn * tstep : cB;
        for (int t = 0; t < nt; t += 2) {
            const bool last = (t == nt - 2);
            const char* a1 = cA + (size_t)(t + 1) * kstep;
            const char* a2 = last ? nA : cA + (size_t)(t + 2) * kstep; const char* b2 = last ? nB : cB + (size_t)(t + 2) * kstep;
            const char* a3 = a2 + kstep; const char* b3 = b2 + kstep;
            if (last && has_next) S.a_ready(nxt);
            if constexpr (SP2) {
            PG8_LDB(B0, 0, 0); PG8_LDB(B1, 0, 1); PG8_SCHED; PG8_LDA(At, 0, 0); PG8_STAGE(PG8_SA(1, 1), a1 + hstep, voffA);
            PG8_WAIT_V(8); PG8_WAIT_L(0); PG8_BAR; PG8_MMA(0, 0, At, B0); PG8_MMA(0, 1, At, B1); PG8_BAR; PG8_SCHED;
            PG8_LDA(At, 0, 1); PG8_STAGE(PG8_SB(0, 0), b2, voffB); PG8_STAGE(PG8_SB(0, 1), b2 + hstep, voffB); PG8_STAGE(PG8_SA(0, 0), a2, voffA);
            PG8_WAIT_V(8); PG8_WAIT_L(0); PG8_BAR; PG8_MMA(1, 0, At, B0); PG8_MMA(1, 1, At, B1); PG8_BAR; PG8_SCHED;
            PG8_LDB(B0, 1, 0); PG8_LDB(B1, 1, 1); PG8_SCHED; PG8_LDA(At, 1, 0); PG8_STAGE(PG8_SA(0, 1), a2 + hstep, voffA);
            PG8_WAIT_V(8); PG8_WAIT_L(0); PG8_BAR; PG8_MMA(0, 0, At, B0); PG8_MMA(0, 1, At, B1); PG8_BAR; PG8_SCHED;
            PG8_LDA(At, 1, 1); PG8_STAGE(PG8_SB(1, 0), b3, voffB); PG8_STAGE(PG8_SB(1, 1), b3 + hstep, voffB); PG8_STAGE(PG8_SA(1, 0), a3, voffA);
            PG8_WAIT_V(8); PG8_WAIT_L(0); PG8_BAR; PG8_MMA(1, 0, At, B0); PG8_MMA(1, 1, At, B1); PG8_BAR; PG8_SCHED;
            } else {
            PG8_LDB(B0, 0, 0); PG8_SCHED; PG8_LDA(At, 0, 0); PG8_STAGE(PG8_SA(1, 1), a1 + hstep, voffA);
            PG8_WAIT_L(8); PG8_BAR; PG8_WAIT_L(0); PG8_MMA(0, 0, At, B0); PG8_BAR; PG8_SCHED;
            PG8_LDB(B1, 0, 1); PG8_STAGE(PG8_SB(0, 0), b2, voffB);
            PG8_BAR; PG8_WAIT_L(0); PG8_MMA(0, 1, At, B1); PG8_BAR;
            PG8_LDA(At, 0, 1); PG8_STAGE(PG8_SA(0, 0), a2, voffA);
            PG8_BAR; PG8_WAIT_L(0); PG8_MMA(1, 0, At, B0); PG8_BAR; PG8_SCHED;
            PG8_STAGE(PG8_SB(0, 1), b2 + hstep, voffB);
            PG8_WAIT_V(6); PG8_BAR; PG8_MMA(1, 1, At, B1); PG8_BAR;
            PG8_LDB(B0, 1, 0); PG8_SCHED; PG8_LDA(At, 1, 0); PG8_STAGE(PG8_SA(0, 1), a2 + hstep, voffA);
            PG8_WAIT_L(8); PG8_BAR; PG8_WAIT_L(0); PG8_MMA(0, 0, At, B0); PG8_BAR; PG8_SCHED;
            PG8_LDB(B1, 1, 1); PG8_STAGE(PG8_SB(1, 0), b3, voffB);
            PG8_BAR; PG8_WAIT_L(0); PG8_MMA(0, 1, At, B1); PG8_BAR;
            PG8_LDA(At, 1, 1); PG8_STAGE(PG8_SA(1, 0), a3, voffA);
            PG8_BAR; PG8_WAIT_L(0); PG8_MMA(1, 0, At, B0); PG8_BAR; PG8_SCHED;
            PG8_STAGE(PG8_SB(1, 1), b3 + hstep, voffB);
            PG8_WAIT_V(6); PG8_BAR; PG8_MMA(1, 1, At, B1); PG8_BAR;
            }
        }
        if constexpr (ALIGN_EPI) { if (wr == 0) PG8_BAR; }
        if constexpr (!Epi::AFTER_DRAIN) { E(acc, cur, wr, wc, fr, fq); S.done(cur); }
        if (!has_next) break;
#pragma unroll
        for (int a = 0; a < 2; ++a)
#pragma unroll
            for (int b = 0; b < 2; ++b)
#pragma unroll
                for (int m = 0; m < 4; ++m)
#pragma unroll
                    for (int n = 0; n < 2; ++n) acc[a][b][m][n] = (f32x4){0.f, 0.f, 0.f, 0.f};
        cur = nxt; cA = nA; cB = nB; ++ui;
        if constexpr (ALIGN_EPI) { if (wr == 1) PG8_BAR; }
    }
    PG8_WAIT_V(0);
    if constexpr (!ALIGN_EPI) { if (wr == 0) PG8_BAR; }
    PG8_BAR;
    if constexpr (Epi::AFTER_DRAIN) { E.fused(acc, cur, wr, wc, fr, fq, lds, wid, lane); S.done(cur); }
#undef PG8_SA
#undef PG8_SB
#undef PG8_STAGE
#undef PG8_LDA
#undef PG8_LDB
#undef PG8_MMA
#undef PG8_WAIT_V
#undef PG8_WAIT_L
#undef PG8_BAR
#undef PG8_SCHED
}
}

#define GAS __attribute__((address_space(1)))
#define LAS __attribute__((address_space(3)))
typedef unsigned short bf16;
typedef unsigned v4u __attribute__((ext_vector_type(4)));
typedef unsigned v2u __attribute__((ext_vector_type(2)));
typedef float f32x4 __attribute__((ext_vector_type(4)));
typedef float f32x2 __attribute__((ext_vector_type(2)));

constexpr int D = 2048, NB = 4, SEQ = 2048, CTX = 256, PB = 2304, M = NB * PB, DEPTH = 4, DFF = 5632, NIN = 4000, NINP = 4096, NMODC = 9 * D;
constexpr int NT = 512, NW = 8;
constexpr int C_XB = 0, C_GATE = 512, C_MQ = 1024, C_MKV = 1408, C_MKR = 1664, C_DQ = 1696, C_DK = 2208, C_DV = 2720, C_GQ = 3232, C_GK = 3744, C_GV = 3872;

constexpr size_t MiB = 1u << 20;
constexpr size_t WS_CTL = 0;
constexpr size_t WS_MOD = 1 * MiB;
constexpr size_t WS_ROPE = 3 * MiB;
constexpr size_t WS_WFFI = 4 * MiB;
constexpr size_t WS_WFFO = WS_WFFI + 352 * MiB;
constexpr size_t WS_WIN = WS_WFFO + 176 * MiB;
constexpr size_t WS_WOUT = WS_WIN + 64 * MiB;
constexpr size_t WS_WQB = WS_WOUT + 32 * MiB;
constexpr size_t WS_WKVB = WS_WQB + 3 * MiB;
constexpr size_t WS_WG = WS_WKVB + 2 * MiB;
constexpr size_t WS_X = WS_WG + 8 * MiB;
constexpr size_t WS_H = WS_X + 72 * MiB;
constexpr size_t WS_ACT = WS_H + 36 * MiB;
constexpr size_t WS_Y = WS_ACT + 99 * MiB;
constexpr size_t WS_COLS = WS_Y + 72 * MiB;
constexpr size_t WS_U = WS_COLS + 72 * MiB;
constexpr size_t WS_GATES = WS_U + 9 * MiB;
constexpr size_t WS_QN = WS_GATES + 72 * MiB;
constexpr size_t WS_KVN = WS_QN + 7 * MiB;
constexpr size_t WS_QUP = WS_KVN + 5 * MiB;
constexpr size_t WS_KVUP = WS_QUP + 14 * MiB;
constexpr size_t WS_QM = WS_KVUP + 18 * MiB;
constexpr size_t WS_KM = WS_QM + 14 * MiB;
constexpr size_t WS_AB = WS_KM + 14 * MiB;
constexpr size_t WS_HS = WS_AB + 72 * MiB;
constexpr size_t WS_DIFFO = WS_HS + 36 * MiB;
constexpr size_t WS_YMIX = WS_DIFFO + 36 * MiB;
constexpr size_t WS_VTD = WS_YMIX + 36 * MiB;
constexpr size_t WS_VTG = WS_VTD + 9 * MiB;
constexpr size_t WS_VTM = WS_VTG + 3 * MiB;
constexpr size_t WS_SUM = WS_VTM + 9 * MiB;
constexpr size_t WS_YP = WS_SUM + 2 * MiB;
constexpr size_t WS_END = WS_YP + 64 * MiB;

constexpr int LDS_BYTES = 147456;

struct P { const float* in[23]; float* out; unsigned char* ws; };
typedef const __attribute__((address_space(4))) P* KP;
__device__ __forceinline__ P load_P(KP kp) {
#if defined(__HIP_DEVICE_COMPILE__)
    asm volatile("" : "+s"(kp)); P r; for (int i = 0; i < 23; ++i) r.in[i] = kp->in[i]; r.out = kp->out; r.ws = kp->ws; return r;
#else
    (void)kp; return P{};
#endif
}

#define LDS_WAIT() asm volatile("s_waitcnt lgkmcnt(0)" ::: "memory")
__device__ __forceinline__ unsigned f2bf(float f) { unsigned u = __builtin_bit_cast(unsigned, f); return (u + 0x7fffu + ((u >> 16) & 1u)) >> 16; }
__device__ __forceinline__ unsigned pk2(float lo, float hi) { return f2bf(lo) | (f2bf(hi) << 16); }
__device__ __forceinline__ float bf2f(unsigned v) { return __builtin_bit_cast(float, v << 16); }
__device__ __forceinline__ float bflo(unsigned w) { return __builtin_bit_cast(float, w << 16); }
__device__ __forceinline__ float bfhi(unsigned w) { return __builtin_bit_cast(float, w & 0xffff0000u); }
template <int XM> __device__ __forceinline__ float swz_xor(float v) { return __builtin_bit_cast(float, __builtin_amdgcn_ds_swizzle(__builtin_bit_cast(int, v), (XM << 10) | 0x1f)); }
__device__ __forceinline__ void pl32swap(unsigned& a, unsigned& b) { asm volatile("s_nop 1\n\tv_permlane32_swap_b32 %0, %1\n\ts_nop 1" : "+v"(a), "+v"(b)); }
__device__ __forceinline__ float xhalf_sum(float v) { unsigned a = __builtin_bit_cast(unsigned, v), b = a; pl32swap(a, b); return __builtin_bit_cast(float, a) + __builtin_bit_cast(float, b); }
__device__ __forceinline__ float xhalf_max(float v) { unsigned a = __builtin_bit_cast(unsigned, v), b = a; pl32swap(a, b); return fmaxf(__builtin_bit_cast(float, a), __builtin_bit_cast(float, b)); }
__device__ __forceinline__ float wave_sum(float v) {
    v += swz_xor<1>(v); v += swz_xor<2>(v); v += swz_xor<4>(v); v += swz_xor<8>(v); v += swz_xor<16>(v);
    return xhalf_sum(v);
}
__device__ __forceinline__ float sigmoidf_(float x) { return 1.f / (1.f + __expf(-x)); }
__device__ __forceinline__ float siluf_(float x) { return x / (1.f + __expf(-x)); }
__device__ __forceinline__ float gelu_tanh(float x) { const float u = 0.7978845608028654f * (x + 0.044715f * x * x * x); return 0.5f * x * (1.f + tanhf(u)); }

struct TileOrder {
    pg8::StaticOrder so; int latonly;
    __device__ __forceinline__ void init(int nMt, int N, int G, int c, int lat) { so.nM = nMt; so.nN = N / 256; so.nwg = so.nM * so.nN; so.G = G; so.c = c; latonly = lat; }
    __device__ __forceinline__ bool next(int i, pg8::Unit& u) const { if (!so.next(i, u)) return false; if (latonly) u.pm = (u.pm >> 3) * 9 + 1 + (u.pm & 7); return true; }
    __device__ __forceinline__ void a_ready(const pg8::Unit&) const {}
    __device__ __forceinline__ void done(const pg8::Unit&) const {}
};
struct EpiF32 {
    static constexpr bool PERM = false, AFTER_DRAIN = false;
    float* C; int ldc;
    __device__ __forceinline__ void operator()(const f32x4 (&acc)[2][2][4][2], const pg8::Unit& u, int wr, int wc, int fr, int fq) const {
        const int row0 = u.pm * 256 + wr * 64 + fr, col0 = u.pn * 256 + wc * 32 + 4 * fq;
#pragma unroll
        for (int ai = 0; ai < 2; ++ai)
#pragma unroll
            for (int m = 0; m < 4; ++m) { float* rowp = C + (size_t)(row0 + ai * 128 + m * 16) * ldc + col0;
#pragma unroll
                for (int bj = 0; bj < 2; ++bj)
#pragma unroll
                    for (int n = 0; n < 2; ++n) *(f32x4*)(rowp + bj * 128 + n * 16) = acc[ai][bj][m][n]; }
    }
};
struct EpiB16 {
    static constexpr bool PERM = true, AFTER_DRAIN = false;
    bf16* O; int ldc;
    __device__ __forceinline__ void operator()(const f32x4 (&acc)[2][2][4][2], const pg8::Unit& u, int wr, int wc, int fr, int fq) const {
        const int row0 = u.pm * 256 + wr * 64 + fr, col0 = u.pn * 256 + wc * 32 + 8 * fq;
#pragma unroll
        for (int ai = 0; ai < 2; ++ai)
#pragma unroll
            for (int m = 0; m < 4; ++m) { bf16* rowp = O + (size_t)(row0 + ai * 128 + m * 16) * ldc + col0;
#pragma unroll
                for (int bj = 0; bj < 2; ++bj) { const f32x4 v0 = acc[ai][bj][m][0], v1 = acc[ai][bj][m][1];
                    v4u w; w.x = pg8::cvt_pk_bf16(v0[0], v0[1]); w.y = pg8::cvt_pk_bf16(v0[2], v0[3]); w.z = pg8::cvt_pk_bf16(v1[0], v1[1]); w.w = pg8::cvt_pk_bf16(v1[2], v1[3]);
                    *(v4u*)(rowp + bj * 128) = w; } }
    }
};
struct EpiSwiglu {
    static constexpr bool PERM = true, AFTER_DRAIN = false;
    bf16* O; int ldc;
    __device__ __forceinline__ void operator()(const f32x4 (&acc)[2][2][4][2], const pg8::Unit& u, int wr, int wc, int fr, int fq) const {
        const int row0 = u.pm * 256 + wr * 64 + fr, col0 = u.pn * 128 + wc * 32 + 8 * fq;
#pragma unroll
        for (int ai = 0; ai < 2; ++ai)
#pragma unroll
            for (int m = 0; m < 4; ++m) { bf16* rowp = O + (size_t)(row0 + ai * 128 + m * 16) * ldc + col0;
                float r[8];
#pragma unroll
                for (int n = 0; n < 2; ++n)
#pragma unroll
                    for (int e = 0; e < 4; ++e) { const float g = acc[ai][0][m][n][e], uu = acc[ai][1][m][n][e]; r[n * 4 + e] = siluf_(g) * uu; }
                v4u w; w.x = pg8::cvt_pk_bf16(r[0], r[1]); w.y = pg8::cvt_pk_bf16(r[2], r[3]); w.z = pg8::cvt_pk_bf16(r[4], r[5]); w.w = pg8::cvt_pk_bf16(r[6], r[7]);
                *(v4u*)rowp = w; }
    }
};

__device__ __forceinline__ void transpose_item(const float* W, int N, int K, bf16* WT, int k0, int n0, int drow0, LAS float* scr, int lane) {
#pragma unroll 8
    for (int i = 0; i < 32; ++i) { const int kk = 2 * i + (lane >> 5); scr[kk * 33 + (lane & 31)] = W[(size_t)(k0 + kk) * N + n0 + (lane & 31)]; }
    LDS_WAIT(); asm volatile("" ::: "memory");
    const int c = lane & 7;
#pragma unroll
    for (int j = 0; j < 4; ++j) { const int n = (lane >> 3) + 8 * j; const LAS float* s = scr + (8 * c) * 33 + n;
        v4u o; o.x = pk2(s[0 * 33], s[1 * 33]); o.y = pk2(s[2 * 33], s[3 * 33]); o.z = pk2(s[4 * 33], s[5 * 33]); o.w = pk2(s[6 * 33], s[7 * 33]);
        *(v4u*)(WT + (size_t)(drow0 + n) * K + k0 + 8 * c) = o; }
    LDS_WAIT(); asm volatile("" ::: "memory");
}

__device__ __forceinline__ void phase_pro1(const P& p, LAS unsigned char* lds) {
    unsigned char* wsb = opq_p(p.ws);
    const int tid = tid_opaque(), lane = tid & 63, wave = __builtin_amdgcn_readfirstlane(tid >> 6);
    const int G = gridDim.x, blk = blockIdx.x;
    {
        LAS float* sc = (LAS float*)lds;
        LAS float* red = (LAS float*)(lds + 40960);
        const float* c = p.in[1]; const float* cc = p.in[3];
        for (int i = tid; i < 5 * D; i += NT) { const int v = i / D, k = i % D; const float x = v < 4 ? c[v * D + k] : cc[k]; sc[i] = x / (1.f + expf(-x)); }
        __syncthreads();
        const float* wmod = p.in[4]; const float* bmod = p.in[5];
        float* MOD = (float*)(wsb + WS_MOD);
        for (int unit = blk; unit < DEPTH * 288; unit += G) {
            const int l = unit / 288, n0 = (unit % 288) * 64, kq = lane >> 4;
            const float* W = wmod + (size_t)l * D * NMODC + n0 + 4 * (lane & 15);
            float acc[5][4];
#pragma unroll
            for (int v = 0; v < 5; ++v)
#pragma unroll
                for (int e = 0; e < 4; ++e) acc[v][e] = 0.f;
            const int kbase = wave * 256 + kq;
#pragma unroll 4
            for (int i = 0; i < 64; ++i) { const int k = kbase + 4 * i; const f32x4 w = *(const f32x4*)(W + (size_t)k * NMODC);
#pragma unroll
                for (int v = 0; v < 5; ++v) { const float s = sc[v * D + k];
#pragma unroll
                    for (int e = 0; e < 4; ++e) acc[v][e] += s * w[e]; } }
#pragma unroll
            for (int v = 0; v < 5; ++v)
#pragma unroll
                for (int e = 0; e < 4; ++e) { float a = acc[v][e]; a += swz_xor<16>(a); a = xhalf_sum(a); acc[v][e] = a; }
            if (kq == 0) {
#pragma unroll
                for (int v = 0; v < 5; ++v)
#pragma unroll
                    for (int e = 0; e < 4; ++e) red[(wave * 5 + v) * 64 + 4 * (lane & 15) + e] = acc[v][e]; }
            __syncthreads();
            if (tid < 320) { const int v = tid / 64, col = tid % 64; float s = 0.f;
#pragma unroll
                for (int w = 0; w < 8; ++w) s += red[(w * 5 + v) * 64 + col];
                MOD[((size_t)l * 5 + v) * NMODC + n0 + col] = s + bmod[l * NMODC + n0 + col]; }
            __syncthreads();
        }
    }
    __syncthreads();
    {
        LAS float* scr = (LAS float*)(lds + wave * 16384);
        const int gw = wave * G + blk, NGW = NW * G;
        constexpr int I_FI = 32 * 352, I_FO = 88 * 64, I_IN = 32 * 125, I_OUT = 32 * 64, I_QB = 6 * 24, I_KVB = 4 * 32;
        constexpr int T_FI = 8 * I_FI, T_FO = 8 * I_FO, T_IN = 4 * I_IN, T_OUT = 4 * I_OUT, T_QB = 4 * I_QB, T_KVB = 4 * I_KVB;
        constexpr int NITEMS = T_FI + T_FO + T_IN + T_OUT + T_QB + T_KVB;
        for (int it = gw; it < NITEMS; it += NGW) {
            int r = it;
            if (r < T_FI) { const int mat = r / I_FI; r %= I_FI; const int kb = r / 352, nb = r % 352, n0 = nb * 32;
                const int half = n0 / DFF, cc = n0 % DFF, drow0 = (cc / 128) * 256 + half * 128 + (cc % 128);
                transpose_item(p.in[7] + (size_t)mat * D * (2 * DFF), 2 * DFF, D, (bf16*)(wsb + WS_WFFI) + (size_t)mat * (2 * DFF) * D, kb * 64, n0, drow0, scr, lane); continue; }
            r -= T_FI;
            if (r < T_FO) { const int mat = r / I_FO; r %= I_FO; const int kb = r / 64, nb = r % 64;
                transpose_item(p.in[8] + (size_t)mat * DFF * D, D, DFF, (bf16*)(wsb + WS_WFFO) + (size_t)mat * D * DFF, kb * 64, nb * 32, nb * 32, scr, lane); continue; }
            r -= T_FO;
            if (r < T_IN) { const int mat = r / I_IN; r %= I_IN; const int kb = r / 125, nb = r % 125;
                transpose_item(p.in[9] + (size_t)mat * D * NIN, NIN, D, (bf16*)(wsb + WS_WIN) + (size_t)mat * NINP * D, kb * 64, nb * 32, nb * 32, scr, lane); continue; }
            r -= T_IN;
            if (r < T_OUT) { const int mat = r / I_OUT; r %= I_OUT; const int kb = r / 64, nb = r % 64;
                transpose_item(p.in[10] + (size_t)mat * D * D, D, D, (bf16*)(wsb + WS_WOUT) + (size_t)mat * D * D, kb * 64, nb * 32, nb * 32, scr, lane); continue; }
            r -= T_OUT;
            if (r < T_QB) { const int mat = r / I_QB; r %= I_QB; const int kb = r / 24, nb = r % 24;
                transpose_item(p.in[17] + (size_t)mat * 384 * 768, 768, 384, (bf16*)(wsb + WS_WQB) + (size_t)mat * 768 * 384, kb * 64, nb * 32, nb * 32, scr, lane); continue; }
            r -= T_QB;
            { const int mat = r / I_KVB; r %= I_KVB; const int kb = r / 32, nb = r % 32;
                transpose_item(p.in[19] + (size_t)mat * 256 * 1024, 1024, 256, (bf16*)(wsb + WS_WKVB) + (size_t)mat * 1024 * 256, kb * 64, nb * 32, nb * 32, scr, lane); }
        }
    }
    {
        const int gt = blk * NT + tid, NGT = G * NT;
        for (int i = gt; i < DEPTH * 96 * (D / 8); i += NGT) { const int l = i / (96 * (D / 8)), r = i % (96 * (D / 8));
            *(v4u*)((bf16*)(wsb + WS_WIN) + ((size_t)l * NINP + NIN) * D + (size_t)r * 8) = (v4u){0u, 0u, 0u, 0u}; }
        const float* wg = p.in[13];
        for (int i = gt; i < DEPTH * 2048 * 64; i += NGT) { const int l = i / (2048 * 64), r = i % (2048 * 64), np = r / 64, k0 = (r % 64) * 8;
            const int c7 = np & 127, gate = (np >> 7) & 1, chunk = (np >> 8) & 3, dir = np >> 10, ch = chunk * 128 + c7, head = ch >> 6, j = ch & 63;
            v4u o = (v4u){0u, 0u, 0u, 0u};
            if ((k0 >> 6) == head) { const float* src = wg + ((((size_t)l * 2 + dir) * 2 + gate) * 8 + head) * 4096 + (size_t)(k0 & 63) * 64 + j;
                o.x = pk2(src[0], src[64]); o.y = pk2(src[128], src[192]); o.z = pk2(src[256], src[320]); o.w = pk2(src[384], src[448]); }
            *(v4u*)((bf16*)(wsb + WS_WG) + ((size_t)l * 2048 + np) * 512 + k0) = o; }
        float* rope = (float*)(wsb + WS_ROPE);
        for (int i = gt; i < SEQ * 32; i += NGT) { const int t = i / 32, k = i % 32; const float inv = powf(10000.f, -(float)(k & 15) / 16.f);
            const float ang = (k < 16 ? (float)(t / 64) : (float)(t % 64)) * inv; rope[i] = cosf(ang); rope[SEQ * 32 + i] = sinf(ang); }
        for (int i = gt; i < SEQ * 16; i += NGT) { const int t = i / 16, k = i % 16; const float inv = powf(10000.f, -(float)(k & 7) / 8.f);
            const float ang = (k < 8 ? (float)(t / 64) : (float)(t % 64)) * inv; rope[SEQ * 64 + i] = cosf(ang); rope[SEQ * 64 + SEQ * 16 + i] = sinf(ang); }
    }
}

__device__ __forceinline__ float row_rstd(const f32x4 (&v)[8]) {
    float s = 0.f;
#pragma unroll
    for (int j = 0; j < 8; ++j) s += (v[j][0] * v[j][0] + v[j][1] * v[j][1]) + (v[j][2] * v[j][2] + v[j][3] * v[j][3]);
    s = wave_sum(s);
    return 1.0f / sqrtf(s * (1.0f / D) + 1e-6f);
}
__device__ __forceinline__ void store_prenorm(bf16* hrow, int lane, const f32x4 (&v)[8], const float* g, const float* shift, const float* scale) {
    const float rstd = row_rstd(v);
#pragma unroll
    for (int j = 0; j < 8; ++j) { const int idx = lane + 64 * j;
        const f32x4 gg = ((const f32x4*)g)[idx], sh = ((const f32x4*)shift)[idx], sc = ((const f32x4*)scale)[idx];
        const f32x4 o = (v[j] * rstd) * gg * (sc + 1.0f) + sh;
        v2u w; w.x = pk2(o[0], o[1]); w.y = pk2(o[2], o[3]);
        *(v2u*)(hrow + 4 * idx) = w; }
}

__device__ __forceinline__ void phase_pro2(const P& p) {
    unsigned char* wsb = opq_p(p.ws);
    const int tid = tid_opaque(), lane = tid & 63, wave = tid >> 6, G = gridDim.x, blk = blockIdx.x;
    const int gw = wave * G + blk, NGW = NW * G;
    float* X = (float*)(wsb + WS_X); bf16* H = (bf16*)(wsb + WS_H); const float* MOD = (const float*)(wsb + WS_MOD);
    for (int row = gw; row < M; row += NGW) {
        const int b = row / PB, pp = row % PB; const bool isctx = pp < CTX; const int v = isctx ? 4 : b;
        const float* src = isctx ? p.in[2] + ((size_t)b * CTX + pp) * D : p.in[0] + ((size_t)b * SEQ + (pp - CTX)) * D;
        f32x4 xv[8];
#pragma unroll
        for (int j = 0; j < 8; ++j) xv[j] = ((const f32x4*)src)[lane + 64 * j];
#pragma unroll
        for (int j = 0; j < 8; ++j) ((f32x4*)(X + (size_t)row * D))[lane + 64 * j] = xv[j];
        const float* mod = MOD + ((size_t)0 * 5 + v) * NMODC;
        store_prenorm(H + (size_t)row * D, lane, xv, p.in[6] + (size_t)(0 * 6 + 0) * D, mod + 0 * D, mod + 1 * D);
    }
}

__device__ __forceinline__ void phase_post(const P& p, int layer, int s) {
    unsigned char* wsb = opq_p(p.ws);
    layer = opq_s(layer);
    const int tid = tid_opaque(), lane = tid & 63, wave = tid >> 6, G = gridDim.x, blk = blockIdx.x;
    const int gw = wave * G + blk, NGW = NW * G;
    float* X = (float*)(wsb + WS_X); bf16* H = (bf16*)(wsb + WS_H); const float* Y = (const float*)(wsb + WS_Y); const float* MOD = (const float*)(wsb + WS_MOD);
    const bool last = layer == DEPTH - 1, final = last && s == 2, split = !(last && s >= 1);
    const float wgt = (s == 1) ? 1.0f : 0.5f;
    const int l2 = (s < 2) ? layer : layer + 1, s2 = (s < 2) ? s + 1 : 0;
    for (int row = gw; row < M; row += NGW) {
        const int b = row / PB, pp = row % PB; const bool isctx = pp < CTX; const int v = isctx ? 4 : b;
        if (last && s >= 1 && isctx) continue;
        f32x4 yv[8], xv[8];
        if (split && row >= 8192) { const float* yp = (const float*)(wsb + WS_YP) + (size_t)(row - 8192) * D;
#pragma unroll
            for (int j = 0; j < 8; ++j) { f32x4 a = ((const f32x4*)yp)[lane + 64 * j];
#pragma unroll
                for (int sl = 1; sl < 8; ++sl) a += ((const f32x4*)(yp + (size_t)sl * 1024 * 2048))[lane + 64 * j];
                yv[j] = a; } }
        else {
#pragma unroll
            for (int j = 0; j < 8; ++j) yv[j] = ((const f32x4*)(Y + (size_t)row * D))[lane + 64 * j]; }
#pragma unroll
        for (int j = 0; j < 8; ++j) xv[j] = ((const f32x4*)(X + (size_t)row * D))[lane + 64 * j];
        const float rstd = row_rstd(yv);
        const float* gate = MOD + ((size_t)layer * 5 + v) * NMODC + (size_t)(3 * s + 2) * D;
        const float* gpost = p.in[6] + (size_t)(layer * 6 + 2 * s + 1) * D;
        float* dst = final ? p.out + ((size_t)b * SEQ + (pp - CTX)) * D : X + (size_t)row * D;
#pragma unroll
        for (int j = 0; j < 8; ++j) { const int idx = lane + 64 * j; const f32x4 ga = ((const f32x4*)gate)[idx], gp = ((const f32x4*)gpost)[idx];
            xv[j] = xv[j] + (ga * wgt) * ((yv[j] * rstd) * gp);
            ((f32x4*)dst)[idx] = xv[j]; }
        if (!final) { const float* mod = MOD + ((size_t)l2 * 5 + v) * NMODC;
            store_prenorm(H + (size_t)row * D, lane, xv, p.in[6] + (size_t)(l2 * 6 + 2 * s2) * D, mod + (size_t)(3 * s2) * D, mod + (size_t)(3 * s2 + 1) * D); }
    }
}

template <class Epi>
__device__ __forceinline__ void run_gemm(LAS unsigned char* lds, const bf16* A, const bf16* Bt, int nMt, int N, int K, int latonly, int coff, const Epi& E) {
    pg8::Gemm g{A, Bt, M, N, K, K};
    TileOrder S; S.init(nMt, N, (int)gridDim.x, (int)((blockIdx.x + coff) % gridDim.x), latonly);
    pg8::gemm_phase<Epi, TileOrder, true, true>(lds, g, S, E);
}
struct OneUnit { int pm, pn;
    __device__ __forceinline__ bool next(int i, pg8::Unit& u) const { if (i != 0) return false; u.pm = pm; u.pn = pn; return true; }
    __device__ __forceinline__ void a_ready(const pg8::Unit&) const {}
    __device__ __forceinline__ void done(const pg8::Unit&) const {}
};
__device__ __forceinline__ void run_gemm_n2048_split(LAS unsigned char* lds, const bf16* A, const bf16* Bt, int K, float* Y, float* YP) {
    { EpiF32 E{Y, D}; run_gemm(lds, A, Bt, 32, D, K, 0, 0, E); }
    __syncthreads();
    const int nkt = K / 64;
    for (int L = blockIdx.x; L < 256; L += gridDim.x) {
        const int s = L & 7, tile = L >> 3, pm = 32 + (tile >> 3), pn = tile & 7;
        const int per = nkt >> 3, odd = per & 1;
        const int kt0 = per * s + (odd ? (s & 1) : 0), nk = odd ? per + 1 - 2 * (s & 1) : per;
        pg8::Gemm g{A + (size_t)kt0 * 64, Bt + (size_t)kt0 * 64, M, D, nk * 64, K};
        OneUnit S{pm, pn};
        EpiF32 E{YP + (ptrdiff_t)s * (1024 * 2048) - (ptrdiff_t)(32 * 256) * 2048, D};
        pg8::gemm_phase<EpiF32, OneUnit, true, true>(lds, g, S, E);
        __syncthreads();
    }
}
__device__ __forceinline__ void phase_ffn_in(const P& p, LAS unsigned char* lds, int layer, int which) {
    unsigned char* wsb = opq_p(p.ws);
    layer = opq_s(layer);
    const bool lat = (layer == DEPTH - 1) && which == 1;
    EpiSwiglu E{(bf16*)(wsb + WS_ACT), DFF};
    run_gemm(lds, (const bf16*)(wsb + WS_H), (const bf16*)(wsb + WS_WFFI) + (size_t)(layer * 2 + which) * (2 * DFF) * D, lat ? 32 : 36, 2 * DFF, D, lat, 0, E);
}
__device__ __forceinline__ void phase_ffn_out(const P& p, LAS unsigned char* lds, int layer, int which) {
    unsigned char* wsb = opq_p(p.ws);
    layer = opq_s(layer);
    const bool lat = (layer == DEPTH - 1) && which == 1;
    const bf16* A = (const bf16*)(wsb + WS_ACT); const bf16* Bt = (const bf16*)(wsb + WS_WFFO) + (size_t)(layer * 2 + which) * D * DFF;
    if (lat) { EpiF32 E{(float*)(wsb + WS_Y), D}; run_gemm(lds, A, Bt, 32, D, DFF, 1, 0, E); }
    else run_gemm_n2048_split(lds, A, Bt, DFF, (float*)(wsb + WS_Y), (float*)(wsb + WS_YP));
}
__device__ __forceinline__ void phase_inproj(const P& p, LAS unsigned char* lds, int layer) {
    unsigned char* wsb = opq_p(p.ws);
    layer = opq_s(layer);
    EpiB16 E{(bf16*)(wsb + WS_COLS), NINP};
    run_gemm(lds, (const bf16*)(wsb + WS_H), (const bf16*)(wsb + WS_WIN) + (size_t)layer * NINP * D, 36, NINP, D, 0, 0, E);
}
__device__ __forceinline__ void phase_outproj(const P& p, LAS unsigned char* lds, int layer) {
    unsigned char* wsb = opq_p(p.ws);
    layer = opq_s(layer);
    const bool lat = (layer == DEPTH - 1);
    const bf16* A = (const bf16*)(wsb + WS_YMIX); const bf16* Bt = (const bf16*)(wsb + WS_WOUT) + (size_t)layer * D * D;
    if (lat) { EpiF32 E{(float*)(wsb + WS_Y), D}; run_gemm(lds, A, Bt, 32, D, D, 1, 0, E); }
    else run_gemm_n2048_split(lds, A, Bt, D, (float*)(wsb + WS_Y), (float*)(wsb + WS_YP));
}
__device__ __forceinline__ void phase_mgemm(const P& p, LAS unsigned char* lds, int layer) {
    unsigned char* wsb = opq_p(p.ws);
    layer = opq_s(layer);
    { EpiB16 E{(bf16*)(wsb + WS_QUP), 768};
      run_gemm(lds, (const bf16*)(wsb + WS_QN), (const bf16*)(wsb + WS_WQB) + (size_t)layer * 768 * 384, 36, 768, 384, 0, 0, E); }
    __syncthreads();
    { EpiB16 E{(bf16*)(wsb + WS_KVUP), 1024};
      run_gemm(lds, (const bf16*)(wsb + WS_KVN), (const bf16*)(wsb + WS_WKVB) + (size_t)layer * 1024 * 256, 36, 1024, 256, 0, 148, E); }
    __syncthreads();
    { EpiF32 E{(float*)(wsb + WS_GATES), 2048};
      run_gemm(lds, (const bf16*)(wsb + WS_U), (const bf16*)(wsb + WS_WG) + (size_t)layer * 2048 * 512, 36, 2048, 512, 0, 0, E); }
}


__device__ __forceinline__ void transpose_tok_item(const bf16* src, int ss, bf16* dst, LAS unsigned short* scr, int lane) {
#pragma unroll
    for (int i = 0; i < 8; ++i) { const int id = lane + 64 * i, row = id >> 3, ch = id & 7;
        const v4u w = *(const v4u*)(src + (size_t)row * ss + ch * 8);
        LAS unsigned* d = (LAS unsigned*)(scr + row * 66 + ch * 8);
        d[0] = w.x; d[1] = w.y; d[2] = w.z; d[3] = w.w; }
    LDS_WAIT(); asm volatile("" ::: "memory");
#pragma unroll
    for (int i = 0; i < 8; ++i) { const int id = lane + 64 * i, e = id >> 3, ch = id & 7;
        unsigned v[8];
#pragma unroll
        for (int k = 0; k < 8; ++k) v[k] = scr[(ch * 8 + k) * 66 + e];
        v4u w; w.x = v[0] | (v[1] << 16); w.y = v[2] | (v[3] << 16); w.z = v[4] | (v[5] << 16); w.w = v[6] | (v[7] << 16);
        *(v4u*)(dst + (size_t)e * PB + ch * 8) = w; }
    LDS_WAIT(); asm volatile("" ::: "memory");
}
__device__ __forceinline__ void phase_prep(const P& p, LAS unsigned char* lds, int layer) {
    unsigned char* wsb = opq_p(p.ws);
    layer = opq_s(layer);
    const int tid = tid_opaque(), lane = tid & 63, wave = tid >> 6, G = gridDim.x, blk = blockIdx.x;
    const int gw = wave * G + blk, NGW = NW * G;
    bf16* COLS = (bf16*)(wsb + WS_COLS); bf16* U = (bf16*)(wsb + WS_U); bf16* QN = (bf16*)(wsb + WS_QN); bf16* KVN = (bf16*)(wsb + WS_KVN);
    const float* rope = (const float*)(wsb + WS_ROPE);
    const float* cw = p.in[11] + (size_t)layer * 4 * 512; const float* cb = p.in[12] + (size_t)layer * 512;
    const float* qg = p.in[16] + (size_t)layer * 384; const float* kvg = p.in[18] + (size_t)layer * 256;
    for (int row = gw; row < M; row += NGW) {
        const int pp = row % PB; const bool isctx = pp < CTX;
        const int lo = isctx ? 0 : CTX, hi = isctx ? CTX : PB;
        bf16* crow = COLS + (size_t)row * NINP;
#pragma unroll
        for (int cblk = 0; cblk < 8; ++cblk) { const int ch = cblk * 64 + lane; float acc = cb[ch];
#pragma unroll
            for (int j = 0; j < 4; ++j) { const int q = pp + j - 2; if (q >= lo && q < hi) acc += cw[j * 512 + ch] * bf2f(crow[(ptrdiff_t)(j - 2) * NINP + C_XB + ch]); }
            U[(size_t)row * 512 + ch] = (bf16)f2bf(acc); }
        { float v[6]; float s = 0.f;
#pragma unroll
            for (int j = 0; j < 6; ++j) { v[j] = bf2f(crow[C_MQ + lane + 64 * j]); s += v[j] * v[j]; }
            s = wave_sum(s); const float rstd = 1.0f / sqrtf(s * (1.0f / 384.f) + 1e-6f);
#pragma unroll
            for (int j = 0; j < 6; ++j) QN[(size_t)row * 384 + lane + 64 * j] = (bf16)f2bf(v[j] * rstd * qg[lane + 64 * j]); }
        { float v[4]; float s = 0.f;
#pragma unroll
            for (int j = 0; j < 4; ++j) { v[j] = bf2f(crow[C_MKV + lane + 64 * j]); s += v[j] * v[j]; }
            s = wave_sum(s); const float rstd = 1.0f / sqrtf(s * (1.0f / 256.f) + 1e-6f);
#pragma unroll
            for (int j = 0; j < 4; ++j) KVN[(size_t)row * 256 + lane + 64 * j] = (bf16)f2bf(v[j] * rstd * kvg[lane + 64 * j]); }
        if (!isctx) { const int t = pp - CTX; const int i = lane & 31, hsel = lane >> 5;
            const float c = rope[t * 32 + i], sn = rope[SEQ * 32 + t * 32 + i];
#pragma unroll
            for (int hp = 0; hp < 13; ++hp) { const int hd = hp * 2 + hsel; const int base = hd < 16 ? C_DQ + hd * 64 : C_GQ + (hd - 16) * 64;
                const float x1 = bf2f(crow[base + i]), x2 = bf2f(crow[base + 32 + i]);
                crow[base + i] = (bf16)f2bf(x1 * c - x2 * sn); crow[base + 32 + i] = (bf16)f2bf(x1 * sn + x2 * c); }
            if (lane < 16) { const float c2 = rope[SEQ * 64 + t * 16 + lane], s2 = rope[SEQ * 64 + SEQ * 16 + t * 16 + lane];
                const float x1 = bf2f(crow[C_MKR + lane]), x2 = bf2f(crow[C_MKR + 16 + lane]);
                crow[C_MKR + lane] = (bf16)f2bf(x1 * c2 - x2 * s2); crow[C_MKR + 16 + lane] = (bf16)f2bf(x1 * s2 + x2 * c2); }
        }
    }
    { LAS unsigned short* scr = (LAS unsigned short*)(lds + wave * 16384);
      bf16* VTD = (bf16*)(wsb + WS_VTD); bf16* VTG = (bf16*)(wsb + WS_VTG);
      for (int it = gw; it < NB * 36 * 10; it += NGW) { const int b = it / 360, r = it % 360, tb = r / 10, cb = r % 10;
          const bf16* s = COLS + ((size_t)b * PB + tb * 64) * NINP + (cb < 8 ? C_DV + cb * 64 : C_GV + (cb - 8) * 64);
          bf16* d = cb < 8 ? VTD + ((size_t)b * 512 + cb * 64) * PB + tb * 64 : VTG + ((size_t)b * 128 + (cb - 8) * 64) * PB + tb * 64;
          transpose_tok_item(s, NINP, d, scr, lane); } }
}

__device__ __forceinline__ void phase_prep2(const P& p, LAS unsigned char* lds, int layer) {
    unsigned char* wsb = opq_p(p.ws);
    layer = opq_s(layer);
    const int tid = tid_opaque(), lane = tid & 63, wave = tid >> 6, G = gridDim.x, blk = blockIdx.x;
    const int gw = wave * G + blk, NGW = NW * G;
    const bf16* COLS = (const bf16*)(wsb + WS_COLS); const bf16* U = (const bf16*)(wsb + WS_U);
    const bf16* QUP = (const bf16*)(wsb + WS_QUP); const bf16* KVUP = (const bf16*)(wsb + WS_KVUP);
    bf16* QM = (bf16*)(wsb + WS_QM); bf16* KM = (bf16*)(wsb + WS_KM);
    const float* GATES = (const float*)(wsb + WS_GATES); f32x2* AB = (f32x2*)(wsb + WS_AB);
    const float* rope = (const float*)(wsb + WS_ROPE);
    const float* bg = p.in[14] + (size_t)layer * 2 * 2 * 512; const float* lam = p.in[15] + (size_t)layer * 2 * 512;
    for (int row = gw; row < M; row += NGW) {
        const int pp = row % PB; const bool isctx = pp < CTX; const int t = pp - CTX;
#pragma unroll
        for (int j = 0; j < 12; ++j) { const int e = lane + 64 * j, h = e / 96, d = e % 96;
            float qv = bf2f(QUP[(size_t)row * 768 + e]);
            if (d >= 64 && !isctx) { const int i = (d - 64) & 15; const bool second = (d - 64) >= 16;
                const float c = rope[SEQ * 64 + t * 16 + i], sn = rope[SEQ * 64 + SEQ * 16 + t * 16 + i];
                const float x1 = bf2f(QUP[(size_t)row * 768 + h * 96 + 64 + i]), x2 = bf2f(QUP[(size_t)row * 768 + h * 96 + 80 + i]);
                qv = second ? (x1 * sn + x2 * c) : (x1 * c - x2 * sn); }
            QM[(size_t)row * 768 + e] = (bf16)f2bf(qv);
            KM[(size_t)row * 768 + e] = d < 64 ? KVUP[(size_t)row * 1024 + h * 128 + d] : COLS[(size_t)row * NINP + C_MKR + (d - 64)]; }
#pragma unroll
        for (int dir = 0; dir < 2; ++dir)
#pragma unroll
            for (int cblk = 0; cblk < 8; ++cblk) { const int ch = cblk * 64 + lane;
                const float* gp = GATES + (size_t)row * 2048 + ((dir * 4 + (ch >> 7)) * 2) * 128 + (ch & 127);
                const float gr = gp[0] + bg[(dir * 2 + 0) * 512 + ch], gi = gp[128] + bg[(dir * 2 + 1) * 512 + ch];
                const float r = 1.f / (1.f + expf(-gr)), ig = 1.f / (1.f + expf(-gi));
                const float sp = log1pf(expf(-lam[dir * 512 + ch]));
                const float log_a = -8.0f * r * sp, a = expf(log_a);
                const float u = bf2f(U[(size_t)row * 512 + ch]);
                const float bco = sqrtf(-expm1f(2.0f * log_a)) * (ig * u);
                AB[((size_t)dir * M + row) * 512 + ch] = (f32x2){a, bco}; }
    }
    { LAS unsigned short* scr = (LAS unsigned short*)(lds + wave * 16384);
      bf16* VTM = (bf16*)(wsb + WS_VTM);
      for (int it = gw; it < NB * 36 * 8; it += NGW) { const int b = it / 288, r = it % 288, tb = r / 8, hh = r % 8;
          transpose_tok_item(KVUP + ((size_t)b * PB + tb * 64) * 1024 + hh * 128 + 64, 1024, VTM + ((size_t)b * 512 + hh * 64) * PB + tb * 64, scr, lane); } }
}

template <int DQK, int DV, int MODE, bool OUTF32>
__device__ __forceinline__ void naive_attn(const bf16* Q, int qs, const bf16* K, int ks, const bf16* V, int vs, void* O, int os,
                                           int b, int pp0, int lane, float scale, float sink) {
    const size_t rowbase = (size_t)b * PB; const int pp = pp0 + lane;
    float q[DQK], o[DV];
    { const bf16* qr = Q + (rowbase + pp) * qs;
#pragma unroll
      for (int c = 0; c < DQK / 8; ++c) { const v4u w = *(const v4u*)(qr + 8 * c);
          q[8 * c + 0] = bflo(w.x); q[8 * c + 1] = bfhi(w.x); q[8 * c + 2] = bflo(w.y); q[8 * c + 3] = bfhi(w.y);
          q[8 * c + 4] = bflo(w.z); q[8 * c + 5] = bfhi(w.z); q[8 * c + 6] = bflo(w.w); q[8 * c + 7] = bfhi(w.w); } }
    const float sl2 = scale * 1.4426950408889634f;
#pragma unroll
    for (int d = 0; d < DQK; ++d) q[d] *= sl2;
#pragma unroll
    for (int e = 0; e < DV; ++e) o[e] = 0.f;
    float m = (MODE == 1) ? sink * 1.4426950408889634f : -1e30f, l = (MODE == 1) ? 1.f : 0.f;
    const bool isctx = pp0 < CTX; const int t = pp - CTX, t0 = pp0 - CTX;
    for (int seg = 0; seg < 2; ++seg) {
        int k0, k1;
        if (seg == 0) { k0 = 0; k1 = CTX; }
        else { if (isctx) break;
            if (MODE == 0) { k0 = CTX; k1 = PB; }
            else { const int a0 = t0 - 128 < 0 ? 0 : t0 - 128, a1 = t0 + 63 + 128 > SEQ - 1 ? SEQ - 1 : t0 + 63 + 128; k0 = CTX + a0; k1 = CTX + a1 + 1; } }
        for (int key = k0; key < k1; ++key) {
            const bf16* kr = K + (rowbase + key) * ks; const bf16* vr = V + (rowbase + key) * vs;
            asm volatile("" : "+v"(kr)); asm volatile("" : "+v"(vr));
            float s = 0.f;
#pragma unroll
            for (int c = 0; c < DQK / 8; ++c) { const v4u w = *(const v4u*)(kr + 8 * c);
                s += q[8 * c + 0] * bflo(w.x); s += q[8 * c + 1] * bfhi(w.x); s += q[8 * c + 2] * bflo(w.y); s += q[8 * c + 3] * bfhi(w.y);
                s += q[8 * c + 4] * bflo(w.z); s += q[8 * c + 5] * bfhi(w.z); s += q[8 * c + 6] * bflo(w.w); s += q[8 * c + 7] * bfhi(w.w); }
            bool valid = true;
            if (MODE == 1 && seg == 1) { const int rel = (key - CTX) - t; valid = (rel <= 128) && (rel >= -128); }
            if (valid) {
                const float mn = fmaxf(m, s), alpha = exp2f(m - mn), pr = exp2f(s - mn);
                l = l * alpha + pr; m = mn;
#pragma unroll
                for (int c = 0; c < DV / 8; ++c) { const v4u w = *(const v4u*)(vr + 8 * c);
                    o[8 * c + 0] = o[8 * c + 0] * alpha + pr * bflo(w.x); o[8 * c + 1] = o[8 * c + 1] * alpha + pr * bfhi(w.x);
                    o[8 * c + 2] = o[8 * c + 2] * alpha + pr * bflo(w.y); o[8 * c + 3] = o[8 * c + 3] * alpha + pr * bfhi(w.y);
                    o[8 * c + 4] = o[8 * c + 4] * alpha + pr * bflo(w.z); o[8 * c + 5] = o[8 * c + 5] * alpha + pr * bfhi(w.z);
                    o[8 * c + 6] = o[8 * c + 6] * alpha + pr * bflo(w.w); o[8 * c + 7] = o[8 * c + 7] * alpha + pr * bfhi(w.w); }
            }
        }
    }
    const float il = 1.f / l;
    if (OUTF32) { float* orow = (float*)O + (rowbase + pp) * os;
#pragma unroll
        for (int e = 0; e < DV; e += 4) *(f32x4*)(orow + e) = (f32x4){o[e] * il, o[e + 1] * il, o[e + 2] * il, o[e + 3] * il}; }
    else { bf16* orow = (bf16*)O + (rowbase + pp) * os;
#pragma unroll
        for (int e = 0; e < DV; e += 8) { v4u w; w.x = pk2(o[e] * il, o[e + 1] * il); w.y = pk2(o[e + 2] * il, o[e + 3] * il); w.z = pk2(o[e + 4] * il, o[e + 5] * il); w.w = pk2(o[e + 6] * il, o[e + 7] * il);
            *(v4u*)(orow + e) = w; } }
}


typedef short bf16x8 __attribute__((ext_vector_type(8)));
typedef float f32x16 __attribute__((ext_vector_type(16)));
__device__ __forceinline__ int crow16(int r, int hi) { return (r & 3) + 8 * (r >> 2) + 4 * hi; }

typedef __bf16 bf16x2_t __attribute__((ext_vector_type(2)));
__device__ __forceinline__ unsigned cvtpk_s(float lo, float hi) { const f32x2 v = {lo, hi}; const bf16x2_t b = __builtin_convertvector(v, bf16x2_t); return __builtin_bit_cast(unsigned, b); }
template <int DQK, int DV, int MODE, bool OUTF32>
__device__ __forceinline__ void attn_unit(LAS unsigned char* lds, const bf16* Qb, int qs, const bf16* Kb, int ks, const bf16* VTb, void* Ob, int os,
                                          int q0, int ntd, float scale, float sink, int tid_in) {
    int tid = tid_in; asm volatile("" : "+v"(tid));
    constexpr int RSK = DQK * 2 + 16, RSV = 136, KBUF = 64 * RSK, VBUF = DV * RSV, CPR = DQK / 8, NKC = 64 * CPR, NVC = DV * 8;
    constexpr int NKI = (NKC + NT - 1) / NT, NVI = NVC / NT, ND0 = DQK / 16, NDB = DV / 32;
    const int lane = tid & 63, wave = __builtin_amdgcn_readfirstlane(tid >> 6), r32 = lane & 31, hi = lane >> 5;
    int ta = 4, ntiles = ntd;
    if (MODE == 1) { if (q0 < CTX) ntiles = 4; else { const int t0 = q0 - CTX; const int lo = t0 - 128 < 0 ? 0 : t0 - 128, hh = t0 + 383 > SEQ - 1 ? SEQ - 1 : t0 + 383; ta = 4 + (lo >> 6); ntiles = 4 + ((hh >> 6) - (lo >> 6) + 1); } }
#define TILE_OF(i) ((MODE == 1 && (i) >= 4) ? ta + (i) - 4 : (i))
    const int qrow = q0 + wave * 32 + r32;
    bf16x8 qf[ND0];
#pragma unroll
    for (int d0 = 0; d0 < ND0; ++d0) qf[d0] = *(const bf16x8*)(Qb + (size_t)qrow * qs + 16 * d0 + 8 * hi);
    f32x16 o[NDB];
#pragma unroll
    for (int db = 0; db < NDB; ++db)
#pragma unroll
        for (int r = 0; r < 16; ++r) o[db][r] = 0.f;
    const float c = scale * 1.4426950408889634f;
    float m = (MODE == 1) ? sink / scale : -1e30f, l = (MODE == 1 && hi == 0) ? 1.f : 0.f;
    v4u kreg[NKI], vreg[NVI];
#pragma unroll
    for (int i_ = 0; i_ < NKI; ++i_) kreg[i_] = (v4u){0u, 0u, 0u, 0u};
#pragma unroll
    for (int i_ = 0; i_ < NVI; ++i_) vreg[i_] = (v4u){0u, 0u, 0u, 0u};
#define LOAD_TILE(tile) do { const int kb_ = (tile) * 64; \
        _Pragma("unroll") for (int i_ = 0; i_ < NKI; ++i_) { const int id_ = tid + NT * i_; if (id_ < NKC) { const int row_ = id_ / CPR, ch_ = id_ % CPR; kreg[i_] = *(const v4u*)(Kb + (size_t)(kb_ + row_) * ks + ch_ * 8); } } \
        _Pragma("unroll") for (int i_ = 0; i_ < NVI; ++i_) { const int id_ = tid + NT * i_, d_ = id_ >> 3, ch_ = id_ & 7; vreg[i_] = *(const v4u*)(VTb + (size_t)d_ * PB + kb_ + ch_ * 8); } } while (0)
#define STORE_TILE(buf) do { \
        _Pragma("unroll") for (int i_ = 0; i_ < NKI; ++i_) { const int id_ = tid + NT * i_; if (id_ < NKC) { const int row_ = id_ / CPR, ch_ = id_ % CPR; *(LAS v4u*)(lds + (buf) * KBUF + row_ * RSK + ch_ * 16) = kreg[i_]; } } \
        _Pragma("unroll") for (int i_ = 0; i_ < NVI; ++i_) { const int id_ = tid + NT * i_, d_ = id_ >> 3, ch_ = id_ & 7; LAS v2u* w_ = (LAS v2u*)(lds + 2 * KBUF + (buf) * VBUF + d_ * RSV + ch_ * 16); \
            w_[0] = (v2u){vreg[i_].x, vreg[i_].y}; w_[1] = (v2u){vreg[i_].z, vreg[i_].w}; } } while (0)
    LOAD_TILE(TILE_OF(0)); STORE_TILE(0); __syncthreads();
    for (int i = 0; i < ntiles; ++i) {
        const int cur = i & 1, tile = TILE_OF(i);
        if (i + 1 < ntiles) LOAD_TILE(TILE_OF(i + 1));
        bool active = true;
        if (MODE == 1 && i >= 4) { const int kt0 = tile * 64 - CTX, qt0 = q0 - CTX + wave * 32; active = (kt0 + 63 >= qt0 - 128) && (kt0 <= qt0 + 31 + 128); }
        if (active) {
            f32x16 p0, p1;
#pragma unroll
            for (int r = 0; r < 16; ++r) { p0[r] = 0.f; p1[r] = 0.f; }
            const LAS unsigned char* kb = lds + cur * KBUF + r32 * RSK + hi * 16;
#pragma unroll
            for (int d0 = 0; d0 < ND0; ++d0) { const bf16x8 k0 = *(const LAS bf16x8*)(kb + d0 * 32), k1 = *(const LAS bf16x8*)(kb + 32 * RSK + d0 * 32);
                p0 = __builtin_amdgcn_mfma_f32_32x32x16_bf16(k0, qf[d0], p0, 0, 0, 0); p1 = __builtin_amdgcn_mfma_f32_32x32x16_bf16(k1, qf[d0], p1, 0, 0, 0); }
            if (MODE == 1 && i >= 4) { const int rel0 = (tile * 64 - CTX) - (qrow - CTX);
#pragma unroll
                for (int r = 0; r < 16; ++r) { const int ra = rel0 + crow16(r, hi), rb = ra + 32;
                    if (ra > 128 || ra < -128) p0[r] = -1e30f; if (rb > 128 || rb < -128) p1[r] = -1e30f; } }
            float mx = fmaxf(p0[0], p1[0]);
#pragma unroll
            for (int r = 1; r < 16; ++r) mx = fmaxf(mx, fmaxf(p0[r], p1[r]));
            mx = xhalf_max(mx);
            const float mn = fmaxf(m, mx), alpha = __builtin_amdgcn_exp2f((m - mn) * c), nmc = -mn * c; m = mn;
            float sum = 0.f;
#pragma unroll
            for (int r = 0; r < 16; ++r) { p0[r] = __builtin_amdgcn_exp2f(fmaf(p0[r], c, nmc)); p1[r] = __builtin_amdgcn_exp2f(fmaf(p1[r], c, nmc)); sum += p0[r] + p1[r]; }
            l = l * alpha + sum;
            if (!__all(alpha == 1.f)) {
#pragma unroll
                for (int db = 0; db < NDB; ++db)
#pragma unroll
                    for (int r = 0; r < 16; ++r) o[db][r] *= alpha; }
            const LAS unsigned char* vb = lds + 2 * KBUF + cur * VBUF + r32 * RSV + hi * 8;
#pragma unroll
            for (int s = 0; s < 4; ++s) { const int rb = (s & 1) * 8;
                v4u pw;
                if (s < 2) { pw.x = cvtpk_s(p0[rb + 0], p0[rb + 1]); pw.y = cvtpk_s(p0[rb + 2], p0[rb + 3]); pw.z = cvtpk_s(p0[rb + 4], p0[rb + 5]); pw.w = cvtpk_s(p0[rb + 6], p0[rb + 7]); }
                else       { pw.x = cvtpk_s(p1[rb + 0], p1[rb + 1]); pw.y = cvtpk_s(p1[rb + 2], p1[rb + 3]); pw.z = cvtpk_s(p1[rb + 4], p1[rb + 5]); pw.w = cvtpk_s(p1[rb + 6], p1[rb + 7]); }
                const bf16x8 pf = __builtin_bit_cast(bf16x8, pw);
#pragma unroll
                for (int db = 0; db < NDB; ++db) { const LAS unsigned char* vp = vb + db * 32 * RSV + s * 32;
                    const v2u a0 = *(const LAS v2u*)(vp), a1 = *(const LAS v2u*)(vp + 16);
                    const bf16x8 vf = __builtin_bit_cast(bf16x8, (v4u){a0.x, a0.y, a1.x, a1.y});
                    o[db] = __builtin_amdgcn_mfma_f32_32x32x16_bf16(vf, pf, o[db], 0, 0, 0); }
                __builtin_amdgcn_sched_barrier(0); }
        }
        if (i + 1 < ntiles) STORE_TILE(cur ^ 1);
        __syncthreads();
    }
#undef LOAD_TILE
#undef STORE_TILE
#undef TILE_OF
    l = xhalf_sum(l);
    const float il = 1.f / l;
#pragma unroll
    for (int db = 0; db < NDB; ++db)
#pragma unroll
        for (int rr = 0; rr < 4; ++rr) { const int d = 32 * db + 8 * rr + 4 * hi;
            const float a = o[db][4 * rr] * il, b = o[db][4 * rr + 1] * il, cc = o[db][4 * rr + 2] * il, dd = o[db][4 * rr + 3] * il;
            if (OUTF32) *(f32x4*)((float*)Ob + (size_t)qrow * os + d) = (f32x4){a, b, cc, dd};
            else *(v2u*)((bf16*)Ob + (size_t)qrow * os + d) = (v2u){cvtpk_s(a, b), cvtpk_s(cc, dd)}; }
}

__device__ __forceinline__ void phase_att(const P& p, LAS unsigned char* lds, int layer) {
    unsigned char* wsb = opq_p(p.ws);
    layer = opq_s(layer);
    const int tid = tid_opaque(), lane = tid & 63, wave = __builtin_amdgcn_readfirstlane(tid >> 6), G = gridDim.x, blk = blockIdx.x;
    const int gw = wave * G + blk;
    const bool last = layer == DEPTH - 1;
    const bf16* COLS = (const bf16*)(wsb + WS_COLS);
    const bf16* QM = (const bf16*)(wsb + WS_QM); const bf16* KM = (const bf16*)(wsb + WS_KM);
    const bf16* VTD = (const bf16*)(wsb + WS_VTD); const bf16* VTG = (const bf16*)(wsb + WS_VTG); const bf16* VTM = (const bf16*)(wsb + WS_VTM);
    bf16* YMIX = (bf16*)(wsb + WS_YMIX); float* DIFFO = (float*)(wsb + WS_DIFFO);
    const f32x2* AB = (const f32x2*)(wsb + WS_AB);
    { f32x2* SUM = (f32x2*)(wsb + WS_SUM);
      for (int it = gw; it < NB * 2 * 36 * 8; it += NW * G) { const int g = it & 7, c = (it >> 3) % 36, dir = (it / 288) & 1, b = it / 576, ch = g * 64 + lane;
          const f32x2* ab = AB + ((size_t)dir * M + (size_t)b * PB + c * 64) * 512 + ch;
          float A = 1.f, H = 0.f;
          if (dir == 0) {
#pragma unroll 16
              for (int q = 0; q < 64; ++q) { const f32x2 cf = ab[(size_t)q * 512]; H = cf.x * H + cf.y; A *= cf.x; }
          } else {
#pragma unroll 16
              for (int q = 63; q >= 0; --q) { const f32x2 cf = ab[(size_t)q * 512]; H = cf.x * H + cf.y; A *= cf.x; }
          }
          const int ord = dir == 0 ? c : (c <= 3 ? 3 - c : 39 - c);
          SUM[(((size_t)dir * NB + b) * 40 + ord) * 512 + ch] = (f32x2){A, H}; } }
    for (int u = blk; u < 256; u += G) {
        const int xcd = u & 7, j = u >> 3, grp = xcd * 4 + (j >> 3), qb = j & 7, b = grp >> 3, hh = grp & 7, q0 = CTX + qb * 256;
        const size_t rb = (size_t)b * PB;
        attn_unit<96, 64, 0, false>(lds, QM + rb * 768 + hh * 96, 768, KM + rb * 768 + hh * 96, 768, VTM + ((size_t)b * 512 + hh * 64) * PB, YMIX + rb * 2048 + 512 + hh * 64, 2048, q0, 36, 0.10206207261596575f, 0.f, tid);
        for (int vh = 0; vh < 2; ++vh)
            attn_unit<64, 64, 0, true>(lds, COLS + rb * NINP + C_DQ + hh * 64, NINP, COLS + rb * NINP + C_DK + hh * 64, NINP, VTD + ((size_t)b * 512 + (hh >> 1) * 128 + vh * 64) * PB, DIFFO + rb * 1024 + hh * 128 + vh * 64, 1024, q0, 36, 0.125f, 0.f, tid);
        attn_unit<64, 64, 1, false>(lds, COLS + rb * NINP + C_GQ + hh * 64, NINP, COLS + rb * NINP + C_GK + (hh >> 2) * 64, NINP, VTG + ((size_t)b * 128 + (hh >> 2) * 64) * PB, YMIX + rb * 2048 + 1536 + hh * 64, 2048, q0, 0, 0.125f, p.in[22][layer * 8 + hh], tid);
    }
    if (!last) {
        for (int u = blk; u < 96; u += G) { const int kind = u >> 5, b = (u >> 3) & 3, hh = u & 7; const size_t rb = (size_t)b * PB;
            if (kind == 0) attn_unit<96, 64, 0, false>(lds, QM + rb * 768 + hh * 96, 768, KM + rb * 768 + hh * 96, 768, VTM + ((size_t)b * 512 + hh * 64) * PB, YMIX + rb * 2048 + 512 + hh * 64, 2048, 0, 4, 0.10206207261596575f, 0.f, tid);
            else if (kind == 1) { for (int vh = 0; vh < 2; ++vh) attn_unit<64, 64, 0, true>(lds, COLS + rb * NINP + C_DQ + hh * 64, NINP, COLS + rb * NINP + C_DK + hh * 64, NINP, VTD + ((size_t)b * 512 + (hh >> 1) * 128 + vh * 64) * PB, DIFFO + rb * 1024 + hh * 128 + vh * 64, 1024, 0, 4, 0.125f, 0.f, tid); }
            else attn_unit<64, 64, 1, false>(lds, COLS + rb * NINP + C_GQ + hh * 64, NINP, COLS + rb * NINP + C_GK + (hh >> 2) * 64, NINP, VTG + ((size_t)b * 128 + (hh >> 2) * 64) * PB, YMIX + rb * 2048 + 1536 + hh * 64, 2048, 0, 0, 0.125f, p.in[22][layer * 8 + hh], tid);
        }
    }
}

__device__ __forceinline__ void phase_mixfin(const P& p, LAS unsigned char* lds, int layer) {
    layer = opq_s(layer);
    unsigned char* wsb = opq_p(p.ws);
    const int tid = tid_opaque(), lane = tid & 63, wave = tid >> 6, G = gridDim.x, blk = blockIdx.x;
    const int gw = wave * G + blk, NGW = NW * G;
    const bool last = layer == DEPTH - 1;
    const bf16* COLS = (const bf16*)(wsb + WS_COLS); bf16* YMIX = (bf16*)(wsb + WS_YMIX); const float* DIFFO = (const float*)(wsb + WS_DIFFO);
    { const f32x2* AB = (const f32x2*)(wsb + WS_AB); const f32x2* SUM = (const f32x2*)(wsb + WS_SUM);
      LAS float* hf = (LAS float*)(lds + wave * 16384);
      for (int it = gw; it < NB * 36 * 8; it += NGW) { const int g = it & 7, c = (it >> 3) % 36, b = it / 288, ch = g * 64 + lane;
          if (last && c < 4) continue;
          { const f32x2* sm = SUM + (((size_t)0 * NB + b) * 40) * 512 + ch; float h = 0.f;
            for (int o = 0; o < c; ++o) { const f32x2 s = sm[(size_t)o * 512]; h = s.x * h + s.y; }
            const f32x2* ab = AB + ((size_t)0 * M + (size_t)b * PB + c * 64) * 512 + ch;
#pragma unroll 16
            for (int q = 0; q < 64; ++q) { const f32x2 cf = ab[(size_t)q * 512]; h = cf.x * h + cf.y; hf[q * 64 + lane] = h; } }
          { const int ord = c <= 3 ? 3 - c : 39 - c;
            const f32x2* sm = SUM + (((size_t)1 * NB + b) * 40) * 512 + ch; float h = 0.f;
            for (int o = 0; o < ord; ++o) { const f32x2 s = sm[(size_t)o * 512]; h = s.x * h + s.y; }
            const f32x2* ab = AB + ((size_t)1 * M + (size_t)b * PB + c * 64) * 512 + ch;
            LDS_WAIT();
#pragma unroll 8
            for (int q = 63; q >= 0; --q) { const f32x2 cf = ab[(size_t)q * 512]; h = cf.x * h + cf.y; const size_t row = (size_t)b * PB + c * 64 + q;
                const float gt = bf2f(COLS[row * NINP + C_GATE + ch]);
                YMIX[row * 2048 + ch] = (bf16)f2bf((hf[q * 64 + lane] + h) * gelu_tanh(gt)); } }
          LDS_WAIT(); } }
    const float* lv = p.in[20] + (size_t)layer * 4 * 64; const float* dg = p.in[21] + (size_t)layer * 128;
    const float lam_init = 0.8f - 0.6f * expf(-0.3f * (float)layer);
    const float lam = expf(wave_sum(lv[lane] * lv[64 + lane])) - expf(wave_sum(lv[128 + lane] * lv[192 + lane])) + lam_init;
    for (int row = gw; row < M; row += NGW) {
        const int pp = row % PB; if (last && pp < CTX) continue;
#pragma unroll
        for (int hh = 0; hh < 4; ++hh) { float o[2]; float s = 0.f;
#pragma unroll
            for (int j = 0; j < 2; ++j) { const int e = lane + 64 * j;
                o[j] = DIFFO[(size_t)row * 1024 + (2 * hh) * 128 + e] - lam * DIFFO[(size_t)row * 1024 + (2 * hh + 1) * 128 + e]; s += o[j] * o[j]; }
            s = wave_sum(s); const float rstd = 1.0f / sqrtf(s * (1.0f / 128.f) + 1e-6f);
#pragma unroll
            for (int j = 0; j < 2; ++j) { const int e = lane + 64 * j; YMIX[(size_t)row * 2048 + 1024 + hh * 128 + e] = (bf16)f2bf(o[j] * rstd * dg[e] * (1.0f - lam_init)); } }
    }
}

#define XB_TMO      128
#define XB_XCNT(j)  (256  + 64 * (j))
#define XB_XSUB(j)  (1280 + 64 * (j))
#define XB_XGEN(j)  (2304 + 64 * (j))
#define XB_TOP      3328
#define XB_TOPGEN   3392
#define XCD_BAR_WORDS 3456
#define XB_SPIN_CAP (1u << 18)

__device__ __forceinline__ unsigned xb_ld(unsigned* p)              { return __hip_atomic_load(p, __ATOMIC_RELAXED, __HIP_MEMORY_SCOPE_AGENT); }
__device__ __forceinline__ unsigned xb_add(unsigned* p, unsigned v) { return __hip_atomic_fetch_add(p, v, __ATOMIC_RELAXED, __HIP_MEMORY_SCOPE_AGENT); }
__device__ __forceinline__ unsigned xb_xcc_id() { return (unsigned)__builtin_amdgcn_s_getreg((3 << 11) | 20) & 0xFu; }
#define XB_SPIN(cond, bar) do { unsigned _sp = 0; while (cond) { __builtin_amdgcn_s_sleep(1); \
    if ((++_sp & 255u) == 0u) { if (xb_ld(&(bar)[XB_TMO])) break; if (_sp > XB_SPIN_CAP) { atomicAdd(&(bar)[XB_TMO], 1u); break; } } } } while (0)

struct XcdBarrier {
    unsigned* bar; unsigned x;
    volatile LAS unsigned* st;
};

__device__ __forceinline__ XcdBarrier xcd_barrier_post(unsigned* bar, volatile LAS unsigned* st) {
    XcdBarrier b; b.bar = bar; b.x = xb_xcc_id(); b.st = st;
    if (threadIdx.x == 0) (void)xb_add(&bar[XB_XCNT(b.x)], 1u);
    return b;
}
__device__ __forceinline__ void xcd_barrier_complete(unsigned* bar, unsigned x, unsigned& nloc, unsigned& nx) {
    const unsigned G = gridDim.x * gridDim.y * gridDim.z;
    unsigned sum, cnt, mine, sp = 0u;
    for (;;) {
        sum = 0u; cnt = 0u; mine = 0u;
#pragma unroll
        for (unsigned j = 0; j < 16; ++j) { const unsigned c = xb_ld(&bar[XB_XCNT(j)]); sum += c; cnt += (c > 0u) ? 1u : 0u; mine = (j == x) ? c : mine; }
        if (sum == G) break;
        __builtin_amdgcn_s_sleep(1);
        if ((++sp & 255u) == 0u) { if (xb_ld(&bar[XB_TMO])) break; if (sp > XB_SPIN_CAP) { atomicAdd(&bar[XB_TMO], 1u); break; } }
    }
    nloc = mine > 0u ? mine : 1u; nx = cnt > 0u ? cnt : 1u;
}

__device__ __forceinline__ void xcd_barrier(const XcdBarrier& b) {
    asm volatile("s_waitcnt vmcnt(0)" ::: "memory");
    __syncthreads();
    if (threadIdx.x == 0) {
        unsigned* bar = b.bar; const unsigned bx = xb_xcc_id();
        __builtin_amdgcn_s_waitcnt(0);
        unsigned nloc = b.st[0], nx = b.st[1];
        if (nloc == 0u) { xcd_barrier_complete(bar, bx, nloc, nx); b.st[0] = nloc; b.st[1] = nx; }
        const unsigned old = xb_add(&bar[XB_XSUB(bx)], 1u);
        const unsigned gen = old / nloc;
        if (old + 1u == (gen + 1u) * nloc) {
            __builtin_amdgcn_fence(__ATOMIC_RELEASE, "agent");
            asm volatile("s_waitcnt vmcnt(0)" ::: "memory");
            const unsigned og = xb_add(&bar[XB_TOP], 1u);
            const unsigned tg = og / nx;
            if (og + 1u == (tg + 1u) * nx) xb_add(&bar[XB_TOPGEN], 1u);
            else XB_SPIN(xb_ld(&bar[XB_TOPGEN]) == tg, bar);
            __builtin_amdgcn_fence(__ATOMIC_ACQUIRE, "agent");
            xb_add(&bar[XB_XGEN(bx)], 1u);
            asm volatile("s_waitcnt vmcnt(0)" ::: "memory");
        } else {
            XB_SPIN(xb_ld(&bar[XB_XGEN(bx)]) == gen, bar);
            __builtin_amdgcn_fence(__ATOMIC_ACQUIRE, "agent");
            asm volatile("s_waitcnt vmcnt(0)" ::: "memory");
        }
    }
    __syncthreads();
}

constexpr int CW_BAR = 4096;
constexpr size_t CTL_ZERO_BYTES = 1 * MiB;
constexpr int LDSCTL_OFF = 131072, MISC_OFF = LDSCTL_OFF + 320;

__global__ void __launch_bounds__(NT, 2) k_mega(P p) {
    extern __shared__ __attribute__((aligned(16))) unsigned char lds_raw[];
    LAS unsigned char* lds = (LAS unsigned char*)lds_raw;
    const KP kp = (KP)__builtin_amdgcn_kernarg_segment_ptr();
    for (int u = threadIdx.x; u < (LDS_BYTES - LDSCTL_OFF) / 4; u += NT) ((LAS unsigned*)(lds + LDSCTL_OFF))[u] = 0u;
    __syncthreads();
    unsigned* barw = (unsigned*)(p.ws + WS_CTL) + CW_BAR;
    XcdBarrier bar = xcd_barrier_post(barw, (volatile LAS unsigned*)(lds + MISC_OFF) + 8);
#define GB() xcd_barrier(bar)
    phase_pro1(load_P(kp), lds); GB();
    phase_pro2(load_P(kp)); GB();
    for (int l = 0; l < DEPTH; ++l) {
        for (int which = 0; which < 2; ++which) {
            phase_ffn_in(load_P(kp), lds, l, which); GB();
            phase_ffn_out(load_P(kp), lds, l, which); GB();
            phase_post(load_P(kp), l, which == 0 ? 0 : 2); GB();
            if (which == 0) {
                phase_inproj(load_P(kp), lds, l); GB();
                phase_prep(load_P(kp), lds, l); GB();
                phase_mgemm(load_P(kp), lds, l); GB();
                phase_prep2(load_P(kp), lds, l); GB();
                phase_att(load_P(kp), lds, l); GB();
                phase_mixfin(load_P(kp), lds, l); GB();
                phase_outproj(load_P(kp), lds, l); GB();
                phase_post(load_P(kp), l, 1); GB();
            }
        }
    }
#undef GB
    if (__hip_atomic_load(barw + XB_TMO, __ATOMIC_RELAXED, __HIP_MEMORY_SCOPE_AGENT) != 0u) {
        const float q = __builtin_nanf("");
        for (size_t i = (size_t)blockIdx.x * NT + threadIdx.x; i < (size_t)NB * SEQ * D; i += (size_t)gridDim.x * NT) p.out[i] = q;
    }
}

extern "C" void kernel_launch(void* const* d_in, const int* in_sizes, int n_in, void* d_out, int out_size, void* d_ws, size_t ws_size, hipStream_t stream) {
    static int grid = 0;
    if (grid == 0) {
        if (n_in != 23 || out_size != NB * SEQ * D || ws_size < WS_END) { fprintf(stderr, "kernel_launch: unexpected shapes (n_in %d out %d ws %zu need %zu)\n", n_in, out_size, ws_size, (size_t)WS_END); grid = -1; return; }
        int dev = 0, cus = 0, per_cu = 0;
        if (hipGetDevice(&dev) != hipSuccess || hipDeviceGetAttribute(&cus, hipDeviceAttributeMultiprocessorCount, dev) != hipSuccess) { grid = -1; return; }
        if (hipFuncSetAttribute((const void*)k_mega, hipFuncAttributeMaxDynamicSharedMemorySize, LDS_BYTES) != hipSuccess) { fprintf(stderr, "kernel_launch: hipFuncSetAttribute failed\n"); grid = -1; return; }
        if (hipOccupancyMaxActiveBlocksPerMultiprocessor(&per_cu, (const void*)k_mega, NT, LDS_BYTES) != hipSuccess || per_cu < 1)
            fprintf(stderr, "kernel_launch: note: occupancy query reports %d workgroups per CU\n", per_cu);
        (void)hipGetLastError();
        grid = cus;
    }
    if (grid < 0) return;
    if (hipMemsetAsync((char*)d_ws + WS_CTL, 0, CTL_ZERO_BYTES, stream) != hipSuccess) { fprintf(stderr, "kernel_launch: memset failed\n"); return; }
    P p{};
    for (int i = 0; i < 23; ++i) p.in[i] = (const float*)d_in[i];
    p.out = (float*)d_out; p.ws = (unsigned char*)d_ws;
    hipLaunchKernelGGL(k_mega, dim3(grid), dim3(NT), LDS_BYTES, stream, p);
}
```

```cpp
#include <hip/hip_runtime.h>
#include <cstdio>
#include <cstdint>
__device__ __forceinline__ int opq_s(int x) { asm volatile("" : "+s"(x)); return x; }
__device__ __forceinline__ unsigned char* opq_p(unsigned char* x) { asm volatile("" : "+s"(x)); return x; }
__device__ __forceinline__ int tid_opaque() { int t = (int)threadIdx.x; asm volatile("" : "+v"(t)); return t; }
namespace pg8 {
#define PG8_LAS __attribute__((address_space(3)))
typedef unsigned short bf16_t;
typedef short bf16x8 __attribute__((ext_vector_type(8)));
typedef float f32x4 __attribute__((ext_vector_type(4)));
typedef unsigned u32x4 __attribute__((ext_vector_type(4)));
constexpr int BM = 256, BK = 64, HALF = 128, HTB = HALF * BK * 2  , STAGE_BYTES = 8 * HTB, NXCD = 8, WGM = 8;

__host__ __device__ __forceinline__ int lds_byte(int r, int c) { const int st = (r >> 4) * 2 + (c >> 5), rr = r & 15, cc = c & 31, ob = rr * 64 + cc * 2; return st * 1024 + (ob ^ (((ob >> 9) & 1) << 5)); }
__host__ __device__ __forceinline__ void stage_rc(int b, int& R, int& C) { const int st = b / 1024, sb = b % 1024, swz = sb ^ (((sb >> 9) & 1) << 5); R = (st >> 1) * 16 + swz / 64; C = (st & 1) * 32 + (swz % 64) / 2; }
__host__ __device__ __forceinline__ int perm32(int rho) { const int n = rho >> 4, i = rho & 15; return 8 * (i >> 2) + 4 * n + (i & 3); }

struct Unit { int pm, pn; };
struct Gemm { const bf16_t* A; const bf16_t* Bt; int M, N, K, ld; };

struct StaticOrder {
    int nM, nN, nwg, G, c;
    __host__ __device__ void init(int M, int N, int G_, int c_) { nM = M / BM; nN = N / BM; nwg = nM * nN; G = G_; c = c_; }
    __host__ __device__ bool next(int i, Unit& u) const {
        const long L = (long)i * G + c; if (L >= nwg) return false;
        int wgid = (int)L; { const int q = nwg / NXCD, r = nwg % NXCD, xcd = wgid % NXCD, off = wgid / NXCD; wgid = (xcd < r ? xcd * (q + 1) : r * (q + 1) + (xcd - r) * q) + off; }
        const int nig = WGM * nN, gid = wgid / nig, fm = gid * WGM, gsz = (nM - fm) < WGM ? (nM - fm) : WGM;
        u.pm = fm + ((wgid % nig) % gsz); u.pn = (wgid % nig) / gsz; return true;
    }
    __device__ __forceinline__ void a_ready(const Unit&) const {}
    __device__ __forceinline__ void done(const Unit&) const {}
};

__device__ __forceinline__ unsigned cvt_pk_bf16(float lo, float hi) { unsigned r; asm volatile("v_cvt_pk_bf16_f32 %0, %1, %2" : "=v"(r) : "v"(lo), "v"(hi)); return r; }
typedef float f32x2 __attribute__((ext_vector_type(2)));
}
namespace pg8 {
template <class Epi, class Sched, bool ALIGN_EPI = false, bool SP2 = false>
__device__ __forceinline__ void gemm_phase(PG8_LAS unsigned char* lds, const Gemm g, const Sched& S, const Epi& E) {
    const int tid = tid_opaque(), wid = __builtin_amdgcn_readfirstlane(tid >> 6), lane = tid & 63, wr = wid >> 2, wc = wid & 3, fr = lane & 15, fq = lane >> 4;
    const int K = g.ld, nt = g.K / BK;
    unsigned voffA[2], voffB[2];
#pragma unroll
    for (int i = 0; i < 2; ++i) { int R, C; stage_rc(tid * 16 + i * 8192, R, C); const int Rb = Epi::PERM ? ((R & ~31) + perm32(R & 31)) : R;
        voffA[i] = (unsigned)(R * K + C) * 2u; voffB[i] = (unsigned)(Rb * K + C) * 2u; }
    const size_t kstep = (size_t)(BK * 2);
    const size_t hstep = (size_t)HALF * K * 2;
    const size_t tstep = 2 * hstep;
    const unsigned ldsw = (unsigned)wid * 1024u;
    const int aoff = lds_byte(wr * 64 + fr, fq * 8), boff = lds_byte(wc * 32 + fr, fq * 8);
#define PG8_SA(b, h) (((b) * 2 + (h)) * HTB)
#define PG8_SB(b, h) ((4 + (b) * 2 + (h)) * HTB)
#define PG8_STAGE(bufoff, gbase, voff) do { _Pragma("unroll") for (int _i = 0; _i < 2; ++_i) \
        __builtin_amdgcn_global_load_lds((const unsigned*)((const char*)(gbase) + (voff)[_i]), (PG8_LAS unsigned*)(lds + (bufoff) + ldsw + _i * 8192), 16, 0, 0); } while (0)
#define PG8_LDA(dst, b, h) do { _Pragma("unroll") for (int m = 0; m < 4; ++m) _Pragma("unroll") for (int k = 0; k < 2; ++k) dst[m][k] = *(const PG8_LAS bf16x8*)(lds + PG8_SA(b, h) + aoff + m * 2048 + k * 1024); } while (0)
#define PG8_LDB(dst, b, h) do { _Pragma("unroll") for (int n = 0; n < 2; ++n) _Pragma("unroll") for (int k = 0; k < 2; ++k) dst[n][k] = *(const PG8_LAS bf16x8*)(lds + PG8_SB(b, h) + boff + n * 2048 + k * 1024); } while (0)
#define PG8_MMA(ai, bj, At, Bt) do { __builtin_amdgcn_s_setprio(1); _Pragma("unroll") for (int m = 0; m < 4; ++m) _Pragma("unroll") for (int n = 0; n < 2; ++n) _Pragma("unroll") for (int k = 0; k < 2; ++k) \
        acc[ai][bj][m][n] = __builtin_amdgcn_mfma_f32_16x16x32_bf16(Bt[n][k], At[m][k], acc[ai][bj][m][n], 0, 0, 0); __builtin_amdgcn_s_setprio(0); } while (0)
#define PG8_WAIT_V(n) asm volatile("s_waitcnt vmcnt(" #n ")" ::: "memory")
#define PG8_WAIT_L(n) asm volatile("s_waitcnt lgkmcnt(" #n ")" ::: "memory")
#define PG8_BAR __builtin_amdgcn_s_barrier()
#define PG8_SCHED __builtin_amdgcn_sched_barrier(0)
    Unit cur, nxt; int ui = 0;
    if (!S.next(0, cur)) return;
    f32x4 acc[2][2][4][2];
#pragma unroll
    for (int a = 0; a < 2; ++a)
#pragma unroll
        for (int b = 0; b < 2; ++b)
#pragma unroll
            for (int m = 0; m < 4; ++m)
#pragma unroll
                for (int n = 0; n < 2; ++n) acc[a][b][m][n] = (f32x4){0.f, 0.f, 0.f, 0.f};
    bf16x8 At[4][2], B0[2][2], B1[2][2];
    const char* cA = (const char*)g.A + (size_t)cur.pm * tstep; const char* cB = (const char*)g.Bt + (size_t)cur.pn * tstep;
    S.a_ready(cur);
    if constexpr (SP2) {
        PG8_STAGE(PG8_SB(0, 0), cB, voffB); PG8_STAGE(PG8_SB(0, 1), cB + hstep, voffB); PG8_STAGE(PG8_SA(0, 0), cA, voffA); PG8_STAGE(PG8_SA(0, 1), cA + hstep, voffA);
        if (wr == 1) PG8_BAR;
        PG8_WAIT_V(2); PG8_BAR;
        PG8_STAGE(PG8_SB(1, 0), cB + kstep, voffB); PG8_STAGE(PG8_SA(1, 0), cA + kstep, voffA); PG8_STAGE(PG8_SB(1, 1), cB + hstep + kstep, voffB);
        PG8_WAIT_V(6); PG8_BAR;
    } else {
        PG8_STAGE(PG8_SB(0, 0), cB, voffB); PG8_STAGE(PG8_SA(0, 0), cA, voffA); PG8_STAGE(PG8_SB(0, 1), cB + hstep, voffB); PG8_STAGE(PG8_SA(0, 1), cA + hstep, voffA);
        if (wr == 1) PG8_BAR;
        PG8_WAIT_V(4); PG8_BAR;
        PG8_STAGE(PG8_SB(1, 0), cB + kstep, voffB); PG8_STAGE(PG8_SA(1, 0), cA + kstep, voffA); PG8_STAGE(PG8_SB(1, 1), cB + hstep + kstep, voffB);
        PG8_WAIT_V(6); PG8_BAR;
    }
    for (;;) {
        const bool has_next = S.next(ui + 1, nxt);
        const char* nA = has_next ? (const char*)g.A + (size_t)nxt.pm * tstep : cA; const char* nB = has_next ? (const char*)g.Bt + (size_t)nxt.pn * tstep : cB;
        for (int t = 0; t < nt; t += 2) {
            const bool last = (t == nt - 2);
            const char* a1 = cA + (size_t)(t + 1) * kstep;
            const char* a2 = last ? nA : cA + (size_t)(t + 2) * kstep; const char* b2 = last ? nB : cB + (size_t)(t + 2) * kstep;
            const char* a3 = a2 + kstep; const char* b3 = b2 + kstep;
            if (last && has_next) S.a_ready(nxt);
            if constexpr (SP2) {
            PG8_LDB(B0, 0, 0); PG8_LDB(B1, 0, 1); PG8_SCHED; PG8_LDA(At, 0, 0); PG8_STAGE(PG8_SA(1, 1), a1 + hstep, voffA);
            PG8_WAIT_V(8); PG8_WAIT_L(0); PG8_BAR; PG8_MMA(0, 0, At, B0); PG8_MMA(0, 1, At, B1); PG8_BAR; PG8_SCHED;
            PG8_LDA(At, 0, 1); PG8_STAGE(PG8_SB(0, 0), b2, voffB); PG8_STAGE(PG8_SB(0, 1), b2 + hstep, voffB); PG8_STAGE(PG8_SA(0, 0), a2, voffA);
            PG8_WAIT_V(8); PG8_WAIT_L(0); PG8_BAR; PG8_MMA(1, 0, At, B0); PG8_MMA(1, 1, At, B1); PG8_BAR; PG8_SCHED;
            PG8_LDB(B0, 1, 0); PG8_LDB(B1, 1, 1); PG8_SCHED; PG8_LDA(At, 1, 0); PG8_STAGE(PG8_SA(0, 1), a2 + hstep, voffA);
            PG8_WAIT_V(8); PG8_WAIT_L(0); PG8_BAR; PG8_MMA(0, 0, At, B0); PG8_MMA(0, 1, At, B1); PG8_BAR; PG8_SCHED;
            PG8_LDA(At, 1, 1); PG8_STAGE(PG8_SB(1, 0), b3, voffB); PG8_STAGE(PG8_SB(1, 1), b3 + hstep, voffB); PG8_STAGE(PG8_SA(1, 0), a3, voffA);
            PG8_WAIT_V(8); PG8_WAIT_L(0); PG8_BAR; PG8_MMA(1, 0, At, B0); PG8_MMA(1, 1, At, B1); PG8_BAR; PG8_SCHED;
            } else {
            PG8_LDB(B0, 0, 0); PG8_SCHED; PG8_LDA(At, 0, 0); PG8_STAGE(PG8_SA(1, 1), a1 + hstep, voffA);
            PG8_WAIT_L(8); PG8_BAR; PG8_WAIT_L(0); PG8_MMA(0, 0, At, B0); PG8_BAR; PG8_SCHED;
            PG8_LDB(B1, 0, 1); PG8_STAGE(PG8_SB(0, 0), b2, voffB);
            PG8_BAR; PG8_WAIT_L(0); PG8_MMA(0, 1, At, B1); PG8_BAR;
            PG8_LDA(At, 0, 1); PG8_STAGE(PG8_SA(0, 0), a2, voffA);
            PG8_BAR; PG8_WAIT_L(0); PG8_MMA(1, 0, At, B0); PG8_BAR; PG8_SCHED;
            PG8_STAGE(PG8_SB(0, 1), b2 + hstep, voffB);
            PG8_WAIT_V(6); PG8_BAR; PG8_MMA(1, 1, At, B1); PG8_BAR;
            PG8_LDB(B0, 1, 0); PG8_SCHED; PG8_LDA(At, 1, 0); PG8_STAGE(PG8_SA(0, 1), a2 + hstep, voffA);
            PG8_WAIT_L(8); PG8_BAR; PG8_WAIT_L(0); PG8_MMA(0, 0, At, B0); PG8_BAR; PG8_SCHED;
            PG8_LDB(B1, 1, 1); PG8_STAGE(PG8_SB(1, 0), b3, voffB);
            PG8_BAR; PG8_WAIT_L(0); PG8_MMA(0, 1, At, B1); PG8_BAR;
            PG8_LDA(At, 1, 1); PG8_STAGE(PG8_SA(1, 0), a3, voffA);
            PG8_BAR; PG8_WAIT_L(0); PG8_MMA(1, 0, At, B0); PG8_BAR; PG8_SCHED;
            PG8_STAGE(PG8_SB(1, 1), b3 + hstep, voffB);
            PG8_WAIT_V(6); PG8_BAR; PG8_MMA(1, 1, At, B1); PG8_BAR;
            }
        }
        if constexpr (ALIGN_EPI) { if (wr == 0) PG8_BAR; }
        if constexpr (!Epi::AFTER_DRAIN) { E(acc, cur, wr, wc, fr, fq); S.done(cur); }
        if (!has_next) break;
#pragma unroll
        for (int a = 0; a < 2; ++a)
#pragma unroll
            for (int b = 0; b < 2; ++b)
#pragma unroll
                for (int m = 0; m < 4; ++m)
#pragma unroll
                    for (int n = 0; n < 2; ++n) acc[a][b][m][n] = (f32x4){0.f, 0.f, 0.f, 0.f};
        cur = nxt; cA = nA; cB = nB; ++ui;
        if constexpr (ALIGN_EPI) { if (wr == 1) PG8_BAR; }
    }
    PG8_WAIT_V(0);
    if constexpr (!ALIGN_EPI) { if (wr == 0) PG8_BAR; }
    PG8_BAR;
    if constexpr (Epi::AFTER_DRAIN) { E.fused(acc, cur, wr, wc, fr, fq, lds, wid, lane); S.done(cur); }
#undef PG8_SA
#undef PG8_SB
#undef PG8_STAGE
#undef PG8_LDA
#undef PG8_LDB
#undef PG8_MMA
#undef PG8_WAIT_V
#undef PG8_WAIT_L
#undef PG8_BAR
#undef PG8_SCHED
}
}

#define GAS __attribute__((address_space(1)))
#define LAS __attribute__((address_space(3)))
typedef unsigned short bf16;
typedef unsigned v4u __attribute__((ext_vector_type(4)));
typedef unsigned v2u __attribute__((ext_vector_type(2)));
typedef float f32x4 __attribute__((ext_vector_type(4)));
typedef float f32x2 __attribute__((ext_vector_type(2)));

constexpr int D = 2048, NB = 4, SEQ = 2048, CTX = 256, PB = 2304, M = NB * PB, DEPTH = 4, DFF = 5632, NIN = 4000, NINP = 4096, NMODC = 9 * D;
constexpr int NT = 512, NW = 8;
constexpr int C_XB = 0, C_GATE = 512, C_MQ = 1024, C_MKV = 1408, C_MKR = 1664, C_DQ = 1696, C_DK = 2208, C_DV = 2720, C_GQ = 3232, C_GK = 3744, C_GV = 3872;

constexpr size_t MiB = 1u << 20;
constexpr size_t WS_CTL = 0;
constexpr size_t WS_MOD = 1 * MiB;
constexpr size_t WS_ROPE = 3 * MiB;
constexpr size_t WS_WFFI = 4 * MiB;
constexpr size_t WS_WFFO = WS_WFFI + 352 * MiB;
constexpr size_t WS_WIN = WS_WFFO + 176 * MiB;
constexpr size_t WS_WOUT = WS_WIN + 64 * MiB;
constexpr size_t WS_WQB = WS_WOUT + 32 * MiB;
constexpr size_t WS_WKVB = WS_WQB + 3 * MiB;
constexpr size_t WS_WG = WS_WKVB + 2 * MiB;
constexpr size_t WS_X = WS_WG + 8 * MiB;
constexpr size_t WS_H = WS_X + 72 * MiB;
constexpr size_t WS_ACT = WS_H + 36 * MiB;
constexpr size_t WS_Y = WS_ACT + 99 * MiB;
constexpr size_t WS_COLS = WS_Y + 72 * MiB;
constexpr size_t WS_U = WS_COLS + 72 * MiB;
constexpr size_t WS_GATES = WS_U + 9 * MiB;
constexpr size_t WS_QN = WS_GATES + 72 * MiB;
constexpr size_t WS_KVN = WS_QN + 7 * MiB;
constexpr size_t WS_QUP = WS_KVN + 5 * MiB;
constexpr size_t WS_KVUP = WS_QUP + 14 * MiB;
constexpr size_t WS_QM = WS_KVUP + 18 * MiB;
constexpr size_t WS_KM = WS_QM + 14 * MiB;
constexpr size_t WS_KMN = WS_KM;
constexpr size_t WS_AB = WS_KM + 14 * MiB;
constexpr size_t WS_HS = WS_AB + 72 * MiB;
constexpr size_t WS_DIFFO = WS_HS + 36 * MiB;
constexpr size_t WS_YMIX = WS_DIFFO + 36 * MiB;
constexpr size_t WS_VTD = WS_YMIX + 36 * MiB;
constexpr size_t WS_VTG = WS_VTD + 9 * MiB;
constexpr size_t WS_VTM = WS_VTG + 3 * MiB;
constexpr size_t WS_SUM = WS_VTM + 9 * MiB;
constexpr size_t WS_YP = WS_SUM + 2 * MiB;
constexpr size_t WS_END = WS_YP + 64 * MiB;

constexpr int LDS_BYTES = 147456;

struct P { const float* in[23]; float* out; unsigned char* ws; };
typedef const __attribute__((address_space(4))) P* KP;
__device__ __forceinline__ P load_P(KP kp) {
#if defined(__HIP_DEVICE_COMPILE__)
    asm volatile("" : "+s"(kp)); P r; for (int i = 0; i < 23; ++i) r.in[i] = kp->in[i]; r.out = kp->out; r.ws = kp->ws; return r;
#else
    (void)kp; return P{};
#endif
}

#define LDS_WAIT() asm volatile("s_waitcnt lgkmcnt(0)" ::: "memory")
__device__ __forceinline__ unsigned f2bf(float f) { unsigned u = __builtin_bit_cast(unsigned, f); return (u + 0x7fffu + ((u >> 16) & 1u)) >> 16; }
__device__ __forceinline__ unsigned pk2(float lo, float hi) { return f2bf(lo) | (f2bf(hi) << 16); }
__device__ __forceinline__ float bf2f(unsigned v) { return __builtin_bit_cast(float, v << 16); }
__device__ __forceinline__ float bflo(unsigned w) { return __builtin_bit_cast(float, w << 16); }
__device__ __forceinline__ float bfhi(unsigned w) { return __builtin_bit_cast(float, w & 0xffff0000u); }
template <int XM> __device__ __forceinline__ float swz_xor(float v) { return __builtin_bit_cast(float, __builtin_amdgcn_ds_swizzle(__builtin_bit_cast(int, v), (XM << 10) | 0x1f)); }
__device__ __forceinline__ void pl32swap(unsigned& a, unsigned& b) { asm volatile("s_nop 1\n\tv_permlane32_swap_b32 %0, %1\n\ts_nop 1" : "+v"(a), "+v"(b)); }
__device__ __forceinline__ float xhalf_sum(float v) { unsigned a = __builtin_bit_cast(unsigned, v), b = a; pl32swap(a, b); return __builtin_bit_cast(float, a) + __builtin_bit_cast(float, b); }
__device__ __forceinline__ float xhalf_max(float v) { unsigned a = __builtin_bit_cast(unsigned, v), b = a; pl32swap(a, b); return fmaxf(__builtin_bit_cast(float, a), __builtin_bit_cast(float, b)); }
__device__ __forceinline__ float wave_sum(float v) {
    v += swz_xor<1>(v); v += swz_xor<2>(v); v += swz_xor<4>(v); v += swz_xor<8>(v); v += swz_xor<16>(v);
    return xhalf_sum(v);
}
__device__ __forceinline__ float sigmoidf_(float x) { return 1.f / (1.f + __expf(-x)); }
__device__ __forceinline__ float siluf_(float x) { return x / (1.f + __expf(-x)); }
__device__ __forceinline__ float gelu_tanh(float x) { const float u = 0.7978845608028654f * (x + 0.044715f * x * x * x); return 0.5f * x * (1.f + tanhf(u)); }

struct TileOrder {
    pg8::StaticOrder so; int latonly;
    __device__ __forceinline__ void init(int nMt, int N, int G, int c, int lat) { so.nM = nMt; so.nN = N / 256; so.nwg = so.nM * so.nN; so.G = G; so.c = c; latonly = lat; }
    __device__ __forceinline__ bool next(int i, pg8::Unit& u) const { if (!so.next(i, u)) return false; if (latonly) u.pm = (u.pm >> 3) * 9 + 1 + (u.pm & 7); return true; }
    __device__ __forceinline__ void a_ready(const pg8::Unit&) const {}
    __device__ __forceinline__ void done(const pg8::Unit&) const {}
};
struct EpiF32 {
    static constexpr bool PERM = false, AFTER_DRAIN = false;
    float* C; int ldc;
    __device__ __forceinline__ void operator()(const f32x4 (&acc)[2][2][4][2], const pg8::Unit& u, int wr, int wc, int fr, int fq) const {
        const int row0 = u.pm * 256 + wr * 64 + fr, col0 = u.pn * 256 + wc * 32 + 4 * fq;
#pragma unroll
        for (int ai = 0; ai < 2; ++ai)
#pragma unroll
            for (int m = 0; m < 4; ++m) { float* rowp = C + (size_t)(row0 + ai * 128 + m * 16) * ldc + col0;
#pragma unroll
                for (int bj = 0; bj < 2; ++bj)
#pragma unroll
                    for (int n = 0; n < 2; ++n) *(f32x4*)(rowp + bj * 128 + n * 16) = acc[ai][bj][m][n]; }
    }
};
struct EpiB16 {
    static constexpr bool PERM = true, AFTER_DRAIN = false;
    bf16* O; int ldc;
    __device__ __forceinline__ void operator()(const f32x4 (&acc)[2][2][4][2], const pg8::Unit& u, int wr, int wc, int fr, int fq) const {
        const int row0 = u.pm * 256 + wr * 64 + fr, col0 = u.pn * 256 + wc * 32 + 8 * fq;
#pragma unroll
        for (int ai = 0; ai < 2; ++ai)
#pragma unroll
            for (int m = 0; m < 4; ++m) { bf16* rowp = O + (size_t)(row0 + ai * 128 + m * 16) * ldc + col0;
#pragma unroll
                for (int bj = 0; bj < 2; ++bj) { const f32x4 v0 = acc[ai][bj][m][0], v1 = acc[ai][bj][m][1];
                    v4u w; w.x = pg8::cvt_pk_bf16(v0[0], v0[1]); w.y = pg8::cvt_pk_bf16(v0[2], v0[3]); w.z = pg8::cvt_pk_bf16(v1[0], v1[1]); w.w = pg8::cvt_pk_bf16(v1[2], v1[3]);
                    *(v4u*)(rowp + bj * 128) = w; } }
    }
};
struct EpiSwiglu {
    static constexpr bool PERM = true, AFTER_DRAIN = false;
    bf16* O; int ldc;
    __device__ __forceinline__ void operator()(const f32x4 (&acc)[2][2][4][2], const pg8::Unit& u, int wr, int wc, int fr, int fq) const {
        const int row0 = u.pm * 256 + wr * 64 + fr, col0 = u.pn * 128 + wc * 32 + 8 * fq;
#pragma unroll
        for (int ai = 0; ai < 2; ++ai)
#pragma unroll
            for (int m = 0; m < 4; ++m) { bf16* rowp = O + (size_t)(row0 + ai * 128 + m * 16) * ldc + col0;
                float r[8];
#pragma unroll
                for (int n = 0; n < 2; ++n)
#pragma unroll
                    for (int e = 0; e < 4; ++e) { const float g = acc[ai][0][m][n][e], uu = acc[ai][1][m][n][e]; r[n * 4 + e] = siluf_(g) * uu; }
                v4u w; w.x = pg8::cvt_pk_bf16(r[0], r[1]); w.y = pg8::cvt_pk_bf16(r[2], r[3]); w.z = pg8::cvt_pk_bf16(r[4], r[5]); w.w = pg8::cvt_pk_bf16(r[6], r[7]);
                *(v4u*)rowp = w; }
    }
};

__device__ __forceinline__ void transpose_item(const float* W, int N, int K, bf16* WT, int k0, int n0, int drow0, LAS float* scr, int lane) {
#pragma unroll 8
    for (int i = 0; i < 32; ++i) { const int kk = 2 * i + (lane >> 5); scr[kk * 33 + (lane & 31)] = W[(size_t)(k0 + kk) * N + n0 + (lane & 31)]; }
    LDS_WAIT(); asm volatile("" ::: "memory");
    const int c = lane & 7;
#pragma unroll
    for (int j = 0; j < 4; ++j) { const int n = (lane >> 3) + 8 * j; const LAS float* s = scr + (8 * c) * 33 + n;
        v4u o; o.x = pk2(s[0 * 33], s[1 * 33]); o.y = pk2(s[2 * 33], s[3 * 33]); o.z = pk2(s[4 * 33], s[5 * 33]); o.w = pk2(s[6 * 33], s[7 * 33]);
        *(v4u*)(WT + (size_t)(drow0 + n) * K + k0 + 8 * c) = o; }
    LDS_WAIT(); asm volatile("" ::: "memory");
}

__device__ __forceinline__ void phase_pro1(const P& p, LAS unsigned char* lds) {
    unsigned char* wsb = opq_p(p.ws);
    const int tid = tid_opaque(), lane = tid & 63, wave = __builtin_amdgcn_readfirstlane(tid >> 6);
    const int G = gridDim.x, blk = blockIdx.x;
    {
        LAS float* sc = (LAS float*)lds;
        LAS float* red = (LAS float*)(lds + 40960);
        const float* c = p.in[1]; const float* cc = p.in[3];
        for (int i = tid; i < 5 * D; i += NT) { const int v = i / D, k = i % D; const float x = v < 4 ? c[v * D + k] : cc[k]; sc[i] = x / (1.f + expf(-x)); }
        __syncthreads();
        const float* wmod = p.in[4]; const float* bmod = p.in[5];
        float* MOD = (float*)(wsb + WS_MOD);
        for (int unit = blk; unit < DEPTH * 288; unit += G) {
            const int l = unit / 288, n0 = (unit % 288) * 64, kq = lane >> 4;
            const float* W = wmod + (size_t)l * D * NMODC + n0 + 4 * (lane & 15);
            float acc[5][4];
#pragma unroll
            for (int v = 0; v < 5; ++v)
#pragma unroll
                for (int e = 0; e < 4; ++e) acc[v][e] = 0.f;
            const int kbase = wave * 256 + kq;
#pragma unroll 4
            for (int i = 0; i < 64; ++i) { const int k = kbase + 4 * i; const f32x4 w = *(const f32x4*)(W + (size_t)k * NMODC);
#pragma unroll
                for (int v = 0; v < 5; ++v) { const float s = sc[v * D + k];
#pragma unroll
                    for (int e = 0; e < 4; ++e) acc[v][e] += s * w[e]; } }
#pragma unroll
            for (int v = 0; v < 5; ++v)
#pragma unroll
                for (int e = 0; e < 4; ++e) { float a = acc[v][e]; a += swz_xor<16>(a); a = xhalf_sum(a); acc[v][e] = a; }
            if (kq == 0) {
#pragma unroll
                for (int v = 0; v < 5; ++v)
#pragma unroll
                    for (int e = 0; e < 4; ++e) red[(wave * 5 + v) * 64 + 4 * (lane & 15) + e] = acc[v][e]; }
            __syncthreads();
            if (tid < 320) { const int v = tid / 64, col = tid % 64; float s = 0.f;
#pragma unroll
                for (int w = 0; w < 8; ++w) s += red[(w * 5 + v) * 64 + col];
                MOD[((size_t)l * 5 + v) * NMODC + n0 + col] = s + bmod[l * NMODC + n0 + col]; }
            __syncthreads();
        }
    }
    __syncthreads();
    {
        LAS float* scr = (LAS float*)(lds + wave * 16384);
        const int gw = wave * G + blk, NGW = NW * G;
        constexpr int I_FI = 32 * 352, I_FO = 88 * 64, I_IN = 32 * 125, I_OUT = 32 * 64, I_QB = 6 * 24, I_KVB = 4 * 32;
        constexpr int T_FI = 8 * I_FI, T_FO = 8 * I_FO, T_IN = 4 * I_IN, T_OUT = 4 * I_OUT, T_QB = 4 * I_QB, T_KVB = 4 * I_KVB;
        constexpr int NITEMS = T_FI + T_FO + T_IN + T_OUT + T_QB + T_KVB;
        for (int it = gw; it < NITEMS; it += NGW) {
            int r = it;
            if (r < T_FI) { const int mat = r / I_FI; r %= I_FI; const int kb = r / 352, nb = r % 352, n0 = nb * 32;
                const int half = n0 / DFF, cc = n0 % DFF, drow0 = (cc / 128) * 256 + half * 128 + (cc % 128);
                transpose_item(p.in[7] + (size_t)mat * D * (2 * DFF), 2 * DFF, D, (bf16*)(wsb + WS_WFFI) + (size_t)mat * (2 * DFF) * D, kb * 64, n0, drow0, scr, lane); continue; }
            r -= T_FI;
            if (r < T_FO) { const int mat = r / I_FO; r %= I_FO; const int kb = r / 64, nb = r % 64;
                transpose_item(p.in[8] + (size_t)mat * DFF * D, D, DFF, (bf16*)(wsb + WS_WFFO) + (size_t)mat * D * DFF, kb * 64, nb * 32, nb * 32, scr, lane); continue; }
            r -= T_FO;
            if (r < T_IN) { const int mat = r / I_IN; r %= I_IN; const int kb = r / 125, nb = r % 125;
                transpose_item(p.in[9] + (size_t)mat * D * NIN, NIN, D, (bf16*)(wsb + WS_WIN) + (size_t)mat * NINP * D, kb * 64, nb * 32, nb * 32, scr, lane); continue; }
            r -= T_IN;
            if (r < T_OUT) { const int mat = r / I_OUT; r %= I_OUT; const int kb = r / 64, nb = r % 64;
                transpose_item(p.in[10] + (size_t)mat * D * D, D, D, (bf16*)(wsb + WS_WOUT) + (size_t)mat * D * D, kb * 64, nb * 32, nb * 32, scr, lane); continue; }
            r -= T_OUT;
            if (r < T_QB) { const int mat = r / I_QB; r %= I_QB; const int kb = r / 24, nb = r % 24;
                transpose_item(p.in[17] + (size_t)mat * 384 * 768, 768, 384, (bf16*)(wsb + WS_WQB) + (size_t)mat * 768 * 384, kb * 64, nb * 32, nb * 32, scr, lane); continue; }
            r -= T_QB;
            { const int mat = r / I_KVB; r %= I_KVB; const int kb = r / 32, nb = r % 32;
                transpose_item(p.in[19] + (size_t)mat * 256 * 1024, 1024, 256, (bf16*)(wsb + WS_WKVB) + (size_t)mat * 1024 * 256, kb * 64, nb * 32, nb * 32, scr, lane); }
        }
    }
    {
        const int gt = blk * NT + tid, NGT = G * NT;
        for (int i = gt; i < DEPTH * 96 * (D / 8); i += NGT) { const int l = i / (96 * (D / 8)), r = i % (96 * (D / 8));
            *(v4u*)((bf16*)(wsb + WS_WIN) + ((size_t)l * NINP + NIN) * D + (size_t)r * 8) = (v4u){0u, 0u, 0u, 0u}; }
        const float* wg = p.in[13];
        for (int i = gt; i < DEPTH * 2048 * 64; i += NGT) { const int l = i / (2048 * 64), r = i % (2048 * 64), np = r / 64, k0 = (r % 64) * 8;
            const int c7 = np & 127, gate = (np >> 7) & 1, chunk = (np >> 8) & 3, dir = np >> 10, ch = chunk * 128 + c7, head = ch >> 6, j = ch & 63;
            v4u o = (v4u){0u, 0u, 0u, 0u};
            if ((k0 >> 6) == head) { const float* src = wg + ((((size_t)l * 2 + dir) * 2 + gate) * 8 + head) * 4096 + (size_t)(k0 & 63) * 64 + j;
                o.x = pk2(src[0], src[64]); o.y = pk2(src[128], src[192]); o.z = pk2(src[256], src[320]); o.w = pk2(src[384], src[448]); }
            *(v4u*)((bf16*)(wsb + WS_WG) + ((size_t)l * 2048 + np) * 512 + k0) = o; }
        float* rope = (float*)(wsb + WS_ROPE);
        for (int i = gt; i < SEQ * 32; i += NGT) { const int t = i / 32, k = i % 32; const float inv = powf(10000.f, -(float)(k & 15) / 16.f);
            const float ang = (k < 16 ? (float)(t / 64) : (float)(t % 64)) * inv; rope[i] = cosf(ang); rope[SEQ * 32 + i] = sinf(ang); }
        for (int i = gt; i < SEQ * 16; i += NGT) { const int t = i / 16, k = i % 16; const float inv = powf(10000.f, -(float)(k & 7) / 8.f);
            const float ang = (k < 8 ? (float)(t / 64) : (float)(t % 64)) * inv; rope[SEQ * 64 + i] = cosf(ang); rope[SEQ * 64 + SEQ * 16 + i] = sinf(ang); }
    }
}

__device__ __forceinline__ float row_rstd(const f32x4 (&v)[8]) {
    float s = 0.f;
#pragma unroll
    for (int j = 0; j < 8; ++j) s += (v[j][0] * v[j][0] + v[j][1] * v[j][1]) + (v[j][2] * v[j][2] + v[j][3] * v[j][3]);
    s = wave_sum(s);
    return 1.0f / sqrtf(s * (1.0f / D) + 1e-6f);
}
__device__ __forceinline__ void store_prenorm(bf16* hrow, int lane, const f32x4 (&v)[8], const float* g, const float* shift, const float* scale) {
    const float rstd = row_rstd(v);
#pragma unroll
    for (int j = 0; j < 8; ++j) { const int idx = lane + 64 * j;
        const f32x4 gg = ((const f32x4*)g)[idx], sh = ((const f32x4*)shift)[idx], sc = ((const f32x4*)scale)[idx];
        const f32x4 o = (v[j] * rstd) * gg * (sc + 1.0f) + sh;
        v2u w; w.x = pk2(o[0], o[1]); w.y = pk2(o[2], o[3]);
        *(v2u*)(hrow + 4 * idx) = w; }
}

__device__ __forceinline__ void phase_pro2(const P& p) {
    unsigned char* wsb = opq_p(p.ws);
    const int tid = tid_opaque(), lane = tid & 63, wave = tid >> 6, G = gridDim.x, blk = blockIdx.x;
    const int gw = wave * G + blk, NGW = NW * G;
    float* X = (float*)(wsb + WS_X); bf16* H = (bf16*)(wsb + WS_H); const float* MOD = (const float*)(wsb + WS_MOD);
    for (int row = gw; row < M; row += NGW) {
        const int b = row / PB, pp = row % PB; const bool isctx = pp < CTX; const int v = isctx ? 4 : b;
        const float* src = isctx ? p.in[2] + ((size_t)b * CTX + pp) * D : p.in[0] + ((size_t)b * SEQ + (pp - CTX)) * D;
        f32x4 xv[8];
#pragma unroll
        for (int j = 0; j < 8; ++j) xv[j] = ((const f32x4*)src)[lane + 64 * j];
#pragma unroll
        for (int j = 0; j < 8; ++j) ((f32x4*)(X + (size_t)row * D))[lane + 64 * j] = xv[j];
        const float* mod = MOD + ((size_t)0 * 5 + v) * NMODC;
        store_prenorm(H + (size_t)row * D, lane, xv, p.in[6] + (size_t)(0 * 6 + 0) * D, mod + 0 * D, mod + 1 * D);
    }
}

__device__ __forceinline__ void phase_post(const P& p, int layer, int s) {
    unsigned char* wsb = opq_p(p.ws);
    layer = opq_s(layer);
    const int tid = tid_opaque(), lane = tid & 63, wave = tid >> 6, G = gridDim.x, blk = blockIdx.x;
    const int gw = wave * G + blk, NGW = NW * G;
    float* X = (float*)(wsb + WS_X); bf16* H = (bf16*)(wsb + WS_H); const float* Y = (const float*)(wsb + WS_Y); const float* MOD = (const float*)(wsb + WS_MOD);
    const bool last = layer == DEPTH - 1, final = last && s == 2, split = !(last && s >= 1);
    const float wgt = (s == 1) ? 1.0f : 0.5f;
    const int l2 = (s < 2) ? layer : layer + 1, s2 = (s < 2) ? s + 1 : 0;
    for (int row = gw; row < M; row += NGW) {
        const int b = row / PB, pp = row % PB; const bool isctx = pp < CTX; const int v = isctx ? 4 : b;
        if (last && s >= 1 && isctx) continue;
        f32x4 yv[8], xv[8];
        if (split && row >= 8192) { const float* yp = (const float*)(wsb + WS_YP) + (size_t)(row - 8192) * D;
#pragma unroll
            for (int j = 0; j < 8; ++j) { f32x4 a = ((const f32x4*)yp)[lane + 64 * j];
#pragma unroll
                for (int sl = 1; sl < 8; ++sl) a += ((const f32x4*)(yp + (size_t)sl * 1024 * 2048))[lane + 64 * j];
                yv[j] = a; } }
        else {
#pragma unroll
            for (int j = 0; j < 8; ++j) yv[j] = ((const f32x4*)(Y + (size_t)row * D))[lane + 64 * j]; }
#pragma unroll
        for (int j = 0; j < 8; ++j) xv[j] = ((const f32x4*)(X + (size_t)row * D))[lane + 64 * j];
        const float rstd = row_rstd(yv);
        const float* gate = MOD + ((size_t)layer * 5 + v) * NMODC + (size_t)(3 * s + 2) * D;
        const float* gpost = p.in[6] + (size_t)(layer * 6 + 2 * s + 1) * D;
        float* dst = final ? p.out + ((size_t)b * SEQ + (pp - CTX)) * D : X + (size_t)row * D;
#pragma unroll
        for (int j = 0; j < 8; ++j) { const int idx = lane + 64 * j; const f32x4 ga = ((const f32x4*)gate)[idx], gp = ((const f32x4*)gpost)[idx];
            xv[j] = xv[j] + (ga * wgt) * ((yv[j] * rstd) * gp);
            ((f32x4*)dst)[idx] = xv[j]; }
        if (!final) { const float* mod = MOD + ((size_t)l2 * 5 + v) * NMODC;
            store_prenorm(H + (size_t)row * D, lane, xv, p.in[6] + (size_t)(l2 * 6 + 2 * s2) * D, mod + (size_t)(3 * s2) * D, mod + (size_t)(3 * s2 + 1) * D); }
    }
}

template <class Epi>
__device__ __forceinline__ void run_gemm(LAS unsigned char* lds, const bf16* A, const bf16* Bt, int nMt, int N, int K, int latonly, int coff, const Epi& E) {
    pg8::Gemm g{A, Bt, M, N, K, K};
    TileOrder S; S.init(nMt, N, (int)gridDim.x, (int)((blockIdx.x + coff) % gridDim.x), latonly);
    pg8::gemm_phase<Epi, TileOrder, true, true>(lds, g, S, E);
}
struct OneUnit { int pm, pn;
    __device__ __forceinline__ bool next(int i, pg8::Unit& u) const { if (i != 0) return false; u.pm = pm; u.pn = pn; return true; }
    __device__ __forceinline__ void a_ready(const pg8::Unit&) const {}
    __device__ __forceinline__ void done(const pg8::Unit&) const {}
};
__device__ __forceinline__ void run_gemm_n2048_split(LAS unsigned char* lds, const bf16* A, const bf16* Bt, int K, float* Y, float* YP) {
    { EpiF32 E{Y, D}; run_gemm(lds, A, Bt, 32, D, K, 0, 0, E); }
    __syncthreads();
    const int nkt = K / 64;
    for (int L = blockIdx.x; L < 256; L += gridDim.x) {
        const int s = L & 7, tile = L >> 3, pm = 32 + (tile >> 3), pn = tile & 7;
        const int per = nkt >> 3, odd = per & 1;
        const int kt0 = per * s + (odd ? (s & 1) : 0), nk = odd ? per + 1 - 2 * (s & 1) : per;
        pg8::Gemm g{A + (size_t)kt0 * 64, Bt + (size_t)kt0 * 64, M, D, nk * 64, K};
        OneUnit S{pm, pn};
        EpiF32 E{YP + (ptrdiff_t)s * (1024 * 2048) - (ptrdiff_t)(32 * 256) * 2048, D};
        pg8::gemm_phase<EpiF32, OneUnit, true, true>(lds, g, S, E);
        __syncthreads();
    }
}
__device__ __forceinline__ void phase_ffn_in(const P& p, LAS unsigned char* lds, int layer, int which) {
    unsigned char* wsb = opq_p(p.ws);
    layer = opq_s(layer);
    const bool lat = (layer == DEPTH - 1) && which == 1;
    EpiSwiglu E{(bf16*)(wsb + WS_ACT), DFF};
    run_gemm(lds, (const bf16*)(wsb + WS_H), (const bf16*)(wsb + WS_WFFI) + (size_t)(layer * 2 + which) * (2 * DFF) * D, lat ? 32 : 36, 2 * DFF, D, lat, 0, E);
}
__device__ __forceinline__ void phase_ffn_out(const P& p, LAS unsigned char* lds, int layer, int which) {
    unsigned char* wsb = opq_p(p.ws);
    layer = opq_s(layer);
    const bool lat = (layer == DEPTH - 1) && which == 1;
    const bf16* A = (const bf16*)(wsb + WS_ACT); const bf16* Bt = (const bf16*)(wsb + WS_WFFO) + (size_t)(layer * 2 + which) * D * DFF;
    if (lat) { EpiF32 E{(float*)(wsb + WS_Y), D}; run_gemm(lds, A, Bt, 32, D, DFF, 1, 0, E); }
    else run_gemm_n2048_split(lds, A, Bt, DFF, (float*)(wsb + WS_Y), (float*)(wsb + WS_YP));
}
__device__ __forceinline__ void phase_inproj(const P& p, LAS unsigned char* lds, int layer) {
    unsigned char* wsb = opq_p(p.ws);
    layer = opq_s(layer);
    EpiB16 E{(bf16*)(wsb + WS_COLS), NINP};
    run_gemm(lds, (const bf16*)(wsb + WS_H), (const bf16*)(wsb + WS_WIN) + (size_t)layer * NINP * D, 36, NINP, D, 0, 0, E);
}
__device__ __forceinline__ void phase_outproj(const P& p, LAS unsigned char* lds, int layer) {
    unsigned char* wsb = opq_p(p.ws);
    layer = opq_s(layer);
    const bool lat = (layer == DEPTH - 1);
    const bf16* A = (const bf16*)(wsb + WS_YMIX); const bf16* Bt = (const bf16*)(wsb + WS_WOUT) + (size_t)layer * D * D;
    if (lat) { EpiF32 E{(float*)(wsb + WS_Y), D}; run_gemm(lds, A, Bt, 32, D, D, 1, 0, E); }
    else run_gemm_n2048_split(lds, A, Bt, D, (float*)(wsb + WS_Y), (float*)(wsb + WS_YP));
}

__device__ __forceinline__ int lane_fresh() { unsigned ones = ~0u; asm volatile("" : "+s"(ones)); return (int)__builtin_amdgcn_mbcnt_hi(ones, __builtin_amdgcn_mbcnt_lo(ones, 0u)); }
struct EpiLru {
    static constexpr bool PERM = false, AFTER_DRAIN = false;
    f32x2* AB; const bf16* U; const float* bg; const float* lam;
    __device__ __forceinline__ void operator()(const f32x4 (&acc)[2][2][4][2], const pg8::Unit& u, int wr, int wc, int fr, int fq) const {
        { const int ln = lane_fresh(); fr = ln & 15; fq = ln >> 4; }
        const int dir = u.pn >> 2, ch0 = (u.pn & 3) * 128 + wc * 32 + 4 * fq, row0 = u.pm * 256 + wr * 64 + fr;
        float br[2][4], bi[2][4], sp8[2][4];
#pragma unroll
        for (int n = 0; n < 2; ++n)
#pragma unroll
            for (int e = 0; e < 4; ++e) { const int ch = ch0 + 16 * n + e; br[n][e] = bg[(dir * 2 + 0) * 512 + ch]; bi[n][e] = bg[(dir * 2 + 1) * 512 + ch]; const float ee = __expf(-lam[dir * 512 + ch]); sp8[n][e] = 8.0f * (ee < 0.03f ? ee * (1.0f - ee * (0.5f - ee * 0.33333333f)) : __logf(1.0f + ee)); }
#pragma unroll
        for (int ai = 0; ai < 2; ++ai)
#pragma unroll
            for (int m = 0; m < 4; ++m) { const size_t row = (size_t)(row0 + ai * 128 + m * 16);
#pragma unroll
                for (int n = 0; n < 2; ++n) { const v2u uw = *(const v2u*)(U + row * 512 + ch0 + 16 * n);
                    const float uu[4] = {bflo(uw.x), bfhi(uw.x), bflo(uw.y), bfhi(uw.y)};
                    float o[8];
#pragma unroll
                    for (int e = 0; e < 4; ++e) { const float gr = acc[ai][0][m][n][e] + br[n][e], gi = acc[ai][1][m][n][e] + bi[n][e];
                        const float r = __builtin_amdgcn_rcpf(1.f + __expf(-gr)), ig = __builtin_amdgcn_rcpf(1.f + __expf(-gi));
                        const float log_a = -r * sp8[n][e], x2 = 2.0f * log_a;
                        const float om = x2 > -0.1f ? -x2 * (1.0f + x2 * (0.5f + x2 * (0.16666667f + x2 * 0.041666667f))) : 1.0f - __expf(x2);
                        o[2 * e] = __expf(log_a); o[2 * e + 1] = __builtin_amdgcn_sqrtf(om) * (ig * uu[e]); }
                    f32x4* dst = (f32x4*)(AB + ((size_t)dir * M + row) * 512 + ch0 + 16 * n);
                    dst[0] = (f32x4){o[0], o[1], o[2], o[3]}; dst[1] = (f32x4){o[4], o[5], o[6], o[7]}; } }
    }
};
struct EpiKvup {
    static constexpr bool PERM = true, AFTER_DRAIN = false;
    bf16* KMN; bf16* VTM;
    __device__ __forceinline__ void operator()(const f32x4 (&acc)[2][2][4][2], const pg8::Unit& u, int wr, int wc, int fr, int fq) const {
        { const int ln = lane_fresh(); fr = ln & 15; fq = ln >> 4; }
        const int row0 = u.pm * 256 + wr * 64 + fr, b = u.pm / 9, p0 = (u.pm % 9) * 256 + wr * 64 + fr;
#pragma unroll
        for (int ai = 0; ai < 2; ++ai)
#pragma unroll
            for (int m = 0; m < 4; ++m) { const size_t row = (size_t)(row0 + ai * 128 + m * 16); const int pp = p0 + ai * 128 + m * 16;
#pragma unroll
                for (int bj = 0; bj < 2; ++bj) { const int h = 2 * u.pn + bj; const f32x4 v0 = acc[ai][bj][m][0], v1 = acc[ai][bj][m][1];
                    if (wc < 2) { v4u w; w.x = pg8::cvt_pk_bf16(v0[0], v0[1]); w.y = pg8::cvt_pk_bf16(v0[2], v0[3]); w.z = pg8::cvt_pk_bf16(v1[0], v1[1]); w.w = pg8::cvt_pk_bf16(v1[2], v1[3]);
                        *(v4u*)(KMN + row * 512 + h * 64 + wc * 32 + 8 * fq) = w; }
                    else { bf16* vt = VTM + ((size_t)b * 512 + h * 64 + (wc - 2) * 32 + 8 * fq) * PB + pp;
                        vt[0 * (size_t)PB] = (bf16)f2bf(v0[0]); vt[1 * (size_t)PB] = (bf16)f2bf(v0[1]); vt[2 * (size_t)PB] = (bf16)f2bf(v0[2]); vt[3 * (size_t)PB] = (bf16)f2bf(v0[3]);
                        vt[4 * (size_t)PB] = (bf16)f2bf(v1[0]); vt[5 * (size_t)PB] = (bf16)f2bf(v1[1]); vt[6 * (size_t)PB] = (bf16)f2bf(v1[2]); vt[7 * (size_t)PB] = (bf16)f2bf(v1[3]); } } }
    }
};
__device__ __forceinline__ void phase_mgemm(const P& p, LAS unsigned char* lds, int layer) {
    unsigned char* wsb = opq_p(p.ws);
    layer = opq_s(layer);
    { EpiB16 E{(bf16*)(wsb + WS_QUP), 768};
      run_gemm(lds, (const bf16*)(wsb + WS_QN), (const bf16*)(wsb + WS_WQB) + (size_t)layer * 768 * 384, 36, 768, 384, 0, 0, E); }
    __syncthreads();
    { EpiKvup E{(bf16*)(wsb + WS_KMN), (bf16*)(wsb + WS_VTM)};
      run_gemm(lds, (const bf16*)(wsb + WS_KVN), (const bf16*)(wsb + WS_WKVB) + (size_t)layer * 1024 * 256, 36, 1024, 256, 0, 148, E); }
    __syncthreads();
    { EpiLru E{(f32x2*)(wsb + WS_AB), (const bf16*)(wsb + WS_U), p.in[14] + (size_t)layer * 2 * 2 * 512, p.in[15] + (size_t)layer * 2 * 512};
      run_gemm(lds, (const bf16*)(wsb + WS_U), (const bf16*)(wsb + WS_WG) + (size_t)layer * 2048 * 512, 36, 2048, 512, 0, 0, E); }
}


__device__ __forceinline__ void transpose_tok_item(const bf16* src, int ss, bf16* dst, LAS unsigned short* scr, int lane) {
#pragma unroll
    for (int i = 0; i < 8; ++i) { const int id = lane + 64 * i, row = id >> 3, ch = id & 7;
        const v4u w = *(const v4u*)(src + (size_t)row * ss + ch * 8);
        LAS unsigned* d = (LAS unsigned*)(scr + row * 66 + ch * 8);
        d[0] = w.x; d[1] = w.y; d[2] = w.z; d[3] = w.w; }
    LDS_WAIT(); asm volatile("" ::: "memory");
#pragma unroll
    for (int i = 0; i < 8; ++i) { const int id = lane + 64 * i, e = id >> 3, ch = id & 7;
        unsigned v[8];
#pragma unroll
        for (int k = 0; k < 8; ++k) v[k] = scr[(ch * 8 + k) * 66 + e];
        v4u w; w.x = v[0] | (v[1] << 16); w.y = v[2] | (v[3] << 16); w.z = v[4] | (v[5] << 16); w.w = v[6] | (v[7] << 16);
        *(v4u*)(dst + (size_t)e * PB + ch * 8) = w; }
    LDS_WAIT(); asm volatile("" ::: "memory");
}
__device__ __forceinline__ void phase_prep(const P& p, LAS unsigned char* lds, int layer) {
    unsigned char* wsb = opq_p(p.ws);
    layer = opq_s(layer);
    const int tid = tid_opaque(), lane = tid & 63, wave = tid >> 6, G = gridDim.x, blk = blockIdx.x;
    const int gw = wave * G + blk, NGW = NW * G;
    bf16* COLS = (bf16*)(wsb + WS_COLS); bf16* U = (bf16*)(wsb + WS_U); bf16* QN = (bf16*)(wsb + WS_QN); bf16* KVN = (bf16*)(wsb + WS_KVN);
    const float* rope = (const float*)(wsb + WS_ROPE);
    const float* cw = p.in[11] + (size_t)layer * 4 * 512; const float* cb = p.in[12] + (size_t)layer * 512;
    const float* qg = p.in[16] + (size_t)layer * 384; const float* kvg = p.in[18] + (size_t)layer * 256;
    for (int row = gw; row < M; row += NGW) {
        const int pp = row % PB; const bool isctx = pp < CTX;
        const int lo = isctx ? 0 : CTX, hi = isctx ? CTX : PB;
        bf16* crow = COLS + (size_t)row * NINP;
#pragma unroll
        for (int cblk = 0; cblk < 8; ++cblk) { const int ch = cblk * 64 + lane; float acc = cb[ch];
#pragma unroll
            for (int j = 0; j < 4; ++j) { const int q = pp + j - 2; if (q >= lo && q < hi) acc += cw[j * 512 + ch] * bf2f(crow[(ptrdiff_t)(j - 2) * NINP + C_XB + ch]); }
            U[(size_t)row * 512 + ch] = (bf16)f2bf(acc); }
        { float v[6]; float s = 0.f;
#pragma unroll
            for (int j = 0; j < 6; ++j) { v[j] = bf2f(crow[C_MQ + lane + 64 * j]); s += v[j] * v[j]; }
            s = wave_sum(s); const float rstd = 1.0f / sqrtf(s * (1.0f / 384.f) + 1e-6f);
#pragma unroll
            for (int j = 0; j < 6; ++j) QN[(size_t)row * 384 + lane + 64 * j] = (bf16)f2bf(v[j] * rstd * qg[lane + 64 * j]); }
        { float v[4]; float s = 0.f;
#pragma unroll
            for (int j = 0; j < 4; ++j) { v[j] = bf2f(crow[C_MKV + lane + 64 * j]); s += v[j] * v[j]; }
            s = wave_sum(s); const float rstd = 1.0f / sqrtf(s * (1.0f / 256.f) + 1e-6f);
#pragma unroll
            for (int j = 0; j < 4; ++j) KVN[(size_t)row * 256 + lane + 64 * j] = (bf16)f2bf(v[j] * rstd * kvg[lane + 64 * j]); }
        if (!isctx) { const int t = pp - CTX; const int i = lane & 31, hsel = lane >> 5;
            const float c = rope[t * 32 + i], sn = rope[SEQ * 32 + t * 32 + i];
#pragma unroll
            for (int hp = 0; hp < 13; ++hp) { const int hd = hp * 2 + hsel; const int base = hd < 16 ? C_DQ + hd * 64 : C_GQ + (hd - 16) * 64;
                const float x1 = bf2f(crow[base + i]), x2 = bf2f(crow[base + 32 + i]);
                crow[base + i] = (bf16)f2bf(x1 * c - x2 * sn); crow[base + 32 + i] = (bf16)f2bf(x1 * sn + x2 * c); }
            if (lane < 16) { const float c2 = rope[SEQ * 64 + t * 16 + lane], s2 = rope[SEQ * 64 + SEQ * 16 + t * 16 + lane];
                const float x1 = bf2f(crow[C_MKR + lane]), x2 = bf2f(crow[C_MKR + 16 + lane]);
                crow[C_MKR + lane] = (bf16)f2bf(x1 * c2 - x2 * s2); crow[C_MKR + 16 + lane] = (bf16)f2bf(x1 * s2 + x2 * c2); }
        }
    }
    { LAS unsigned short* scr = (LAS unsigned short*)(lds + wave * 16384);
      bf16* VTD = (bf16*)(wsb + WS_VTD); bf16* VTG = (bf16*)(wsb + WS_VTG);
      for (int it = gw; it < NB * 36 * 10; it += NGW) { const int b = it / 360, r = it % 360, tb = r / 10, cb = r % 10;
          const bf16* s = COLS + ((size_t)b * PB + tb * 64) * NINP + (cb < 8 ? C_DV + cb * 64 : C_GV + (cb - 8) * 64);
          bf16* d = cb < 8 ? VTD + ((size_t)b * 512 + cb * 64) * PB + tb * 64 : VTG + ((size_t)b * 128 + (cb - 8) * 64) * PB + tb * 64;
          transpose_tok_item(s, NINP, d, scr, lane); } }
}

__device__ __forceinline__ void phase_prep2(const P& p, LAS unsigned char* lds, int layer) {
    unsigned char* wsb = opq_p(p.ws);
    layer = opq_s(layer);
    const int tid = tid_opaque(), lane = tid & 63, wave = tid >> 6, G = gridDim.x, blk = blockIdx.x;
    const int gw = wave * G + blk, NGW = NW * G;
    const bf16* COLS = (const bf16*)(wsb + WS_COLS); const bf16* U = (const bf16*)(wsb + WS_U);
    const bf16* QUP = (const bf16*)(wsb + WS_QUP); const bf16* KVUP = (const bf16*)(wsb + WS_KVUP);
    bf16* QM = (bf16*)(wsb + WS_QM); bf16* KM = (bf16*)(wsb + WS_KM);
    const float* GATES = (const float*)(wsb + WS_GATES); f32x2* AB = (f32x2*)(wsb + WS_AB);
    const float* rope = (const float*)(wsb + WS_ROPE);
    const float* bg = p.in[14] + (size_t)layer * 2 * 2 * 512; const float* lam = p.in[15] + (size_t)layer * 2 * 512;
    for (int row = gw; row < M; row += NGW) {
        const int pp = row % PB; const bool isctx = pp < CTX; const int t = pp - CTX;
#pragma unroll
        for (int j = 0; j < 12; ++j) { const int e = lane + 64 * j, h = e / 96, d = e % 96;
            float qv = bf2f(QUP[(size_t)row * 768 + e]);
            if (d >= 64 && !isctx) { const int i = (d - 64) & 15; const bool second = (d - 64) >= 16;
                const float c = rope[SEQ * 64 + t * 16 + i], sn = rope[SEQ * 64 + SEQ * 16 + t * 16 + i];
                const float x1 = bf2f(QUP[(size_t)row * 768 + h * 96 + 64 + i]), x2 = bf2f(QUP[(size_t)row * 768 + h * 96 + 80 + i]);
                qv = second ? (x1 * sn + x2 * c) : (x1 * c - x2 * sn); }
            QM[(size_t)row * 768 + e] = (bf16)f2bf(qv);
            KM[(size_t)row * 768 + e] = d < 64 ? KVUP[(size_t)row * 1024 + h * 128 + d] : COLS[(size_t)row * NINP + C_MKR + (d - 64)]; }
#pragma unroll
        for (int dir = 0; dir < 2; ++dir)
#pragma unroll
            for (int cblk = 0; cblk < 8; ++cblk) { const int ch = cblk * 64 + lane;
                const float* gp = GATES + (size_t)row * 2048 + ((dir * 4 + (ch >> 7)) * 2) * 128 + (ch & 127);
                const float gr = gp[0] + bg[(dir * 2 + 0) * 512 + ch], gi = gp[128] + bg[(dir * 2 + 1) * 512 + ch];
                const float r = 1.f / (1.f + expf(-gr)), ig = 1.f / (1.f + expf(-gi));
                const float sp = log1pf(expf(-lam[dir * 512 + ch]));
                const float log_a = -8.0f * r * sp, a = expf(log_a);
                const float u = bf2f(U[(size_t)row * 512 + ch]);
                const float bco = sqrtf(-expm1f(2.0f * log_a)) * (ig * u);
                AB[((size_t)dir * M + row) * 512 + ch] = (f32x2){a, bco}; }
    }
    { LAS unsigned short* scr = (LAS unsigned short*)(lds + wave * 16384);
      bf16* VTM = (bf16*)(wsb + WS_VTM);
      for (int it = gw; it < NB * 36 * 8; it += NGW) { const int b = it / 288, r = it % 288, tb = r / 8, hh = r % 8;
          transpose_tok_item(KVUP + ((size_t)b * PB + tb * 64) * 1024 + hh * 128 + 64, 1024, VTM + ((size_t)b * 512 + hh * 64) * PB + tb * 64, scr, lane); } }
}

template <int DQK, int DV, int MODE, bool OUTF32>
__device__ __forceinline__ void naive_attn(const bf16* Q, int qs, const bf16* K, int ks, const bf16* V, int vs, void* O, int os,
                                           int b, int pp0, int lane, float scale, float sink) {
    const size_t rowbase = (size_t)b * PB; const int pp = pp0 + lane;
    float q[DQK], o[DV];
    { const bf16* qr = Q + (rowbase + pp) * qs;
#pragma unroll
      for (int c = 0; c < DQK / 8; ++c) { const v4u w = *(const v4u*)(qr + 8 * c);
          q[8 * c + 0] = bflo(w.x); q[8 * c + 1] = bfhi(w.x); q[8 * c + 2] = bflo(w.y); q[8 * c + 3] = bfhi(w.y);
          q[8 * c + 4] = bflo(w.z); q[8 * c + 5] = bfhi(w.z); q[8 * c + 6] = bflo(w.w); q[8 * c + 7] = bfhi(w.w); } }
    const float sl2 = scale * 1.4426950408889634f;
#pragma unroll
    for (int d = 0; d < DQK; ++d) q[d] *= sl2;
#pragma unroll
    for (int e = 0; e < DV; ++e) o[e] = 0.f;
    float m = (MODE == 1) ? sink * 1.4426950408889634f : -1e30f, l = (MODE == 1) ? 1.f : 0.f;
    const bool isctx = pp0 < CTX; const int t = pp - CTX, t0 = pp0 - CTX;
    for (int seg = 0; seg < 2; ++seg) {
        int k0, k1;
        if (seg == 0) { k0 = 0; k1 = CTX; }
        else { if (isctx) break;
            if (MODE == 0) { k0 = CTX; k1 = PB; }
            else { const int a0 = t0 - 128 < 0 ? 0 : t0 - 128, a1 = t0 + 63 + 128 > SEQ - 1 ? SEQ - 1 : t0 + 63 + 128; k0 = CTX + a0; k1 = CTX + a1 + 1; } }
        for (int key = k0; key < k1; ++key) {
            const bf16* kr = K + (rowbase + key) * ks; const bf16* vr = V + (rowbase + key) * vs;
            asm volatile("" : "+v"(kr)); asm volatile("" : "+v"(vr));
            float s = 0.f;
#pragma unroll
            for (int c = 0; c < DQK / 8; ++c) { const v4u w = *(const v4u*)(kr + 8 * c);
                s += q[8 * c + 0] * bflo(w.x); s += q[8 * c + 1] * bfhi(w.x); s += q[8 * c + 2] * bflo(w.y); s += q[8 * c + 3] * bfhi(w.y);
                s += q[8 * c + 4] * bflo(w.z); s += q[8 * c + 5] * bfhi(w.z); s += q[8 * c + 6] * bflo(w.w); s += q[8 * c + 7] * bfhi(w.w); }
            bool valid = true;
            if (MODE == 1 && seg == 1) { const int rel = (key - CTX) - t; valid = (rel <= 128) && (rel >= -128); }
            if (valid) {
                const float mn = fmaxf(m, s), alpha = exp2f(m - mn), pr = exp2f(s - mn);
                l = l * alpha + pr; m = mn;
#pragma unroll
                for (int c = 0; c < DV / 8; ++c) { const v4u w = *(const v4u*)(vr + 8 * c);
                    o[8 * c + 0] = o[8 * c + 0] * alpha + pr * bflo(w.x); o[8 * c + 1] = o[8 * c + 1] * alpha + pr * bfhi(w.x);
                    o[8 * c + 2] = o[8 * c + 2] * alpha + pr * bflo(w.y); o[8 * c + 3] = o[8 * c + 3] * alpha + pr * bfhi(w.y);
                    o[8 * c + 4] = o[8 * c + 4] * alpha + pr * bflo(w.z); o[8 * c + 5] = o[8 * c + 5] * alpha + pr * bfhi(w.z);
                    o[8 * c + 6] = o[8 * c + 6] * alpha + pr * bflo(w.w); o[8 * c + 7] = o[8 * c + 7] * alpha + pr * bfhi(w.w); }
            }
        }
    }
    const float il = 1.f / l;
    if (OUTF32) { float* orow = (float*)O + (rowbase + pp) * os;
#pragma unroll
        for (int e = 0; e < DV; e += 4) *(f32x4*)(orow + e) = (f32x4){o[e] * il, o[e + 1] * il, o[e + 2] * il, o[e + 3] * il}; }
    else { bf16* orow = (bf16*)O + (rowbase + pp) * os;
#pragma unroll
        for (int e = 0; e < DV; e += 8) { v4u w; w.x = pk2(o[e] * il, o[e + 1] * il); w.y = pk2(o[e + 2] * il, o[e + 3] * il); w.z = pk2(o[e + 4] * il, o[e + 5] * il); w.w = pk2(o[e + 6] * il, o[e + 7] * il);
            *(v4u*)(orow + e) = w; } }
}


typedef short bf16x8 __attribute__((ext_vector_type(8)));
typedef float f32x16 __attribute__((ext_vector_type(16)));
__device__ __forceinline__ int crow16(int r, int hi) { return (r & 3) + 8 * (r >> 2) + 4 * hi; }

typedef __bf16 bf16x2_t __attribute__((ext_vector_type(2)));
__device__ __forceinline__ unsigned cvtpk_s(float lo, float hi) { const f32x2 v = {lo, hi}; const bf16x2_t b = __builtin_convertvector(v, bf16x2_t); return __builtin_bit_cast(unsigned, b); }
template <int DQK, int DV, int MODE, bool OUTF32>
__device__ __forceinline__ void attn_unit(LAS unsigned char* lds, const bf16* Qb, int qs, const bf16* Kb, int ks, const bf16* Kb2, int ks2, const float* ropeq, const bf16* VTb, void* Ob, int os,
                                          int q0, int ntd, float scale, float sink, int tid_in) {
    int tid = tid_in; asm volatile("" : "+v"(tid));
    constexpr int RSK = DQK * 2 + 16, RSV = 136, KBUF = 64 * RSK, VBUF = DV * RSV, CPR = DQK / 8, NKC = 64 * CPR, NVC = DV * 8;
    constexpr int NKI = (NKC + NT - 1) / NT, NVI = NVC / NT, ND0 = DQK / 16, NDB = DV / 32;
    const int lane = tid & 63, wave = __builtin_amdgcn_readfirstlane(tid >> 6), r32 = lane & 31, hi = lane >> 5;
    int ta = 4, ntiles = ntd;
    if (MODE == 1) { if (q0 < CTX) ntiles = 4; else { const int t0 = q0 - CTX; const int lo = t0 - 128 < 0 ? 0 : t0 - 128, hh = t0 + 383 > SEQ - 1 ? SEQ - 1 : t0 + 383; ta = 4 + (lo >> 6); ntiles = 4 + ((hh >> 6) - (lo >> 6) + 1); } }
#define TILE_OF(i) ((MODE == 1 && (i) >= 4) ? ta + (i) - 4 : (i))
    const int qrow = q0 + wave * 32 + r32;
    bf16x8 qf[ND0];
#pragma unroll
    for (int d0 = 0; d0 < ND0; ++d0) qf[d0] = *(const bf16x8*)(Qb + (size_t)qrow * qs + 16 * d0 + 8 * hi);
    if (DQK == 96 && ropeq != nullptr) {
        const float* cs = ropeq + (size_t)(qrow - CTX) * 16 + 8 * hi; const float* sn = cs + SEQ * 16;
        const f32x4 c0 = *(const f32x4*)cs, c1 = *(const f32x4*)(cs + 4), s0 = *(const f32x4*)sn, s1 = *(const f32x4*)(sn + 4);
        float y1[8], y2[8];
#pragma unroll
        for (int j = 0; j < 8; ++j) { const float x1 = bf2f((unsigned short)qf[ND0 - 2][j]), x2 = bf2f((unsigned short)qf[ND0 - 1][j]);
            const float cc = j < 4 ? c0[j] : c1[j - 4], ss = j < 4 ? s0[j] : s1[j - 4];
            y1[j] = x1 * cc - x2 * ss; y2[j] = x1 * ss + x2 * cc; }
        qf[ND0 - 2] = __builtin_bit_cast(bf16x8, (v4u){cvtpk_s(y1[0], y1[1]), cvtpk_s(y1[2], y1[3]), cvtpk_s(y1[4], y1[5]), cvtpk_s(y1[6], y1[7])});
        qf[ND0 - 1] = __builtin_bit_cast(bf16x8, (v4u){cvtpk_s(y2[0], y2[1]), cvtpk_s(y2[2], y2[3]), cvtpk_s(y2[4], y2[5]), cvtpk_s(y2[6], y2[7])});
    }
    f32x16 o[NDB];
#pragma unroll
    for (int db = 0; db < NDB; ++db)
#pragma unroll
        for (int r = 0; r < 16; ++r) o[db][r] = 0.f;
    const float c = scale * 1.4426950408889634f;
    float m = (MODE == 1) ? sink / scale : -1e30f, l = (MODE == 1 && hi == 0) ? 1.f : 0.f;
    v4u kreg[NKI], vreg[NVI];
#pragma unroll
    for (int i_ = 0; i_ < NKI; ++i_) kreg[i_] = (v4u){0u, 0u, 0u, 0u};
#pragma unroll
    for (int i_ = 0; i_ < NVI; ++i_) vreg[i_] = (v4u){0u, 0u, 0u, 0u};
#define LOAD_TILE(tile) do { const int kb_ = (tile) * 64; \
        _Pragma("unroll") for (int i_ = 0; i_ < NKI; ++i_) { const int id_ = tid + NT * i_; if (id_ < NKC) { const int row_ = id_ / CPR, ch_ = id_ % CPR; kreg[i_] = (DQK == 96 && ch_ >= 8) ? *(const v4u*)(Kb2 + (size_t)(kb_ + row_) * ks2 + (ch_ - 8) * 8) : *(const v4u*)(Kb + (size_t)(kb_ + row_) * ks + ch_ * 8); } } \
        _Pragma("unroll") for (int i_ = 0; i_ < NVI; ++i_) { const int id_ = tid + NT * i_, d_ = id_ >> 3, ch_ = id_ & 7; vreg[i_] = *(const v4u*)(VTb + (size_t)d_ * PB + kb_ + ch_ * 8); } } while (0)
#define STORE_TILE(buf) do { \
        _Pragma("unroll") for (int i_ = 0; i_ < NKI; ++i_) { const int id_ = tid + NT * i_; if (id_ < NKC) { const int row_ = id_ / CPR, ch_ = id_ % CPR; *(LAS v4u*)(lds + (buf) * KBUF + row_ * RSK + ch_ * 16) = kreg[i_]; } } \
        _Pragma("unroll") for (int i_ = 0; i_ < NVI; ++i_) { const int id_ = tid + NT * i_, d_ = id_ >> 3, ch_ = id_ & 7; LAS v2u* w_ = (LAS v2u*)(lds + 2 * KBUF + (buf) * VBUF + d_ * RSV + ch_ * 16); \
            w_[0] = (v2u){vreg[i_].x, vreg[i_].y}; w_[1] = (v2u){vreg[i_].z, vreg[i_].w}; } } while (0)
    LOAD_TILE(TILE_OF(0)); STORE_TILE(0); __syncthreads();
    for (int i = 0; i < ntiles; ++i) {
        const int cur = i & 1, tile = TILE_OF(i);
        if (i + 1 < ntiles) LOAD_TILE(TILE_OF(i + 1));
        bool active = true;
        if (MODE == 1 && i >= 4) { const int kt0 = tile * 64 - CTX, qt0 = q0 - CTX + wave * 32; active = (kt0 + 63 >= qt0 - 128) && (kt0 <= qt0 + 31 + 128); }
        if (active) {
            f32x16 p0, p1;
#pragma unroll
            for (int r = 0; r < 16; ++r) { p0[r] = 0.f; p1[r] = 0.f; }
            const LAS unsigned char* kb = lds + cur * KBUF + r32 * RSK + hi * 16;
#pragma unroll
            for (int d0 = 0; d0 < ND0; ++d0) { const bf16x8 k0 = *(const LAS bf16x8*)(kb + d0 * 32), k1 = *(const LAS bf16x8*)(kb + 32 * RSK + d0 * 32);
                p0 = __builtin_amdgcn_mfma_f32_32x32x16_bf16(k0, qf[d0], p0, 0, 0, 0); p1 = __builtin_amdgcn_mfma_f32_32x32x16_bf16(k1, qf[d0], p1, 0, 0, 0); }
            if (MODE == 1 && i >= 4) { const int rel0 = (tile * 64 - CTX) - (qrow - CTX);
#pragma unroll
                for (int r = 0; r < 16; ++r) { const int ra = rel0 + crow16(r, hi), rb = ra + 32;
                    if (ra > 128 || ra < -128) p0[r] = -1e30f; if (rb > 128 || rb < -128) p1[r] = -1e30f; } }
            float mx = fmaxf(p0[0], p1[0]);
#pragma unroll
            for (int r = 1; r < 16; ++r) mx = fmaxf(mx, fmaxf(p0[r], p1[r]));
            mx = xhalf_max(mx);
            const float mn = fmaxf(m, mx), alpha = __builtin_amdgcn_exp2f((m - mn) * c), nmc = -mn * c; m = mn;
            float sum = 0.f;
#pragma unroll
            for (int r = 0; r < 16; ++r) { p0[r] = __builtin_amdgcn_exp2f(fmaf(p0[r], c, nmc)); p1[r] = __builtin_amdgcn_exp2f(fmaf(p1[r], c, nmc)); sum += p0[r] + p1[r]; }
            l = l * alpha + sum;
            if (!__all(alpha == 1.f)) {
#pragma unroll
                for (int db = 0; db < NDB; ++db)
#pragma unroll
                    for (int r = 0; r < 16; ++r) o[db][r] *= alpha; }
            const LAS unsigned char* vb = lds + 2 * KBUF + cur * VBUF + r32 * RSV + hi * 8;
#pragma unroll
            for (int s = 0; s < 4; ++s) { const int rb = (s & 1) * 8;
                v4u pw;
                if (s < 2) { pw.x = cvtpk_s(p0[rb + 0], p0[rb + 1]); pw.y = cvtpk_s(p0[rb + 2], p0[rb + 3]); pw.z = cvtpk_s(p0[rb + 4], p0[rb + 5]); pw.w = cvtpk_s(p0[rb + 6], p0[rb + 7]); }
                else       { pw.x = cvtpk_s(p1[rb + 0], p1[rb + 1]); pw.y = cvtpk_s(p1[rb + 2], p1[rb + 3]); pw.z = cvtpk_s(p1[rb + 4], p1[rb + 5]); pw.w = cvtpk_s(p1[rb + 6], p1[rb + 7]); }
                const bf16x8 pf = __builtin_bit_cast(bf16x8, pw);
#pragma unroll
                for (int db = 0; db < NDB; ++db) { const LAS unsigned char* vp = vb + db * 32 * RSV + s * 32;
                    const v2u a0 = *(const LAS v2u*)(vp), a1 = *(const LAS v2u*)(vp + 16);
                    const bf16x8 vf = __builtin_bit_cast(bf16x8, (v4u){a0.x, a0.y, a1.x, a1.y});
                    o[db] = __builtin_amdgcn_mfma_f32_32x32x16_bf16(vf, pf, o[db], 0, 0, 0); }
                __builtin_amdgcn_sched_barrier(0); }
        }
        if (i + 1 < ntiles) STORE_TILE(cur ^ 1);
        __syncthreads();
    }
#undef LOAD_TILE
#undef STORE_TILE
#undef TILE_OF
    l = xhalf_sum(l);
    const float il = 1.f / l;
#pragma unroll
    for (int db = 0; db < NDB; ++db)
#pragma unroll
        for (int rr = 0; rr < 4; ++rr) { const int d = 32 * db + 8 * rr + 4 * hi;
            const float a = o[db][4 * rr] * il, b = o[db][4 * rr + 1] * il, cc = o[db][4 * rr + 2] * il, dd = o[db][4 * rr + 3] * il;
            if (OUTF32) *(f32x4*)((float*)Ob + (size_t)qrow * os + d) = (f32x4){a, b, cc, dd};
            else *(v2u*)((bf16*)Ob + (size_t)qrow * os + d) = (v2u){cvtpk_s(a, b), cvtpk_s(cc, dd)}; }
}

__device__ __forceinline__ void phase_att(const P& p, LAS unsigned char* lds, int layer) {
    unsigned char* wsb = opq_p(p.ws);
    layer = opq_s(layer);
    const int tid = tid_opaque(), lane = tid & 63, wave = __builtin_amdgcn_readfirstlane(tid >> 6), G = gridDim.x, blk = blockIdx.x;
    const int gw = wave * G + blk;
    const bool last = layer == DEPTH - 1;
    const bf16* COLS = (const bf16*)(wsb + WS_COLS);
    const bf16* QUP = (const bf16*)(wsb + WS_QUP); const bf16* KMN = (const bf16*)(wsb + WS_KMN);
    const bf16* VTD = (const bf16*)(wsb + WS_VTD); const bf16* VTG = (const bf16*)(wsb + WS_VTG); const bf16* VTM = (const bf16*)(wsb + WS_VTM);
    bf16* YMIX = (bf16*)(wsb + WS_YMIX); float* DIFFO = (float*)(wsb + WS_DIFFO);
    const f32x2* AB = (const f32x2*)(wsb + WS_AB);
    { f32x2* SUM = (f32x2*)(wsb + WS_SUM);
      for (int it = gw; it < NB * 2 * 36 * 8; it += NW * G) { const int g = it & 7, c = (it >> 3) % 36, dir = (it / 288) & 1, b = it / 576, ch = g * 64 + lane;
          const f32x2* ab = AB + ((size_t)dir * M + (size_t)b * PB + c * 64) * 512 + ch;
          float A = 1.f, H = 0.f;
          if (dir == 0) {
#pragma unroll 16
              for (int q = 0; q < 64; ++q) { const f32x2 cf = ab[(size_t)q * 512]; H = cf.x * H + cf.y; A *= cf.x; }
          } else {
#pragma unroll 16
              for (int q = 63; q >= 0; --q) { const f32x2 cf = ab[(size_t)q * 512]; H = cf.x * H + cf.y; A *= cf.x; }
          }
          const int ord = dir == 0 ? c : (c <= 3 ? 3 - c : 39 - c);
          SUM[(((size_t)dir * NB + b) * 40 + ord) * 512 + ch] = (f32x2){A, H}; } }
    for (int u = blk; u < 256; u += G) {
        const int xcd = u & 7, j = u >> 3, grp = xcd * 4 + (j >> 3), qb = j & 7, b = grp >> 3, hh = grp & 7, q0 = CTX + qb * 256;
        const size_t rb = (size_t)b * PB;
        attn_unit<96, 64, 0, false>(lds, QUP + rb * 768 + hh * 96, 768, KMN + rb * 512 + hh * 64, 512, COLS + rb * NINP + C_MKR, NINP, (const float*)(wsb + WS_ROPE) + SEQ * 64, VTM + ((size_t)b * 512 + hh * 64) * PB, YMIX + rb * 2048 + 512 + hh * 64, 2048, q0, 36, 0.10206207261596575f, 0.f, tid);
        for (int vh = 0; vh < 2; ++vh)
            attn_unit<64, 64, 0, true>(lds, COLS + rb * NINP + C_DQ + hh * 64, NINP, COLS + rb * NINP + C_DK + hh * 64, NINP, nullptr, 0, nullptr, VTD + ((size_t)b * 512 + (hh >> 1) * 128 + vh * 64) * PB, DIFFO + rb * 1024 + hh * 128 + vh * 64, 1024, q0, 36, 0.125f, 0.f, tid);
        attn_unit<64, 64, 1, false>(lds, COLS + rb * NINP + C_GQ + hh * 64, NINP, COLS + rb * NINP + C_GK + (hh >> 2) * 64, NINP, nullptr, 0, nullptr, VTG + ((size_t)b * 128 + (hh >> 2) * 64) * PB, YMIX + rb * 2048 + 1536 + hh * 64, 2048, q0, 0, 0.125f, p.in[22][layer * 8 + hh], tid);
    }
    if (!last) {
        for (int u = blk; u < 96; u += G) { const int kind = u >> 5, b = (u >> 3) & 3, hh = u & 7; const size_t rb = (size_t)b * PB;
            if (kind == 0) attn_unit<96, 64, 0, false>(lds, QUP + rb * 768 + hh * 96, 768, KMN + rb * 512 + hh * 64, 512, COLS + rb * NINP + C_MKR, NINP, nullptr, VTM + ((size_t)b * 512 + hh * 64) * PB, YMIX + rb * 2048 + 512 + hh * 64, 2048, 0, 4, 0.10206207261596575f, 0.f, tid);
            else if (kind == 1) { for (int vh = 0; vh < 2; ++vh) attn_unit<64, 64, 0, true>(lds, COLS + rb * NINP + C_DQ + hh * 64, NINP, COLS + rb * NINP + C_DK + hh * 64, NINP, nullptr, 0, nullptr, VTD + ((size_t)b * 512 + (hh >> 1) * 128 + vh * 64) * PB, DIFFO + rb * 1024 + hh * 128 + vh * 64, 1024, 0, 4, 0.125f, 0.f, tid); }
            else attn_unit<64, 64, 1, false>(lds, COLS + rb * NINP + C_GQ + hh * 64, NINP, COLS + rb * NINP + C_GK + (hh >> 2) * 64, NINP, nullptr, 0, nullptr, VTG + ((size_t)b * 128 + (hh >> 2) * 64) * PB, YMIX + rb * 2048 + 1536 + hh * 64, 2048, 0, 0, 0.125f, p.in[22][layer * 8 + hh], tid);
        }
    }
}

__device__ __forceinline__ void phase_mixfin(const P& p, LAS unsigned char* lds, int layer) {
    layer = opq_s(layer);
    unsigned char* wsb = opq_p(p.ws);
    const int tid = tid_opaque(), lane = tid & 63, wave = tid >> 6, G = gridDim.x, blk = blockIdx.x;
    const int gw = wave * G + blk, NGW = NW * G;
    const bool last = layer == DEPTH - 1;
    const bf16* COLS = (const bf16*)(wsb + WS_COLS); bf16* YMIX = (bf16*)(wsb + WS_YMIX); const float* DIFFO = (const float*)(wsb + WS_DIFFO);
    { const f32x2* AB = (const f32x2*)(wsb + WS_AB); const f32x2* SUM = (const f32x2*)(wsb + WS_SUM);
      LAS float* hf = (LAS float*)(lds + wave * 16384);
      for (int it = gw; it < NB * 36 * 8; it += NGW) { const int g = it & 7, c = (it >> 3) % 36, b = it / 288, ch = g * 64 + lane;
          if (last && c < 4) continue;
          { const f32x2* sm = SUM + (((size_t)0 * NB + b) * 40) * 512 + ch; float h = 0.f;
            for (int o = 0; o < c; ++o) { const f32x2 s = sm[(size_t)o * 512]; h = s.x * h + s.y; }
            const f32x2* ab = AB + ((size_t)0 * M + (size_t)b * PB + c * 64) * 512 + ch;
#pragma unroll 16
            for (int q = 0; q < 64; ++q) { const f32x2 cf = ab[(size_t)q * 512]; h = cf.x * h + cf.y; hf[q * 64 + lane] = h; } }
          { const int ord = c <= 3 ? 3 - c : 39 - c;
            const f32x2* sm = SUM + (((size_t)1 * NB + b) * 40) * 512 + ch; float h = 0.f;
            for (int o = 0; o < ord; ++o) { const f32x2 s = sm[(size_t)o * 512]; h = s.x * h + s.y; }
            const f32x2* ab = AB + ((size_t)1 * M + (size_t)b * PB + c * 64) * 512 + ch;
            LDS_WAIT();
#pragma unroll 8
            for (int q = 63; q >= 0; --q) { const f32x2 cf = ab[(size_t)q * 512]; h = cf.x * h + cf.y; const size_t row = (size_t)b * PB + c * 64 + q;
                const float gt = bf2f(COLS[row * NINP + C_GATE + ch]);
                YMIX[row * 2048 + ch] = (bf16)f2bf((hf[q * 64 + lane] + h) * gelu_tanh(gt)); } }
          LDS_WAIT(); } }
    const float* lv = p.in[20] + (size_t)layer * 4 * 64; const float* dg = p.in[21] + (size_t)layer * 128;
    const float lam_init = 0.8f - 0.6f * expf(-0.3f * (float)layer);
    const float lam = expf(wave_sum(lv[lane] * lv[64 + lane])) - expf(wave_sum(lv[128 + lane] * lv[192 + lane])) + lam_init;
    for (int row = gw; row < M; row += NGW) {
        const int pp = row % PB; if (last && pp < CTX) continue;
#pragma unroll
        for (int hh = 0; hh < 4; ++hh) { float o[2]; float s = 0.f;
#pragma unroll
            for (int j = 0; j < 2; ++j) { const int e = lane + 64 * j;
                o[j] = DIFFO[(size_t)row * 1024 + (2 * hh) * 128 + e] - lam * DIFFO[(size_t)row * 1024 + (2 * hh + 1) * 128 + e]; s += o[j] * o[j]; }
            s = wave_sum(s); const float rstd = 1.0f / sqrtf(s * (1.0f / 128.f) + 1e-6f);
#pragma unroll
            for (int j = 0; j < 2; ++j) { const int e = lane + 64 * j; YMIX[(size_t)row * 2048 + 1024 + hh * 128 + e] = (bf16)f2bf(o[j] * rstd * dg[e] * (1.0f - lam_init)); } }
    }
}

#define XB_TMO      128
#define XB_XCNT(j)  (256  + 64 * (j))
#define XB_XSUB(j)  (1280 + 64 * (j))
#define XB_XGEN(j)  (2304 + 64 * (j))
#define XB_TOP      3328
#define XB_TOPGEN   3392
#define XCD_BAR_WORDS 3456
#define XB_SPIN_CAP (1u << 18)

__device__ __forceinline__ unsigned xb_ld(unsigned* p)              { return __hip_atomic_load(p, __ATOMIC_RELAXED, __HIP_MEMORY_SCOPE_AGENT); }
__device__ __forceinline__ unsigned xb_add(unsigned* p, unsigned v) { return __hip_atomic_fetch_add(p, v, __ATOMIC_RELAXED, __HIP_MEMORY_SCOPE_AGENT); }
__device__ __forceinline__ unsigned xb_xcc_id() { return (unsigned)__builtin_amdgcn_s_getreg((3 << 11) | 20) & 0xFu; }
#define XB_SPIN(cond, bar) do { unsigned _sp = 0; while (cond) { __builtin_amdgcn_s_sleep(1); \
    if ((++_sp & 255u) == 0u) { if (xb_ld(&(bar)[XB_TMO])) break; if (_sp > XB_SPIN_CAP) { atomicAdd(&(bar)[XB_TMO], 1u); break; } } } } while (0)

struct XcdBarrier {
    unsigned* bar; unsigned x;
    volatile LAS unsigned* st;
};

__device__ __forceinline__ XcdBarrier xcd_barrier_post(unsigned* bar, volatile LAS unsigned* st) {
    XcdBarrier b; b.bar = bar; b.x = xb_xcc_id(); b.st = st;
    if (threadIdx.x == 0) (void)xb_add(&bar[XB_XCNT(b.x)], 1u);
    return b;
}
__device__ __forceinline__ void xcd_barrier_complete(unsigned* bar, unsigned x, unsigned& nloc, unsigned& nx) {
    const unsigned G = gridDim.x * gridDim.y * gridDim.z;
    unsigned sum, cnt, mine, sp = 0u;
    for (;;) {
        sum = 0u; cnt = 0u; mine = 0u;
#pragma unroll
        for (unsigned j = 0; j < 16; ++j) { const unsigned c = xb_ld(&bar[XB_XCNT(j)]); sum += c; cnt += (c > 0u) ? 1u : 0u; mine = (j == x) ? c : mine; }
        if (sum == G) break;
        __builtin_amdgcn_s_sleep(1);
        if ((++sp & 255u) == 0u) { if (xb_ld(&bar[XB_TMO])) break; if (sp > XB_SPIN_CAP) { atomicAdd(&bar[XB_TMO], 1u); break; } }
    }
    nloc = mine > 0u ? mine : 1u; nx = cnt > 0u ? cnt : 1u;
}

__device__ __forceinline__ void xcd_barrier(const XcdBarrier& b) {
    asm volatile("s_waitcnt vmcnt(0)" ::: "memory");
    __syncthreads();
    if (threadIdx.x == 0) {
        unsigned* bar = b.bar; const unsigned bx = xb_xcc_id();
        __builtin_amdgcn_s_waitcnt(0);
        unsigned nloc = b.st[0], nx = b.st[1];
        if (nloc == 0u) { xcd_barrier_complete(bar, bx, nloc, nx); b.st[0] = nloc; b.st[1] = nx; }
        const unsigned old = xb_add(&bar[XB_XSUB(bx)], 1u);
        const unsigned gen = old / nloc;
        if (old + 1u == (gen + 1u) * nloc) {
            __builtin_amdgcn_fence(__ATOMIC_RELEASE, "agent");
            asm volatile("s_waitcnt vmcnt(0)" ::: "memory");
            const unsigned og = xb_add(&bar[XB_TOP], 1u);
            const unsigned tg = og / nx;
            if (og + 1u == (tg + 1u) * nx) xb_add(&bar[XB_TOPGEN], 1u);
            else XB_SPIN(xb_ld(&bar[XB_TOPGEN]) == tg, bar);
            __builtin_amdgcn_fence(__ATOMIC_ACQUIRE, "agent");
            xb_add(&bar[XB_XGEN(bx)], 1u);
            asm volatile("s_waitcnt vmcnt(0)" ::: "memory");
        } else {
            XB_SPIN(xb_ld(&bar[XB_XGEN(bx)]) == gen, bar);
            __builtin_amdgcn_fence(__ATOMIC_ACQUIRE, "agent");
            asm volatile("s_waitcnt vmcnt(0)" ::: "memory");
        }
    }
    __syncthreads();
}

constexpr int CW_BAR = 4096;
constexpr size_t CTL_ZERO_BYTES = 1 * MiB;
constexpr int LDSCTL_OFF = 131072, MISC_OFF = LDSCTL_OFF + 320;

__global__ void __launch_bounds__(NT, 2) k_mega(P p) {
    extern __shared__ __attribute__((aligned(16))) unsigned char lds_raw[];
    LAS unsigned char* lds = (LAS unsigned char*)lds_raw;
    const KP kp = (KP)__builtin_amdgcn_kernarg_segment_ptr();
    for (int u = threadIdx.x; u < (LDS_BYTES - LDSCTL_OFF) / 4; u += NT) ((LAS unsigned*)(lds + LDSCTL_OFF))[u] = 0u;
    __syncthreads();
    unsigned* barw = (unsigned*)(p.ws + WS_CTL) + CW_BAR;
    XcdBarrier bar = xcd_barrier_post(barw, (volatile LAS unsigned*)(lds + MISC_OFF) + 8);
#define GB() xcd_barrier(bar)
    phase_pro1(load_P(kp), lds); GB();
    phase_pro2(load_P(kp)); GB();
    for (int l = 0; l < DEPTH; ++l) {
        for (int which = 0; which < 2; ++which) {
            phase_ffn_in(load_P(kp), lds, l, which); GB();
            phase_ffn_out(load_P(kp), lds, l, which); GB();
            phase_post(load_P(kp), l, which == 0 ? 0 : 2); GB();
            if (which == 0) {
                phase_inproj(load_P(kp), lds, l); GB();
                phase_prep(load_P(kp), lds, l); GB();
                phase_mgemm(load_P(kp), lds, l); GB();
                phase_att(load_P(kp), lds, l); GB();
                phase_mixfin(load_P(kp), lds, l); GB();
                phase_outproj(load_P(kp), lds, l); GB();
                phase_post(load_P(kp), l, 1); GB();
            }
        }
    }
#undef GB
    if (__hip_atomic_load(barw + XB_TMO, __ATOMIC_RELAXED, __HIP_MEMORY_SCOPE_AGENT) != 0u) {
        const float q = __builtin_nanf("");
        for (size_t i = (size_t)blockIdx.x * NT + threadIdx.x; i < (size_t)NB * SEQ * D; i += (size_t)gridDim.x * NT) p.out[i] = q;
    }
}

extern "C" void kernel_launch(void* const* d_in, const int* in_sizes, int n_in, void* d_out, int out_size, void* d_ws, size_t ws_size, hipStream_t stream) {
    static int grid = 0;
    if (grid == 0) {
        if (n_in != 23 || out_size != NB * SEQ * D || ws_size < WS_END) { fprintf(stderr, "kernel_launch: unexpected shapes (n_in %d out %d ws %zu need %zu)\n", n_in, out_size, ws_size, (size_t)WS_END); grid = -1; return; }
        int dev = 0, cus = 0, per_cu = 0;
        if (hipGetDevice(&dev) != hipSuccess || hipDeviceGetAttribute(&cus, hipDeviceAttributeMultiprocessorCount, dev) != hipSuccess) { grid = -1; return; }
        if (hipFuncSetAttribute((const void*)k_mega, hipFuncAttributeMaxDynamicSharedMemorySize, LDS_BYTES) != hipSuccess) { fprintf(stderr, "kernel_launch: hipFuncSetAttribute failed\n"); grid = -1; return; }
        if (hipOccupancyMaxActiveBlocksPerMultiprocessor(&per_cu, (const void*)k_mega, NT, LDS_BYTES) != hipSuccess || per_cu < 1)
            fprintf(stderr, "kernel_launch: note: occupancy query reports %d workgroups per CU\n", per_cu);
        (void)hipGetLastError();
        grid = cus;
    }
    if (grid < 0) return;
    if (hipMemsetAsync((char*)d_ws + WS_CTL, 0, CTL_ZERO_BYTES, stream) != hipSuccess) { fprintf(stderr, "kernel_launch: memset failed\n"); return; }
    P p{};
    for (int i = 0; i < 23; ++i) p.in[i] = (const float*)d_in[i];
    p.out = (float*)d_out; p.ws = (unsigned char*)d_ws;
    hipLaunchKernelGGL(k_mega, dim3(grid), dim3(NT), LDS_BYTES, stream, p);
}
```

```cpp
#include <hip/hip_runtime.h>
#include <cstdio>
#include <cstdint>
__device__ __forceinline__ int opq_s(int x) { asm volatile("" : "+s"(x)); return x; }
__device__ __forceinline__ unsigned char* opq_p(unsigned char* x) { asm volatile("" : "+s"(x)); return x; }
__device__ __forceinline__ int tid_opaque() { int t = (int)threadIdx.x; asm volatile("" : "+v"(t)); return t; }
namespace pg8 {
#define PG8_LAS __attribute__((address_space(3)))
typedef unsigned short bf16_t;
typedef short bf16x8 __attribute__((ext_vector_type(8)));
typedef float f32x4 __attribute__((ext_vector_type(4)));
typedef unsigned u32x4 __attribute__((ext_vector_type(4)));
constexpr int BM = 256, BK = 64, HALF = 128, HTB = HALF * BK * 2  , STAGE_BYTES = 8 * HTB, NXCD = 8, WGM = 8;

__host__ __device__ __forceinline__ int lds_byte(int r, int c) { const int st = (r >> 4) * 2 + (c >> 5), rr = r & 15, cc = c & 31, ob = rr * 64 + cc * 2; return st * 1024 + (ob ^ (((ob >> 9) & 1) << 5)); }
__host__ __device__ __forceinline__ void stage_rc(int b, int& R, int& C) { const int st = b / 1024, sb = b % 1024, swz = sb ^ (((sb >> 9) & 1) << 5); R = (st >> 1) * 16 + swz / 64; C = (st & 1) * 32 + (swz % 64) / 2; }
__host__ __device__ __forceinline__ int perm32(int rho) { const int n = rho >> 4, i = rho & 15; return 8 * (i >> 2) + 4 * n + (i & 3); }

struct Unit { int pm, pn; };
struct Gemm { const bf16_t* A; const bf16_t* Bt; int M, N, K, ld; };

struct StaticOrder {
    int nM, nN, nwg, G, c;
    __host__ __device__ void init(int M, int N, int G_, int c_) { nM = M / BM; nN = N / BM; nwg = nM * nN; G = G_; c = c_; }
    __host__ __device__ bool next(int i, Unit& u) const {
        const long L = (long)i * G + c; if (L >= nwg) return false;
        int wgid = (int)L; { const int q = nwg / NXCD, r = nwg % NXCD, xcd = wgid % NXCD, off = wgid / NXCD; wgid = (xcd < r ? xcd * (q + 1) : r * (q + 1) + (xcd - r) * q) + off; }
        const int nig = WGM * nN, gid = wgid / nig, fm = gid * WGM, gsz = (nM - fm) < WGM ? (nM - fm) : WGM;
        u.pm = fm + ((wgid % nig) % gsz); u.pn = (wgid % nig) / gsz; return true;
    }
    __device__ __forceinline__ void a_ready(const Unit&) const {}
    __device__ __forceinline__ void done(const Unit&) const {}
};

__device__ __forceinline__ unsigned cvt_pk_bf16(float lo, float hi) { unsigned r; asm volatile("v_cvt_pk_bf16_f32 %0, %1, %2" : "=v"(r) : "v"(lo), "v"(hi)); return r; }
typedef float f32x2 __attribute__((ext_vector_type(2)));
}
namespace pg8 {
template <class Epi, class Sched, bool ALIGN_EPI = false, bool SP2 = false>
__device__ __forceinline__ void gemm_phase(PG8_LAS unsigned char* lds, const Gemm g, const Sched& S, const Epi& E) {
    const int tid = tid_opaque(), wid = __builtin_amdgcn_readfirstlane(tid >> 6), lane = tid & 63, wr = wid >> 2, wc = wid & 3, fr = lane & 15, fq = lane >> 4;
    const int K = g.ld, nt = g.K / BK;
    unsigned voffA[2], voffB[2];
#pragma unroll
    for (int i = 0; i < 2; ++i) { int R, C; stage_rc(tid * 16 + i * 8192, R, C); const int Rb = Epi::PERM ? ((R & ~31) + perm32(R & 31)) : R;
        voffA[i] = (unsigned)(R * K + C) * 2u; voffB[i] = (unsigned)(Rb * K + C) * 2u; }
    const size_t kstep = (size_t)(BK * 2);
    const size_t hstep = (size_t)HALF * K * 2;
    const size_t tstep = 2 * hstep;
    const unsigned ldsw = (unsigned)wid * 1024u;
    const int aoff = lds_byte(wr * 64 + fr, fq * 8), boff = lds_byte(wc * 32 + fr, fq * 8);
#define PG8_SA(b, h) (((b) * 2 + (h)) * HTB)
#define PG8_SB(b, h) ((4 + (b) * 2 + (h)) * HTB)
#define PG8_STAGE(bufoff, gbase, voff) do { _Pragma("unroll") for (int _i = 0; _i < 2; ++_i) \
        __builtin_amdgcn_global_load_lds((const unsigned*)((const char*)(gbase) + (voff)[_i]), (PG8_LAS unsigned*)(lds + (bufoff) + ldsw + _i * 8192), 16, 0, 0); } while (0)
#define PG8_LDA(dst, b, h) do { _Pragma("unroll") for (int m = 0; m < 4; ++m) _Pragma("unroll") for (int k = 0; k < 2; ++k) dst[m][k] = *(const PG8_LAS bf16x8*)(lds + PG8_SA(b, h) + aoff + m * 2048 + k * 1024); } while (0)
#define PG8_LDB(dst, b, h) do { _Pragma("unroll") for (int n = 0; n < 2; ++n) _Pragma("unroll") for (int k = 0; k < 2; ++k) dst[n][k] = *(const PG8_LAS bf16x8*)(lds + PG8_SB(b, h) + boff + n * 2048 + k * 1024); } while (0)
#define PG8_MMA(ai, bj, At, Bt) do { __builtin_amdgcn_s_setprio(1); _Pragma("unroll") for (int m = 0; m < 4; ++m) _Pragma("unroll") for (int n = 0; n < 2; ++n) _Pragma("unroll") for (int k = 0; k < 2; ++k) \
        acc[ai][bj][m][n] = __builtin_amdgcn_mfma_f32_16x16x32_bf16(Bt[n][k], At[m][k], acc[ai][bj][m][n], 0, 0, 0); __builtin_amdgcn_s_setprio(0); } while (0)
#define PG8_WAIT_V(n) asm volatile("s_waitcnt vmcnt(" #n ")" ::: "memory")
#define PG8_WAIT_L(n) asm volatile("s_waitcnt lgkmcnt(" #n ")" ::: "memory")
#define PG8_BAR __builtin_amdgcn_s_barrier()
#define PG8_SCHED __builtin_amdgcn_sched_barrier(0)
    Unit cur, nxt; int ui = 0;
    if (!S.next(0, cur)) return;
    f32x4 acc[2][2][4][2];
#pragma unroll
    for (int a = 0; a < 2; ++a)
#pragma unroll
        for (int b = 0; b < 2; ++b)
#pragma unroll
            for (int m = 0; m < 4; ++m)
#pragma unroll
                for (int n = 0; n < 2; ++n) acc[a][b][m][n] = (f32x4){0.f, 0.f, 0.f, 0.f};
    bf16x8 At[4][2], B0[2][2], B1[2][2];
    const char* cA = (const char*)g.A + (size_t)cur.pm * tstep; const char* cB = (const char*)g.Bt + (size_t)cur.pn * tstep;
    S.a_ready(cur);
    if constexpr (SP2) {
        PG8_STAGE(PG8_SB(0, 0), cB, voffB); PG8_STAGE(PG8_SB(0, 1), cB + hstep, voffB); PG8_STAGE(PG8_SA(0, 0), cA, voffA); PG8_STAGE(PG8_SA(0, 1), cA + hstep, voffA);
        if (wr == 1) PG8_BAR;
        PG8_WAIT_V(2); PG8_BAR;
        PG8_STAGE(PG8_SB(1, 0), cB + kstep, voffB); PG8_STAGE(PG8_SA(1, 0), cA + kstep, voffA); PG8_STAGE(PG8_SB(1, 1), cB + hstep + kstep, voffB);
        PG8_WAIT_V(6); PG8_BAR;
    } else {
        PG8_STAGE(PG8_SB(0, 0), cB, voffB); PG8_STAGE(PG8_SA(0, 0), cA, voffA); PG8_STAGE(PG8_SB(0, 1), cB + hstep, voffB); PG8_STAGE(PG8_SA(0, 1), cA + hstep, voffA);
        if (wr == 1) PG8_BAR;
        PG8_WAIT_V(4); PG8_BAR;
        PG8_STAGE(PG8_SB(1, 0), cB + kstep, voffB); PG8_STAGE(PG8_SA(1, 0), cA + kstep, voffA); PG8_STAGE(PG8_SB(1, 1), cB + hstep + kstep, voffB);
        PG8_WAIT_V(6); PG8_BAR;
    }
    for (;;) {
        const bool has_next = S.next(ui + 1, nxt);
        const char* nA = has_next ? (const char*)g.A + (size_t)nxt.pm * tstep : cA; const char* nB = has_next ? (const char*)g.Bt + (size_t)nxt.pn * tstep : cB;
        for (int t = 0; t < nt; t += 2) {
            const bool last = (t == nt - 2);
            const char* a1 = cA + (size_t)(t + 1) * kstep;
            const char* a2 = last ? nA : cA + (size_t)(t + 2) * kstep; const char* b2 = last ? nB : cB + (size_t)(t + 2) * kstep;
            const char* a3 = a2 + kstep; const char* b3 = b2 + kstep;
            if (last && has_next) S.a_ready(nxt);
            if constexpr (SP2) {
            PG8_LDB(B0, 0, 0); PG8_LDB(B1, 0, 1); PG8_SCHED; PG8_LDA(At, 0, 0); PG8_STAGE(PG8_SA(1, 1), a1 + hstep, voffA);
            PG8_WAIT_V(8); PG8_WAIT_L(0); PG8_BAR; PG8_MMA(0, 0, At, B0); PG8_MMA(0, 1, At, B1); PG8_BAR; PG8_SCHED;
            PG8_LDA(At, 0, 1); PG8_STAGE(PG8_SB(0, 0), b2, voffB); PG8_STAGE(PG8_SB(0, 1), b2 + hstep, voffB); PG8_STAGE(PG8_SA(0, 0), a2, voffA);
            PG8_WAIT_V(8); PG8_WAIT_L(0); PG8_BAR; PG8_MMA(1, 0, At, B0); PG8_MMA(1, 1, At, B1); PG8_BAR; PG8_SCHED;
            PG8_LDB(B0, 1, 0); PG8_LDB(B1, 1, 1); PG8_SCHED; PG8_LDA(At, 1, 0); PG8_STAGE(PG8_SA(0, 1), a2 + hstep, voffA);
            PG8_WAIT_V(8); PG8_WAIT_L(0); PG8_BAR; PG8_MMA(0, 0, At, B0); PG8_MMA(0, 1, At, B1); PG8_BAR; PG8_SCHED;
            PG8_LDA(At, 1, 1); PG8_STAGE(PG8_SB(1, 0), b3, voffB); PG8_STAGE(PG8_SB(1, 1), b3 + hstep, voffB); PG8_STAGE(PG8_SA(1, 0), a3, voffA);
            PG8_WAIT_V(8); PG8_WAIT_L(0); PG8_BAR; PG8_MMA(1, 0, At, B0); PG8_MMA(1, 1, At, B1); PG8_BAR; PG8_SCHED;
            } else {
            PG8_LDB(B0, 0, 0); PG8_SCHED; PG8_LDA(At, 0, 0); PG8_STAGE(PG8_SA(1, 1), a1 + hstep, voffA);
            PG8_WAIT_L(8); PG8_BAR; PG8_WAIT_L(0); PG8_MMA(0, 0, At, B0); PG8_BAR; PG8_SCHED;
            PG8_LDB(B1, 0, 1); PG8_STAGE(PG8_SB(0, 0), b2, voffB);
            PG8_BAR; PG8_WAIT_L(0); PG8_MMA(0, 1, At, B1); PG8_BAR;
            PG8_LDA(At, 0, 1); PG8_STAGE(PG8_SA(0, 0), a2, voffA);
            PG8_BAR; PG8_WAIT_L(0); PG8_MMA(1, 0, At, B0); PG8_BAR; PG8_SCHED;
            PG8_STAGE(PG8_SB(0, 1), b2 + hstep, voffB);
            PG8_WAIT_V(6); PG8_BAR; PG8_MMA(1, 1, At, B1); PG8_BAR;
            PG8_LDB(B0, 1, 0); PG8_SCHED; PG8_LDA(At, 1, 0); PG8_STAGE(PG8_SA(0, 1), a2 + hstep, voffA);
            PG8_WAIT_L(8); PG8_BAR; PG8_WAIT_L(0); PG8_MMA(0, 0, At, B0); PG8_BAR; PG8_SCHED;
            PG8_LDB(B1, 1, 1); PG8_STAGE(PG8_SB(1, 0), b3, voffB);
            PG8_BAR; PG8_WAIT_L(0); PG8_MMA(0, 1, At, B1); PG8_BAR;
            PG8_LDA(At, 1, 1); PG8_STAGE(PG8_SA(1, 0), a3, voffA);
            PG8_BAR; PG8_WAIT_L(0); PG8_MMA(1, 0, At, B0); PG8_BAR; PG8_SCHED;
            PG8_STAGE(PG8_SB(1, 1), b3 + hstep, voffB);
            PG8_WAIT_V(6); PG8_BAR; PG8_MMA(1, 1, At, B1); PG8_BAR;
            }
        }
        if constexpr (ALIGN_EPI) { if (wr == 0) PG8_BAR; }
        if constexpr (!Epi::AFTER_DRAIN) { E(acc, cur, wr, wc, fr, fq); S.done(cur); }
        if (!has_next) break;
#pragma unroll
        for (int a = 0; a < 2; ++a)
#pragma unroll
            for (int b = 0; b < 2; ++b)
#pragma unroll
                for (int m = 0; m < 4; ++m)
#pragma unroll
                    for (int n = 0; n < 2; ++n) acc[a][b][m][n] = (f32x4){0.f, 0.f, 0.f, 0.f};
        cur = nxt; cA = nA; cB = nB; ++ui;
        if constexpr (ALIGN_EPI) { if (wr == 1) PG8_BAR; }
    }
    PG8_WAIT_V(0);
    if constexpr (!ALIGN_EPI) { if (wr == 0) PG8_BAR; }
    PG8_BAR;
    if constexpr (Epi::AFTER_DRAIN) { E.fused(acc, cur, wr, wc, fr, fq, lds, wid, lane); S.done(cur); }
#undef PG8_SA
#undef PG8_SB
#undef PG8_STAGE
#undef PG8_LDA
#undef PG8_LDB
#undef PG8_MMA
#undef PG8_WAIT_V
#undef PG8_WAIT_L
#undef PG8_BAR
#undef PG8_SCHED
}
}

#define GAS __attribute__((address_space(1)))
#define LAS __attribute__((address_space(3)))
typedef unsigned short bf16;
typedef unsigned v4u __attribute__((ext_vector_type(4)));
typedef unsigned v2u __attribute__((ext_vector_type(2)));
typedef float f32x4 __attribute__((ext_vector_type(4)));
typedef float f32x2 __attribute__((ext_vector_type(2)));

constexpr int D = 2048, NB = 4, SEQ = 2048, CTX = 256, PB = 2304, M = NB * PB, DEPTH = 4, DFF = 5632, NIN = 4000, NINP = 4096, NMODC = 9 * D;
constexpr int NT = 512, NW = 8;
constexpr int C_XB = 0, C_GATE = 512, C_MQ = 1024, C_MKV = 1408, C_MKR = 1664, C_DQ = 1696, C_DK = 2208, C_DV = 2720, C_GQ = 3232, C_GK = 3744, C_GV = 3872;

constexpr size_t MiB = 1u << 20;
constexpr size_t WS_CTL = 0;
constexpr size_t WS_MOD = 1 * MiB;
constexpr size_t WS_ROPE = 3 * MiB;
constexpr size_t WS_WFFI = 4 * MiB;
constexpr size_t WS_WFFO = WS_WFFI + 352 * MiB;
constexpr size_t WS_WIN = WS_WFFO + 176 * MiB;
constexpr size_t WS_WOUT = WS_WIN + 64 * MiB;
constexpr size_t WS_WQB = WS_WOUT + 32 * MiB;
constexpr size_t WS_WKVB = WS_WQB + 3 * MiB;
constexpr size_t WS_WG = WS_WKVB + 2 * MiB;
constexpr size_t WS_X = WS_WG + 8 * MiB;
constexpr size_t WS_H = WS_X + 72 * MiB;
constexpr size_t WS_ACT = WS_H + 36 * MiB;
constexpr size_t WS_Y = WS_ACT + 99 * MiB;
constexpr size_t WS_COLS = WS_Y + 72 * MiB;
constexpr size_t WS_U = WS_COLS + 72 * MiB;
constexpr size_t WS_GATES = WS_U + 9 * MiB;
constexpr size_t WS_QN = WS_GATES + 72 * MiB;
constexpr size_t WS_KVN = WS_QN + 7 * MiB;
constexpr size_t WS_QUP = WS_KVN + 5 * MiB;
constexpr size_t WS_KVUP = WS_QUP + 14 * MiB;
constexpr size_t WS_QM = WS_KVUP + 18 * MiB;
constexpr size_t WS_KM = WS_QM + 14 * MiB;
constexpr size_t WS_KMN = WS_KM;
constexpr size_t WS_AB = WS_KM + 14 * MiB;
constexpr size_t WS_HS = WS_AB + 72 * MiB;
constexpr size_t WS_DIFFO = WS_HS + 36 * MiB;
constexpr size_t WS_YMIX = WS_DIFFO + 36 * MiB;
constexpr size_t WS_VTD = WS_YMIX + 36 * MiB;
constexpr size_t WS_VTG = WS_VTD + 9 * MiB;
constexpr size_t WS_VTM = WS_VTG + 3 * MiB;
constexpr size_t WS_SUM = WS_VTM + 9 * MiB;
constexpr size_t WS_YP = WS_SUM + 2 * MiB;
constexpr size_t WS_END = WS_YP + 64 * MiB;

constexpr int LDS_BYTES = 147456;

struct P { const float* in[23]; float* out; unsigned char* ws; };
typedef const __attribute__((address_space(4))) P* KP;
__device__ __forceinline__ P load_P(KP kp) {
#if defined(__HIP_DEVICE_COMPILE__)
    asm volatile("" : "+s"(kp)); P r; for (int i = 0; i < 23; ++i) r.in[i] = kp->in[i]; r.out = kp->out; r.ws = kp->ws; return r;
#else
    (void)kp; return P{};
#endif
}

#define LDS_WAIT() asm volatile("s_waitcnt lgkmcnt(0)" ::: "memory")
__device__ __forceinline__ unsigned f2bf(float f) { unsigned u = __builtin_bit_cast(unsigned, f); return (u + 0x7fffu + ((u >> 16) & 1u)) >> 16; }
__device__ __forceinline__ unsigned pk2(float lo, float hi) { return f2bf(lo) | (f2bf(hi) << 16); }
__device__ __forceinline__ float bf2f(unsigned v) { return __builtin_bit_cast(float, v << 16); }
__device__ __forceinline__ float bflo(unsigned w) { return __builtin_bit_cast(float, w << 16); }
__device__ __forceinline__ float bfhi(unsigned w) { return __builtin_bit_cast(float, w & 0xffff0000u); }
template <int XM> __device__ __forceinline__ float swz_xor(float v) { return __builtin_bit_cast(float, __builtin_amdgcn_ds_swizzle(__builtin_bit_cast(int, v), (XM << 10) | 0x1f)); }
__device__ __forceinline__ void pl32swap(unsigned& a, unsigned& b) { asm volatile("s_nop 1\n\tv_permlane32_swap_b32 %0, %1\n\ts_nop 1" : "+v"(a), "+v"(b)); }
__device__ __forceinline__ float xhalf_sum(float v) { unsigned a = __builtin_bit_cast(unsigned, v), b = a; pl32swap(a, b); return __builtin_bit_cast(float, a) + __builtin_bit_cast(float, b); }
__device__ __forceinline__ float xhalf_max(float v) { unsigned a = __builtin_bit_cast(unsigned, v), b = a; pl32swap(a, b); return fmaxf(__builtin_bit_cast(float, a), __builtin_bit_cast(float, b)); }
__device__ __forceinline__ float wave_sum(float v) {
    v += swz_xor<1>(v); v += swz_xor<2>(v); v += swz_xor<4>(v); v += swz_xor<8>(v); v += swz_xor<16>(v);
    return xhalf_sum(v);
}
__device__ __forceinline__ float sigmoidf_(float x) { return 1.f / (1.f + __expf(-x)); }
__device__ __forceinline__ float siluf_(float x) { return x / (1.f + __expf(-x)); }
__device__ __forceinline__ float gelu_tanh(float x) { const float u = 0.7978845608028654f * (x + 0.044715f * x * x * x); return 0.5f * x * (1.f + tanhf(u)); }

struct TileOrder {
    pg8::StaticOrder so; int latonly;
    __device__ __forceinline__ void init(int nMt, int N, int G, int c, int lat) { so.nM = nMt; so.nN = N / 256; so.nwg = so.nM * so.nN; so.G = G; so.c = c; latonly = lat; }
    __device__ __forceinline__ bool next(int i, pg8::Unit& u) const { if (!so.next(i, u)) return false; if (latonly) u.pm = (u.pm >> 3) * 9 + 1 + (u.pm & 7); return true; }
    __device__ __forceinline__ void a_ready(const pg8::Unit&) const {}
    __device__ __forceinline__ void done(const pg8::Unit&) const {}
};
struct EpiF32 {
    static constexpr bool PERM = false, AFTER_DRAIN = false;
    float* C; int ldc;
    __device__ __forceinline__ void operator()(const f32x4 (&acc)[2][2][4][2], const pg8::Unit& u, int wr, int wc, int fr, int fq) const {
        const int row0 = u.pm * 256 + wr * 64 + fr, col0 = u.pn * 256 + wc * 32 + 4 * fq;
#pragma unroll
        for (int ai = 0; ai < 2; ++ai)
#pragma unroll
            for (int m = 0; m < 4; ++m) { float* rowp = C + (size_t)(row0 + ai * 128 + m * 16) * ldc + col0;
#pragma unroll
                for (int bj = 0; bj < 2; ++bj)
#pragma unroll
                    for (int n = 0; n < 2; ++n) *(f32x4*)(rowp + bj * 128 + n * 16) = acc[ai][bj][m][n]; }
    }
};
struct EpiB16 {
    static constexpr bool PERM = true, AFTER_DRAIN = false;
    bf16* O; int ldc;
    __device__ __forceinline__ void operator()(const f32x4 (&acc)[2][2][4][2], const pg8::Unit& u, int wr, int wc, int fr, int fq) const {
        const int row0 = u.pm * 256 + wr * 64 + fr, col0 = u.pn * 256 + wc * 32 + 8 * fq;
#pragma unroll
        for (int ai = 0; ai < 2; ++ai)
#pragma unroll
            for (int m = 0; m < 4; ++m) { bf16* rowp = O + (size_t)(row0 + ai * 128 + m * 16) * ldc + col0;
#pragma unroll
                for (int bj = 0; bj < 2; ++bj) { const f32x4 v0 = acc[ai][bj][m][0], v1 = acc[ai][bj][m][1];
                    v4u w; w.x = pg8::cvt_pk_bf16(v0[0], v0[1]); w.y = pg8::cvt_pk_bf16(v0[2], v0[3]); w.z = pg8::cvt_pk_bf16(v1[0], v1[1]); w.w = pg8::cvt_pk_bf16(v1[2], v1[3]);
                    *(v4u*)(rowp + bj * 128) = w; } }
    }
};
struct EpiSwiglu {
    static constexpr bool PERM = true, AFTER_DRAIN = false;
    bf16* O; int ldc;
    __device__ __forceinline__ void operator()(const f32x4 (&acc)[2][2][4][2], const pg8::Unit& u, int wr, int wc, int fr, int fq) const {
        const int row0 = u.pm * 256 + wr * 64 + fr, col0 = u.pn * 128 + wc * 32 + 8 * fq;
#pragma unroll
        for (int ai = 0; ai < 2; ++ai)
#pragma unroll
            for (int m = 0; m < 4; ++m) { bf16* rowp = O + (size_t)(row0 + ai * 128 + m * 16) * ldc + col0;
                float r[8];
#pragma unroll
                for (int n = 0; n < 2; ++n)
#pragma unroll
                    for (int e = 0; e < 4; ++e) { const float g = acc[ai][0][m][n][e], uu = acc[ai][1][m][n][e]; r[n * 4 + e] = siluf_(g) * uu; }
                v4u w; w.x = pg8::cvt_pk_bf16(r[0], r[1]); w.y = pg8::cvt_pk_bf16(r[2], r[3]); w.z = pg8::cvt_pk_bf16(r[4], r[5]); w.w = pg8::cvt_pk_bf16(r[6], r[7]);
                *(v4u*)rowp = w; }
    }
};

__device__ __forceinline__ void transpose_item(const float* W, int N, int K, bf16* WT, int k0, int n0, int drow0, LAS float* scr, int lane) {
#pragma unroll 8
    for (int i = 0; i < 32; ++i) { const int kk = 2 * i + (lane >> 5); scr[kk * 33 + (lane & 31)] = W[(size_t)(k0 + kk) * N + n0 + (lane & 31)]; }
    LDS_WAIT(); asm volatile("" ::: "memory");
    const int c = lane & 7;
#pragma unroll
    for (int j = 0; j < 4; ++j) { const int n = (lane >> 3) + 8 * j; const LAS float* s = scr + (8 * c) * 33 + n;
        v4u o; o.x = pk2(s[0 * 33], s[1 * 33]); o.y = pk2(s[2 * 33], s[3 * 33]); o.z = pk2(s[4 * 33], s[5 * 33]); o.w = pk2(s[6 * 33], s[7 * 33]);
        *(v4u*)(WT + (size_t)(drow0 + n) * K + k0 + 8 * c) = o; }
    LDS_WAIT(); asm volatile("" ::: "memory");
}

__device__ __forceinline__ void phase_pro1(const P& p, LAS unsigned char* lds) {
    unsigned char* wsb = opq_p(p.ws);
    const int tid = tid_opaque(), lane = tid & 63, wave = __builtin_amdgcn_readfirstlane(tid >> 6);
    const int G = gridDim.x, blk = blockIdx.x;
    {
        LAS float* sc = (LAS float*)lds;
        LAS float* red = (LAS float*)(lds + 40960);
        const float* c = p.in[1]; const float* cc = p.in[3];
        for (int i = tid; i < 5 * D; i += NT) { const int v = i / D, k = i % D; const float x = v < 4 ? c[v * D + k] : cc[k]; sc[i] = x / (1.f + expf(-x)); }
        __syncthreads();
        const float* wmod = p.in[4]; const float* bmod = p.in[5];
        float* MOD = (float*)(wsb + WS_MOD);
        for (int unit = blk; unit < DEPTH * 288; unit += G) {
            const int l = unit / 288, n0 = (unit % 288) * 64, kq = lane >> 4;
            const float* W = wmod + (size_t)l * D * NMODC + n0 + 4 * (lane & 15);
            float acc[5][4];
#pragma unroll
            for (int v = 0; v < 5; ++v)
#pragma unroll
                for (int e = 0; e < 4; ++e) acc[v][e] = 0.f;
            const int kbase = wave * 256 + kq;
#pragma unroll 4
            for (int i = 0; i < 64; ++i) { const int k = kbase + 4 * i; const f32x4 w = *(const f32x4*)(W + (size_t)k * NMODC);
#pragma unroll
                for (int v = 0; v < 5; ++v) { const float s = sc[v * D + k];
#pragma unroll
                    for (int e = 0; e < 4; ++e) acc[v][e] += s * w[e]; } }
#pragma unroll
            for (int v = 0; v < 5; ++v)
#pragma unroll
                for (int e = 0; e < 4; ++e) { float a = acc[v][e]; a += swz_xor<16>(a); a = xhalf_sum(a); acc[v][e] = a; }
            if (kq == 0) {
#pragma unroll
                for (int v = 0; v < 5; ++v)
#pragma unroll
                    for (int e = 0; e < 4; ++e) red[(wave * 5 + v) * 64 + 4 * (lane & 15) + e] = acc[v][e]; }
            __syncthreads();
            if (tid < 320) { const int v = tid / 64, col = tid % 64; float s = 0.f;
#pragma unroll
                for (int w = 0; w < 8; ++w) s += red[(w * 5 + v) * 64 + col];
                MOD[((size_t)l * 5 + v) * NMODC + n0 + col] = s + bmod[l * NMODC + n0 + col]; }
            __syncthreads();
        }
    }
    __syncthreads();
    {
        LAS float* scr = (LAS float*)(lds + wave * 16384);
        const int gw = wave * G + blk, NGW = NW * G;
        constexpr int I_FI = 32 * 352, I_FO = 88 * 64, I_IN = 32 * 125, I_OUT = 32 * 64, I_QB = 6 * 24, I_KVB = 4 * 32;
        constexpr int T_FI = 8 * I_FI, T_FO = 8 * I_FO, T_IN = 4 * I_IN, T_OUT = 4 * I_OUT, T_QB = 4 * I_QB, T_KVB = 4 * I_KVB;
        constexpr int NITEMS = T_FI + T_FO + T_IN + T_OUT + T_QB + T_KVB;
        for (int it = gw; it < NITEMS; it += NGW) {
            int r = it;
            if (r < T_FI) { const int mat = r / I_FI; r %= I_FI; const int kb = r / 352, nb = r % 352, n0 = nb * 32;
                const int half = n0 / DFF, cc = n0 % DFF, drow0 = (cc / 128) * 256 + half * 128 + (cc % 128);
                transpose_item(p.in[7] + (size_t)mat * D * (2 * DFF), 2 * DFF, D, (bf16*)(wsb + WS_WFFI) + (size_t)mat * (2 * DFF) * D, kb * 64, n0, drow0, scr, lane); continue; }
            r -= T_FI;
            if (r < T_FO) { const int mat = r / I_FO; r %= I_FO; const int kb = r / 64, nb = r % 64;
                transpose_item(p.in[8] + (size_t)mat * DFF * D, D, DFF, (bf16*)(wsb + WS_WFFO) + (size_t)mat * D * DFF, kb * 64, nb * 32, nb * 32, scr, lane); continue; }
            r -= T_FO;
            if (r < T_IN) { const int mat = r / I_IN; r %= I_IN; const int kb = r / 125, nb = r % 125;
                transpose_item(p.in[9] + (size_t)mat * D * NIN, NIN, D, (bf16*)(wsb + WS_WIN) + (size_t)mat * NINP * D, kb * 64, nb * 32, nb * 32, scr, lane); continue; }
            r -= T_IN;
            if (r < T_OUT) { const int mat = r / I_OUT; r %= I_OUT; const int kb = r / 64, nb = r % 64;
                transpose_item(p.in[10] + (size_t)mat * D * D, D, D, (bf16*)(wsb + WS_WOUT) + (size_t)mat * D * D, kb * 64, nb * 32, nb * 32, scr, lane); continue; }
            r -= T_OUT;
            if (r < T_QB) { const int mat = r / I_QB; r %= I_QB; const int kb = r / 24, nb = r % 24;
                transpose_item(p.in[17] + (size_t)mat * 384 * 768, 768, 384, (bf16*)(wsb + WS_WQB) + (size_t)mat * 768 * 384, kb * 64, nb * 32, nb * 32, scr, lane); continue; }
            r -= T_QB;
            { const int mat = r / I_KVB; r %= I_KVB; const int kb = r / 32, nb = r % 32;
                transpose_item(p.in[19] + (size_t)mat * 256 * 1024, 1024, 256, (bf16*)(wsb + WS_WKVB) + (size_t)mat * 1024 * 256, kb * 64, nb * 32, nb * 32, scr, lane); }
        }
    }
    {
        const int gt = blk * NT + tid, NGT = G * NT;
        for (int i = gt; i < DEPTH * 96 * (D / 8); i += NGT) { const int l = i / (96 * (D / 8)), r = i % (96 * (D / 8));
            *(v4u*)((bf16*)(wsb + WS_WIN) + ((size_t)l * NINP + NIN) * D + (size_t)r * 8) = (v4u){0u, 0u, 0u, 0u}; }
        const float* wg = p.in[13];
        for (int i = gt; i < DEPTH * 2048 * 64; i += NGT) { const int l = i / (2048 * 64), r = i % (2048 * 64), np = r / 64, k0 = (r % 64) * 8;
            const int c7 = np & 127, gate = (np >> 7) & 1, chunk = (np >> 8) & 3, dir = np >> 10, ch = chunk * 128 + c7, head = ch >> 6, j = ch & 63;
            v4u o = (v4u){0u, 0u, 0u, 0u};
            if ((k0 >> 6) == head) { const float* src = wg + ((((size_t)l * 2 + dir) * 2 + gate) * 8 + head) * 4096 + (size_t)(k0 & 63) * 64 + j;
                o.x = pk2(src[0], src[64]); o.y = pk2(src[128], src[192]); o.z = pk2(src[256], src[320]); o.w = pk2(src[384], src[448]); }
            *(v4u*)((bf16*)(wsb + WS_WG) + ((size_t)l * 2048 + np) * 512 + k0) = o; }
        float* rope = (float*)(wsb + WS_ROPE);
        for (int i = gt; i < SEQ * 32; i += NGT) { const int t = i / 32, k = i % 32; const float inv = powf(10000.f, -(float)(k & 15) / 16.f);
            const float ang = (k < 16 ? (float)(t / 64) : (float)(t % 64)) * inv; rope[i] = cosf(ang); rope[SEQ * 32 + i] = sinf(ang); }
        for (int i = gt; i < SEQ * 16; i += NGT) { const int t = i / 16, k = i % 16; const float inv = powf(10000.f, -(float)(k & 7) / 8.f);
            const float ang = (k < 8 ? (float)(t / 64) : (float)(t % 64)) * inv; rope[SEQ * 64 + i] = cosf(ang); rope[SEQ * 64 + SEQ * 16 + i] = sinf(ang); }
    }
}

__device__ __forceinline__ float row_rstd(const f32x4 (&v)[8]) {
    float s = 0.f;
#pragma unroll
    for (int j = 0; j < 8; ++j) s += (v[j][0] * v[j][0] + v[j][1] * v[j][1]) + (v[j][2] * v[j][2] + v[j][3] * v[j][3]);
    s = wave_sum(s);
    return 1.0f / sqrtf(s * (1.0f / D) + 1e-6f);
}
__device__ __forceinline__ void store_prenorm(bf16* hrow, int lane, const f32x4 (&v)[8], const float* g, const float* shift, const float* scale) {
    const float rstd = row_rstd(v);
#pragma unroll
    for (int j = 0; j < 8; ++j) { const int idx = lane + 64 * j;
        const f32x4 gg = ((const f32x4*)g)[idx], sh = ((const f32x4*)shift)[idx], sc = ((const f32x4*)scale)[idx];
        const f32x4 o = (v[j] * rstd) * gg * (sc + 1.0f) + sh;
        v2u w; w.x = pk2(o[0], o[1]); w.y = pk2(o[2], o[3]);
        *(v2u*)(hrow + 4 * idx) = w; }
}

__device__ __forceinline__ void phase_pro2(const P& p) {
    unsigned char* wsb = opq_p(p.ws);
    const int tid = tid_opaque(), lane = tid & 63, wave = tid >> 6, G = gridDim.x, blk = blockIdx.x;
    const int gw = wave * G + blk, NGW = NW * G;
    float* X = (float*)(wsb + WS_X); bf16* H = (bf16*)(wsb + WS_H); const float* MOD = (const float*)(wsb + WS_MOD);
    for (int row = gw; row < M; row += NGW) {
        const int b = row / PB, pp = row % PB; const bool isctx = pp < CTX; const int v = isctx ? 4 : b;
        const float* src = isctx ? p.in[2] + ((size_t)b * CTX + pp) * D : p.in[0] + ((size_t)b * SEQ + (pp - CTX)) * D;
        f32x4 xv[8];
#pragma unroll
        for (int j = 0; j < 8; ++j) xv[j] = ((const f32x4*)src)[lane + 64 * j];
#pragma unroll
        for (int j = 0; j < 8; ++j) ((f32x4*)(X + (size_t)row * D))[lane + 64 * j] = xv[j];
        const float* mod = MOD + ((size_t)0 * 5 + v) * NMODC;
        store_prenorm(H + (size_t)row * D, lane, xv, p.in[6] + (size_t)(0 * 6 + 0) * D, mod + 0 * D, mod + 1 * D);
    }
}

__device__ __forceinline__ void phase_post(const P& p, int layer, int s) {
    unsigned char* wsb = opq_p(p.ws);
    layer = opq_s(layer);
    const int tid = tid_opaque(), lane = tid & 63, wave = tid >> 6, G = gridDim.x, blk = blockIdx.x;
    const int gw = wave * G + blk, NGW = NW * G;
    float* X = (float*)(wsb + WS_X); bf16* H = (bf16*)(wsb + WS_H); const float* Y = (const float*)(wsb + WS_Y); const float* MOD = (const float*)(wsb + WS_MOD);
    const bool last = layer == DEPTH - 1, final = last && s == 2, split = !(last && s >= 1);
    const float wgt = (s == 1) ? 1.0f : 0.5f;
    const int l2 = (s < 2) ? layer : layer + 1, s2 = (s < 2) ? s + 1 : 0;
    for (int row = gw; row < M; row += NGW) {
        const int b = row / PB, pp = row % PB; const bool isctx = pp < CTX; const int v = isctx ? 4 : b;
        if (last && s >= 1 && isctx) continue;
        f32x4 yv[8], xv[8];
        if (split && row >= 8192) { const float* yp = (const float*)(wsb + WS_YP) + (size_t)(row - 8192) * D;
#pragma unroll
            for (int j = 0; j < 8; ++j) { f32x4 a = ((const f32x4*)yp)[lane + 64 * j];
#pragma unroll
                for (int sl = 1; sl < 8; ++sl) a += ((const f32x4*)(yp + (size_t)sl * 1024 * 2048))[lane + 64 * j];
                yv[j] = a; } }
        else {
#pragma unroll
            for (int j = 0; j < 8; ++j) yv[j] = ((const f32x4*)(Y + (size_t)row * D))[lane + 64 * j]; }
#pragma unroll
        for (int j = 0; j < 8; ++j) xv[j] = ((const f32x4*)(X + (size_t)row * D))[lane + 64 * j];
        const float rstd = row_rstd(yv);
        const float* gate = MOD + ((size_t)layer * 5 + v) * NMODC + (size_t)(3 * s + 2) * D;
        const float* gpost = p.in[6] + (size_t)(layer * 6 + 2 * s + 1) * D;
        float* dst = final ? p.out + ((size_t)b * SEQ + (pp - CTX)) * D : X + (size_t)row * D;
#pragma unroll
        for (int j = 0; j < 8; ++j) { const int idx = lane + 64 * j; const f32x4 ga = ((const f32x4*)gate)[idx], gp = ((const f32x4*)gpost)[idx];
            xv[j] = xv[j] + (ga * wgt) * ((yv[j] * rstd) * gp);
            ((f32x4*)dst)[idx] = xv[j]; }
        if (!final) { const float* mod = MOD + ((size_t)l2 * 5 + v) * NMODC;
            store_prenorm(H + (size_t)row * D, lane, xv, p.in[6] + (size_t)(l2 * 6 + 2 * s2) * D, mod + (size_t)(3 * s2) * D, mod + (size_t)(3 * s2 + 1) * D); }
    }
}

template <class Epi>
__device__ __forceinline__ void run_gemm(LAS unsigned char* lds, const bf16* A, const bf16* Bt, int nMt, int N, int K, int latonly, int coff, const Epi& E) {
    pg8::Gemm g{A, Bt, M, N, K, K};
    TileOrder S; S.init(nMt, N, (int)gridDim.x, (int)((blockIdx.x + coff) % gridDim.x), latonly);
    pg8::gemm_phase<Epi, TileOrder, true, true>(lds, g, S, E);
}
struct OneUnit { int pm, pn;
    __device__ __forceinline__ bool next(int i, pg8::Unit& u) const { if (i != 0) return false; u.pm = pm; u.pn = pn; return true; }
    __device__ __forceinline__ void a_ready(const pg8::Unit&) const {}
    __device__ __forceinline__ void done(const pg8::Unit&) const {}
};
__device__ __forceinline__ void run_gemm_n2048_split(LAS unsigned char* lds, const bf16* A, const bf16* Bt, int K, float* Y, float* YP) {
    { EpiF32 E{Y, D}; run_gemm(lds, A, Bt, 32, D, K, 0, 0, E); }
    __syncthreads();
    const int nkt = K / 64;
    for (int L = blockIdx.x; L < 256; L += gridDim.x) {
        const int s = L & 7, tile = L >> 3, pm = 32 + (tile >> 3), pn = tile & 7;
        const int per = nkt >> 3, odd = per & 1;
        const int kt0 = per * s + (odd ? (s & 1) : 0), nk = odd ? per + 1 - 2 * (s & 1) : per;
        pg8::Gemm g{A + (size_t)kt0 * 64, Bt + (size_t)kt0 * 64, M, D, nk * 64, K};
        OneUnit S{pm, pn};
        EpiF32 E{YP + (ptrdiff_t)s * (1024 * 2048) - (ptrdiff_t)(32 * 256) * 2048, D};
        pg8::gemm_phase<EpiF32, OneUnit, true, true>(lds, g, S, E);
        __syncthreads();
    }
}
__device__ __forceinline__ void phase_ffn_in(const P& p, LAS unsigned char* lds, int layer, int which) {
    unsigned char* wsb = opq_p(p.ws);
    layer = opq_s(layer);
    const bool lat = (layer == DEPTH - 1) && which == 1;
    EpiSwiglu E{(bf16*)(wsb + WS_ACT), DFF};
    run_gemm(lds, (const bf16*)(wsb + WS_H), (const bf16*)(wsb + WS_WFFI) + (size_t)(layer * 2 + which) * (2 * DFF) * D, lat ? 32 : 36, 2 * DFF, D, lat, 0, E);
}
__device__ __forceinline__ void phase_ffn_out(const P& p, LAS unsigned char* lds, int layer, int which) {
    unsigned char* wsb = opq_p(p.ws);
    layer = opq_s(layer);
    const bool lat = (layer == DEPTH - 1) && which == 1;
    const bf16* A = (const bf16*)(wsb + WS_ACT); const bf16* Bt = (const bf16*)(wsb + WS_WFFO) + (size_t)(layer * 2 + which) * D * DFF;
    if (lat) { EpiF32 E{(float*)(wsb + WS_Y), D}; run_gemm(lds, A, Bt, 32, D, DFF, 1, 0, E); }
    else run_gemm_n2048_split(lds, A, Bt, DFF, (float*)(wsb + WS_Y), (float*)(wsb + WS_YP));
}
__device__ __forceinline__ void phase_inproj(const P& p, LAS unsigned char* lds, int layer) {
    unsigned char* wsb = opq_p(p.ws);
    layer = opq_s(layer);
    EpiB16 E{(bf16*)(wsb + WS_COLS), NINP};
    run_gemm(lds, (const bf16*)(wsb + WS_H), (const bf16*)(wsb + WS_WIN) + (size_t)layer * NINP * D, 36, NINP, D, 0, 0, E);
}
__device__ __forceinline__ void phase_outproj(const P& p, LAS unsigned char* lds, int layer) {
    unsigned char* wsb = opq_p(p.ws);
    layer = opq_s(layer);
    const bool lat = (layer == DEPTH - 1);
    const bf16* A = (const bf16*)(wsb + WS_YMIX); const bf16* Bt = (const bf16*)(wsb + WS_WOUT) + (size_t)layer * D * D;
    if (lat) { EpiF32 E{(float*)(wsb + WS_Y), D}; run_gemm(lds, A, Bt, 32, D, D, 1, 0, E); }
    else run_gemm_n2048_split(lds, A, Bt, D, (float*)(wsb + WS_Y), (float*)(wsb + WS_YP));
}

__device__ __forceinline__ int lane_fresh() { unsigned ones = ~0u; asm volatile("" : "+s"(ones)); return (int)__builtin_amdgcn_mbcnt_hi(ones, __builtin_amdgcn_mbcnt_lo(ones, 0u)); }
struct EpiLru {
    static constexpr bool PERM = false, AFTER_DRAIN = false;
    f32x2* AB; const bf16* U; const float* bg; const float* lam;
    __device__ __forceinline__ void operator()(const f32x4 (&acc)[2][2][4][2], const pg8::Unit& u, int wr, int wc, int fr, int fq) const {
        { const int ln = lane_fresh(); fr = ln & 15; fq = ln >> 4; }
        const int dir = u.pn >> 2, ch0 = (u.pn & 3) * 128 + wc * 32 + 4 * fq, row0 = u.pm * 256 + wr * 64 + fr;
        float br[2][4], bi[2][4], sp8[2][4];
#pragma unroll
        for (int n = 0; n < 2; ++n)
#pragma unroll
            for (int e = 0; e < 4; ++e) { const int ch = ch0 + 16 * n + e; br[n][e] = bg[(dir * 2 + 0) * 512 + ch]; bi[n][e] = bg[(dir * 2 + 1) * 512 + ch]; const float ee = __expf(-lam[dir * 512 + ch]); sp8[n][e] = 8.0f * (ee < 0.03f ? ee * (1.0f - ee * (0.5f - ee * 0.33333333f)) : __logf(1.0f + ee)); }
#pragma unroll
        for (int ai = 0; ai < 2; ++ai)
#pragma unroll
            for (int m = 0; m < 4; ++m) { const size_t row = (size_t)(row0 + ai * 128 + m * 16);
#pragma unroll
                for (int n = 0; n < 2; ++n) { const v2u uw = *(const v2u*)(U + row * 512 + ch0 + 16 * n);
                    const float uu[4] = {bflo(uw.x), bfhi(uw.x), bflo(uw.y), bfhi(uw.y)};
                    float o[8];
#pragma unroll
                    for (int e = 0; e < 4; ++e) { const float gr = acc[ai][0][m][n][e] + br[n][e], gi = acc[ai][1][m][n][e] + bi[n][e];
                        const float r = __builtin_amdgcn_rcpf(1.f + __expf(-gr)), ig = __builtin_amdgcn_rcpf(1.f + __expf(-gi));
                        const float log_a = -r * sp8[n][e], x2 = 2.0f * log_a;
                        const float om = x2 > -0.1f ? -x2 * (1.0f + x2 * (0.5f + x2 * (0.16666667f + x2 * 0.041666667f))) : 1.0f - __expf(x2);
                        o[2 * e] = __expf(log_a); o[2 * e + 1] = __builtin_amdgcn_sqrtf(om) * (ig * uu[e]); }
                    f32x4* dst = (f32x4*)(AB + ((size_t)dir * M + row) * 512 + ch0 + 16 * n);
                    dst[0] = (f32x4){o[0], o[1], o[2], o[3]}; dst[1] = (f32x4){o[4], o[5], o[6], o[7]}; } }
    }
};
struct EpiKvup {
    static constexpr bool PERM = true, AFTER_DRAIN = false;
    bf16* KMN; bf16* VTM;
    __device__ __forceinline__ void operator()(const f32x4 (&acc)[2][2][4][2], const pg8::Unit& u, int wr, int wc, int fr, int fq) const {
        { const int ln = lane_fresh(); fr = ln & 15; fq = ln >> 4; }
        const int row0 = u.pm * 256 + wr * 64 + fr, b = u.pm / 9, p0 = (u.pm % 9) * 256 + wr * 64 + fr;
#pragma unroll
        for (int ai = 0; ai < 2; ++ai)
#pragma unroll
            for (int m = 0; m < 4; ++m) { const size_t row = (size_t)(row0 + ai * 128 + m * 16); const int pp = p0 + ai * 128 + m * 16;
#pragma unroll
                for (int bj = 0; bj < 2; ++bj) { const int h = 2 * u.pn + bj; const f32x4 v0 = acc[ai][bj][m][0], v1 = acc[ai][bj][m][1];
                    if (wc < 2) { v4u w; w.x = pg8::cvt_pk_bf16(v0[0], v0[1]); w.y = pg8::cvt_pk_bf16(v0[2], v0[3]); w.z = pg8::cvt_pk_bf16(v1[0], v1[1]); w.w = pg8::cvt_pk_bf16(v1[2], v1[3]);
                        *(v4u*)(KMN + row * 512 + h * 64 + wc * 32 + 8 * fq) = w; }
                    else { bf16* vt = VTM + ((size_t)b * 512 + h * 64 + (wc - 2) * 32 + 8 * fq) * PB + pp;
                        vt[0 * (size_t)PB] = (bf16)f2bf(v0[0]); vt[1 * (size_t)PB] = (bf16)f2bf(v0[1]); vt[2 * (size_t)PB] = (bf16)f2bf(v0[2]); vt[3 * (size_t)PB] = (bf16)f2bf(v0[3]);
                        vt[4 * (size_t)PB] = (bf16)f2bf(v1[0]); vt[5 * (size_t)PB] = (bf16)f2bf(v1[1]); vt[6 * (size_t)PB] = (bf16)f2bf(v1[2]); vt[7 * (size_t)PB] = (bf16)f2bf(v1[3]); } } }
    }
};
__device__ __forceinline__ void phase_mgemm(const P& p, LAS unsigned char* lds, int layer) {
    unsigned char* wsb = opq_p(p.ws);
    layer = opq_s(layer);
    { EpiB16 E{(bf16*)(wsb + WS_QUP), 768};
      run_gemm(lds, (const bf16*)(wsb + WS_QN), (const bf16*)(wsb + WS_WQB) + (size_t)layer * 768 * 384, 36, 768, 384, 0, 0, E); }
    __syncthreads();
    { EpiKvup E{(bf16*)(wsb + WS_KMN), (bf16*)(wsb + WS_VTM)};
      run_gemm(lds, (const bf16*)(wsb + WS_KVN), (const bf16*)(wsb + WS_WKVB) + (size_t)layer * 1024 * 256, 36, 1024, 256, 0, 148, E); }
    __syncthreads();
    { EpiLru E{(f32x2*)(wsb + WS_AB), (const bf16*)(wsb + WS_U), p.in[14] + (size_t)layer * 2 * 2 * 512, p.in[15] + (size_t)layer * 2 * 512};
      run_gemm(lds, (const bf16*)(wsb + WS_U), (const bf16*)(wsb + WS_WG) + (size_t)layer * 2048 * 512, 36, 2048, 512, 0, 0, E); }
}


__device__ __forceinline__ void transpose_tok_item(const bf16* src, int ss, bf16* dst, LAS unsigned short* scr, int lane) {
#pragma unroll
    for (int i = 0; i < 8; ++i) { const int id = lane + 64 * i, row = id >> 3, ch = id & 7;
        const v4u w = *(const v4u*)(src + (size_t)row * ss + ch * 8);
        LAS unsigned* d = (LAS unsigned*)(scr + row * 66 + ch * 8);
        d[0] = w.x; d[1] = w.y; d[2] = w.z; d[3] = w.w; }
    LDS_WAIT(); asm volatile("" ::: "memory");
#pragma unroll
    for (int i = 0; i < 8; ++i) { const int id = lane + 64 * i, e = id >> 3, ch = id & 7;
        unsigned v[8];
#pragma unroll
        for (int k = 0; k < 8; ++k) v[k] = scr[(ch * 8 + k) * 66 + e];
        v4u w; w.x = v[0] | (v[1] << 16); w.y = v[2] | (v[3] << 16); w.z = v[4] | (v[5] << 16); w.w = v[6] | (v[7] << 16);
        *(v4u*)(dst + (size_t)e * PB + ch * 8) = w; }
    LDS_WAIT(); asm volatile("" ::: "memory");
}
__device__ __forceinline__ void phase_prep(const P& p, LAS unsigned char* lds, int layer) {
    unsigned char* wsb = opq_p(p.ws);
    layer = opq_s(layer);
    const int tid = tid_opaque(), lane = tid & 63, wave = tid >> 6, G = gridDim.x, blk = blockIdx.x;
    const int gw = wave * G + blk, NGW = NW * G;
    bf16* COLS = (bf16*)(wsb + WS_COLS); bf16* U = (bf16*)(wsb + WS_U); bf16* QN = (bf16*)(wsb + WS_QN); bf16* KVN = (bf16*)(wsb + WS_KVN);
    const float* rope = (const float*)(wsb + WS_ROPE);
    const float* cw = p.in[11] + (size_t)layer * 4 * 512; const float* cb = p.in[12] + (size_t)layer * 512;
    const float* qg = p.in[16] + (size_t)layer * 384; const float* kvg = p.in[18] + (size_t)layer * 256;
    auto unpack8 = [](const v4u& w, float (&f)[8]) { f[0] = bflo(w.x); f[1] = bfhi(w.x); f[2] = bflo(w.y); f[3] = bfhi(w.y); f[4] = bflo(w.z); f[5] = bfhi(w.z); f[6] = bflo(w.w); f[7] = bfhi(w.w); };
    auto pack8 = [](const float (&f)[8]) { v4u w; w.x = pk2(f[0], f[1]); w.y = pk2(f[2], f[3]); w.z = pk2(f[4], f[5]); w.w = pk2(f[6], f[7]); return w; };
    for (int row = gw; row < M; row += NGW) {
        const int pp = row % PB; const bool isctx = pp < CTX;
        const int lo = isctx ? 0 : CTX, hi = isctx ? CTX : PB;
        bf16* crow = COLS + (size_t)row * NINP;
        { float acc[8];
          { const f32x4 b0 = *(const f32x4*)(cb + 8 * lane), b1 = *(const f32x4*)(cb + 8 * lane + 4);
            acc[0] = b0[0]; acc[1] = b0[1]; acc[2] = b0[2]; acc[3] = b0[3]; acc[4] = b1[0]; acc[5] = b1[1]; acc[6] = b1[2]; acc[7] = b1[3]; }
#pragma unroll
          for (int j = 0; j < 4; ++j) { const int q = pp + j - 2;
              if (q >= lo && q < hi) { float xv[8]; unpack8(*(const v4u*)(crow + (ptrdiff_t)(j - 2) * NINP + C_XB + 8 * lane), xv);
                  const f32x4 w0 = *(const f32x4*)(cw + j * 512 + 8 * lane), w1 = *(const f32x4*)(cw + j * 512 + 8 * lane + 4);
#pragma unroll
                  for (int e = 0; e < 4; ++e) { acc[e] += w0[e] * xv[e]; acc[4 + e] += w1[e] * xv[4 + e]; } } }
          *(v4u*)(U + (size_t)row * 512 + 8 * lane) = pack8(acc); }
        { float v[8]; float s = 0.f; const int l8 = lane < 48 ? lane : 47;
          unpack8(*(const v4u*)(crow + C_MQ + 8 * l8), v);
          if (lane < 48) {
#pragma unroll
              for (int e = 0; e < 8; ++e) s += v[e] * v[e]; }
          s = wave_sum(s); const float rstd = 1.0f / sqrtf(s * (1.0f / 384.f) + 1e-6f);
          const f32x4 g0 = *(const f32x4*)(qg + 8 * l8), g1 = *(const f32x4*)(qg + 8 * l8 + 4);
#pragma unroll
          for (int e = 0; e < 4; ++e) { v[e] = v[e] * rstd * g0[e]; v[4 + e] = v[4 + e] * rstd * g1[e]; }
          if (lane < 48) *(v4u*)(QN + (size_t)row * 384 + 8 * lane) = pack8(v); }
        { float v[8]; float s = 0.f; const int l8 = lane & 31;
          unpack8(*(const v4u*)(crow + C_MKV + 8 * l8), v);
          if (lane < 32) {
#pragma unroll
              for (int e = 0; e < 8; ++e) s += v[e] * v[e]; }
          s = wave_sum(s); const float rstd = 1.0f / sqrtf(s * (1.0f / 256.f) + 1e-6f);
          const f32x4 g0 = *(const f32x4*)(kvg + 8 * l8), g1 = *(const f32x4*)(kvg + 8 * l8 + 4);
#pragma unroll
          for (int e = 0; e < 4; ++e) { v[e] = v[e] * rstd * g0[e]; v[4 + e] = v[4 + e] * rstd * g1[e]; }
          if (lane < 32) *(v4u*)(KVN + (size_t)row * 256 + 8 * lane) = pack8(v); }
        if (!isctx) { const int t = pp - CTX; const int c = lane & 3, hsub = lane >> 2;
            const float* ct = rope + (size_t)t * 32 + 8 * c; const float* st = ct + SEQ * 32;
            const f32x4 c0 = *(const f32x4*)ct, c1 = *(const f32x4*)(ct + 4), s0 = *(const f32x4*)st, s1 = *(const f32x4*)(st + 4);
            const float cs[8] = {c0[0], c0[1], c0[2], c0[3], c1[0], c1[1], c1[2], c1[3]}, sn[8] = {s0[0], s0[1], s0[2], s0[3], s1[0], s1[1], s1[2], s1[3]};
#pragma unroll
            for (int k = 0; k < 2; ++k) { const int hd = 16 * k + hsub;
                if (hd < 26) { bf16* hp = crow + (hd < 16 ? C_DQ + hd * 64 : C_GQ + (hd - 16) * 64) + 8 * c;
                    float a[8], b[8], o1[8], o2[8]; unpack8(*(const v4u*)hp, a); unpack8(*(const v4u*)(hp + 32), b);
#pragma unroll
                    for (int e = 0; e < 8; ++e) { o1[e] = a[e] * cs[e] - b[e] * sn[e]; o2[e] = a[e] * sn[e] + b[e] * cs[e]; }
                    *(v4u*)hp = pack8(o1); *(v4u*)(hp + 32) = pack8(o2); } }
            if (lane < 2) { const float* ct2 = rope + SEQ * 64 + (size_t)t * 16 + 8 * lane; const float* st2 = ct2 + SEQ * 16;
                const f32x4 d0 = *(const f32x4*)ct2, d1 = *(const f32x4*)(ct2 + 4), e0 = *(const f32x4*)st2, e1 = *(const f32x4*)(st2 + 4);
                const float cs2[8] = {d0[0], d0[1], d0[2], d0[3], d1[0], d1[1], d1[2], d1[3]}, sn2[8] = {e0[0], e0[1], e0[2], e0[3], e1[0], e1[1], e1[2], e1[3]};
                bf16* hp = crow + C_MKR + 8 * lane;
                float a[8], b[8], o1[8], o2[8]; unpack8(*(const v4u*)hp, a); unpack8(*(const v4u*)(hp + 16), b);
#pragma unroll
                for (int e = 0; e < 8; ++e) { o1[e] = a[e] * cs2[e] - b[e] * sn2[e]; o2[e] = a[e] * sn2[e] + b[e] * cs2[e]; }
                *(v4u*)hp = pack8(o1); *(v4u*)(hp + 16) = pack8(o2); }
        }
    }
    { LAS unsigned short* scr = (LAS unsigned short*)(lds + wave * 16384);
      bf16* VTD = (bf16*)(wsb + WS_VTD); bf16* VTG = (bf16*)(wsb + WS_VTG);
      for (int it = gw; it < NB * 36 * 10; it += NGW) { const int b = it / 360, r = it % 360, tb = r / 10, cb = r % 10;
          const bf16* s = COLS + ((size_t)b * PB + tb * 64) * NINP + (cb < 8 ? C_DV + cb * 64 : C_GV + (cb - 8) * 64);
          bf16* d = cb < 8 ? VTD + ((size_t)b * 512 + cb * 64) * PB + tb * 64 : VTG + ((size_t)b * 128 + (cb - 8) * 64) * PB + tb * 64;
          transpose_tok_item(s, NINP, d, scr, lane); } }
}

__device__ __forceinline__ void phase_prep2(const P& p, LAS unsigned char* lds, int layer) {
    unsigned char* wsb = opq_p(p.ws);
    layer = opq_s(layer);
    const int tid = tid_opaque(), lane = tid & 63, wave = tid >> 6, G = gridDim.x, blk = blockIdx.x;
    const int gw = wave * G + blk, NGW = NW * G;
    const bf16* COLS = (const bf16*)(wsb + WS_COLS); const bf16* U = (const bf16*)(wsb + WS_U);
    const bf16* QUP = (const bf16*)(wsb + WS_QUP); const bf16* KVUP = (const bf16*)(wsb + WS_KVUP);
    bf16* QM = (bf16*)(wsb + WS_QM); bf16* KM = (bf16*)(wsb + WS_KM);
    const float* GATES = (const float*)(wsb + WS_GATES); f32x2* AB = (f32x2*)(wsb + WS_AB);
    const float* rope = (const float*)(wsb + WS_ROPE);
    const float* bg = p.in[14] + (size_t)layer * 2 * 2 * 512; const float* lam = p.in[15] + (size_t)layer * 2 * 512;
    for (int row = gw; row < M; row += NGW) {
        const int pp = row % PB; const bool isctx = pp < CTX; const int t = pp - CTX;
#pragma unroll
        for (int j = 0; j < 12; ++j) { const int e = lane + 64 * j, h = e / 96, d = e % 96;
            float qv = bf2f(QUP[(size_t)row * 768 + e]);
            if (d >= 64 && !isctx) { const int i = (d - 64) & 15; const bool second = (d - 64) >= 16;
                const float c = rope[SEQ * 64 + t * 16 + i], sn = rope[SEQ * 64 + SEQ * 16 + t * 16 + i];
                const float x1 = bf2f(QUP[(size_t)row * 768 + h * 96 + 64 + i]), x2 = bf2f(QUP[(size_t)row * 768 + h * 96 + 80 + i]);
                qv = second ? (x1 * sn + x2 * c) : (x1 * c - x2 * sn); }
            QM[(size_t)row * 768 + e] = (bf16)f2bf(qv);
            KM[(size_t)row * 768 + e] = d < 64 ? KVUP[(size_t)row * 1024 + h * 128 + d] : COLS[(size_t)row * NINP + C_MKR + (d - 64)]; }
#pragma unroll
        for (int dir = 0; dir < 2; ++dir)
#pragma unroll
            for (int cblk = 0; cblk < 8; ++cblk) { const int ch = cblk * 64 + lane;
                const float* gp = GATES + (size_t)row * 2048 + ((dir * 4 + (ch >> 7)) * 2) * 128 + (ch & 127);
                const float gr = gp[0] + bg[(dir * 2 + 0) * 512 + ch], gi = gp[128] + bg[(dir * 2 + 1) * 512 + ch];
                const float r = 1.f / (1.f + expf(-gr)), ig = 1.f / (1.f + expf(-gi));
                const float sp = log1pf(expf(-lam[dir * 512 + ch]));
                const float log_a = -8.0f * r * sp, a = expf(log_a);
                const float u = bf2f(U[(size_t)row * 512 + ch]);
                const float bco = sqrtf(-expm1f(2.0f * log_a)) * (ig * u);
                AB[((size_t)dir * M + row) * 512 + ch] = (f32x2){a, bco}; }
    }
    { LAS unsigned short* scr = (LAS unsigned short*)(lds + wave * 16384);
      bf16* VTM = (bf16*)(wsb + WS_VTM);
      for (int it = gw; it < NB * 36 * 8; it += NGW) { const int b = it / 288, r = it % 288, tb = r / 8, hh = r % 8;
          transpose_tok_item(KVUP + ((size_t)b * PB + tb * 64) * 1024 + hh * 128 + 64, 1024, VTM + ((size_t)b * 512 + hh * 64) * PB + tb * 64, scr, lane); } }
}

template <int DQK, int DV, int MODE, bool OUTF32>
__device__ __forceinline__ void naive_attn(const bf16* Q, int qs, const bf16* K, int ks, const bf16* V, int vs, void* O, int os,
                                           int b, int pp0, int lane, float scale, float sink) {
    const size_t rowbase = (size_t)b * PB; const int pp = pp0 + lane;
    float q[DQK], o[DV];
    { const bf16* qr = Q + (rowbase + pp) * qs;
#pragma unroll
      for (int c = 0; c < DQK / 8; ++c) { const v4u w = *(const v4u*)(qr + 8 * c);
          q[8 * c + 0] = bflo(w.x); q[8 * c + 1] = bfhi(w.x); q[8 * c + 2] = bflo(w.y); q[8 * c + 3] = bfhi(w.y);
          q[8 * c + 4] = bflo(w.z); q[8 * c + 5] = bfhi(w.z); q[8 * c + 6] = bflo(w.w); q[8 * c + 7] = bfhi(w.w); } }
    const float sl2 = scale * 1.4426950408889634f;
#pragma unroll
    for (int d = 0; d < DQK; ++d) q[d] *= sl2;
#pragma unroll
    for (int e = 0; e < DV; ++e) o[e] = 0.f;
    float m = (MODE == 1) ? sink * 1.4426950408889634f : -1e30f, l = (MODE == 1) ? 1.f : 0.f;
    const bool isctx = pp0 < CTX; const int t = pp - CTX, t0 = pp0 - CTX;
    for (int seg = 0; seg < 2; ++seg) {
        int k0, k1;
        if (seg == 0) { k0 = 0; k1 = CTX; }
        else { if (isctx) break;
            if (MODE == 0) { k0 = CTX; k1 = PB; }
            else { const int a0 = t0 - 128 < 0 ? 0 : t0 - 128, a1 = t0 + 63 + 128 > SEQ - 1 ? SEQ - 1 : t0 + 63 + 128; k0 = CTX + a0; k1 = CTX + a1 + 1; } }
        for (int key = k0; key < k1; ++key) {
            const bf16* kr = K + (rowbase + key) * ks; const bf16* vr = V + (rowbase + key) * vs;
            asm volatile("" : "+v"(kr)); asm volatile("" : "+v"(vr));
            float s = 0.f;
#pragma unroll
            for (int c = 0; c < DQK / 8; ++c) { const v4u w = *(const v4u*)(kr + 8 * c);
                s += q[8 * c + 0] * bflo(w.x); s += q[8 * c + 1] * bfhi(w.x); s += q[8 * c + 2] * bflo(w.y); s += q[8 * c + 3] * bfhi(w.y);
                s += q[8 * c + 4] * bflo(w.z); s += q[8 * c + 5] * bfhi(w.z); s += q[8 * c + 6] * bflo(w.w); s += q[8 * c + 7] * bfhi(w.w); }
            bool valid = true;
            if (MODE == 1 && seg == 1) { const int rel = (key - CTX) - t; valid = (rel <= 128) && (rel >= -128); }
            if (valid) {
                const float mn = fmaxf(m, s), alpha = exp2f(m - mn), pr = exp2f(s - mn);
                l = l * alpha + pr; m = mn;
#pragma unroll
                for (int c = 0; c < DV / 8; ++c) { const v4u w = *(const v4u*)(vr + 8 * c);
                    o[8 * c + 0] = o[8 * c + 0] * alpha + pr * bflo(w.x); o[8 * c + 1] = o[8 * c + 1] * alpha + pr * bfhi(w.x);
                    o[8 * c + 2] = o[8 * c + 2] * alpha + pr * bflo(w.y); o[8 * c + 3] = o[8 * c + 3] * alpha + pr * bfhi(w.y);
                    o[8 * c + 4] = o[8 * c + 4] * alpha + pr * bflo(w.z); o[8 * c + 5] = o[8 * c + 5] * alpha + pr * bfhi(w.z);
                    o[8 * c + 6] = o[8 * c + 6] * alpha + pr * bflo(w.w); o[8 * c + 7] = o[8 * c + 7] * alpha + pr * bfhi(w.w); }
            }
        }
    }
    const float il = 1.f / l;
    if (OUTF32) { float* orow = (float*)O + (rowbase + pp) * os;
#pragma unroll
        for (int e = 0; e < DV; e += 4) *(f32x4*)(orow + e) = (f32x4){o[e] * il, o[e + 1] * il, o[e + 2] * il, o[e + 3] * il}; }
    else { bf16* orow = (bf16*)O + (rowbase + pp) * os;
#pragma unroll
        for (int e = 0; e < DV; e += 8) { v4u w; w.x = pk2(o[e] * il, o[e + 1] * il); w.y = pk2(o[e + 2] * il, o[e + 3] * il); w.z = pk2(o[e + 4] * il, o[e + 5] * il); w.w = pk2(o[e + 6] * il, o[e + 7] * il);
            *(v4u*)(orow + e) = w; } }
}


typedef short bf16x8 __attribute__((ext_vector_type(8)));
typedef float f32x16 __attribute__((ext_vector_type(16)));
__device__ __forceinline__ int crow16(int r, int hi) { return (r & 3) + 8 * (r >> 2) + 4 * hi; }

typedef __bf16 bf16x2_t __attribute__((ext_vector_type(2)));
__device__ __forceinline__ unsigned cvtpk_s(float lo, float hi) { const f32x2 v = {lo, hi}; const bf16x2_t b = __builtin_convertvector(v, bf16x2_t); return __builtin_bit_cast(unsigned, b); }
template <int DQK, int DV, int MODE, bool OUTF32>
__device__ __forceinline__ void attn_unit(LAS unsigned char* lds, const bf16* Qb, int qs, const bf16* Kb, int ks, const bf16* Kb2, int ks2, const float* ropeq, const bf16* VTb, void* Ob, int os,
                                          int q0, int ntd, float scale, float sink, int tid_in) {
    int tid = tid_in; asm volatile("" : "+v"(tid));
    constexpr int RSK = DQK * 2 + 16, RSV = 136, KBUF = 64 * RSK, VBUF = DV * RSV, CPR = DQK / 8, NKC = 64 * CPR, NVC = DV * 8;
    constexpr int NKI = (NKC + NT - 1) / NT, NVI = NVC / NT, ND0 = DQK / 16, NDB = DV / 32;
    const int lane = tid & 63, wave = __builtin_amdgcn_readfirstlane(tid >> 6), r32 = lane & 31, hi = lane >> 5;
    int ta = 4, ntiles = ntd;
    if (MODE == 1) { if (q0 < CTX) ntiles = 4; else { const int t0 = q0 - CTX; const int lo = t0 - 128 < 0 ? 0 : t0 - 128, hh = t0 + 383 > SEQ - 1 ? SEQ - 1 : t0 + 383; ta = 4 + (lo >> 6); ntiles = 4 + ((hh >> 6) - (lo >> 6) + 1); } }
#define TILE_OF(i) ((MODE == 1 && (i) >= 4) ? ta + (i) - 4 : (i))
    const int qrow = q0 + wave * 32 + r32;
    bf16x8 qf[ND0];
#pragma unroll
    for (int d0 = 0; d0 < ND0; ++d0) qf[d0] = *(const bf16x8*)(Qb + (size_t)qrow * qs + 16 * d0 + 8 * hi);
    if (DQK == 96 && ropeq != nullptr) {
        const float* cs = ropeq + (size_t)(qrow - CTX) * 16 + 8 * hi; const float* sn = cs + SEQ * 16;
        const f32x4 c0 = *(const f32x4*)cs, c1 = *(const f32x4*)(cs + 4), s0 = *(const f32x4*)sn, s1 = *(const f32x4*)(sn + 4);
        float y1[8], y2[8];
#pragma unroll
        for (int j = 0; j < 8; ++j) { const float x1 = bf2f((unsigned short)qf[ND0 - 2][j]), x2 = bf2f((unsigned short)qf[ND0 - 1][j]);
            const float cc = j < 4 ? c0[j] : c1[j - 4], ss = j < 4 ? s0[j] : s1[j - 4];
            y1[j] = x1 * cc - x2 * ss; y2[j] = x1 * ss + x2 * cc; }
        qf[ND0 - 2] = __builtin_bit_cast(bf16x8, (v4u){cvtpk_s(y1[0], y1[1]), cvtpk_s(y1[2], y1[3]), cvtpk_s(y1[4], y1[5]), cvtpk_s(y1[6], y1[7])});
        qf[ND0 - 1] = __builtin_bit_cast(bf16x8, (v4u){cvtpk_s(y2[0], y2[1]), cvtpk_s(y2[2], y2[3]), cvtpk_s(y2[4], y2[5]), cvtpk_s(y2[6], y2[7])});
    }
    f32x16 o[NDB];
#pragma unroll
    for (int db = 0; db < NDB; ++db)
#pragma unroll
        for (int r = 0; r < 16; ++r) o[db][r] = 0.f;
    const float c = scale * 1.4426950408889634f;
    float m = (MODE == 1) ? sink / scale : -1e30f, l = (MODE == 1 && hi == 0) ? 1.f : 0.f;
    v4u kreg[NKI], vreg[NVI];
#pragma unroll
    for (int i_ = 0; i_ < NKI; ++i_) kreg[i_] = (v4u){0u, 0u, 0u, 0u};
#pragma unroll
    for (int i_ = 0; i_ < NVI; ++i_) vreg[i_] = (v4u){0u, 0u, 0u, 0u};
#define LOAD_TILE(tile) do { const int kb_ = (tile) * 64; \
        _Pragma("unroll") for (int i_ = 0; i_ < NKI; ++i_) { const int id_ = tid + NT * i_; if (id_ < NKC) { const int row_ = id_ / CPR, ch_ = id_ % CPR; kreg[i_] = (DQK == 96 && ch_ >= 8) ? *(const v4u*)(Kb2 + (size_t)(kb_ + row_) * ks2 + (ch_ - 8) * 8) : *(const v4u*)(Kb + (size_t)(kb_ + row_) * ks + ch_ * 8); } } \
        _Pragma("unroll") for (int i_ = 0; i_ < NVI; ++i_) { const int id_ = tid + NT * i_, d_ = id_ >> 3, ch_ = id_ & 7; vreg[i_] = *(const v4u*)(VTb + (size_t)d_ * PB + kb_ + ch_ * 8); } } while (0)
#define STORE_TILE(buf) do { \
        _Pragma("unroll") for (int i_ = 0; i_ < NKI; ++i_) { const int id_ = tid + NT * i_; if (id_ < NKC) { const int row_ = id_ / CPR, ch_ = id_ % CPR; *(LAS v4u*)(lds + (buf) * KBUF + row_ * RSK + ch_ * 16) = kreg[i_]; } } \
        _Pragma("unroll") for (int i_ = 0; i_ < NVI; ++i_) { const int id_ = tid + NT * i_, d_ = id_ >> 3, ch_ = id_ & 7; LAS v2u* w_ = (LAS v2u*)(lds + 2 * KBUF + (buf) * VBUF + d_ * RSV + ch_ * 16); \
            w_[0] = (v2u){vreg[i_].x, vreg[i_].y}; w_[1] = (v2u){vreg[i_].z, vreg[i_].w}; } } while (0)
    LOAD_TILE(TILE_OF(0)); STORE_TILE(0); __syncthreads();
    for (int i = 0; i < ntiles; ++i) {
        const int cur = i & 1, tile = TILE_OF(i);
        if (i + 1 < ntiles) LOAD_TILE(TILE_OF(i + 1));
        bool active = true;
        if (MODE == 1 && i >= 4) { const int kt0 = tile * 64 - CTX, qt0 = q0 - CTX + wave * 32; active = (kt0 + 63 >= qt0 - 128) && (kt0 <= qt0 + 31 + 128); }
        if (active) {
            f32x16 p0, p1;
#pragma unroll
            for (int r = 0; r < 16; ++r) { p0[r] = 0.f; p1[r] = 0.f; }
            const LAS unsigned char* kb = lds + cur * KBUF + r32 * RSK + hi * 16;
#pragma unroll
            for (int d0 = 0; d0 < ND0; ++d0) { const bf16x8 k0 = *(const LAS bf16x8*)(kb + d0 * 32), k1 = *(const LAS bf16x8*)(kb + 32 * RSK + d0 * 32);
                p0 = __builtin_amdgcn_mfma_f32_32x32x16_bf16(k0, qf[d0], p0, 0, 0, 0); p1 = __builtin_amdgcn_mfma_f32_32x32x16_bf16(k1, qf[d0], p1, 0, 0, 0); }
            if (MODE == 1 && i >= 4) { const int rel0 = (tile * 64 - CTX) - (qrow - CTX);
#pragma unroll
                for (int r = 0; r < 16; ++r) { const int ra = rel0 + crow16(r, hi), rb = ra + 32;
                    if (ra > 128 || ra < -128) p0[r] = -1e30f; if (rb > 128 || rb < -128) p1[r] = -1e30f; } }
            float mx = fmaxf(p0[0], p1[0]);
#pragma unroll
            for (int r = 1; r < 16; ++r) mx = fmaxf(mx, fmaxf(p0[r], p1[r]));
            mx = xhalf_max(mx);
            const float mn = fmaxf(m, mx), alpha = __builtin_amdgcn_exp2f((m - mn) * c), nmc = -mn * c; m = mn;
            float sum = 0.f;
#pragma unroll
            for (int r = 0; r < 16; ++r) { p0[r] = __builtin_amdgcn_exp2f(fmaf(p0[r], c, nmc)); p1[r] = __builtin_amdgcn_exp2f(fmaf(p1[r], c, nmc)); sum += p0[r] + p1[r]; }
            l = l * alpha + sum;
            if (!__all(alpha == 1.f)) {
#pragma unroll
                for (int db = 0; db < NDB; ++db)
#pragma unroll
                    for (int r = 0; r < 16; ++r) o[db][r] *= alpha; }
            const LAS unsigned char* vb = lds + 2 * KBUF + cur * VBUF + r32 * RSV + hi * 8;
#pragma unroll
            for (int s = 0; s < 4; ++s) { const int rb = (s & 1) * 8;
                v4u pw;
                if (s < 2) { pw.x = cvtpk_s(p0[rb + 0], p0[rb + 1]); pw.y = cvtpk_s(p0[rb + 2], p0[rb + 3]); pw.z = cvtpk_s(p0[rb + 4], p0[rb + 5]); pw.w = cvtpk_s(p0[rb + 6], p0[rb + 7]); }
                else       { pw.x = cvtpk_s(p1[rb + 0], p1[rb + 1]); pw.y = cvtpk_s(p1[rb + 2], p1[rb + 3]); pw.z = cvtpk_s(p1[rb + 4], p1[rb + 5]); pw.w = cvtpk_s(p1[rb + 6], p1[rb + 7]); }
                const bf16x8 pf = __builtin_bit_cast(bf16x8, pw);
#pragma unroll
                for (int db = 0; db < NDB; ++db) { const LAS unsigned char* vp = vb + db * 32 * RSV + s * 32;
                    const v2u a0 = *(const LAS v2u*)(vp), a1 = *(const LAS v2u*)(vp + 16);
                    const bf16x8 vf = __builtin_bit_cast(bf16x8, (v4u){a0.x, a0.y, a1.x, a1.y});
                    o[db] = __builtin_amdgcn_mfma_f32_32x32x16_bf16(vf, pf, o[db], 0, 0, 0); }
                __builtin_amdgcn_sched_barrier(0); }
        }
        if (i + 1 < ntiles) STORE_TILE(cur ^ 1);
        __syncthreads();
    }
#undef LOAD_TILE
#undef STORE_TILE
#undef TILE_OF
    l = xhalf_sum(l);
    const float il = 1.f / l;
#pragma unroll
    for (int db = 0; db < NDB; ++db)
#pragma unroll
        for (int rr = 0; rr < 4; ++rr) { const int d = 32 * db + 8 * rr + 4 * hi;
            const float a = o[db][4 * rr] * il, b = o[db][4 * rr + 1] * il, cc = o[db][4 * rr + 2] * il, dd = o[db][4 * rr + 3] * il;
            if (OUTF32) *(f32x4*)((float*)Ob + (size_t)qrow * os + d) = (f32x4){a, b, cc, dd};
            else *(v2u*)((bf16*)Ob + (size_t)qrow * os + d) = (v2u){cvtpk_s(a, b), cvtpk_s(cc, dd)}; }
}

__device__ __forceinline__ void phase_att(const P& p, LAS unsigned char* lds, int layer) {
    unsigned char* wsb = opq_p(p.ws);
    layer = opq_s(layer);
    const int tid = tid_opaque(), lane = tid & 63, wave = __builtin_amdgcn_readfirstlane(tid >> 6), G = gridDim.x, blk = blockIdx.x;
    const int gw = wave * G + blk;
    const bool last = layer == DEPTH - 1;
    const bf16* COLS = (const bf16*)(wsb + WS_COLS);
    const bf16* QUP = (const bf16*)(wsb + WS_QUP); const bf16* KMN = (const bf16*)(wsb + WS_KMN);
    const bf16* VTD = (const bf16*)(wsb + WS_VTD); const bf16* VTG = (const bf16*)(wsb + WS_VTG); const bf16* VTM = (const bf16*)(wsb + WS_VTM);
    bf16* YMIX = (bf16*)(wsb + WS_YMIX); float* DIFFO = (float*)(wsb + WS_DIFFO);
    const f32x2* AB = (const f32x2*)(wsb + WS_AB);
    { f32x2* SUM = (f32x2*)(wsb + WS_SUM);
      for (int it = gw; it < NB * 2 * 36 * 8; it += NW * G) { const int g = it & 7, c = (it >> 3) % 36, dir = (it / 288) & 1, b = it / 576, ch = g * 64 + lane;
          const f32x2* ab = AB + ((size_t)dir * M + (size_t)b * PB + c * 64) * 512 + ch;
          float A = 1.f, H = 0.f;
          if (dir == 0) {
#pragma unroll 16
              for (int q = 0; q < 64; ++q) { const f32x2 cf = ab[(size_t)q * 512]; H = cf.x * H + cf.y; A *= cf.x; }
          } else {
#pragma unroll 16
              for (int q = 63; q >= 0; --q) { const f32x2 cf = ab[(size_t)q * 512]; H = cf.x * H + cf.y; A *= cf.x; }
          }
          const int ord = dir == 0 ? c : (c <= 3 ? 3 - c : 39 - c);
          SUM[(((size_t)dir * NB + b) * 40 + ord) * 512 + ch] = (f32x2){A, H}; } }
    for (int u = blk; u < 256; u += G) {
        const int xcd = u & 7, j = u >> 3, grp = xcd * 4 + (j >> 3), qb = j & 7, b = grp >> 3, hh = grp & 7, q0 = CTX + qb * 256;
        const size_t rb = (size_t)b * PB;
        attn_unit<96, 64, 0, false>(lds, QUP + rb * 768 + hh * 96, 768, KMN + rb * 512 + hh * 64, 512, COLS + rb * NINP + C_MKR, NINP, (const float*)(wsb + WS_ROPE) + SEQ * 64, VTM + ((size_t)b * 512 + hh * 64) * PB, YMIX + rb * 2048 + 512 + hh * 64, 2048, q0, 36, 0.10206207261596575f, 0.f, tid);
        for (int vh = 0; vh < 2; ++vh)
            attn_unit<64, 64, 0, true>(lds, COLS + rb * NINP + C_DQ + hh * 64, NINP, COLS + rb * NINP + C_DK + hh * 64, NINP, nullptr, 0, nullptr, VTD + ((size_t)b * 512 + (hh >> 1) * 128 + vh * 64) * PB, DIFFO + rb * 1024 + hh * 128 + vh * 64, 1024, q0, 36, 0.125f, 0.f, tid);
        attn_unit<64, 64, 1, false>(lds, COLS + rb * NINP + C_GQ + hh * 64, NINP, COLS + rb * NINP + C_GK + (hh >> 2) * 64, NINP, nullptr, 0, nullptr, VTG + ((size_t)b * 128 + (hh >> 2) * 64) * PB, YMIX + rb * 2048 + 1536 + hh * 64, 2048, q0, 0, 0.125f, p.in[22][layer * 8 + hh], tid);
    }
    if (!last) {
        for (int u = blk; u < 96; u += G) { const int kind = u >> 5, b = (u >> 3) & 3, hh = u & 7; const size_t rb = (size_t)b * PB;
            if (kind == 0) attn_unit<96, 64, 0, false>(lds, QUP + rb * 768 + hh * 96, 768, KMN + rb * 512 + hh * 64, 512, COLS + rb * NINP + C_MKR, NINP, nullptr, VTM + ((size_t)b * 512 + hh * 64) * PB, YMIX + rb * 2048 + 512 + hh * 64, 2048, 0, 4, 0.10206207261596575f, 0.f, tid);
            else if (kind == 1) { for (int vh = 0; vh < 2; ++vh) attn_unit<64, 64, 0, true>(lds, COLS + rb * NINP + C_DQ + hh * 64, NINP, COLS + rb * NINP + C_DK + hh * 64, NINP, nullptr, 0, nullptr, VTD + ((size_t)b * 512 + (hh >> 1) * 128 + vh * 64) * PB, DIFFO + rb * 1024 + hh * 128 + vh * 64, 1024, 0, 4, 0.125f, 0.f, tid); }
            else attn_unit<64, 64, 1, false>(lds, COLS + rb * NINP + C_GQ + hh * 64, NINP, COLS + rb * NINP + C_GK + (hh >> 2) * 64, NINP, nullptr, 0, nullptr, VTG + ((size_t)b * 128 + (hh >> 2) * 64) * PB, YMIX + rb * 2048 + 1536 + hh * 64, 2048, 0, 0, 0.125f, p.in[22][layer * 8 + hh], tid);
        }
    }
}

__device__ __forceinline__ void phase_mixfin(const P& p, LAS unsigned char* lds, int layer) {
    layer = opq_s(layer);
    unsigned char* wsb = opq_p(p.ws);
    const int tid = tid_opaque(), lane = tid & 63, wave = tid >> 6, G = gridDim.x, blk = blockIdx.x;
    const int gw = wave * G + blk, NGW = NW * G;
    const bool last = layer == DEPTH - 1;
    const bf16* COLS = (const bf16*)(wsb + WS_COLS); bf16* YMIX = (bf16*)(wsb + WS_YMIX); const float* DIFFO = (const float*)(wsb + WS_DIFFO);
    { const f32x2* AB = (const f32x2*)(wsb + WS_AB); const f32x2* SUM = (const f32x2*)(wsb + WS_SUM);
      LAS float* hf = (LAS float*)(lds + wave * 16384);
      for (int it = gw; it < NB * 36 * 8; it += NGW) { const int g = it & 7, c = (it >> 3) % 36, b = it / 288, ch = g * 64 + lane;
          if (last && c < 4) continue;
          { const f32x2* sm = SUM + (((size_t)0 * NB + b) * 40) * 512 + ch; float h = 0.f;
            for (int o = 0; o < c; ++o) { const f32x2 s = sm[(size_t)o * 512]; h = s.x * h + s.y; }
            const f32x2* ab = AB + ((size_t)0 * M + (size_t)b * PB + c * 64) * 512 + ch;
#pragma unroll 16
            for (int q = 0; q < 64; ++q) { const f32x2 cf = ab[(size_t)q * 512]; h = cf.x * h + cf.y; hf[q * 64 + lane] = h; } }
          { const int ord = c <= 3 ? 3 - c : 39 - c;
            const f32x2* sm = SUM + (((size_t)1 * NB + b) * 40) * 512 + ch; float h = 0.f;
            for (int o = 0; o < ord; ++o) { const f32x2 s = sm[(size_t)o * 512]; h = s.x * h + s.y; }
            const f32x2* ab = AB + ((size_t)1 * M + (size_t)b * PB + c * 64) * 512 + ch;
            LDS_WAIT();
#pragma unroll 8
            for (int q = 63; q >= 0; --q) { const f32x2 cf = ab[(size_t)q * 512]; h = cf.x * h + cf.y; const size_t row = (size_t)b * PB + c * 64 + q;
                const float gt = bf2f(COLS[row * NINP + C_GATE + ch]);
                YMIX[row * 2048 + ch] = (bf16)f2bf((hf[q * 64 + lane] + h) * gelu_tanh(gt)); } }
          LDS_WAIT(); } }
    const float* lv = p.in[20] + (size_t)layer * 4 * 64; const float* dg = p.in[21] + (size_t)layer * 128;
    const float lam_init = 0.8f - 0.6f * expf(-0.3f * (float)layer);
    const float lam = expf(wave_sum(lv[lane] * lv[64 + lane])) - expf(wave_sum(lv[128 + lane] * lv[192 + lane])) + lam_init;
    for (int row = gw; row < M; row += NGW) {
        const int pp = row % PB; if (last && pp < CTX) continue;
#pragma unroll
        for (int hh = 0; hh < 4; ++hh) { float o[2]; float s = 0.f;
#pragma unroll
            for (int j = 0; j < 2; ++j) { const int e = lane + 64 * j;
                o[j] = DIFFO[(size_t)row * 1024 + (2 * hh) * 128 + e] - lam * DIFFO[(size_t)row * 1024 + (2 * hh + 1) * 128 + e]; s += o[j] * o[j]; }
            s = wave_sum(s); const float rstd = 1.0f / sqrtf(s * (1.0f / 128.f) + 1e-6f);
#pragma unroll
            for (int j = 0; j < 2; ++j) { const int e = lane + 64 * j; YMIX[(size_t)row * 2048 + 1024 + hh * 128 + e] = (bf16)f2bf(o[j] * rstd * dg[e] * (1.0f - lam_init)); } }
    }
}

#define XB_TMO      128
#define XB_XCNT(j)  (256  + 64 * (j))
#define XB_XSUB(j)  (1280 + 64 * (j))
#define XB_XGEN(j)  (2304 + 64 * (j))
#define XB_TOP      3328
#define XB_TOPGEN   3392
#define XCD_BAR_WORDS 3456
#define XB_SPIN_CAP (1u << 18)

__device__ __forceinline__ unsigned xb_ld(unsigned* p)              { return __hip_atomic_load(p, __ATOMIC_RELAXED, __HIP_MEMORY_SCOPE_AGENT); }
__device__ __forceinline__ unsigned xb_add(unsigned* p, unsigned v) { return __hip_atomic_fetch_add(p, v, __ATOMIC_RELAXED, __HIP_MEMORY_SCOPE_AGENT); }
__device__ __forceinline__ unsigned xb_xcc_id() { return (unsigned)__builtin_amdgcn_s_getreg((3 << 11) | 20) & 0xFu; }
#define XB_SPIN(cond, bar) do { unsigned _sp = 0; while (cond) { __builtin_amdgcn_s_sleep(1); \
    if ((++_sp & 255u) == 0u) { if (xb_ld(&(bar)[XB_TMO])) break; if (_sp > XB_SPIN_CAP) { atomicAdd(&(bar)[XB_TMO], 1u); break; } } } } while (0)

struct XcdBarrier {
    unsigned* bar; unsigned x;
    volatile LAS unsigned* st;
};

__device__ __forceinline__ XcdBarrier xcd_barrier_post(unsigned* bar, volatile LAS unsigned* st) {
    XcdBarrier b; b.bar = bar; b.x = xb_xcc_id(); b.st = st;
    if (threadIdx.x == 0) (void)xb_add(&bar[XB_XCNT(b.x)], 1u);
    return b;
}
__device__ __forceinline__ void xcd_barrier_complete(unsigned* bar, unsigned x, unsigned& nloc, unsigned& nx) {
    const unsigned G = gridDim.x * gridDim.y * gridDim.z;
    unsigned sum, cnt, mine, sp = 0u;
    for (;;) {
        sum = 0u; cnt = 0u; mine = 0u;
#pragma unroll
        for (unsigned j = 0; j < 16; ++j) { const unsigned c = xb_ld(&bar[XB_XCNT(j)]); sum += c; cnt += (c > 0u) ? 1u : 0u; mine = (j == x) ? c : mine; }
        if (sum == G) break;
        __builtin_amdgcn_s_sleep(1);
        if ((++sp & 255u) == 0u) { if (xb_ld(&bar[XB_TMO])) break; if (sp > XB_SPIN_CAP) { atomicAdd(&bar[XB_TMO], 1u); break; } }
    }
    nloc = mine > 0u ? mine : 1u; nx = cnt > 0u ? cnt : 1u;
}

__device__ __forceinline__ void xcd_barrier(const XcdBarrier& b) {
    asm volatile("s_waitcnt vmcnt(0)" ::: "memory");
    __syncthreads();
    if (threadIdx.x == 0) {
        unsigned* bar = b.bar; const unsigned bx = xb_xcc_id();
        __builtin_amdgcn_s_waitcnt(0);
        unsigned nloc = b.st[0], nx = b.st[1];
        if (nloc == 0u) { xcd_barrier_complete(bar, bx, nloc, nx); b.st[0] = nloc; b.st[1] = nx; }
        const unsigned old = xb_add(&bar[XB_XSUB(bx)], 1u);
        const unsigned gen = old / nloc;
        if (old + 1u == (gen + 1u) * nloc) {
            __builtin_amdgcn_fence(__ATOMIC_RELEASE, "agent");
            asm volatile("s_waitcnt vmcnt(0)" ::: "memory");
            const unsigned og = xb_add(&bar[XB_TOP], 1u);
            const unsigned tg = og / nx;
            if (og + 1u == (tg + 1u) * nx) xb_add(&bar[XB_TOPGEN], 1u);
            else XB_SPIN(xb_ld(&bar[XB_TOPGEN]) == tg, bar);
            __builtin_amdgcn_fence(__ATOMIC_ACQUIRE, "agent");
            xb_add(&bar[XB_XGEN(bx)], 1u);
            asm volatile("s_waitcnt vmcnt(0)" ::: "memory");
        } else {
            XB_SPIN(xb_ld(&bar[XB_XGEN(bx)]) == gen, bar);
            __builtin_amdgcn_fence(__ATOMIC_ACQUIRE, "agent");
            asm volatile("s_waitcnt vmcnt(0)" ::: "memory");
        }
    }
    __syncthreads();
}

constexpr int CW_BAR = 4096;
constexpr size_t CTL_ZERO_BYTES = 1 * MiB;
constexpr int LDSCTL_OFF = 131072, MISC_OFF = LDSCTL_OFF + 320;

__global__ void __launch_bounds__(NT, 2) k_mega(P p) {
    extern __shared__ __attribute__((aligned(16))) unsigned char lds_raw[];
    LAS unsigned char* lds = (LAS unsigned char*)lds_raw;
    const KP kp = (KP)__builtin_amdgcn_kernarg_segment_ptr();
    for (int u = threadIdx.x; u < (LDS_BYTES - LDSCTL_OFF) / 4; u += NT) ((LAS unsigned*)(lds + LDSCTL_OFF))[u] = 0u;
    __syncthreads();
    unsigned* barw = (unsigned*)(p.ws + WS_CTL) + CW_BAR;
    XcdBarrier bar = xcd_barrier_post(barw, (volatile LAS unsigned*)(lds + MISC_OFF) + 8);
#define GB() xcd_barrier(bar)
    phase_pro1(load_P(kp), lds); GB();
    phase_pro2(load_P(kp)); GB();
    for (int l = 0; l < DEPTH; ++l) {
        for (int which = 0; which < 2; ++which) {
            phase_ffn_in(load_P(kp), lds, l, which); GB();
            phase_ffn_out(load_P(kp), lds, l, which); GB();
            phase_post(load_P(kp), l, which == 0 ? 0 : 2); GB();
            if (which == 0) {
                phase_inproj(load_P(kp), lds, l); GB();
                phase_prep(load_P(kp), lds, l); GB();
                phase_mgemm(load_P(kp), lds, l); GB();
                phase_att(load_P(kp), lds, l); GB();
                phase_mixfin(load_P(kp), lds, l); GB();
                phase_outproj(load_P(kp), lds, l); GB();
                phase_post(load_P(kp), l, 1); GB();
            }
        }
    }
#undef GB
    if (__hip_atomic_load(barw + XB_TMO, __ATOMIC_RELAXED, __HIP_MEMORY_SCOPE_AGENT) != 0u) {
        const float q = __builtin_nanf("");
        for (size_t i = (size_t)blockIdx.x * NT + threadIdx.x; i < (size_t)NB * SEQ * D; i += (size_t)gridDim.x * NT) p.out[i] = q;
    }
}

extern "C" void kernel_launch(void* const* d_in, const int* in_sizes, int n_in, void* d_out, int out_size, void* d_ws, size_t ws_size, hipStream_t stream) {
    static int grid = 0;
    if (grid == 0) {
        if (n_in != 23 || out_size != NB * SEQ * D || ws_size < WS_END) { fprintf(stderr, "kernel_launch: unexpected shapes (n_in %d out %d ws %zu need %zu)\n", n_in, out_size, ws_size, (size_t)WS_END); grid = -1; return; }
        int dev = 0, cus = 0, per_cu = 0;
        if (hipGetDevice(&dev) != hipSuccess || hipDeviceGetAttribute(&cus, hipDeviceAttributeMultiprocessorCount, dev) != hipSuccess) { grid = -1; return; }
        if (hipFuncSetAttribute((const void*)k_mega, hipFuncAttributeMaxDynamicSharedMemorySize, LDS_BYTES) != hipSuccess) { fprintf(stderr, "kernel_launch: hipFuncSetAttribute failed\n"); grid = -1; return; }
        if (hipOccupancyMaxActiveBlocksPerMultiprocessor(&per_cu, (const void*)k_mega, NT, LDS_BYTES) != hipSuccess || per_cu < 1)
            fprintf(stderr, "kernel_launch: note: occupancy query reports %d workgroups per CU\n", per_cu);
        (void)hipGetLastError();
        grid = cus;
    }
    if (grid < 0) return;
    if (hipMemsetAsync((char*)d_ws + WS_CTL, 0, CTL_ZERO_BYTES, stream) != hipSuccess) { fprintf(stderr, "kernel_launch: memset failed\n"); return; }
    P p{};
    for (int i = 0; i < 23; ++i) p.in[i] = (const float*)d_in[i];
    p.out = (float*)d_out; p.ws = (unsigned char*)d_ws;
    hipLaunchKernelGGL(k_mega, dim3(grid), dim3(NT), LDS_BYTES, stream, p);
}
```

```cpp
#include <hip/hip_runtime.h>
#include <cstdio>
#include <cstdint>
__device__ __forceinline__ int opq_s(int x) { asm volatile("" : "+s"(x)); return x; }
__device__ __forceinline__ unsigned char* opq_p(unsigned char* x) { asm volatile("" : "+s"(x)); return x; }
__device__ __forceinline__ int lane_fresh() { unsigned ones = ~0u; asm volatile("" : "+s"(ones)); return (int)__builtin_amdgcn_mbcnt_hi(ones, __builtin_amdgcn_mbcnt_lo(ones, 0u)); }
__device__ __forceinline__ int tid_opaque(int wv) { unsigned ones = ~0u; asm volatile("" : "+s"(ones)); const int ln = (int)__builtin_amdgcn_mbcnt_hi(ones, __builtin_amdgcn_mbcnt_lo(ones, 0u)); return (wv << 6) | ln; }
namespace pg8 {
#define PG8_LAS __attribute__((address_space(3)))
typedef unsigned short bf16_t;
typedef short bf16x8 __attribute__((ext_vector_type(8)));
typedef float f32x4 __attribute__((ext_vector_type(4)));
typedef unsigned u32x4 __attribute__((ext_vector_type(4)));
constexpr int BM = 256, BK = 64, HALF = 128, HTB = HALF * BK * 2  , STAGE_BYTES = 8 * HTB, NXCD = 8, WGM = 8;

__host__ __device__ __forceinline__ int lds_byte(int r, int c) { const int st = (r >> 4) * 2 + (c >> 5), rr = r & 15, cc = c & 31, ob = rr * 64 + cc * 2; return st * 1024 + (ob ^ (((ob >> 9) & 1) << 5)); }
__host__ __device__ __forceinline__ void stage_rc(int b, int& R, int& C) { const int st = b / 1024, sb = b % 1024, swz = sb ^ (((sb >> 9) & 1) << 5); R = (st >> 1) * 16 + swz / 64; C = (st & 1) * 32 + (swz % 64) / 2; }
__host__ __device__ __forceinline__ int perm32(int rho) { const int n = rho >> 4, i = rho & 15; return 8 * (i >> 2) + 4 * n + (i & 3); }

struct Unit { int pm, pn; };
struct Gemm { const bf16_t* A; const bf16_t* Bt; int M, N, K, ld, wv; };

struct StaticOrder {
    int nM, nN, nwg, G, c;
    __host__ __device__ void init(int M, int N, int G_, int c_) { nM = M / BM; nN = N / BM; nwg = nM * nN; G = G_; c = c_; }
    __host__ __device__ bool next(int i, Unit& u) const {
        const long L = (long)i * G + c; if (L >= nwg) return false;
        int wgid = (int)L; { const int q = nwg / NXCD, r = nwg % NXCD, xcd = wgid % NXCD, off = wgid / NXCD; wgid = (xcd < r ? xcd * (q + 1) : r * (q + 1) + (xcd - r) * q) + off; }
        const int nig = WGM * nN, gid = wgid / nig, fm = gid * WGM, gsz = (nM - fm) < WGM ? (nM - fm) : WGM;
        u.pm = fm + ((wgid % nig) % gsz); u.pn = (wgid % nig) / gsz; return true;
    }
    __device__ __forceinline__ void a_ready(const Unit&) const {}
    __device__ __forceinline__ void done(const Unit&) const {}
};

__device__ __forceinline__ unsigned cvt_pk_bf16(float lo, float hi) { unsigned r; asm volatile("v_cvt_pk_bf16_f32 %0, %1, %2" : "=v"(r) : "v"(lo), "v"(hi)); return r; }
typedef float f32x2 __attribute__((ext_vector_type(2)));
}
namespace pg8 {
template <class Epi, class Sched, bool ALIGN_EPI = false, bool SP2 = false>
__device__ __forceinline__ void gemm_phase(PG8_LAS unsigned char* lds, const Gemm g, const Sched& S, const Epi& E) {
    const int tid = tid_opaque(g.wv), wid = __builtin_amdgcn_readfirstlane(tid >> 6), lane = tid & 63, wr = wid >> 2, wc = wid & 3, fr = lane & 15, fq = lane >> 4;
    const int K = g.ld, nt = g.K / BK;
    unsigned voffA[2], voffB[2];
#pragma unroll
    for (int i = 0; i < 2; ++i) { int R, C; stage_rc(tid * 16 + i * 8192, R, C); const int Rb = Epi::PERM ? ((R & ~31) + perm32(R & 31)) : R;
        voffA[i] = (unsigned)(R * K + C) * 2u; voffB[i] = (unsigned)(Rb * K + C) * 2u; }
    const size_t kstep = (size_t)(BK * 2);
    const size_t hstep = (size_t)HALF * K * 2;
    const size_t tstep = 2 * hstep;
    const unsigned ldsw = (unsigned)wid * 1024u;
    const int aoff = lds_byte(wr * 64 + fr, fq * 8), boff = lds_byte(wc * 32 + fr, fq * 8);
#define PG8_SA(b, h) (((b) * 2 + (h)) * HTB)
#define PG8_SB(b, h) ((4 + (b) * 2 + (h)) * HTB)
#define PG8_STAGE(bufoff, gbase, voff) do { _Pragma("unroll") for (int _i = 0; _i < 2; ++_i) \
        __builtin_amdgcn_global_load_lds((const unsigned*)((const char*)(gbase) + (voff)[_i]), (PG8_LAS unsigned*)(lds + (bufoff) + ldsw + _i * 8192), 16, 0, 0); } while (0)
#define PG8_LDA(dst, b, h) do { _Pragma("unroll") for (int m = 0; m < 4; ++m) _Pragma("unroll") for (int k = 0; k < 2; ++k) dst[m][k] = *(const PG8_LAS bf16x8*)(lds + PG8_SA(b, h) + aoff + m * 2048 + k * 1024); } while (0)
#define PG8_LDB(dst, b, h) do { _Pragma("unroll") for (int n = 0; n < 2; ++n) _Pragma("unroll") for (int k = 0; k < 2; ++k) dst[n][k] = *(const PG8_LAS bf16x8*)(lds + PG8_SB(b, h) + boff + n * 2048 + k * 1024); } while (0)
#define PG8_MMA(ai, bj, At, Bt) do { __builtin_amdgcn_s_setprio(1); _Pragma("unroll") for (int m = 0; m < 4; ++m) _Pragma("unroll") for (int n = 0; n < 2; ++n) _Pragma("unroll") for (int k = 0; k < 2; ++k) \
        acc[ai][bj][m][n] = __builtin_amdgcn_mfma_f32_16x16x32_bf16(Bt[n][k], At[m][k], acc[ai][bj][m][n], 0, 0, 0); __builtin_amdgcn_s_setprio(0); } while (0)
#define PG8_WAIT_V(n) asm volatile("s_waitcnt vmcnt(" #n ")" ::: "memory")
#define PG8_WAIT_L(n) asm volatile("s_waitcnt lgkmcnt(" #n ")" ::: "memory")
#define PG8_BAR __builtin_amdgcn_s_barrier()
#define PG8_SCHED __builtin_amdgcn_sched_barrier(0)
    Unit cur, nxt; int ui = 0;
    if (!S.next(0, cur)) return;
    f32x4 acc[2][2][4][2];
#pragma unroll
    for (int a = 0; a < 2; ++a)
#pragma unroll
        for (int b = 0; b < 2; ++b)
#pragma unroll
            for (int m = 0; m < 4; ++m)
#pragma unroll
                for (int n = 0; n < 2; ++n) acc[a][b][m][n] = (f32x4){0.f, 0.f, 0.f, 0.f};
    bf16x8 At[4][2], B0[2][2], B1[2][2];
    const char* cA = (const char*)g.A + (size_t)cur.pm * tstep; const char* cB = (const char*)g.Bt + (size_t)cur.pn * tstep;
    S.a_ready(cur);
    if constexpr (SP2) {
        PG8_STAGE(PG8_SB(0, 0), cB, voffB); PG8_STAGE(PG8_SB(0, 1), cB + hstep, voffB); PG8_STAGE(PG8_SA(0, 0), cA, voffA); PG8_STAGE(PG8_SA(0, 1), cA + hstep, voffA);
        if (wr == 1) PG8_BAR;
        PG8_WAIT_V(2); PG8_BAR;
        PG8_STAGE(PG8_SB(1, 0), cB + kstep, voffB); PG8_STAGE(PG8_SA(1, 0), cA + kstep, voffA); PG8_STAGE(PG8_SB(1, 1), cB + hstep + kstep, voffB);
        PG8_WAIT_V(6); PG8_BAR;
    } else {
        PG8_STAGE(PG8_SB(0, 0), cB, voffB); PG8_STAGE(PG8_SA(0, 0), cA, voffA); PG8_STAGE(PG8_SB(0, 1), cB + hstep, voffB); PG8_STAGE(PG8_SA(0, 1), cA + hstep, voffA);
        if (wr == 1) PG8_BAR;
        PG8_WAIT_V(4); PG8_BAR;
        PG8_STAGE(PG8_SB(1, 0), cB + kstep, voffB); PG8_STAGE(PG8_SA(1, 0), cA + kstep, voffA); PG8_STAGE(PG8_SB(1, 1), cB + hstep + kstep, voffB);
        PG8_WAIT_V(6); PG8_BAR;
    }
    for (;;) {
        const bool has_next = S.next(ui + 1, nxt);
        const char* nA = has_next ? (const char*)g.A + (size_t)nxt.pm * tstep : cA; const char* nB = has_next ? (const char*)g.Bt + (size_t)nxt.pn * tstep : cB;
        for (int t = 0; t < nt; t += 2) {
            const bool last = (t == nt - 2);
            const char* a1 = cA + (size_t)(t + 1) * kstep;
            const char* a2 = last ? nA : cA + (size_t)(t + 2) * kstep; const char* b2 = last ? nB : cB + (size_t)(t + 2) * kstep;
            const char* a3 = a2 + kstep; const char* b3 = b2 + kstep;
            if (last && has_next) S.a_ready(nxt);
            if constexpr (SP2) {
            PG8_LDB(B0, 0, 0); PG8_LDB(B1, 0, 1); PG8_SCHED; PG8_LDA(At, 0, 0); PG8_STAGE(PG8_SA(1, 1), a1 + hstep, voffA);
            PG8_WAIT_V(8); PG8_WAIT_L(0); PG8_BAR; PG8_MMA(0, 0, At, B0); PG8_MMA(0, 1, At, B1); PG8_BAR; PG8_SCHED;
            PG8_LDA(At, 0, 1); PG8_STAGE(PG8_SB(0, 0), b2, voffB); PG8_STAGE(PG8_SB(0, 1), b2 + hstep, voffB); PG8_STAGE(PG8_SA(0, 0), a2, voffA);
            PG8_WAIT_V(8); PG8_WAIT_L(0); PG8_BAR; PG8_MMA(1, 0, At, B0); PG8_MMA(1, 1, At, B1); PG8_BAR; PG8_SCHED;
            PG8_LDB(B0, 1, 0); PG8_LDB(B1, 1, 1); PG8_SCHED; PG8_LDA(At, 1, 0); PG8_STAGE(PG8_SA(0, 1), a2 + hstep, voffA);
            PG8_WAIT_V(8); PG8_WAIT_L(0); PG8_BAR; PG8_MMA(0, 0, At, B0); PG8_MMA(0, 1, At, B1); PG8_BAR; PG8_SCHED;
            PG8_LDA(At, 1, 1); PG8_STAGE(PG8_SB(1, 0), b3, voffB); PG8_STAGE(PG8_SB(1, 1), b3 + hstep, voffB); PG8_STAGE(PG8_SA(1, 0), a3, voffA);
            PG8_WAIT_V(8); PG8_WAIT_L(0); PG8_BAR; PG8_MMA(1, 0, At, B0); PG8_MMA(1, 1, At, B1); PG8_BAR; PG8_SCHED;
            } else {
            PG8_LDB(B0, 0, 0); PG8_SCHED; PG8_LDA(At, 0, 0); PG8_STAGE(PG8_SA(1, 1), a1 + hstep, voffA);
            PG8_WAIT_L(8); PG8_BAR; PG8_WAIT_L(0); PG8_MMA(0, 0, At, B0); PG8_BAR; PG8_SCHED;
            PG8_LDB(B1, 0, 1); PG8_STAGE(PG8_SB(0, 0), b2, voffB);
            PG8_BAR; PG8_WAIT_L(0); PG8_MMA(0, 1, At, B1); PG8_BAR;
            PG8_LDA(At, 0, 1); PG8_STAGE(PG8_SA(0, 0), a2, voffA);
            PG8_BAR; PG8_WAIT_L(0); PG8_MMA(1, 0, At, B0); PG8_BAR; PG8_SCHED;
            PG8_STAGE(PG8_SB(0, 1), b2 + hstep, voffB);
            PG8_WAIT_V(6); PG8_BAR; PG8_MMA(1, 1, At, B1); PG8_BAR;
            PG8_LDB(B0, 1, 0); PG8_SCHED; PG8_LDA(At, 1, 0); PG8_STAGE(PG8_SA(0, 1), a2 + hstep, voffA);
            PG8_WAIT_L(8); PG8_BAR; PG8_WAIT_L(0); PG8_MMA(0, 0, At, B0); PG8_BAR; PG8_SCHED;
            PG8_LDB(B1, 1, 1); PG8_STAGE(PG8_SB(1, 0), b3, voffB);
            PG8_BAR; PG8_WAIT_L(0); PG8_MMA(0, 1, At, B1); PG8_BAR;
            PG8_LDA(At, 1, 1); PG8_STAGE(PG8_SA(1, 0), a3, voffA);
            PG8_BAR; PG8_WAIT_L(0); PG8_MMA(1, 0, At, B0); PG8_BAR; PG8_SCHED;
            PG8_STAGE(PG8_SB(1, 1), b3 + hstep, voffB);
            PG8_WAIT_V(6); PG8_BAR; PG8_MMA(1, 1, At, B1); PG8_BAR;
            }
        }
        if constexpr (ALIGN_EPI) { if (wr == 0) PG8_BAR; }
        if constexpr (!Epi::AFTER_DRAIN) { E(acc, cur, wr, wc, fr, fq); S.done(cur); }
        if (!has_next) break;
#pragma unroll
        for (int a = 0; a < 2; ++a)
#pragma unroll
            for (int b = 0; b < 2; ++b)
#pragma unroll
                for (int m = 0; m < 4; ++m)
#pragma unroll
                    for (int n = 0; n < 2; ++n) acc[a][b][m][n] = (f32x4){0.f, 0.f, 0.f, 0.f};
        cur = nxt; cA = nA; cB = nB; ++ui;
        if constexpr (ALIGN_EPI) { if (wr == 1) PG8_BAR; }
    }
    PG8_WAIT_V(0);
    if constexpr (!ALIGN_EPI) { if (wr == 0) PG8_BAR; }
    PG8_BAR;
    if constexpr (Epi::AFTER_DRAIN) { E.fused(acc, cur, wr, wc, fr, fq, lds, wid, lane); S.done(cur); }
#undef PG8_SA
#undef PG8_SB
#undef PG8_STAGE
#undef PG8_LDA
#undef PG8_LDB
#undef PG8_MMA
#undef PG8_WAIT_V
#undef PG8_WAIT_L
#undef PG8_BAR
#undef PG8_SCHED
}
}

#define GAS __attribute__((address_space(1)))
#define LAS __attribute__((address_space(3)))
typedef unsigned short bf16;
typedef unsigned v4u __attribute__((ext_vector_type(4)));
typedef unsigned v2u __attribute__((ext_vector_type(2)));
typedef float f32x4 __attribute__((ext_vector_type(4)));
typedef float f32x2 __attribute__((ext_vector_type(2)));

constexpr int D = 2048, NB = 4, SEQ = 2048, CTX = 256, PB = 2304, M = NB * PB, DEPTH = 4, DFF = 5632, NIN = 4000, NINP = 4096, NMODC = 9 * D;
constexpr int NT = 512, NW = 8;
constexpr int C_XB = 0, C_GATE = 512, C_MQ = 1024, C_MKV = 1408, C_MKR = 1664, C_DQ = 1696, C_DK = 2208, C_DV = 2720, C_GQ = 3232, C_GK = 3744, C_GV = 3872;

constexpr size_t MiB = 1u << 20;
constexpr size_t WS_CTL = 0;
constexpr size_t WS_MOD = 1 * MiB;
constexpr size_t WS_ROPE = 3 * MiB;
constexpr size_t WS_WFFI = 4 * MiB;
constexpr size_t WS_WFFO = WS_WFFI + 352 * MiB;
constexpr size_t WS_WIN = WS_WFFO + 176 * MiB;
constexpr size_t WS_WOUT = WS_WIN + 64 * MiB;
constexpr size_t WS_WQB = WS_WOUT + 32 * MiB;
constexpr size_t WS_WKVB = WS_WQB + 3 * MiB;
constexpr size_t WS_WG = WS_WKVB + 2 * MiB;
constexpr size_t WS_X = WS_WG + 8 * MiB;
constexpr size_t WS_H = WS_X + 72 * MiB;
constexpr size_t WS_ACT = WS_H + 36 * MiB;
constexpr size_t WS_Y = WS_ACT + 99 * MiB;
constexpr size_t WS_COLS = WS_Y + 72 * MiB;
constexpr size_t WS_U = WS_COLS + 72 * MiB;
constexpr size_t WS_GATES = WS_U + 9 * MiB;
constexpr size_t WS_QN = WS_GATES + 72 * MiB;
constexpr size_t WS_KVN = WS_QN + 7 * MiB;
constexpr size_t WS_QUP = WS_KVN + 5 * MiB;
constexpr size_t WS_KVUP = WS_QUP + 14 * MiB;
constexpr size_t WS_QM = WS_KVUP + 18 * MiB;
constexpr size_t WS_KM = WS_QM + 14 * MiB;
constexpr size_t WS_KMN = WS_KM;
constexpr size_t WS_AB = WS_KM + 14 * MiB;
constexpr size_t WS_HS = WS_AB + 72 * MiB;
constexpr size_t WS_DIFFO = WS_HS + 36 * MiB;
constexpr size_t WS_YMIX = WS_DIFFO + 36 * MiB;
constexpr size_t WS_VTD = WS_YMIX + 36 * MiB;
constexpr size_t WS_VTG = WS_VTD + 9 * MiB;
constexpr size_t WS_VTM = WS_VTG + 3 * MiB;
constexpr size_t WS_SUM = WS_VTM + 9 * MiB;
constexpr size_t WS_YP = WS_SUM + 2 * MiB;
constexpr size_t WS_END = WS_YP + 64 * MiB;

constexpr int LDS_BYTES = 147456;

struct P { const float* in[23]; float* out; unsigned char* ws; };
struct PX { const float* in[23]; float* out; unsigned char* ws; int wv; };
typedef const __attribute__((address_space(4))) P* KP;
__device__ __forceinline__ PX load_P(KP kp, int wv) {
#if defined(__HIP_DEVICE_COMPILE__)
    asm volatile("" : "+s"(kp)); PX r; for (int i = 0; i < 23; ++i) r.in[i] = kp->in[i]; r.out = kp->out; r.ws = kp->ws; r.wv = wv; return r;
#else
    (void)kp; (void)wv; return PX{};
#endif
}

#define LDS_WAIT() asm volatile("s_waitcnt lgkmcnt(0)" ::: "memory")
__device__ __forceinline__ unsigned f2bf(float f) { unsigned u = __builtin_bit_cast(unsigned, f); return (u + 0x7fffu + ((u >> 16) & 1u)) >> 16; }
__device__ __forceinline__ unsigned pk2(float lo, float hi) { return f2bf(lo) | (f2bf(hi) << 16); }
__device__ __forceinline__ float bf2f(unsigned v) { return __builtin_bit_cast(float, v << 16); }
__device__ __forceinline__ float bflo(unsigned w) { return __builtin_bit_cast(float, w << 16); }
__device__ __forceinline__ float bfhi(unsigned w) { return __builtin_bit_cast(float, w & 0xffff0000u); }
template <int XM> __device__ __forceinline__ float swz_xor(float v) { return __builtin_bit_cast(float, __builtin_amdgcn_ds_swizzle(__builtin_bit_cast(int, v), (XM << 10) | 0x1f)); }
__device__ __forceinline__ void pl32swap(unsigned& a, unsigned& b) { asm volatile("s_nop 1\n\tv_permlane32_swap_b32 %0, %1\n\ts_nop 1" : "+v"(a), "+v"(b)); }
__device__ __forceinline__ float xhalf_sum(float v) { unsigned a = __builtin_bit_cast(unsigned, v), b = a; pl32swap(a, b); return __builtin_bit_cast(float, a) + __builtin_bit_cast(float, b); }
__device__ __forceinline__ float xhalf_max(float v) { unsigned a = __builtin_bit_cast(unsigned, v), b = a; pl32swap(a, b); return fmaxf(__builtin_bit_cast(float, a), __builtin_bit_cast(float, b)); }
__device__ __forceinline__ float wave_sum(float v) {
    v += swz_xor<1>(v); v += swz_xor<2>(v); v += swz_xor<4>(v); v += swz_xor<8>(v); v += swz_xor<16>(v);
    return xhalf_sum(v);
}
__device__ __forceinline__ float sigmoidf_(float x) { return 1.f / (1.f + __expf(-x)); }
__device__ __forceinline__ float siluf_(float x) { return x / (1.f + __expf(-x)); }
__device__ __forceinline__ float gelu_tanh(float x) { const float u = 0.7978845608028654f * (x + 0.044715f * x * x * x); return 0.5f * x * (1.f + tanhf(u)); }

struct TileOrder {
    pg8::StaticOrder so; int latonly;
    __device__ __forceinline__ void init(int nMt, int N, int G, int c, int lat) { so.nM = nMt; so.nN = N / 256; so.nwg = so.nM * so.nN; so.G = G; so.c = c; latonly = lat; }
    __device__ __forceinline__ bool next(int i, pg8::Unit& u) const { if (!so.next(i, u)) return false; if (latonly) u.pm = (u.pm >> 3) * 9 + 1 + (u.pm & 7); return true; }
    __device__ __forceinline__ void a_ready(const pg8::Unit&) const {}
    __device__ __forceinline__ void done(const pg8::Unit&) const {}
};
struct EpiF32 {
    static constexpr bool PERM = false, AFTER_DRAIN = false;
    float* C; int ldc;
    __device__ __forceinline__ void operator()(const f32x4 (&acc)[2][2][4][2], const pg8::Unit& u, int wr, int wc, int fr, int fq) const {
        const int row0 = u.pm * 256 + wr * 64 + fr, col0 = u.pn * 256 + wc * 32 + 4 * fq;
#pragma unroll
        for (int ai = 0; ai < 2; ++ai)
#pragma unroll
            for (int m = 0; m < 4; ++m) { float* rowp = C + (size_t)(row0 + ai * 128 + m * 16) * ldc + col0;
#pragma unroll
                for (int bj = 0; bj < 2; ++bj)
#pragma unroll
                    for (int n = 0; n < 2; ++n) *(f32x4*)(rowp + bj * 128 + n * 16) = acc[ai][bj][m][n]; }
    }
};
struct EpiB16 {
    static constexpr bool PERM = true, AFTER_DRAIN = false;
    bf16* O; int ldc;
    __device__ __forceinline__ void operator()(const f32x4 (&acc)[2][2][4][2], const pg8::Unit& u, int wr, int wc, int fr, int fq) const {
        const int row0 = u.pm * 256 + wr * 64 + fr, col0 = u.pn * 256 + wc * 32 + 8 * fq;
#pragma unroll
        for (int ai = 0; ai < 2; ++ai)
#pragma unroll
            for (int m = 0; m < 4; ++m) { bf16* rowp = O + (size_t)(row0 + ai * 128 + m * 16) * ldc + col0;
#pragma unroll
                for (int bj = 0; bj < 2; ++bj) { const f32x4 v0 = acc[ai][bj][m][0], v1 = acc[ai][bj][m][1];
                    v4u w; w.x = pg8::cvt_pk_bf16(v0[0], v0[1]); w.y = pg8::cvt_pk_bf16(v0[2], v0[3]); w.z = pg8::cvt_pk_bf16(v1[0], v1[1]); w.w = pg8::cvt_pk_bf16(v1[2], v1[3]);
                    *(v4u*)(rowp + bj * 128) = w; } }
    }
};
struct EpiSwiglu {
    static constexpr bool PERM = true, AFTER_DRAIN = false;
    bf16* O; int ldc;
    __device__ __forceinline__ void operator()(const f32x4 (&acc)[2][2][4][2], const pg8::Unit& u, int wr, int wc, int fr, int fq) const {
        const int row0 = u.pm * 256 + wr * 64 + fr, col0 = u.pn * 128 + wc * 32 + 8 * fq;
#pragma unroll
        for (int ai = 0; ai < 2; ++ai)
#pragma unroll
            for (int m = 0; m < 4; ++m) { bf16* rowp = O + (size_t)(row0 + ai * 128 + m * 16) * ldc + col0;
                float r[8];
#pragma unroll
                for (int n = 0; n < 2; ++n)
#pragma unroll
                    for (int e = 0; e < 4; ++e) { const float g = acc[ai][0][m][n][e], uu = acc[ai][1][m][n][e]; r[n * 4 + e] = siluf_(g) * uu; }
                v4u w; w.x = pg8::cvt_pk_bf16(r[0], r[1]); w.y = pg8::cvt_pk_bf16(r[2], r[3]); w.z = pg8::cvt_pk_bf16(r[4], r[5]); w.w = pg8::cvt_pk_bf16(r[6], r[7]);
                *(v4u*)rowp = w; }
    }
};

__device__ __forceinline__ void transpose_item(const float* W, int N, int K, bf16* WT, int k0, int n0, int drow0, LAS float* scr, int lane) {
#pragma unroll 8
    for (int i = 0; i < 32; ++i) { const int kk = 2 * i + (lane >> 5); scr[kk * 33 + (lane & 31)] = W[(size_t)(k0 + kk) * N + n0 + (lane & 31)]; }
    LDS_WAIT(); asm volatile("" ::: "memory");
    const int c = lane & 7;
#pragma unroll
    for (int j = 0; j < 4; ++j) { const int n = (lane >> 3) + 8 * j; const LAS float* s = scr + (8 * c) * 33 + n;
        v4u o; o.x = pk2(s[0 * 33], s[1 * 33]); o.y = pk2(s[2 * 33], s[3 * 33]); o.z = pk2(s[4 * 33], s[5 * 33]); o.w = pk2(s[6 * 33], s[7 * 33]);
        *(v4u*)(WT + (size_t)(drow0 + n) * K + k0 + 8 * c) = o; }
    LDS_WAIT(); asm volatile("" ::: "memory");
}

__device__ __forceinline__ void phase_pro1(const PX& p, LAS unsigned char* lds) {
    unsigned char* wsb = opq_p(p.ws);
    const int tid = tid_opaque(p.wv), lane = tid & 63, wave = __builtin_amdgcn_readfirstlane(tid >> 6);
    const int G = gridDim.x, blk = blockIdx.x;
    {
        LAS float* sc = (LAS float*)lds;
        LAS float* red = (LAS float*)(lds + 40960);
        const float* c = p.in[1]; const float* cc = p.in[3];
        for (int i = tid; i < 5 * D; i += NT) { const int v = i / D, k = i % D; const float x = v < 4 ? c[v * D + k] : cc[k]; sc[i] = x / (1.f + expf(-x)); }
        __syncthreads();
        const float* wmod = p.in[4]; const float* bmod = p.in[5];
        float* MOD = (float*)(wsb + WS_MOD);
        for (int unit = blk; unit < DEPTH * 288; unit += G) {
            const int l = unit / 288, n0 = (unit % 288) * 64, kq = lane >> 4;
            const float* W = wmod + (size_t)l * D * NMODC + n0 + 4 * (lane & 15);
            float acc[5][4];
#pragma unroll
            for (int v = 0; v < 5; ++v)
#pragma unroll
                for (int e = 0; e < 4; ++e) acc[v][e] = 0.f;
            const int kbase = wave * 256 + kq;
#pragma unroll 4
            for (int i = 0; i < 64; ++i) { const int k = kbase + 4 * i; const f32x4 w = *(const f32x4*)(W + (size_t)k * NMODC);
#pragma unroll
                for (int v = 0; v < 5; ++v) { const float s = sc[v * D + k];
#pragma unroll
                    for (int e = 0; e < 4; ++e) acc[v][e] += s * w[e]; } }
#pragma unroll
            for (int v = 0; v < 5; ++v)
#pragma unroll
                for (int e = 0; e < 4; ++e) { float a = acc[v][e]; a += swz_xor<16>(a); a = xhalf_sum(a); acc[v][e] = a; }
            if (kq == 0) {
#pragma unroll
                for (int v = 0; v < 5; ++v)
#pragma unroll
                    for (int e = 0; e < 4; ++e) red[(wave * 5 + v) * 64 + 4 * (lane & 15) + e] = acc[v][e]; }
            __syncthreads();
            if (tid < 320) { const int v = tid / 64, col = tid % 64; float s = 0.f;
#pragma unroll
                for (int w = 0; w < 8; ++w) s += red[(w * 5 + v) * 64 + col];
                MOD[((size_t)l * 5 + v) * NMODC + n0 + col] = s + bmod[l * NMODC + n0 + col]; }
            __syncthreads();
        }
    }
    __syncthreads();
    {
        LAS float* scr = (LAS float*)(lds + wave * 16384);
        const int gw = wave * G + blk, NGW = NW * G;
        constexpr int I_FI = 32 * 352, I_FO = 88 * 64, I_IN = 32 * 125, I_OUT = 32 * 64, I_QB = 6 * 24, I_KVB = 4 * 32;
        constexpr int T_FI = 8 * I_FI, T_FO = 8 * I_FO, T_IN = 4 * I_IN, T_OUT = 4 * I_OUT, T_QB = 4 * I_QB, T_KVB = 4 * I_KVB;
        constexpr int NITEMS = T_FI + T_FO + T_IN + T_OUT + T_QB + T_KVB;
        for (int it = gw; it < NITEMS; it += NGW) {
            int r = it;
            if (r < T_FI) { const int mat = r / I_FI; r %= I_FI; const int kb = r / 352, nb = r % 352, n0 = nb * 32;
                const int half = n0 / DFF, cc = n0 % DFF, drow0 = (cc / 128) * 256 + half * 128 + (cc % 128);
                transpose_item(p.in[7] + (size_t)mat * D * (2 * DFF), 2 * DFF, D, (bf16*)(wsb + WS_WFFI) + (size_t)mat * (2 * DFF) * D, kb * 64, n0, drow0, scr, lane); continue; }
            r -= T_FI;
            if (r < T_FO) { const int mat = r / I_FO; r %= I_FO; const int kb = r / 64, nb = r % 64;
                transpose_item(p.in[8] + (size_t)mat * DFF * D, D, DFF, (bf16*)(wsb + WS_WFFO) + (size_t)mat * D * DFF, kb * 64, nb * 32, nb * 32, scr, lane); continue; }
            r -= T_FO;
            if (r < T_IN) { const int mat = r / I_IN; r %= I_IN; const int kb = r / 125, nb = r % 125;
                transpose_item(p.in[9] + (size_t)mat * D * NIN, NIN, D, (bf16*)(wsb + WS_WIN) + (size_t)mat * NINP * D, kb * 64, nb * 32, nb * 32, scr, lane); continue; }
            r -= T_IN;
            if (r < T_OUT) { const int mat = r / I_OUT; r %= I_OUT; const int kb = r / 64, nb = r % 64;
                transpose_item(p.in[10] + (size_t)mat * D * D, D, D, (bf16*)(wsb + WS_WOUT) + (size_t)mat * D * D, kb * 64, nb * 32, nb * 32, scr, lane); continue; }
            r -= T_OUT;
            if (r < T_QB) { const int mat = r / I_QB; r %= I_QB; const int kb = r / 24, nb = r % 24;
                transpose_item(p.in[17] + (size_t)mat * 384 * 768, 768, 384, (bf16*)(wsb + WS_WQB) + (size_t)mat * 768 * 384, kb * 64, nb * 32, nb * 32, scr, lane); continue; }
            r -= T_QB;
            { const int mat = r / I_KVB; r %= I_KVB; const int kb = r / 32, nb = r % 32;
                transpose_item(p.in[19] + (size_t)mat * 256 * 1024, 1024, 256, (bf16*)(wsb + WS_WKVB) + (size_t)mat * 1024 * 256, kb * 64, nb * 32, nb * 32, scr, lane); }
        }
    }
    {
        const int gt = blk * NT + tid, NGT = G * NT;
        for (int i = gt; i < DEPTH * 96 * (D / 8); i += NGT) { const int l = i / (96 * (D / 8)), r = i % (96 * (D / 8));
            *(v4u*)((bf16*)(wsb + WS_WIN) + ((size_t)l * NINP + NIN) * D + (size_t)r * 8) = (v4u){0u, 0u, 0u, 0u}; }
        const float* wg = p.in[13];
        for (int i = gt; i < DEPTH * 2048 * 64; i += NGT) { const int l = i / (2048 * 64), r = i % (2048 * 64), np = r / 64, k0 = (r % 64) * 8;
            const int c7 = np & 127, gate = (np >> 7) & 1, chunk = (np >> 8) & 3, dir = np >> 10, ch = chunk * 128 + c7, head = ch >> 6, j = ch & 63;
            v4u o = (v4u){0u, 0u, 0u, 0u};
            if ((k0 >> 6) == head) { const float* src = wg + ((((size_t)l * 2 + dir) * 2 + gate) * 8 + head) * 4096 + (size_t)(k0 & 63) * 64 + j;
                o.x = pk2(src[0], src[64]); o.y = pk2(src[128], src[192]); o.z = pk2(src[256], src[320]); o.w = pk2(src[384], src[448]); }
            *(v4u*)((bf16*)(wsb + WS_WG) + ((size_t)l * 2048 + np) * 512 + k0) = o; }
        float* rope = (float*)(wsb + WS_ROPE);
        for (int i = gt; i < SEQ * 32; i += NGT) { const int t = i / 32, k = i % 32; const float inv = powf(10000.f, -(float)(k & 15) / 16.f);
            const float ang = (k < 16 ? (float)(t / 64) : (float)(t % 64)) * inv; rope[i] = cosf(ang); rope[SEQ * 32 + i] = sinf(ang); }
        for (int i = gt; i < SEQ * 16; i += NGT) { const int t = i / 16, k = i % 16; const float inv = powf(10000.f, -(float)(k & 7) / 8.f);
            const float ang = (k < 8 ? (float)(t / 64) : (float)(t % 64)) * inv; rope[SEQ * 64 + i] = cosf(ang); rope[SEQ * 64 + SEQ * 16 + i] = sinf(ang); }
    }
}

__device__ __forceinline__ float row_rstd(const f32x4 (&v)[8]) {
    float s = 0.f;
#pragma unroll
    for (int j = 0; j < 8; ++j) s += (v[j][0] * v[j][0] + v[j][1] * v[j][1]) + (v[j][2] * v[j][2] + v[j][3] * v[j][3]);
    s = wave_sum(s);
    return 1.0f / sqrtf(s * (1.0f / D) + 1e-6f);
}
__device__ __forceinline__ void store_prenorm(bf16* hrow, int lane, const f32x4 (&v)[8], const float* g, const float* shift, const float* scale) {
    const float rstd = row_rstd(v);
#pragma unroll
    for (int j = 0; j < 8; ++j) { const int idx = lane + 64 * j;
        const f32x4 gg = ((const f32x4*)g)[idx], sh = ((const f32x4*)shift)[idx], sc = ((const f32x4*)scale)[idx];
        const f32x4 o = (v[j] * rstd) * gg * (sc + 1.0f) + sh;
        v2u w; w.x = pk2(o[0], o[1]); w.y = pk2(o[2], o[3]);
        *(v2u*)(hrow + 4 * idx) = w; }
}

__device__ __forceinline__ void phase_pro2(const PX& p) {
    unsigned char* wsb = opq_p(p.ws);
    const int tid = tid_opaque(p.wv), lane = tid & 63, wave = tid >> 6, G = gridDim.x, blk = blockIdx.x;
    const int gw = wave * G + blk, NGW = NW * G;
    float* X = (float*)(wsb + WS_X); bf16* H = (bf16*)(wsb + WS_H); const float* MOD = (const float*)(wsb + WS_MOD);
    for (int row = gw; row < M; row += NGW) {
        const int b = row / PB, pp = row % PB; const bool isctx = pp < CTX; const int v = isctx ? 4 : b;
        const float* src = isctx ? p.in[2] + ((size_t)b * CTX + pp) * D : p.in[0] + ((size_t)b * SEQ + (pp - CTX)) * D;
        f32x4 xv[8];
#pragma unroll
        for (int j = 0; j < 8; ++j) xv[j] = ((const f32x4*)src)[lane + 64 * j];
#pragma unroll
        for (int j = 0; j < 8; ++j) ((f32x4*)(X + (size_t)row * D))[lane + 64 * j] = xv[j];
        const float* mod = MOD + ((size_t)0 * 5 + v) * NMODC;
        store_prenorm(H + (size_t)row * D, lane, xv, p.in[6] + (size_t)(0 * 6 + 0) * D, mod + 0 * D, mod + 1 * D);
    }
}

__device__ __forceinline__ void phase_post(const PX& p, int layer, int s) {
    unsigned char* wsb = opq_p(p.ws);
    layer = opq_s(layer);
    const int tid = tid_opaque(p.wv), lane = tid & 63, wave = tid >> 6, G = gridDim.x, blk = blockIdx.x;
    const int gw = wave * G + blk, NGW = NW * G;
    float* X = (float*)(wsb + WS_X); bf16* H = (bf16*)(wsb + WS_H); const float* Y = (const float*)(wsb + WS_Y); const float* MOD = (const float*)(wsb + WS_MOD);
    const bool last = layer == DEPTH - 1, final = last && s == 2, split = !(last && s >= 1);
    const float wgt = (s == 1) ? 1.0f : 0.5f;
    const int l2 = (s < 2) ? layer : layer + 1, s2 = (s < 2) ? s + 1 : 0;
    for (int row = gw; row < M; row += NGW) {
        const int b = row / PB, pp = row % PB; const bool isctx = pp < CTX; const int v = isctx ? 4 : b;
        if (last && s >= 1 && isctx) continue;
        f32x4 yv[8], xv[8];
        if (split && row >= 8192) { const float* yp = (const float*)(wsb + WS_YP) + (size_t)(row - 8192) * D;
#pragma unroll
            for (int j = 0; j < 8; ++j) { f32x4 a = ((const f32x4*)yp)[lane + 64 * j];
#pragma unroll
                for (int sl = 1; sl < 8; ++sl) a += ((const f32x4*)(yp + (size_t)sl * 1024 * 2048))[lane + 64 * j];
                yv[j] = a; } }
        else {
#pragma unroll
            for (int j = 0; j < 8; ++j) yv[j] = ((const f32x4*)(Y + (size_t)row * D))[lane + 64 * j]; }
#pragma unroll
        for (int j = 0; j < 8; ++j) xv[j] = ((const f32x4*)(X + (size_t)row * D))[lane + 64 * j];
        const float rstd = row_rstd(yv);
        const float* gate = MOD + ((size_t)layer * 5 + v) * NMODC + (size_t)(3 * s + 2) * D;
        const float* gpost = p.in[6] + (size_t)(layer * 6 + 2 * s + 1) * D;
        float* dst = final ? p.out + ((size_t)b * SEQ + (pp - CTX)) * D : X + (size_t)row * D;
#pragma unroll
        for (int j = 0; j < 8; ++j) { const int idx = lane + 64 * j; const f32x4 ga = ((const f32x4*)gate)[idx], gp = ((const f32x4*)gpost)[idx];
            xv[j] = xv[j] + (ga * wgt) * ((yv[j] * rstd) * gp);
            ((f32x4*)dst)[idx] = xv[j]; }
        if (!final) { const float* mod = MOD + ((size_t)l2 * 5 + v) * NMODC;
            store_prenorm(H + (size_t)row * D, lane, xv, p.in[6] + (size_t)(l2 * 6 + 2 * s2) * D, mod + (size_t)(3 * s2) * D, mod + (size_t)(3 * s2 + 1) * D); }
    }
}

template <class Epi>
__device__ __forceinline__ void run_gemm(int wv, LAS unsigned char* lds, const bf16* A, const bf16* Bt, int nMt, int N, int K, int latonly, int coff, const Epi& E) {
    pg8::Gemm g{A, Bt, M, N, K, K, wv};
    TileOrder S; S.init(nMt, N, (int)gridDim.x, (int)((blockIdx.x + coff) % gridDim.x), latonly);
    pg8::gemm_phase<Epi, TileOrder, true, true>(lds, g, S, E);
}
struct OneUnit { int pm, pn;
    __device__ __forceinline__ bool next(int i, pg8::Unit& u) const { if (i != 0) return false; u.pm = pm; u.pn = pn; return true; }
    __device__ __forceinline__ void a_ready(const pg8::Unit&) const {}
    __device__ __forceinline__ void done(const pg8::Unit&) const {}
};
__device__ __forceinline__ void run_gemm_n2048_split(int wv, LAS unsigned char* lds, const bf16* A, const bf16* Bt, int K, float* Y, float* YP) {
    { EpiF32 E{Y, D}; run_gemm(wv, lds, A, Bt, 32, D, K, 0, 0, E); }
    __syncthreads();
    const int nkt = K / 64;
    for (int L = blockIdx.x; L < 256; L += gridDim.x) {
        const int s = L & 7, tile = L >> 3, pm = 32 + (tile >> 3), pn = tile & 7;
        const int per = nkt >> 3, odd = per & 1;
        const int kt0 = per * s + (odd ? (s & 1) : 0), nk = odd ? per + 1 - 2 * (s & 1) : per;
        pg8::Gemm g{A + (size_t)kt0 * 64, Bt + (size_t)kt0 * 64, M, D, nk * 64, K, wv};
        OneUnit S{pm, pn};
        EpiF32 E{YP + (ptrdiff_t)s * (1024 * 2048) - (ptrdiff_t)(32 * 256) * 2048, D};
        pg8::gemm_phase<EpiF32, OneUnit, true, true>(lds, g, S, E);
        __syncthreads();
    }
}
__device__ __forceinline__ void phase_ffn_in(const PX& p, LAS unsigned char* lds, int layer, int which) {
    unsigned char* wsb = opq_p(p.ws);
    layer = opq_s(layer);
    const bool lat = (layer == DEPTH - 1) && which == 1;
    EpiSwiglu E{(bf16*)(wsb + WS_ACT), DFF};
    run_gemm(p.wv, lds, (const bf16*)(wsb + WS_H), (const bf16*)(wsb + WS_WFFI) + (size_t)(layer * 2 + which) * (2 * DFF) * D, lat ? 32 : 36, 2 * DFF, D, lat, 0, E);
}
__device__ __forceinline__ void phase_ffn_out(const PX& p, LAS unsigned char* lds, int layer, int which) {
    unsigned char* wsb = opq_p(p.ws);
    layer = opq_s(layer);
    const bool lat = (layer == DEPTH - 1) && which == 1;
    const bf16* A = (const bf16*)(wsb + WS_ACT); const bf16* Bt = (const bf16*)(wsb + WS_WFFO) + (size_t)(layer * 2 + which) * D * DFF;
    if (lat) { EpiF32 E{(float*)(wsb + WS_Y), D}; run_gemm(p.wv, lds, A, Bt, 32, D, DFF, 1, 0, E); }
    else run_gemm_n2048_split(p.wv, lds, A, Bt, DFF, (float*)(wsb + WS_Y), (float*)(wsb + WS_YP));
}
__device__ __forceinline__ void phase_inproj(const PX& p, LAS unsigned char* lds, int layer) {
    unsigned char* wsb = opq_p(p.ws);
    layer = opq_s(layer);
    EpiB16 E{(bf16*)(wsb + WS_COLS), NINP};
    run_gemm(p.wv, lds, (const bf16*)(wsb + WS_H), (const bf16*)(wsb + WS_WIN) + (size_t)layer * NINP * D, 36, NINP, D, 0, 0, E);
}
__device__ __forceinline__ void phase_outproj(const PX& p, LAS unsigned char* lds, int layer) {
    unsigned char* wsb = opq_p(p.ws);
    layer = opq_s(layer);
    const bool lat = (layer == DEPTH - 1);
    const bf16* A = (const bf16*)(wsb + WS_YMIX); const bf16* Bt = (const bf16*)(wsb + WS_WOUT) + (size_t)layer * D * D;
    if (lat) { EpiF32 E{(float*)(wsb + WS_Y), D}; run_gemm(p.wv, lds, A, Bt, 32, D, D, 1, 0, E); }
    else run_gemm_n2048_split(p.wv, lds, A, Bt, D, (float*)(wsb + WS_Y), (float*)(wsb + WS_YP));
}

struct EpiLru {
    static constexpr bool PERM = false, AFTER_DRAIN = false;
    f32x2* AB; const bf16* U; const float* bg; const float* lam;
    __device__ __forceinline__ void operator()(const f32x4 (&acc)[2][2][4][2], const pg8::Unit& u, int wr, int wc, int fr, int fq) const {
        { const int ln = lane_fresh(); fr = ln & 15; fq = ln >> 4; }
        const int dir = u.pn >> 2, ch0 = (u.pn & 3) * 128 + wc * 32 + 4 * fq, row0 = u.pm * 256 + wr * 64 + fr;
        float br[2][4], bi[2][4], sp8[2][4];
#pragma unroll
        for (int n = 0; n < 2; ++n)
#pragma unroll
            for (int e = 0; e < 4; ++e) { const int ch = ch0 + 16 * n + e; br[n][e] = bg[(dir * 2 + 0) * 512 + ch]; bi[n][e] = bg[(dir * 2 + 1) * 512 + ch]; const float ee = __expf(-lam[dir * 512 + ch]); sp8[n][e] = 8.0f * (ee < 0.03f ? ee * (1.0f - ee * (0.5f - ee * 0.33333333f)) : __logf(1.0f + ee)); }
#pragma unroll
        for (int ai = 0; ai < 2; ++ai)
#pragma unroll
            for (int m = 0; m < 4; ++m) { const size_t row = (size_t)(row0 + ai * 128 + m * 16);
#pragma unroll
                for (int n = 0; n < 2; ++n) { const v2u uw = *(const v2u*)(U + row * 512 + ch0 + 16 * n);
                    const float uu[4] = {bflo(uw.x), bfhi(uw.x), bflo(uw.y), bfhi(uw.y)};
                    float o[8];
#pragma unroll
                    for (int e = 0; e < 4; ++e) { const float gr = acc[ai][0][m][n][e] + br[n][e], gi = acc[ai][1][m][n][e] + bi[n][e];
                        const float r = __builtin_amdgcn_rcpf(1.f + __expf(-gr)), ig = __builtin_amdgcn_rcpf(1.f + __expf(-gi));
                        const float log_a = -r * sp8[n][e], x2 = 2.0f * log_a;
                        const float om = x2 > -0.1f ? -x2 * (1.0f + x2 * (0.5f + x2 * (0.16666667f + x2 * 0.041666667f))) : 1.0f - __expf(x2);
                        o[2 * e] = __expf(log_a); o[2 * e + 1] = __builtin_amdgcn_sqrtf(om) * (ig * uu[e]); }
                    f32x4* dst = (f32x4*)(AB + ((size_t)dir * M + row) * 512 + ch0 + 16 * n);
                    dst[0] = (f32x4){o[0], o[1], o[2], o[3]}; dst[1] = (f32x4){o[4], o[5], o[6], o[7]}; } }
    }
};
struct EpiKvup {
    static constexpr bool PERM = true, AFTER_DRAIN = false;
    bf16* KMN; bf16* VTM;
    __device__ __forceinline__ void operator()(const f32x4 (&acc)[2][2][4][2], const pg8::Unit& u, int wr, int wc, int fr, int fq) const {
        { const int ln = lane_fresh(); fr = ln & 15; fq = ln >> 4; }
        const int row0 = u.pm * 256 + wr * 64 + fr, b = u.pm / 9, p0 = (u.pm % 9) * 256 + wr * 64 + fr;
#pragma unroll
        for (int ai = 0; ai < 2; ++ai)
#pragma unroll
            for (int m = 0; m < 4; ++m) { const size_t row = (size_t)(row0 + ai * 128 + m * 16); const int pp = p0 + ai * 128 + m * 16;
#pragma unroll
                for (int bj = 0; bj < 2; ++bj) { const int h = 2 * u.pn + bj; const f32x4 v0 = acc[ai][bj][m][0], v1 = acc[ai][bj][m][1];
                    if (wc < 2) { v4u w; w.x = pg8::cvt_pk_bf16(v0[0], v0[1]); w.y = pg8::cvt_pk_bf16(v0[2], v0[3]); w.z = pg8::cvt_pk_bf16(v1[0], v1[1]); w.w = pg8::cvt_pk_bf16(v1[2], v1[3]);
                        *(v4u*)(KMN + row * 512 + h * 64 + wc * 32 + 8 * fq) = w; }
                    else { bf16* vt = VTM + ((size_t)b * 512 + h * 64 + (wc - 2) * 32 + 8 * fq) * PB + pp;
                        vt[0 * (size_t)PB] = (bf16)f2bf(v0[0]); vt[1 * (size_t)PB] = (bf16)f2bf(v0[1]); vt[2 * (size_t)PB] = (bf16)f2bf(v0[2]); vt[3 * (size_t)PB] = (bf16)f2bf(v0[3]);
                        vt[4 * (size_t)PB] = (bf16)f2bf(v1[0]); vt[5 * (size_t)PB] = (bf16)f2bf(v1[1]); vt[6 * (size_t)PB] = (bf16)f2bf(v1[2]); vt[7 * (size_t)PB] = (bf16)f2bf(v1[3]); } } }
    }
};
__device__ __forceinline__ void phase_mgemm(const PX& p, LAS unsigned char* lds, int layer) {
    unsigned char* wsb = opq_p(p.ws);
    layer = opq_s(layer);
    { EpiB16 E{(bf16*)(wsb + WS_QUP), 768};
      run_gemm(p.wv, lds, (const bf16*)(wsb + WS_QN), (const bf16*)(wsb + WS_WQB) + (size_t)layer * 768 * 384, 36, 768, 384, 0, 0, E); }
    __syncthreads();
    { EpiKvup E{(bf16*)(wsb + WS_KMN), (bf16*)(wsb + WS_VTM)};
      run_gemm(p.wv, lds, (const bf16*)(wsb + WS_KVN), (const bf16*)(wsb + WS_WKVB) + (size_t)layer * 1024 * 256, 36, 1024, 256, 0, 148, E); }
    __syncthreads();
    { EpiLru E{(f32x2*)(wsb + WS_AB), (const bf16*)(wsb + WS_U), p.in[14] + (size_t)layer * 2 * 2 * 512, p.in[15] + (size_t)layer * 2 * 512};
      run_gemm(p.wv, lds, (const bf16*)(wsb + WS_U), (const bf16*)(wsb + WS_WG) + (size_t)layer * 2048 * 512, 36, 2048, 512, 0, 0, E); }
}


__device__ __forceinline__ void transpose_tok_item(const bf16* src, int ss, bf16* dst, LAS unsigned short* scr, int lane) {
#pragma unroll
    for (int i = 0; i < 8; ++i) { const int id = lane + 64 * i, row = id >> 3, ch = id & 7;
        const v4u w = *(const v4u*)(src + (size_t)row * ss + ch * 8);
        LAS unsigned* d = (LAS unsigned*)(scr + row * 66 + ch * 8);
        d[0] = w.x; d[1] = w.y; d[2] = w.z; d[3] = w.w; }
    LDS_WAIT(); asm volatile("" ::: "memory");
#pragma unroll
    for (int i = 0; i < 8; ++i) { const int id = lane + 64 * i, e = id >> 3, ch = id & 7;
        unsigned v[8];
#pragma unroll
        for (int k = 0; k < 8; ++k) v[k] = scr[(ch * 8 + k) * 66 + e];
        v4u w; w.x = v[0] | (v[1] << 16); w.y = v[2] | (v[3] << 16); w.z = v[4] | (v[5] << 16); w.w = v[6] | (v[7] << 16);
        *(v4u*)(dst + (size_t)e * PB + ch * 8) = w; }
    LDS_WAIT(); asm volatile("" ::: "memory");
}
__device__ __forceinline__ void phase_prep(const PX& p, LAS unsigned char* lds, int layer) {
    unsigned char* wsb = opq_p(p.ws);
    layer = opq_s(layer);
    const int tid = tid_opaque(p.wv), lane = tid & 63, wave = tid >> 6, G = gridDim.x, blk = blockIdx.x;
    const int gw = wave * G + blk, NGW = NW * G;
    bf16* COLS = (bf16*)(wsb + WS_COLS); bf16* U = (bf16*)(wsb + WS_U); bf16* QN = (bf16*)(wsb + WS_QN); bf16* KVN = (bf16*)(wsb + WS_KVN);
    const float* rope = (const float*)(wsb + WS_ROPE);
    const float* cw = p.in[11] + (size_t)layer * 4 * 512; const float* cb = p.in[12] + (size_t)layer * 512;
    const float* qg = p.in[16] + (size_t)layer * 384; const float* kvg = p.in[18] + (size_t)layer * 256;
    auto unpack8 = [](const v4u& w, float (&f)[8]) { f[0] = bflo(w.x); f[1] = bfhi(w.x); f[2] = bflo(w.y); f[3] = bfhi(w.y); f[4] = bflo(w.z); f[5] = bfhi(w.z); f[6] = bflo(w.w); f[7] = bfhi(w.w); };
    auto pack8 = [](const float (&f)[8]) { v4u w; w.x = pk2(f[0], f[1]); w.y = pk2(f[2], f[3]); w.z = pk2(f[4], f[5]); w.w = pk2(f[6], f[7]); return w; };
    for (int row = gw; row < M; row += NGW) {
        const int pp = row % PB; const bool isctx = pp < CTX;
        const int lo = isctx ? 0 : CTX, hi = isctx ? CTX : PB;
        bf16* crow = COLS + (size_t)row * NINP;
        { float acc[8];
          { const f32x4 b0 = *(const f32x4*)(cb + 8 * lane), b1 = *(const f32x4*)(cb + 8 * lane + 4);
            acc[0] = b0[0]; acc[1] = b0[1]; acc[2] = b0[2]; acc[3] = b0[3]; acc[4] = b1[0]; acc[5] = b1[1]; acc[6] = b1[2]; acc[7] = b1[3]; }
#pragma unroll
          for (int j = 0; j < 4; ++j) { const int q = pp + j - 2;
              if (q >= lo && q < hi) { float xv[8]; unpack8(*(const v4u*)(crow + (ptrdiff_t)(j - 2) * NINP + C_XB + 8 * lane), xv);
                  const f32x4 w0 = *(const f32x4*)(cw + j * 512 + 8 * lane), w1 = *(const f32x4*)(cw + j * 512 + 8 * lane + 4);
#pragma unroll
                  for (int e = 0; e < 4; ++e) { acc[e] += w0[e] * xv[e]; acc[4 + e] += w1[e] * xv[4 + e]; } } }
          *(v4u*)(U + (size_t)row * 512 + 8 * lane) = pack8(acc); }
        { float v[8]; float s = 0.f; const int l8 = lane < 48 ? lane : 47;
          unpack8(*(const v4u*)(crow + C_MQ + 8 * l8), v);
          if (lane < 48) {
#pragma unroll
              for (int e = 0; e < 8; ++e) s += v[e] * v[e]; }
          s = wave_sum(s); const float rstd = 1.0f / sqrtf(s * (1.0f / 384.f) + 1e-6f);
          const f32x4 g0 = *(const f32x4*)(qg + 8 * l8), g1 = *(const f32x4*)(qg + 8 * l8 + 4);
#pragma unroll
          for (int e = 0; e < 4; ++e) { v[e] = v[e] * rstd * g0[e]; v[4 + e] = v[4 + e] * rstd * g1[e]; }
          if (lane < 48) *(v4u*)(QN + (size_t)row * 384 + 8 * lane) = pack8(v); }
        { float v[8]; float s = 0.f; const int l8 = lane & 31;
          unpack8(*(const v4u*)(crow + C_MKV + 8 * l8), v);
          if (lane < 32) {
#pragma unroll
              for (int e = 0; e < 8; ++e) s += v[e] * v[e]; }
          s = wave_sum(s); const float rstd = 1.0f / sqrtf(s * (1.0f / 256.f) + 1e-6f);
          const f32x4 g0 = *(const f32x4*)(kvg + 8 * l8), g1 = *(const f32x4*)(kvg + 8 * l8 + 4);
#pragma unroll
          for (int e = 0; e < 4; ++e) { v[e] = v[e] * rstd * g0[e]; v[4 + e] = v[4 + e] * rstd * g1[e]; }
          if (lane < 32) *(v4u*)(KVN + (size_t)row * 256 + 8 * lane) = pack8(v); }
        if (!isctx) { const int t = pp - CTX; const int c = lane & 3, hsub = lane >> 2;
            const float* ct = rope + (size_t)t * 32 + 8 * c; const float* st = ct + SEQ * 32;
            const f32x4 c0 = *(const f32x4*)ct, c1 = *(const f32x4*)(ct + 4), s0 = *(const f32x4*)st, s1 = *(const f32x4*)(st + 4);
            const float cs[8] = {c0[0], c0[1], c0[2], c0[3], c1[0], c1[1], c1[2], c1[3]}, sn[8] = {s0[0], s0[1], s0[2], s0[3], s1[0], s1[1], s1[2], s1[3]};
#pragma unroll
            for (int k = 0; k < 2; ++k) { const int hd = 16 * k + hsub;
                if (hd < 26) { bf16* hp = crow + (hd < 16 ? C_DQ + hd * 64 : C_GQ + (hd - 16) * 64) + 8 * c;
                    float a[8], b[8], o1[8], o2[8]; unpack8(*(const v4u*)hp, a); unpack8(*(const v4u*)(hp + 32), b);
#pragma unroll
                    for (int e = 0; e < 8; ++e) { o1[e] = a[e] * cs[e] - b[e] * sn[e]; o2[e] = a[e] * sn[e] + b[e] * cs[e]; }
                    *(v4u*)hp = pack8(o1); *(v4u*)(hp + 32) = pack8(o2); } }
            if (lane < 2) { const float* ct2 = rope + SEQ * 64 + (size_t)t * 16 + 8 * lane; const float* st2 = ct2 + SEQ * 16;
                const f32x4 d0 = *(const f32x4*)ct2, d1 = *(const f32x4*)(ct2 + 4), e0 = *(const f32x4*)st2, e1 = *(const f32x4*)(st2 + 4);
                const float cs2[8] = {d0[0], d0[1], d0[2], d0[3], d1[0], d1[1], d1[2], d1[3]}, sn2[8] = {e0[0], e0[1], e0[2], e0[3], e1[0], e1[1], e1[2], e1[3]};
                bf16* hp = crow + C_MKR + 8 * lane;
                float a[8], b[8], o1[8], o2[8]; unpack8(*(const v4u*)hp, a); unpack8(*(const v4u*)(hp + 16), b);
#pragma unroll
                for (int e = 0; e < 8; ++e) { o1[e] = a[e] * cs2[e] - b[e] * sn2[e]; o2[e] = a[e] * sn2[e] + b[e] * cs2[e]; }
                *(v4u*)hp = pack8(o1); *(v4u*)(hp + 16) = pack8(o2); }
        }
    }
    { LAS unsigned short* scr = (LAS unsigned short*)(lds + wave * 16384);
      bf16* VTD = (bf16*)(wsb + WS_VTD); bf16* VTG = (bf16*)(wsb + WS_VTG);
      for (int it = gw; it < NB * 36 * 10; it += NGW) { const int b = it / 360, r = it % 360, tb = r / 10, cb = r % 10;
          const bf16* s = COLS + ((size_t)b * PB + tb * 64) * NINP + (cb < 8 ? C_DV + cb * 64 : C_GV + (cb - 8) * 64);
          bf16* d = cb < 8 ? VTD + ((size_t)b * 512 + cb * 64) * PB + tb * 64 : VTG + ((size_t)b * 128 + (cb - 8) * 64) * PB + tb * 64;
          transpose_tok_item(s, NINP, d, scr, lane); } }
}

__device__ __forceinline__ void phase_prep2(const PX& p, LAS unsigned char* lds, int layer) {
    unsigned char* wsb = opq_p(p.ws);
    layer = opq_s(layer);
    const int tid = tid_opaque(p.wv), lane = tid & 63, wave = tid >> 6, G = gridDim.x, blk = blockIdx.x;
    const int gw = wave * G + blk, NGW = NW * G;
    const bf16* COLS = (const bf16*)(wsb + WS_COLS); const bf16* U = (const bf16*)(wsb + WS_U);
    const bf16* QUP = (const bf16*)(wsb + WS_QUP); const bf16* KVUP = (const bf16*)(wsb + WS_KVUP);
    bf16* QM = (bf16*)(wsb + WS_QM); bf16* KM = (bf16*)(wsb + WS_KM);
    const float* GATES = (const float*)(wsb + WS_GATES); f32x2* AB = (f32x2*)(wsb + WS_AB);
    const float* rope = (const float*)(wsb + WS_ROPE);
    const float* bg = p.in[14] + (size_t)layer * 2 * 2 * 512; const float* lam = p.in[15] + (size_t)layer * 2 * 512;
    for (int row = gw; row < M; row += NGW) {
        const int pp = row % PB; const bool isctx = pp < CTX; const int t = pp - CTX;
#pragma unroll
        for (int j = 0; j < 12; ++j) { const int e = lane + 64 * j, h = e / 96, d = e % 96;
            float qv = bf2f(QUP[(size_t)row * 768 + e]);
            if (d >= 64 && !isctx) { const int i = (d - 64) & 15; const bool second = (d - 64) >= 16;
                const float c = rope[SEQ * 64 + t * 16 + i], sn = rope[SEQ * 64 + SEQ * 16 + t * 16 + i];
                const float x1 = bf2f(QUP[(size_t)row * 768 + h * 96 + 64 + i]), x2 = bf2f(QUP[(size_t)row * 768 + h * 96 + 80 + i]);
                qv = second ? (x1 * sn + x2 * c) : (x1 * c - x2 * sn); }
            QM[(size_t)row * 768 + e] = (bf16)f2bf(qv);
            KM[(size_t)row * 768 + e] = d < 64 ? KVUP[(size_t)row * 1024 + h * 128 + d] : COLS[(size_t)row * NINP + C_MKR + (d - 64)]; }
#pragma unroll
        for (int dir = 0; dir < 2; ++dir)
#pragma unroll
            for (int cblk = 0; cblk < 8; ++cblk) { const int ch = cblk * 64 + lane;
                const float* gp = GATES + (size_t)row * 2048 + ((dir * 4 + (ch >> 7)) * 2) * 128 + (ch & 127);
                const float gr = gp[0] + bg[(dir * 2 + 0) * 512 + ch], gi = gp[128] + bg[(dir * 2 + 1) * 512 + ch];
                const float r = 1.f / (1.f + expf(-gr)), ig = 1.f / (1.f + expf(-gi));
                const float sp = log1pf(expf(-lam[dir * 512 + ch]));
                const float log_a = -8.0f * r * sp, a = expf(log_a);
                const float u = bf2f(U[(size_t)row * 512 + ch]);
                const float bco = sqrtf(-expm1f(2.0f * log_a)) * (ig * u);
                AB[((size_t)dir * M + row) * 512 + ch] = (f32x2){a, bco}; }
    }
    { LAS unsigned short* scr = (LAS unsigned short*)(lds + wave * 16384);
      bf16* VTM = (bf16*)(wsb + WS_VTM);
      for (int it = gw; it < NB * 36 * 8; it += NGW) { const int b = it / 288, r = it % 288, tb = r / 8, hh = r % 8;
          transpose_tok_item(KVUP + ((size_t)b * PB + tb * 64) * 1024 + hh * 128 + 64, 1024, VTM + ((size_t)b * 512 + hh * 64) * PB + tb * 64, scr, lane); } }
}

template <int DQK, int DV, int MODE, bool OUTF32>
__device__ __forceinline__ void naive_attn(const bf16* Q, int qs, const bf16* K, int ks, const bf16* V, int vs, void* O, int os,
                                           int b, int pp0, int lane, float scale, float sink) {
    const size_t rowbase = (size_t)b * PB; const int pp = pp0 + lane;
    float q[DQK], o[DV];
    { const bf16* qr = Q + (rowbase + pp) * qs;
#pragma unroll
      for (int c = 0; c < DQK / 8; ++c) { const v4u w = *(const v4u*)(qr + 8 * c);
          q[8 * c + 0] = bflo(w.x); q[8 * c + 1] = bfhi(w.x); q[8 * c + 2] = bflo(w.y); q[8 * c + 3] = bfhi(w.y);
          q[8 * c + 4] = bflo(w.z); q[8 * c + 5] = bfhi(w.z); q[8 * c + 6] = bflo(w.w); q[8 * c + 7] = bfhi(w.w); } }
    const float sl2 = scale * 1.4426950408889634f;
#pragma unroll
    for (int d = 0; d < DQK; ++d) q[d] *= sl2;
#pragma unroll
    for (int e = 0; e < DV; ++e) o[e] = 0.f;
    float m = (MODE == 1) ? sink * 1.4426950408889634f : -1e30f, l = (MODE == 1) ? 1.f : 0.f;
    const bool isctx = pp0 < CTX; const int t = pp - CTX, t0 = pp0 - CTX;
    for (int seg = 0; seg < 2; ++seg) {
        int k0, k1;
        if (seg == 0) { k0 = 0; k1 = CTX; }
        else { if (isctx) break;
            if (MODE == 0) { k0 = CTX; k1 = PB; }
            else { const int a0 = t0 - 128 < 0 ? 0 : t0 - 128, a1 = t0 + 63 + 128 > SEQ - 1 ? SEQ - 1 : t0 + 63 + 128; k0 = CTX + a0; k1 = CTX + a1 + 1; } }
        for (int key = k0; key < k1; ++key) {
            const bf16* kr = K + (rowbase + key) * ks; const bf16* vr = V + (rowbase + key) * vs;
            asm volatile("" : "+v"(kr)); asm volatile("" : "+v"(vr));
            float s = 0.f;
#pragma unroll
            for (int c = 0; c < DQK / 8; ++c) { const v4u w = *(const v4u*)(kr + 8 * c);
                s += q[8 * c + 0] * bflo(w.x); s += q[8 * c + 1] * bfhi(w.x); s += q[8 * c + 2] * bflo(w.y); s += q[8 * c + 3] * bfhi(w.y);
                s += q[8 * c + 4] * bflo(w.z); s += q[8 * c + 5] * bfhi(w.z); s += q[8 * c + 6] * bflo(w.w); s += q[8 * c + 7] * bfhi(w.w); }
            bool valid = true;
            if (MODE == 1 && seg == 1) { const int rel = (key - CTX) - t; valid = (rel <= 128) && (rel >= -128); }
            if (valid) {
                const float mn = fmaxf(m, s), alpha = exp2f(m - mn), pr = exp2f(s - mn);
                l = l * alpha + pr; m = mn;
#pragma unroll
                for (int c = 0; c < DV / 8; ++c) { const v4u w = *(const v4u*)(vr + 8 * c);
                    o[8 * c + 0] = o[8 * c + 0] * alpha + pr * bflo(w.x); o[8 * c + 1] = o[8 * c + 1] * alpha + pr * bfhi(w.x);
                    o[8 * c + 2] = o[8 * c + 2] * alpha + pr * bflo(w.y); o[8 * c + 3] = o[8 * c + 3] * alpha + pr * bfhi(w.y);
                    o[8 * c + 4] = o[8 * c + 4] * alpha + pr * bflo(w.z); o[8 * c + 5] = o[8 * c + 5] * alpha + pr * bfhi(w.z);
                    o[8 * c + 6] = o[8 * c + 6] * alpha + pr * bflo(w.w); o[8 * c + 7] = o[8 * c + 7] * alpha + pr * bfhi(w.w); }
            }
        }
    }
    const float il = 1.f / l;
    if (OUTF32) { float* orow = (float*)O + (rowbase + pp) * os;
#pragma unroll
        for (int e = 0; e < DV; e += 4) *(f32x4*)(orow + e) = (f32x4){o[e] * il, o[e + 1] * il, o[e + 2] * il, o[e + 3] * il}; }
    else { bf16* orow = (bf16*)O + (rowbase + pp) * os;
#pragma unroll
        for (int e = 0; e < DV; e += 8) { v4u w; w.x = pk2(o[e] * il, o[e + 1] * il); w.y = pk2(o[e + 2] * il, o[e + 3] * il); w.z = pk2(o[e + 4] * il, o[e + 5] * il); w.w = pk2(o[e + 6] * il, o[e + 7] * il);
            *(v4u*)(orow + e) = w; } }
}


typedef short bf16x8 __attribute__((ext_vector_type(8)));
typedef float f32x16 __attribute__((ext_vector_type(16)));
__device__ __forceinline__ int crow16(int r, int hi) { return (r & 3) + 8 * (r >> 2) + 4 * hi; }

typedef __bf16 bf16x2_t __attribute__((ext_vector_type(2)));
__device__ __forceinline__ unsigned cvtpk_s(float lo, float hi) { const f32x2 v = {lo, hi}; const bf16x2_t b = __builtin_convertvector(v, bf16x2_t); return __builtin_bit_cast(unsigned, b); }
template <int DQK, int DV, int MODE, bool OUTF32>
__device__ __forceinline__ void attn_unit(LAS unsigned char* lds, const bf16* Qb, int qs, const bf16* Kb, int ks, const bf16* Kb2, int ks2, const float* ropeq, const bf16* VTb, void* Ob, int os,
                                          int q0, int ntd, float scale, float sink, int tid_in) {
    int tid = tid_in; asm volatile("" : "+v"(tid));
    constexpr int RSK = DQK * 2 + 16, RSV = 136, KBUF = 64 * RSK, VBUF = DV * RSV, CPR = DQK / 8, NKC = 64 * CPR, NVC = DV * 8;
    constexpr int NKI = (NKC + NT - 1) / NT, NVI = NVC / NT, ND0 = DQK / 16, NDB = DV / 32;
    const int lane = tid & 63, wave = __builtin_amdgcn_readfirstlane(tid >> 6), r32 = lane & 31, hi = lane >> 5;
    int ta = 4, ntiles = ntd;
    if (MODE == 1) { if (q0 < CTX) ntiles = 4; else { const int t0 = q0 - CTX; const int lo = t0 - 128 < 0 ? 0 : t0 - 128, hh = t0 + 383 > SEQ - 1 ? SEQ - 1 : t0 + 383; ta = 4 + (lo >> 6); ntiles = 4 + ((hh >> 6) - (lo >> 6) + 1); } }
#define TILE_OF(i) ((MODE == 1 && (i) >= 4) ? ta + (i) - 4 : (i))
    const int qrow = q0 + wave * 32 + r32;
    bf16x8 qf[ND0];
#pragma unroll
    for (int d0 = 0; d0 < ND0; ++d0) qf[d0] = *(const bf16x8*)(Qb + (size_t)qrow * qs + 16 * d0 + 8 * hi);
    if (DQK == 96 && ropeq != nullptr) {
        const float* cs = ropeq + (size_t)(qrow - CTX) * 16 + 8 * hi; const float* sn = cs + SEQ * 16;
        const f32x4 c0 = *(const f32x4*)cs, c1 = *(const f32x4*)(cs + 4), s0 = *(const f32x4*)sn, s1 = *(const f32x4*)(sn + 4);
        float y1[8], y2[8];
#pragma unroll
        for (int j = 0; j < 8; ++j) { const float x1 = bf2f((unsigned short)qf[ND0 - 2][j]), x2 = bf2f((unsigned short)qf[ND0 - 1][j]);
            const float cc = j < 4 ? c0[j] : c1[j - 4], ss = j < 4 ? s0[j] : s1[j - 4];
            y1[j] = x1 * cc - x2 * ss; y2[j] = x1 * ss + x2 * cc; }
        qf[ND0 - 2] = __builtin_bit_cast(bf16x8, (v4u){cvtpk_s(y1[0], y1[1]), cvtpk_s(y1[2], y1[3]), cvtpk_s(y1[4], y1[5]), cvtpk_s(y1[6], y1[7])});
        qf[ND0 - 1] = __builtin_bit_cast(bf16x8, (v4u){cvtpk_s(y2[0], y2[1]), cvtpk_s(y2[2], y2[3]), cvtpk_s(y2[4], y2[5]), cvtpk_s(y2[6], y2[7])});
    }
    f32x16 o[NDB];
#pragma unroll
    for (int db = 0; db < NDB; ++db)
#pragma unroll
        for (int r = 0; r < 16; ++r) o[db][r] = 0.f;
    const float c = scale * 1.4426950408889634f;
    float m = (MODE == 1) ? sink / scale : -1e30f, l = (MODE == 1 && hi == 0) ? 1.f : 0.f;
    v4u kreg[NKI], vreg[NVI];
#pragma unroll
    for (int i_ = 0; i_ < NKI; ++i_) kreg[i_] = (v4u){0u, 0u, 0u, 0u};
#pragma unroll
    for (int i_ = 0; i_ < NVI; ++i_) vreg[i_] = (v4u){0u, 0u, 0u, 0u};
#define LOAD_TILE(tile) do { const int kb_ = (tile) * 64; \
        _Pragma("unroll") for (int i_ = 0; i_ < NKI; ++i_) { const int id_ = tid + NT * i_; if (id_ < NKC) { const int row_ = id_ / CPR, ch_ = id_ % CPR; kreg[i_] = (DQK == 96 && ch_ >= 8) ? *(const v4u*)(Kb2 + (size_t)(kb_ + row_) * ks2 + (ch_ - 8) * 8) : *(const v4u*)(Kb + (size_t)(kb_ + row_) * ks + ch_ * 8); } } \
        _Pragma("unroll") for (int i_ = 0; i_ < NVI; ++i_) { const int id_ = tid + NT * i_, d_ = id_ >> 3, ch_ = id_ & 7; vreg[i_] = *(const v4u*)(VTb + (size_t)d_ * PB + kb_ + ch_ * 8); } } while (0)
#define STORE_TILE(buf) do { \
        _Pragma("unroll") for (int i_ = 0; i_ < NKI; ++i_) { const int id_ = tid + NT * i_; if (id_ < NKC) { const int row_ = id_ / CPR, ch_ = id_ % CPR; *(LAS v4u*)(lds + (buf) * KBUF + row_ * RSK + ch_ * 16) = kreg[i_]; } } \
        _Pragma("unroll") for (int i_ = 0; i_ < NVI; ++i_) { const int id_ = tid + NT * i_, d_ = id_ >> 3, ch_ = id_ & 7; LAS v2u* w_ = (LAS v2u*)(lds + 2 * KBUF + (buf) * VBUF + d_ * RSV + ch_ * 16); \
            w_[0] = (v2u){vreg[i_].x, vreg[i_].y}; w_[1] = (v2u){vreg[i_].z, vreg[i_].w}; } } while (0)
    LOAD_TILE(TILE_OF(0)); STORE_TILE(0); __syncthreads();
    for (int i = 0; i < ntiles; ++i) {
        const int cur = i & 1, tile = TILE_OF(i);
        if (i + 1 < ntiles) LOAD_TILE(TILE_OF(i + 1));
        bool active = true;
        if (MODE == 1 && i >= 4) { const int kt0 = tile * 64 - CTX, qt0 = q0 - CTX + wave * 32; active = (kt0 + 63 >= qt0 - 128) && (kt0 <= qt0 + 31 + 128); }
        if (active) {
            f32x16 p0, p1;
#pragma unroll
            for (int r = 0; r < 16; ++r) { p0[r] = 0.f; p1[r] = 0.f; }
            const LAS unsigned char* kb = lds + cur * KBUF + r32 * RSK + hi * 16;
#pragma unroll
            for (int d0 = 0; d0 < ND0; ++d0) { const bf16x8 k0 = *(const LAS bf16x8*)(kb + d0 * 32), k1 = *(const LAS bf16x8*)(kb + 32 * RSK + d0 * 32);
                p0 = __builtin_amdgcn_mfma_f32_32x32x16_bf16(k0, qf[d0], p0, 0, 0, 0); p1 = __builtin_amdgcn_mfma_f32_32x32x16_bf16(k1, qf[d0], p1, 0, 0, 0); }
            if (MODE == 1 && i >= 4) { const int rel0 = (tile * 64 - CTX) - (qrow - CTX);
#pragma unroll
                for (int r = 0; r < 16; ++r) { const int ra = rel0 + crow16(r, hi), rb = ra + 32;
                    if (ra > 128 || ra < -128) p0[r] = -1e30f; if (rb > 128 || rb < -128) p1[r] = -1e30f; } }
            float mx = fmaxf(p0[0], p1[0]);
#pragma unroll
            for (int r = 1; r < 16; ++r) mx = fmaxf(mx, fmaxf(p0[r], p1[r]));
            mx = xhalf_max(mx);
            const float mn = fmaxf(m, mx), alpha = __builtin_amdgcn_exp2f((m - mn) * c), nmc = -mn * c; m = mn;
            float sum = 0.f;
#pragma unroll
            for (int r = 0; r < 16; ++r) { p0[r] = __builtin_amdgcn_exp2f(fmaf(p0[r], c, nmc)); p1[r] = __builtin_amdgcn_exp2f(fmaf(p1[r], c, nmc)); sum += p0[r] + p1[r]; }
            l = l * alpha + sum;
            if (!__all(alpha == 1.f)) {
#pragma unroll
                for (int db = 0; db < NDB; ++db)
#pragma unroll
                    for (int r = 0; r < 16; ++r) o[db][r] *= alpha; }
            const LAS unsigned char* vb = lds + 2 * KBUF + cur * VBUF + r32 * RSV + hi * 8;
#pragma unroll
            for (int s = 0; s < 4; ++s) { const int rb = (s & 1) * 8;
                v4u pw;
                if (s < 2) { pw.x = cvtpk_s(p0[rb + 0], p0[rb + 1]); pw.y = cvtpk_s(p0[rb + 2], p0[rb + 3]); pw.z = cvtpk_s(p0[rb + 4], p0[rb + 5]); pw.w = cvtpk_s(p0[rb + 6], p0[rb + 7]); }
                else       { pw.x = cvtpk_s(p1[rb + 0], p1[rb + 1]); pw.y = cvtpk_s(p1[rb + 2], p1[rb + 3]); pw.z = cvtpk_s(p1[rb + 4], p1[rb + 5]); pw.w = cvtpk_s(p1[rb + 6], p1[rb + 7]); }
                const bf16x8 pf = __builtin_bit_cast(bf16x8, pw);
#pragma unroll
                for (int db = 0; db < NDB; ++db) { const LAS unsigned char* vp = vb + db * 32 * RSV + s * 32;
                    const v2u a0 = *(const LAS v2u*)(vp), a1 = *(const LAS v2u*)(vp + 16);
                    const bf16x8 vf = __builtin_bit_cast(bf16x8, (v4u){a0.x, a0.y, a1.x, a1.y});
                    o[db] = __builtin_amdgcn_mfma_f32_32x32x16_bf16(vf, pf, o[db], 0, 0, 0); }
                __builtin_amdgcn_sched_barrier(0); }
        }
        if (i + 1 < ntiles) STORE_TILE(cur ^ 1);
        __syncthreads();
    }
#undef LOAD_TILE
#undef STORE_TILE
#undef TILE_OF
    l = xhalf_sum(l);
    const float il = 1.f / l;
#pragma unroll
    for (int db = 0; db < NDB; ++db)
#pragma unroll
        for (int rr = 0; rr < 4; ++rr) { const int d = 32 * db + 8 * rr + 4 * hi;
            const float a = o[db][4 * rr] * il, b = o[db][4 * rr + 1] * il, cc = o[db][4 * rr + 2] * il, dd = o[db][4 * rr + 3] * il;
            if (OUTF32) *(f32x4*)((float*)Ob + (size_t)qrow * os + d) = (f32x4){a, b, cc, dd};
            else *(v2u*)((bf16*)Ob + (size_t)qrow * os + d) = (v2u){cvtpk_s(a, b), cvtpk_s(cc, dd)}; }
}

__device__ __forceinline__ void phase_att(const PX& p, LAS unsigned char* lds, int layer) {
    unsigned char* wsb = opq_p(p.ws);
    layer = opq_s(layer);
    const int tid = tid_opaque(p.wv), lane = tid & 63, wave = __builtin_amdgcn_readfirstlane(tid >> 6), G = gridDim.x, blk = blockIdx.x;
    const int gw = wave * G + blk;
    const bool last = layer == DEPTH - 1;
    const bf16* COLS = (const bf16*)(wsb + WS_COLS);
    const bf16* QUP = (const bf16*)(wsb + WS_QUP); const bf16* KMN = (const bf16*)(wsb + WS_KMN);
    const bf16* VTD = (const bf16*)(wsb + WS_VTD); const bf16* VTG = (const bf16*)(wsb + WS_VTG); const bf16* VTM = (const bf16*)(wsb + WS_VTM);
    bf16* YMIX = (bf16*)(wsb + WS_YMIX); float* DIFFO = (float*)(wsb + WS_DIFFO);
    const f32x2* AB = (const f32x2*)(wsb + WS_AB);
    { f32x2* SUM = (f32x2*)(wsb + WS_SUM);
      for (int it = gw; it < NB * 2 * 36 * 8; it += NW * G) { const int g = it & 7, c = (it >> 3) % 36, dir = (it / 288) & 1, b = it / 576, ch = g * 64 + lane;
          const f32x2* ab = AB + ((size_t)dir * M + (size_t)b * PB + c * 64) * 512 + ch;
          float A = 1.f, H = 0.f;
          if (dir == 0) {
#pragma unroll 16
              for (int q = 0; q < 64; ++q) { const f32x2 cf = ab[(size_t)q * 512]; H = cf.x * H + cf.y; A *= cf.x; }
          } else {
#pragma unroll 16
              for (int q = 63; q >= 0; --q) { const f32x2 cf = ab[(size_t)q * 512]; H = cf.x * H + cf.y; A *= cf.x; }
          }
          const int ord = dir == 0 ? c : (c <= 3 ? 3 - c : 39 - c);
          SUM[(((size_t)dir * NB + b) * 40 + ord) * 512 + ch] = (f32x2){A, H}; } }
    for (int u = blk; u < 256; u += G) {
        const int xcd = u & 7, j = u >> 3, grp = xcd * 4 + (j >> 3), qb = j & 7, b = grp >> 3, hh = grp & 7, q0 = CTX + qb * 256;
        const size_t rb = (size_t)b * PB;
        attn_unit<96, 64, 0, false>(lds, QUP + rb * 768 + hh * 96, 768, KMN + rb * 512 + hh * 64, 512, COLS + rb * NINP + C_MKR, NINP, (const float*)(wsb + WS_ROPE) + SEQ * 64, VTM + ((size_t)b * 512 + hh * 64) * PB, YMIX + rb * 2048 + 512 + hh * 64, 2048, q0, 36, 0.10206207261596575f, 0.f, tid);
        attn_unit<64, 128, 0, true>(lds, COLS + rb * NINP + C_DQ + hh * 64, NINP, COLS + rb * NINP + C_DK + hh * 64, NINP, nullptr, 0, nullptr, VTD + ((size_t)b * 512 + (hh >> 1) * 128) * PB, DIFFO + rb * 1024 + hh * 128, 1024, q0, 36, 0.125f, 0.f, tid);
        attn_unit<64, 64, 1, false>(lds, COLS + rb * NINP + C_GQ + hh * 64, NINP, COLS + rb * NINP + C_GK + (hh >> 2) * 64, NINP, nullptr, 0, nullptr, VTG + ((size_t)b * 128 + (hh >> 2) * 64) * PB, YMIX + rb * 2048 + 1536 + hh * 64, 2048, q0, 0, 0.125f, p.in[22][layer * 8 + hh], tid);
    }
    if (!last) {
        for (int u = blk; u < 96; u += G) { const int kind = u >> 5, b = (u >> 3) & 3, hh = u & 7; const size_t rb = (size_t)b * PB;
            if (kind == 0) attn_unit<96, 64, 0, false>(lds, QUP + rb * 768 + hh * 96, 768, KMN + rb * 512 + hh * 64, 512, COLS + rb * NINP + C_MKR, NINP, nullptr, VTM + ((size_t)b * 512 + hh * 64) * PB, YMIX + rb * 2048 + 512 + hh * 64, 2048, 0, 4, 0.10206207261596575f, 0.f, tid);
            else if (kind == 1) attn_unit<64, 128, 0, true>(lds, COLS + rb * NINP + C_DQ + hh * 64, NINP, COLS + rb * NINP + C_DK + hh * 64, NINP, nullptr, 0, nullptr, VTD + ((size_t)b * 512 + (hh >> 1) * 128) * PB, DIFFO + rb * 1024 + hh * 128, 1024, 0, 4, 0.125f, 0.f, tid);
            else attn_unit<64, 64, 1, false>(lds, COLS + rb * NINP + C_GQ + hh * 64, NINP, COLS + rb * NINP + C_GK + (hh >> 2) * 64, NINP, nullptr, 0, nullptr, VTG + ((size_t)b * 128 + (hh >> 2) * 64) * PB, YMIX + rb * 2048 + 1536 + hh * 64, 2048, 0, 0, 0.125f, p.in[22][layer * 8 + hh], tid);
        }
    }
}

__device__ __forceinline__ void phase_mixfin(const PX& p, LAS unsigned char* lds, int layer) {
    layer = opq_s(layer);
    unsigned char* wsb = opq_p(p.ws);
    const int tid = tid_opaque(p.wv), lane = tid & 63, wave = tid >> 6, G = gridDim.x, blk = blockIdx.x;
    const int gw = wave * G + blk, NGW = NW * G;
    const bool last = layer == DEPTH - 1;
    const bf16* COLS = (const bf16*)(wsb + WS_COLS); bf16* YMIX = (bf16*)(wsb + WS_YMIX); const float* DIFFO = (const float*)(wsb + WS_DIFFO);
    { const f32x2* AB = (const f32x2*)(wsb + WS_AB); const f32x2* SUM = (const f32x2*)(wsb + WS_SUM);
      LAS float* hf = (LAS float*)(lds + wave * 16384);
      for (int it = gw; it < NB * 36 * 8; it += NGW) { const int g = it & 7, c = (it >> 3) % 36, b = it / 288, ch = g * 64 + lane;
          if (last && c < 4) continue;
          { const f32x2* sm = SUM + (((size_t)0 * NB + b) * 40) * 512 + ch; float h = 0.f;
            for (int o = 0; o < c; ++o) { const f32x2 s = sm[(size_t)o * 512]; h = s.x * h + s.y; }
            const f32x2* ab = AB + ((size_t)0 * M + (size_t)b * PB + c * 64) * 512 + ch;
#pragma unroll 16
            for (int q = 0; q < 64; ++q) { const f32x2 cf = ab[(size_t)q * 512]; h = cf.x * h + cf.y; hf[q * 64 + lane] = h; } }
          { const int ord = c <= 3 ? 3 - c : 39 - c;
            const f32x2* sm = SUM + (((size_t)1 * NB + b) * 40) * 512 + ch; float h = 0.f;
            for (int o = 0; o < ord; ++o) { const f32x2 s = sm[(size_t)o * 512]; h = s.x * h + s.y; }
            const f32x2* ab = AB + ((size_t)1 * M + (size_t)b * PB + c * 64) * 512 + ch;
            LDS_WAIT();
#pragma unroll 8
            for (int q = 63; q >= 0; --q) { const f32x2 cf = ab[(size_t)q * 512]; h = cf.x * h + cf.y; const size_t row = (size_t)b * PB + c * 64 + q;
                const float gt = bf2f(COLS[row * NINP + C_GATE + ch]);
                YMIX[row * 2048 + ch] = (bf16)f2bf((hf[q * 64 + lane] + h) * gelu_tanh(gt)); } }
          LDS_WAIT(); } }
    const float* lv = p.in[20] + (size_t)layer * 4 * 64; const float* dg = p.in[21] + (size_t)layer * 128;
    const float lam_init = 0.8f - 0.6f * expf(-0.3f * (float)layer);
    const float lam = expf(wave_sum(lv[lane] * lv[64 + lane])) - expf(wave_sum(lv[128 + lane] * lv[192 + lane])) + lam_init;
    for (int row = gw; row < M; row += NGW) {
        const int pp = row % PB; if (last && pp < CTX) continue;
#pragma unroll
        for (int hh = 0; hh < 4; ++hh) { float o[2]; float s = 0.f;
#pragma unroll
            for (int j = 0; j < 2; ++j) { const int e = lane + 64 * j;
                o[j] = DIFFO[(size_t)row * 1024 + (2 * hh) * 128 + e] - lam * DIFFO[(size_t)row * 1024 + (2 * hh + 1) * 128 + e]; s += o[j] * o[j]; }
            s = wave_sum(s); const float rstd = 1.0f / sqrtf(s * (1.0f / 128.f) + 1e-6f);
#pragma unroll
            for (int j = 0; j < 2; ++j) { const int e = lane + 64 * j; YMIX[(size_t)row * 2048 + 1024 + hh * 128 + e] = (bf16)f2bf(o[j] * rstd * dg[e] * (1.0f - lam_init)); } }
    }
}

#define XB_TMO      128
#define XB_XCNT(j)  (256  + 64 * (j))
#define XB_XSUB(j)  (1280 + 64 * (j))
#define XB_XGEN(j)  (2304 + 64 * (j))
#define XB_TOP      3328
#define XB_TOPGEN   3392
#define XCD_BAR_WORDS 3456
#define XB_SPIN_CAP (1u << 18)

__device__ __forceinline__ unsigned xb_ld(unsigned* p)              { return __hip_atomic_load(p, __ATOMIC_RELAXED, __HIP_MEMORY_SCOPE_AGENT); }
__device__ __forceinline__ unsigned xb_add(unsigned* p, unsigned v) { return __hip_atomic_fetch_add(p, v, __ATOMIC_RELAXED, __HIP_MEMORY_SCOPE_AGENT); }
__device__ __forceinline__ unsigned xb_xcc_id() { return (unsigned)__builtin_amdgcn_s_getreg((3 << 11) | 20) & 0xFu; }
#define XB_SPIN(cond, bar) do { unsigned _sp = 0; while (cond) { __builtin_amdgcn_s_sleep(1); \
    if ((++_sp & 255u) == 0u) { if (xb_ld(&(bar)[XB_TMO])) break; if (_sp > XB_SPIN_CAP) { atomicAdd(&(bar)[XB_TMO], 1u); break; } } } } while (0)

struct XcdBarrier {
    int wv;
    unsigned* bar; unsigned x;
    volatile LAS unsigned* st;
};

__device__ __forceinline__ XcdBarrier xcd_barrier_post(unsigned* bar, volatile LAS unsigned* st) {
    XcdBarrier b; b.bar = bar; b.x = xb_xcc_id(); b.st = st;
    if (threadIdx.x == 0) (void)xb_add(&bar[XB_XCNT(b.x)], 1u);
    return b;
}
__device__ __forceinline__ void xcd_barrier_complete(unsigned* bar, unsigned x, unsigned& nloc, unsigned& nx) {
    const unsigned G = gridDim.x * gridDim.y * gridDim.z;
    unsigned sum, cnt, mine, sp = 0u;
    for (;;) {
        sum = 0u; cnt = 0u; mine = 0u;
#pragma unroll
        for (unsigned j = 0; j < 16; ++j) { const unsigned c = xb_ld(&bar[XB_XCNT(j)]); sum += c; cnt += (c > 0u) ? 1u : 0u; mine = (j == x) ? c : mine; }
        if (sum == G) break;
        __builtin_amdgcn_s_sleep(1);
        if ((++sp & 255u) == 0u) { if (xb_ld(&bar[XB_TMO])) break; if (sp > XB_SPIN_CAP) { atomicAdd(&bar[XB_TMO], 1u); break; } }
    }
    nloc = mine > 0u ? mine : 1u; nx = cnt > 0u ? cnt : 1u;
}

__device__ __forceinline__ void xcd_barrier(const XcdBarrier& b) {
    asm volatile("s_waitcnt vmcnt(0)" ::: "memory");
    __syncthreads();
    if (b.wv == 0 && lane_fresh() == 0) {
        unsigned* bar = b.bar; const unsigned bx = xb_xcc_id();
        __builtin_amdgcn_s_waitcnt(0);
        unsigned nloc = b.st[0], nx = b.st[1];
        if (nloc == 0u) { xcd_barrier_complete(bar, bx, nloc, nx); b.st[0] = nloc; b.st[1] = nx; }
        const unsigned old = xb_add(&bar[XB_XSUB(bx)], 1u);
        const unsigned gen = old / nloc;
        if (old + 1u == (gen + 1u) * nloc) {
            __builtin_amdgcn_fence(__ATOMIC_RELEASE, "agent");
            asm volatile("s_waitcnt vmcnt(0)" ::: "memory");
            const unsigned og = xb_add(&bar[XB_TOP], 1u);
            const unsigned tg = og / nx;
            if (og + 1u == (tg + 1u) * nx) xb_add(&bar[XB_TOPGEN], 1u);
            else XB_SPIN(xb_ld(&bar[XB_TOPGEN]) == tg, bar);
            __builtin_amdgcn_fence(__ATOMIC_ACQUIRE, "agent");
            xb_add(&bar[XB_XGEN(bx)], 1u);
            asm volatile("s_waitcnt vmcnt(0)" ::: "memory");
        } else {
            XB_SPIN(xb_ld(&bar[XB_XGEN(bx)]) == gen, bar);
            __builtin_amdgcn_fence(__ATOMIC_ACQUIRE, "agent");
            asm volatile("s_waitcnt vmcnt(0)" ::: "memory");
        }
    }
    __syncthreads();
}

constexpr int CW_BAR = 4096;
constexpr size_t CTL_ZERO_BYTES = 1 * MiB;
constexpr int LDSCTL_OFF = 131072, MISC_OFF = LDSCTL_OFF + 320;

__global__ void __launch_bounds__(NT, 2) k_mega(P p) {
    extern __shared__ __attribute__((aligned(16))) unsigned char lds_raw[];
    LAS unsigned char* lds = (LAS unsigned char*)lds_raw;
    const int wv = __builtin_amdgcn_readfirstlane((int)threadIdx.x >> 6);
    const KP kp = (KP)__builtin_amdgcn_kernarg_segment_ptr();
    for (int u = threadIdx.x; u < (LDS_BYTES - LDSCTL_OFF) / 4; u += NT) ((LAS unsigned*)(lds + LDSCTL_OFF))[u] = 0u;
    __syncthreads();
    unsigned* barw = (unsigned*)(p.ws + WS_CTL) + CW_BAR;
    XcdBarrier bar = xcd_barrier_post(barw, (volatile LAS unsigned*)(lds + MISC_OFF) + 8);
    bar.wv = wv;
#define GB() xcd_barrier(bar)
    phase_pro1(load_P(kp, wv), lds); GB();
    phase_pro2(load_P(kp, wv)); GB();
    for (int l = 0; l < DEPTH; ++l) {
        for (int which = 0; which < 2; ++which) {
            phase_ffn_in(load_P(kp, wv), lds, l, which); GB();
            phase_ffn_out(load_P(kp, wv), lds, l, which); GB();
            phase_post(load_P(kp, wv), l, which == 0 ? 0 : 2); GB();
            if (which == 0) {
                phase_inproj(load_P(kp, wv), lds, l); GB();
                phase_prep(load_P(kp, wv), lds, l); GB();
                phase_mgemm(load_P(kp, wv), lds, l); GB();
                phase_att(load_P(kp, wv), lds, l); GB();
                phase_mixfin(load_P(kp, wv), lds, l); GB();
                phase_outproj(load_P(kp, wv), lds, l); GB();
                phase_post(load_P(kp, wv), l, 1); GB();
            }
        }
    }
#undef GB
    if (__hip_atomic_load(barw + XB_TMO, __ATOMIC_RELAXED, __HIP_MEMORY_SCOPE_AGENT) != 0u) {
        const float q = __builtin_nanf("");
        for (size_t i = (size_t)blockIdx.x * NT + tid_opaque(wv); i < (size_t)NB * SEQ * D; i += (size_t)gridDim.x * NT) p.out[i] = q;
    }
}

extern "C" void kernel_launch(void* const* d_in, const int* in_sizes, int n_in, void* d_out, int out_size, void* d_ws, size_t ws_size, hipStream_t stream) {
    static int grid = 0;
    if (grid == 0) {
        if (n_in != 23 || out_size != NB * SEQ * D || ws_size < WS_END) { fprintf(stderr, "kernel_launch: unexpected shapes (n_in %d out %d ws %zu need %zu)\n", n_in, out_size, ws_size, (size_t)WS_END); grid = -1; return; }
        int dev = 0, cus = 0, per_cu = 0;
        if (hipGetDevice(&dev) != hipSuccess || hipDeviceGetAttribute(&cus, hipDeviceAttributeMultiprocessorCount, dev) != hipSuccess) { grid = -1; return; }
        if (hipFuncSetAttribute((const void*)k_mega, hipFuncAttributeMaxDynamicSharedMemorySize, LDS_BYTES) != hipSuccess) { fprintf(stderr, "kernel_launch: hipFuncSetAttribute failed\n"); grid = -1; return; }
        if (hipOccupancyMaxActiveBlocksPerMultiprocessor(&per_cu, (const void*)k_mega, NT, LDS_BYTES) != hipSuccess || per_cu < 1)
            fprintf(stderr, "kernel_launch: note: occupancy query reports %d workgroups per CU\n", per_cu);
        (void)hipGetLastError();
        grid = cus;
    }
    if (grid < 0) return;
    if (hipMemsetAsync((char*)d_ws + WS_CTL, 0, CTL_ZERO_BYTES, stream) != hipSuccess) { fprintf(stderr, "kernel_launch: memset failed\n"); return; }
    P p{};
    for (int i = 0; i < 23; ++i) p.in[i] = (const float*)d_in[i];
    p.out = (float*)d_out; p.ws = (unsigned char*)d_ws;
    hipLaunchKernelGGL(k_mega, dim3(grid), dim3(NT), LDS_BYTES, stream, p);
}
```

```cpp
#include <hip/hip_runtime.h>
#include <cstdio>
#include <cstdint>
__device__ __forceinline__ int opq_s(int x) { asm volatile("" : "+s"(x)); return x; }
__device__ __forceinline__ unsigned char* opq_p(unsigned char* x) { asm volatile("" : "+s"(x)); return x; }
__device__ __forceinline__ int lane_fresh() { unsigned ones = ~0u; asm volatile("" : "+s"(ones)); return (int)__builtin_amdgcn_mbcnt_hi(ones, __builtin_amdgcn_mbcnt_lo(ones, 0u)); }
__device__ __forceinline__ int tid_opaque(int wv) { unsigned ones = ~0u; asm volatile("" : "+s"(ones)); const int ln = (int)__builtin_amdgcn_mbcnt_hi(ones, __builtin_amdgcn_mbcnt_lo(ones, 0u)); return (wv << 6) | ln; }
namespace pg8 {
#define PG8_LAS __attribute__((address_space(3)))
typedef unsigned short bf16_t;
typedef short bf16x8 __attribute__((ext_vector_type(8)));
typedef float f32x4 __attribute__((ext_vector_type(4)));
typedef unsigned u32x4 __attribute__((ext_vector_type(4)));
constexpr int BM = 256, BK = 64, HALF = 128, HTB = HALF * BK * 2  , STAGE_BYTES = 8 * HTB, NXCD = 8, WGM = 8;

__host__ __device__ __forceinline__ int lds_byte(int r, int c) { const int st = (r >> 4) * 2 + (c >> 5), rr = r & 15, cc = c & 31, ob = rr * 64 + cc * 2; return st * 1024 + (ob ^ (((ob >> 9) & 1) << 5)); }
__host__ __device__ __forceinline__ void stage_rc(int b, int& R, int& C) { const int st = b / 1024, sb = b % 1024, swz = sb ^ (((sb >> 9) & 1) << 5); R = (st >> 1) * 16 + swz / 64; C = (st & 1) * 32 + (swz % 64) / 2; }
__host__ __device__ __forceinline__ int perm32(int rho) { const int n = rho >> 4, i = rho & 15; return 8 * (i >> 2) + 4 * n + (i & 3); }

struct Unit { int pm, pn; };
struct Gemm { const bf16_t* A; const bf16_t* Bt; int M, N, K, ld, wv; };

struct StaticOrder {
    int nM, nN, nwg, G, c;
    __host__ __device__ void init(int M, int N, int G_, int c_) { nM = M / BM; nN = N / BM; nwg = nM * nN; G = G_; c = c_; }
    __host__ __device__ bool next(int i, Unit& u) const {
        const long L = (long)i * G + c; if (L >= nwg) return false;
        int wgid = (int)L; { const int q = nwg / NXCD, r = nwg % NXCD, xcd = wgid % NXCD, off = wgid / NXCD; wgid = (xcd < r ? xcd * (q + 1) : r * (q + 1) + (xcd - r) * q) + off; }
        const int nig = WGM * nN, gid = wgid / nig, fm = gid * WGM, gsz = (nM - fm) < WGM ? (nM - fm) : WGM;
        u.pm = fm + ((wgid % nig) % gsz); u.pn = (wgid % nig) / gsz; return true;
    }
    __device__ __forceinline__ void a_ready(const Unit&) const {}
    __device__ __forceinline__ void done(const Unit&) const {}
};

__device__ __forceinline__ unsigned cvt_pk_bf16(float lo, float hi) { unsigned r; asm volatile("v_cvt_pk_bf16_f32 %0, %1, %2" : "=v"(r) : "v"(lo), "v"(hi)); return r; }
typedef float f32x2 __attribute__((ext_vector_type(2)));
}
namespace pg8 {
template <class Epi, class Sched, bool ALIGN_EPI = false, bool SP2 = false>
__device__ __forceinline__ void gemm_phase(PG8_LAS unsigned char* lds, const Gemm g, const Sched& S, const Epi& E) {
    const int tid = tid_opaque(g.wv), wid = __builtin_amdgcn_readfirstlane(tid >> 6), lane = tid & 63, wr = wid >> 2, wc = wid & 3, fr = lane & 15, fq = lane >> 4;
    const int K = g.ld, nt = g.K / BK;
    unsigned voffA[2], voffB[2];
#pragma unroll
    for (int i = 0; i < 2; ++i) { int R, C; stage_rc(tid * 16 + i * 8192, R, C); const int Rb = Epi::PERM ? ((R & ~31) + perm32(R & 31)) : R;
        voffA[i] = (unsigned)(R * K + C) * 2u; voffB[i] = (unsigned)(Rb * K + C) * 2u; }
    const size_t kstep = (size_t)(BK * 2);
    const size_t hstep = (size_t)HALF * K * 2;
    const size_t tstep = 2 * hstep;
    const unsigned ldsw = (unsigned)wid * 1024u;
    const int aoff = lds_byte(wr * 64 + fr, fq * 8), boff = lds_byte(wc * 32 + fr, fq * 8);
#define PG8_SA(b, h) (((b) * 2 + (h)) * HTB)
#define PG8_SB(b, h) ((4 + (b) * 2 + (h)) * HTB)
#define PG8_STAGE(bufoff, gbase, voff) do { _Pragma("unroll") for (int _i = 0; _i < 2; ++_i) \
        __builtin_amdgcn_global_load_lds((const unsigned*)((const char*)(gbase) + (voff)[_i]), (PG8_LAS unsigned*)(lds + (bufoff) + ldsw + _i * 8192), 16, 0, 0); } while (0)
#define PG8_LDA(dst, b, h) do { _Pragma("unroll") for (int m = 0; m < 4; ++m) _Pragma("unroll") for (int k = 0; k < 2; ++k) dst[m][k] = *(const PG8_LAS bf16x8*)(lds + PG8_SA(b, h) + aoff + m * 2048 + k * 1024); } while (0)
#define PG8_LDB(dst, b, h) do { _Pragma("unroll") for (int n = 0; n < 2; ++n) _Pragma("unroll") for (int k = 0; k < 2; ++k) dst[n][k] = *(const PG8_LAS bf16x8*)(lds + PG8_SB(b, h) + boff + n * 2048 + k * 1024); } while (0)
#define PG8_MMA(ai, bj, At, Bt) do { __builtin_amdgcn_s_setprio(1); _Pragma("unroll") for (int m = 0; m < 4; ++m) _Pragma("unroll") for (int n = 0; n < 2; ++n) _Pragma("unroll") for (int k = 0; k < 2; ++k) \
        acc[ai][bj][m][n] = __builtin_amdgcn_mfma_f32_16x16x32_bf16(Bt[n][k], At[m][k], acc[ai][bj][m][n], 0, 0, 0); __builtin_amdgcn_s_setprio(0); } while (0)
#define PG8_WAIT_V(n) asm volatile("s_waitcnt vmcnt(" #n ")" ::: "memory")
#define PG8_WAIT_L(n) asm volatile("s_waitcnt lgkmcnt(" #n ")" ::: "memory")
#define PG8_BAR __builtin_amdgcn_s_barrier()
#define PG8_SCHED __builtin_amdgcn_sched_barrier(0)
    Unit cur, nxt; int ui = 0;
    if (!S.next(0, cur)) return;
    f32x4 acc[2][2][4][2];
#pragma unroll
    for (int a = 0; a < 2; ++a)
#pragma unroll
        for (int b = 0; b < 2; ++b)
#pragma unroll
            for (int m = 0; m < 4; ++m)
#pragma unroll
                for (int n = 0; n < 2; ++n) acc[a][b][m][n] = (f32x4){0.f, 0.f, 0.f, 0.f};
    bf16x8 At[4][2], B0[2][2], B1[2][2];
    const char* cA = (const char*)g.A + (size_t)cur.pm * tstep; const char* cB = (const char*)g.Bt + (size_t)cur.pn * tstep;
    S.a_ready(cur);
    if constexpr (SP2) {
        PG8_STAGE(PG8_SB(0, 0), cB, voffB); PG8_STAGE(PG8_SB(0, 1), cB + hstep, voffB); PG8_STAGE(PG8_SA(0, 0), cA, voffA); PG8_STAGE(PG8_SA(0, 1), cA + hstep, voffA);
        if (wr == 1) PG8_BAR;
        PG8_WAIT_V(2); PG8_BAR;
        PG8_STAGE(PG8_SB(1, 0), cB + kstep, voffB); PG8_STAGE(PG8_SA(1, 0), cA + kstep, voffA); PG8_STAGE(PG8_SB(1, 1), cB + hstep + kstep, voffB);
        PG8_WAIT_V(6); PG8_BAR;
    } else {
        PG8_STAGE(PG8_SB(0, 0), cB, voffB); PG8_STAGE(PG8_SA(0, 0), cA, voffA); PG8_STAGE(PG8_SB(0, 1), cB + hstep, voffB); PG8_STAGE(PG8_SA(0, 1), cA + hstep, voffA);
        if (wr == 1) PG8_BAR;
        PG8_WAIT_V(4); PG8_BAR;
        PG8_STAGE(PG8_SB(1, 0), cB + kstep, voffB); PG8_STAGE(PG8_SA(1, 0), cA + kstep, voffA); PG8_STAGE(PG8_SB(1, 1), cB + hstep + kstep, voffB);
        PG8_WAIT_V(6); PG8_BAR;
    }
    for (;;) {
        const bool has_next = S.next(ui + 1, nxt);
        const char* nA = has_next ? (const char*)g.A + (size_t)nxt.pm * tstep : cA; const char* nB = has_next ? (const char*)g.Bt + (size_t)nxt.pn * tstep : cB;
        for (int t = 0; t < nt; t += 2) {
            const bool last = (t == nt - 2);
            const char* a1 = cA + (size_t)(t + 1) * kstep;
            const char* a2 = last ? nA : cA + (size_t)(t + 2) * kstep; const char* b2 = last ? nB : cB + (size_t)(t + 2) * kstep;
            const char* a3 = a2 + kstep; const char* b3 = b2 + kstep;
            if (last && has_next) S.a_ready(nxt);
            if constexpr (SP2) {
            PG8_LDB(B0, 0, 0); PG8_LDB(B1, 0, 1); PG8_SCHED; PG8_LDA(At, 0, 0); PG8_STAGE(PG8_SA(1, 1), a1 + hstep, voffA);
            PG8_WAIT_V(8); PG8_WAIT_L(0); PG8_BAR; PG8_MMA(0, 0, At, B0); PG8_MMA(0, 1, At, B1); PG8_BAR; PG8_SCHED;
            PG8_LDA(At, 0, 1); PG8_STAGE(PG8_SB(0, 0), b2, voffB); PG8_STAGE(PG8_SB(0, 1), b2 + hstep, voffB); PG8_STAGE(PG8_SA(0, 0), a2, voffA);
            PG8_WAIT_V(8); PG8_WAIT_L(0); PG8_BAR; PG8_MMA(1, 0, At, B0); PG8_MMA(1, 1, At, B1); PG8_BAR; PG8_SCHED;
            PG8_LDB(B0, 1, 0); PG8_LDB(B1, 1, 1); PG8_SCHED; PG8_LDA(At, 1, 0); PG8_STAGE(PG8_SA(0, 1), a2 + hstep, voffA);
            PG8_WAIT_V(8); PG8_WAIT_L(0); PG8_BAR; PG8_MMA(0, 0, At, B0); PG8_MMA(0, 1, At, B1); PG8_BAR; PG8_SCHED;
            PG8_LDA(At, 1, 1); PG8_STAGE(PG8_SB(1, 0), b3, voffB); PG8_STAGE(PG8_SB(1, 1), b3 + hstep, voffB); PG8_STAGE(PG8_SA(1, 0), a3, voffA);
            PG8_WAIT_V(8); PG8_WAIT_L(0); PG8_BAR; PG8_MMA(1, 0, At, B0); PG8_MMA(1, 1, At, B1); PG8_BAR; PG8_SCHED;
            } else {
            PG8_LDB(B0, 0, 0); PG8_SCHED; PG8_LDA(At, 0, 0); PG8_STAGE(PG8_SA(1, 1), a1 + hstep, voffA);
            PG8_WAIT_L(8); PG8_BAR; PG8_WAIT_L(0); PG8_MMA(0, 0, At, B0); PG8_BAR; PG8_SCHED;
            PG8_LDB(B1, 0, 1); PG8_STAGE(PG8_SB(0, 0), b2, voffB);
            PG8_BAR; PG8_WAIT_L(0); PG8_MMA(0, 1, At, B1); PG8_BAR;
            PG8_LDA(At, 0, 1); PG8_STAGE(PG8_SA(0, 0), a2, voffA);
            PG8_BAR; PG8_WAIT_L(0); PG8_MMA(1, 0, At, B0); PG8_BAR; PG8_SCHED;
            PG8_STAGE(PG8_SB(0, 1), b2 + hstep, voffB);
            PG8_WAIT_V(6); PG8_BAR; PG8_MMA(1, 1, At, B1); PG8_BAR;
            PG8_LDB(B0, 1, 0); PG8_SCHED; PG8_LDA(At, 1, 0); PG8_STAGE(PG8_SA(0, 1), a2 + hstep, voffA);
            PG8_WAIT_L(8); PG8_BAR; PG8_WAIT_L(0); PG8_MMA(0, 0, At, B0); PG8_BAR; PG8_SCHED;
            PG8_LDB(B1, 1, 1); PG8_STAGE(PG8_SB(1, 0), b3, voffB);
            PG8_BAR; PG8_WAIT_L(0); PG8_MMA(0, 1, At, B1); PG8_BAR;
            PG8_LDA(At, 1, 1); PG8_STAGE(PG8_SA(1, 0), a3, voffA);
            PG8_BAR; PG8_WAIT_L(0); PG8_MMA(1, 0, At, B0); PG8_BAR; PG8_SCHED;
            PG8_STAGE(PG8_SB(1, 1), b3 + hstep, voffB);
            PG8_WAIT_V(6); PG8_BAR; PG8_MMA(1, 1, At, B1); PG8_BAR;
            }
        }
        if constexpr (ALIGN_EPI) { if (wr == 0) PG8_BAR; }
        if constexpr (!Epi::AFTER_DRAIN) { E(acc, cur, wr, wc, fr, fq); S.done(cur); }
        if (!has_next) break;
#pragma unroll
        for (int a = 0; a < 2; ++a)
#pragma unroll
            for (int b = 0; b < 2; ++b)
#pragma unroll
                for (int m = 0; m < 4; ++m)
#pragma unroll
                    for (int n = 0; n < 2; ++n) acc[a][b][m][n] = (f32x4){0.f, 0.f, 0.f, 0.f};
        cur = nxt; cA = nA; cB = nB; ++ui;
        if constexpr (ALIGN_EPI) { if (wr == 1) PG8_BAR; }
    }
    PG8_WAIT_V(0);
    if constexpr (!ALIGN_EPI) { if (wr == 0) PG8_BAR; }
    PG8_BAR;
    if constexpr (Epi::AFTER_DRAIN) { E.fused(acc, cur, wr, wc, fr, fq, lds, wid, lane); S.done(cur); }
#undef PG8_SA
#undef PG8_SB
#undef PG8_STAGE
#undef PG8_LDA
#undef PG8_LDB
#undef PG8_MMA
#undef PG8_WAIT_V
#undef PG8_WAIT_L
#undef PG8_BAR
#undef PG8_SCHED
}
}

#define GAS __attribute__((address_space(1)))
#define LAS __attribute__((address_space(3)))
typedef unsigned short bf16;
typedef unsigned v4u __attribute__((ext_vector_type(4)));
typedef unsigned v2u __attribute__((ext_vector_type(2)));
typedef float f32x4 __attribute__((ext_vector_type(4)));
typedef float f32x2 __attribute__((ext_vector_type(2)));

constexpr int D = 2048, NB = 4, SEQ = 2048, CTX = 256, PB = 2304, M = NB * PB, DEPTH = 4, DFF = 5632, NIN = 4000, NINP = 4096, NMODC = 9 * D;
constexpr int NT = 512, NW = 8;
constexpr int C_XB = 0, C_GATE = 512, C_MQ = 1024, C_MKV = 1408, C_MKR = 1664, C_DQ = 1696, C_DK = 2208, C_DV = 2720, C_GQ = 3232, C_GK = 3744, C_GV = 3872;

constexpr size_t MiB = 1u << 20;
constexpr size_t WS_CTL = 0;
constexpr size_t WS_MOD = 1 * MiB;
constexpr size_t WS_ROPE = 3 * MiB;
constexpr size_t WS_WFFI = 4 * MiB;
constexpr size_t WS_WFFO = WS_WFFI + 352 * MiB;
constexpr size_t WS_WIN = WS_WFFO + 176 * MiB;
constexpr size_t WS_WOUT = WS_WIN + 64 * MiB;
constexpr size_t WS_WQB = WS_WOUT + 32 * MiB;
constexpr size_t WS_WKVB = WS_WQB + 3 * MiB;
constexpr size_t WS_WG = WS_WKVB + 2 * MiB;
constexpr size_t WS_X = WS_WG + 8 * MiB;
constexpr size_t WS_H = WS_X + 72 * MiB;
constexpr size_t WS_ACT = WS_H + 36 * MiB;
constexpr size_t WS_Y = WS_ACT + 99 * MiB;
constexpr size_t WS_COLS = WS_Y + 72 * MiB;
constexpr size_t WS_U = WS_COLS + 72 * MiB;
constexpr size_t WS_GATES = WS_U + 9 * MiB;
constexpr size_t WS_QN = WS_GATES + 72 * MiB;
constexpr size_t WS_KVN = WS_QN + 7 * MiB;
constexpr size_t WS_QUP = WS_KVN + 5 * MiB;
constexpr size_t WS_KVUP = WS_QUP + 14 * MiB;
constexpr size_t WS_QM = WS_KVUP + 18 * MiB;
constexpr size_t WS_KM = WS_QM + 14 * MiB;
constexpr size_t WS_KMN = WS_KM;
constexpr size_t WS_AB = WS_KM + 14 * MiB;
constexpr size_t WS_HS = WS_AB + 72 * MiB;
constexpr size_t WS_DIFFO = WS_HS + 36 * MiB;
constexpr size_t WS_YMIX = WS_DIFFO + 36 * MiB;
constexpr size_t WS_VTD = WS_YMIX + 36 * MiB;
constexpr size_t WS_VTG = WS_VTD + 9 * MiB;
constexpr size_t WS_VTM = WS_VTG + 3 * MiB;
constexpr size_t WS_SUM = WS_VTM + 9 * MiB;
constexpr size_t WS_YP = WS_SUM + 2 * MiB;
constexpr size_t WS_END = WS_YP + 64 * MiB;

constexpr int LDS_BYTES = 147456;

struct P { const float* in[23]; float* out; unsigned char* ws; };
struct PX { const float* in[23]; float* out; unsigned char* ws; int wv; };
typedef const __attribute__((address_space(4))) P* KP;
__device__ __forceinline__ PX load_P(KP kp, int wv) {
#if defined(__HIP_DEVICE_COMPILE__)
    asm volatile("" : "+s"(kp)); PX r; for (int i = 0; i < 23; ++i) r.in[i] = kp->in[i]; r.out = kp->out; r.ws = kp->ws; r.wv = wv; return r;
#else
    (void)kp; (void)wv; return PX{};
#endif
}

#define LDS_WAIT() asm volatile("s_waitcnt lgkmcnt(0)" ::: "memory")
__device__ __forceinline__ unsigned f2bf(float f) { unsigned u = __builtin_bit_cast(unsigned, f); return (u + 0x7fffu + ((u >> 16) & 1u)) >> 16; }
__device__ __forceinline__ unsigned pk2(float lo, float hi) { return f2bf(lo) | (f2bf(hi) << 16); }
__device__ __forceinline__ float bf2f(unsigned v) { return __builtin_bit_cast(float, v << 16); }
__device__ __forceinline__ float bflo(unsigned w) { return __builtin_bit_cast(float, w << 16); }
__device__ __forceinline__ float bfhi(unsigned w) { return __builtin_bit_cast(float, w & 0xffff0000u); }
template <int XM> __device__ __forceinline__ float swz_xor(float v) { return __builtin_bit_cast(float, __builtin_amdgcn_ds_swizzle(__builtin_bit_cast(int, v), (XM << 10) | 0x1f)); }
__device__ __forceinline__ void pl32swap(unsigned& a, unsigned& b) { asm volatile("s_nop 1\n\tv_permlane32_swap_b32 %0, %1\n\ts_nop 1" : "+v"(a), "+v"(b)); }
__device__ __forceinline__ float xhalf_sum(float v) { unsigned a = __builtin_bit_cast(unsigned, v), b = a; pl32swap(a, b); return __builtin_bit_cast(float, a) + __builtin_bit_cast(float, b); }
__device__ __forceinline__ float xhalf_max(float v) { unsigned a = __builtin_bit_cast(unsigned, v), b = a; pl32swap(a, b); return fmaxf(__builtin_bit_cast(float, a), __builtin_bit_cast(float, b)); }
__device__ __forceinline__ float wave_sum(float v) {
    v += swz_xor<1>(v); v += swz_xor<2>(v); v += swz_xor<4>(v); v += swz_xor<8>(v); v += swz_xor<16>(v);
    return xhalf_sum(v);
}
__device__ __forceinline__ float sigmoidf_(float x) { return 1.f / (1.f + __expf(-x)); }
__device__ __forceinline__ float siluf_(float x) { return x / (1.f + __expf(-x)); }
__device__ __forceinline__ float gelu_tanh(float x) { const float u = 0.7978845608028654f * (x + 0.044715f * x * x * x); return 0.5f * x * (1.f + tanhf(u)); }

struct TileOrder {
    pg8::StaticOrder so; int latonly;
    __device__ __forceinline__ void init(int nMt, int N, int G, int c, int lat) { so.nM = nMt; so.nN = N / 256; so.nwg = so.nM * so.nN; so.G = G; so.c = c; latonly = lat; }
    __device__ __forceinline__ bool next(int i, pg8::Unit& u) const { if (!so.next(i, u)) return false; if (latonly) u.pm = (u.pm >> 3) * 9 + 1 + (u.pm & 7); return true; }
    __device__ __forceinline__ void a_ready(const pg8::Unit&) const {}
    __device__ __forceinline__ void done(const pg8::Unit&) const {}
};
struct EpiF32 {
    static constexpr bool PERM = false, AFTER_DRAIN = false;
    float* C; int ldc;
    __device__ __forceinline__ void operator()(const f32x4 (&acc)[2][2][4][2], const pg8::Unit& u, int wr, int wc, int fr, int fq) const {
        const int row0 = u.pm * 256 + wr * 64 + fr, col0 = u.pn * 256 + wc * 32 + 4 * fq;
#pragma unroll
        for (int ai = 0; ai < 2; ++ai)
#pragma unroll
            for (int m = 0; m < 4; ++m) { float* rowp = C + (size_t)(row0 + ai * 128 + m * 16) * ldc + col0;
#pragma unroll
                for (int bj = 0; bj < 2; ++bj)
#pragma unroll
                    for (int n = 0; n < 2; ++n) *(f32x4*)(rowp + bj * 128 + n * 16) = acc[ai][bj][m][n]; }
    }
};
struct EpiB16 {
    static constexpr bool PERM = true, AFTER_DRAIN = false;
    bf16* O; int ldc;
    __device__ __forceinline__ void operator()(const f32x4 (&acc)[2][2][4][2], const pg8::Unit& u, int wr, int wc, int fr, int fq) const {
        const int row0 = u.pm * 256 + wr * 64 + fr, col0 = u.pn * 256 + wc * 32 + 8 * fq;
#pragma unroll
        for (int ai = 0; ai < 2; ++ai)
#pragma unroll
            for (int m = 0; m < 4; ++m) { bf16* rowp = O + (size_t)(row0 + ai * 128 + m * 16) * ldc + col0;
#pragma unroll
                for (int bj = 0; bj < 2; ++bj) { const f32x4 v0 = acc[ai][bj][m][0], v1 = acc[ai][bj][m][1];
                    v4u w; w.x = pg8::cvt_pk_bf16(v0[0], v0[1]); w.y = pg8::cvt_pk_bf16(v0[2], v0[3]); w.z = pg8::cvt_pk_bf16(v1[0], v1[1]); w.w = pg8::cvt_pk_bf16(v1[2], v1[3]);
                    *(v4u*)(rowp + bj * 128) = w; } }
    }
};
struct EpiSwiglu {
    static constexpr bool PERM = true, AFTER_DRAIN = false;
    bf16* O; int ldc;
    __device__ __forceinline__ void operator()(const f32x4 (&acc)[2][2][4][2], const pg8::Unit& u, int wr, int wc, int fr, int fq) const {
        const int row0 = u.pm * 256 + wr * 64 + fr, col0 = u.pn * 128 + wc * 32 + 8 * fq;
#pragma unroll
        for (int ai = 0; ai < 2; ++ai)
#pragma unroll
            for (int m = 0; m < 4; ++m) { bf16* rowp = O + (size_t)(row0 + ai * 128 + m * 16) * ldc + col0;
                float r[8];
#pragma unroll
                for (int n = 0; n < 2; ++n)
#pragma unroll
                    for (int e = 0; e < 4; ++e) { const float g = acc[ai][0][m][n][e], uu = acc[ai][1][m][n][e]; r[n * 4 + e] = siluf_(g) * uu; }
                v4u w; w.x = pg8::cvt_pk_bf16(r[0], r[1]); w.y = pg8::cvt_pk_bf16(r[2], r[3]); w.z = pg8::cvt_pk_bf16(r[4], r[5]); w.w = pg8::cvt_pk_bf16(r[6], r[7]);
                *(v4u*)rowp = w; }
    }
};

__device__ __forceinline__ void transpose_item(const float* W, int N, int K, bf16* WT, int k0, int n0, int drow0, LAS float* scr, int lane) {
#pragma unroll 8
    for (int i = 0; i < 32; ++i) { const int kk = 2 * i + (lane >> 5); scr[kk * 33 + (lane & 31)] = W[(size_t)(k0 + kk) * N + n0 + (lane & 31)]; }
    LDS_WAIT(); asm volatile("" ::: "memory");
    const int c = lane & 7;
#pragma unroll
    for (int j = 0; j < 4; ++j) { const int n = (lane >> 3) + 8 * j; const LAS float* s = scr + (8 * c) * 33 + n;
        v4u o; o.x = pk2(s[0 * 33], s[1 * 33]); o.y = pk2(s[2 * 33], s[3 * 33]); o.z = pk2(s[4 * 33], s[5 * 33]); o.w = pk2(s[6 * 33], s[7 * 33]);
        *(v4u*)(WT + (size_t)(drow0 + n) * K + k0 + 8 * c) = o; }
    LDS_WAIT(); asm volatile("" ::: "memory");
}

__device__ __forceinline__ void phase_pro1(const PX& p, LAS unsigned char* lds) {
    unsigned char* wsb = opq_p(p.ws);
    const int tid = tid_opaque(p.wv), lane = tid & 63, wave = __builtin_amdgcn_readfirstlane(tid >> 6);
    const int G = gridDim.x, blk = blockIdx.x;
    {
        LAS float* sc = (LAS float*)lds;
        LAS float* red = (LAS float*)(lds + 40960);
        const float* c = p.in[1]; const float* cc = p.in[3];
        for (int i = tid; i < 5 * D; i += NT) { const int v = i / D, k = i % D; const float x = v < 4 ? c[v * D + k] : cc[k]; sc[i] = x / (1.f + expf(-x)); }
        __syncthreads();
        const float* wmod = p.in[4]; const float* bmod = p.in[5];
        float* MOD = (float*)(wsb + WS_MOD);
        for (int unit = blk; unit < DEPTH * 288; unit += G) {
            const int l = unit / 288, n0 = (unit % 288) * 64, kq = lane >> 4;
            const float* W = wmod + (size_t)l * D * NMODC + n0 + 4 * (lane & 15);
            float acc[5][4];
#pragma unroll
            for (int v = 0; v < 5; ++v)
#pragma unroll
                for (int e = 0; e < 4; ++e) acc[v][e] = 0.f;
            const int kbase = wave * 256 + kq;
#pragma unroll 4
            for (int i = 0; i < 64; ++i) { const int k = kbase + 4 * i; const f32x4 w = *(const f32x4*)(W + (size_t)k * NMODC);
#pragma unroll
                for (int v = 0; v < 5; ++v) { const float s = sc[v * D + k];
#pragma unroll
                    for (int e = 0; e < 4; ++e) acc[v][e] += s * w[e]; } }
#pragma unroll
            for (int v = 0; v < 5; ++v)
#pragma unroll
                for (int e = 0; e < 4; ++e) { float a = acc[v][e]; a += swz_xor<16>(a); a = xhalf_sum(a); acc[v][e] = a; }
            if (kq == 0) {
#pragma unroll
                for (int v = 0; v < 5; ++v)
#pragma unroll
                    for (int e = 0; e < 4; ++e) red[(wave * 5 + v) * 64 + 4 * (lane & 15) + e] = acc[v][e]; }
            __syncthreads();
            if (tid < 320) { const int v = tid / 64, col = tid % 64; float s = 0.f;
#pragma unroll
                for (int w = 0; w < 8; ++w) s += red[(w * 5 + v) * 64 + col];
                MOD[((size_t)l * 5 + v) * NMODC + n0 + col] = s + bmod[l * NMODC + n0 + col]; }
            __syncthreads();
        }
    }
    __syncthreads();
    {
        LAS float* scr = (LAS float*)(lds + wave * 16384);
        const int gw = wave * G + blk, NGW = NW * G;
        constexpr int I_FI = 32 * 352, I_FO = 88 * 64, I_IN = 32 * 125, I_OUT = 32 * 64, I_QB = 6 * 24, I_KVB = 4 * 32;
        constexpr int T_FI = 8 * I_FI, T_FO = 8 * I_FO, T_IN = 4 * I_IN, T_OUT = 4 * I_OUT, T_QB = 4 * I_QB, T_KVB = 4 * I_KVB;
        constexpr int NITEMS = T_FI + T_FO + T_IN + T_OUT + T_QB + T_KVB;
        for (int it = gw; it < NITEMS; it += NGW) {
            int r = it;
            if (r < T_FI) { const int mat = r / I_FI; r %= I_FI; const int kb = r / 352, nb = r % 352, n0 = nb * 32;
                const int half = n0 / DFF, cc = n0 % DFF, drow0 = (cc / 128) * 256 + half * 128 + (cc % 128);
                transpose_item(p.in[7] + (size_t)mat * D * (2 * DFF), 2 * DFF, D, (bf16*)(wsb + WS_WFFI) + (size_t)mat * (2 * DFF) * D, kb * 64, n0, drow0, scr, lane); continue; }
            r -= T_FI;
            if (r < T_FO) { const int mat = r / I_FO; r %= I_FO; const int kb = r / 64, nb = r % 64;
                transpose_item(p.in[8] + (size_t)mat * DFF * D, D, DFF, (bf16*)(wsb + WS_WFFO) + (size_t)mat * D * DFF, kb * 64, nb * 32, nb * 32, scr, lane); continue; }
            r -= T_FO;
            if (r < T_IN) { const int mat = r / I_IN; r %= I_IN; const int kb = r / 125, nb = r % 125;
                transpose_item(p.in[9] + (size_t)mat * D * NIN, NIN, D, (bf16*)(wsb + WS_WIN) + (size_t)mat * NINP * D, kb * 64, nb * 32, nb * 32, scr, lane); continue; }
            r -= T_IN;
            if (r < T_OUT) { const int mat = r / I_OUT; r %= I_OUT; const int kb = r / 64, nb = r % 64;
                transpose_item(p.in[10] + (size_t)mat * D * D, D, D, (bf16*)(wsb + WS_WOUT) + (size_t)mat * D * D, kb * 64, nb * 32, nb * 32, scr, lane); continue; }
            r -= T_OUT;
            if (r < T_QB) { const int mat = r / I_QB; r %= I_QB; const int kb = r / 24, nb = r % 24;
                transpose_item(p.in[17] + (size_t)mat * 384 * 768, 768, 384, (bf16*)(wsb + WS_WQB) + (size_t)mat * 768 * 384, kb * 64, nb * 32, nb * 32, scr, lane); continue; }
            r -= T_QB;
            { const int mat = r / I_KVB; r %= I_KVB; const int kb = r / 32, nb = r % 32;
                transpose_item(p.in[19] + (size_t)mat * 256 * 1024, 1024, 256, (bf16*)(wsb + WS_WKVB) + (size_t)mat * 1024 * 256, kb * 64, nb * 32, nb * 32, scr, lane); }
        }
    }
    {
        const int gt = blk * NT + tid, NGT = G * NT;
        for (int i = gt; i < DEPTH * 96 * (D / 8); i += NGT) { const int l = i / (96 * (D / 8)), r = i % (96 * (D / 8));
            *(v4u*)((bf16*)(wsb + WS_WIN) + ((size_t)l * NINP + NIN) * D + (size_t)r * 8) = (v4u){0u, 0u, 0u, 0u}; }
        const float* wg = p.in[13];
        for (int i = gt; i < DEPTH * 2048 * 64; i += NGT) { const int l = i / (2048 * 64), r = i % (2048 * 64), np = r / 64, k0 = (r % 64) * 8;
            const int c7 = np & 127, gate = (np >> 7) & 1, chunk = (np >> 8) & 3, dir = np >> 10, ch = chunk * 128 + c7, head = ch >> 6, j = ch & 63;
            v4u o = (v4u){0u, 0u, 0u, 0u};
            if ((k0 >> 6) == head) { const float* src = wg + ((((size_t)l * 2 + dir) * 2 + gate) * 8 + head) * 4096 + (size_t)(k0 & 63) * 64 + j;
                o.x = pk2(src[0], src[64]); o.y = pk2(src[128], src[192]); o.z = pk2(src[256], src[320]); o.w = pk2(src[384], src[448]); }
            *(v4u*)((bf16*)(wsb + WS_WG) + ((size_t)l * 2048 + np) * 512 + k0) = o; }
        float* rope = (float*)(wsb + WS_ROPE);
        for (int i = gt; i < SEQ * 32; i += NGT) { const int t = i / 32, k = i % 32; const float inv = powf(10000.f, -(float)(k & 15) / 16.f);
            const float ang = (k < 16 ? (float)(t / 64) : (float)(t % 64)) * inv; rope[i] = cosf(ang); rope[SEQ * 32 + i] = sinf(ang); }
        for (int i = gt; i < SEQ * 16; i += NGT) { const int t = i / 16, k = i % 16; const float inv = powf(10000.f, -(float)(k & 7) / 8.f);
            const float ang = (k < 8 ? (float)(t / 64) : (float)(t % 64)) * inv; rope[SEQ * 64 + i] = cosf(ang); rope[SEQ * 64 + SEQ * 16 + i] = sinf(ang); }
    }
}

__device__ __forceinline__ float row_rstd(const f32x4 (&v)[8]) {
    float s = 0.f;
#pragma unroll
    for (int j = 0; j < 8; ++j) s += (v[j][0] * v[j][0] + v[j][1] * v[j][1]) + (v[j][2] * v[j][2] + v[j][3] * v[j][3]);
    s = wave_sum(s);
    return 1.0f / sqrtf(s * (1.0f / D) + 1e-6f);
}
__device__ __forceinline__ void store_prenorm(bf16* hrow, int lane, const f32x4 (&v)[8], const float* g, const float* shift, const float* scale) {
    const float rstd = row_rstd(v);
#pragma unroll
    for (int j = 0; j < 8; ++j) { const int idx = lane + 64 * j;
        const f32x4 gg = ((const f32x4*)g)[idx], sh = ((const f32x4*)shift)[idx], sc = ((const f32x4*)scale)[idx];
        const f32x4 o = (v[j] * rstd) * gg * (sc + 1.0f) + sh;
        v2u w; w.x = pk2(o[0], o[1]); w.y = pk2(o[2], o[3]);
        *(v2u*)(hrow + 4 * idx) = w; }
}

__device__ __forceinline__ void phase_pro2(const PX& p) {
    unsigned char* wsb = opq_p(p.ws);
    const int tid = tid_opaque(p.wv), lane = tid & 63, wave = tid >> 6, G = gridDim.x, blk = blockIdx.x;
    const int gw = wave * G + blk, NGW = NW * G;
    float* X = (float*)(wsb + WS_X); bf16* H = (bf16*)(wsb + WS_H); const float* MOD = (const float*)(wsb + WS_MOD);
    for (int row = gw; row < M; row += NGW) {
        const int b = row / PB, pp = row % PB; const bool isctx = pp < CTX; const int v = isctx ? 4 : b;
        const float* src = isctx ? p.in[2] + ((size_t)b * CTX + pp) * D : p.in[0] + ((size_t)b * SEQ + (pp - CTX)) * D;
        f32x4 xv[8];
#pragma unroll
        for (int j = 0; j < 8; ++j) xv[j] = ((const f32x4*)src)[lane + 64 * j];
#pragma unroll
        for (int j = 0; j < 8; ++j) ((f32x4*)(X + (size_t)row * D))[lane + 64 * j] = xv[j];
        const float* mod = MOD + ((size_t)0 * 5 + v) * NMODC;
        store_prenorm(H + (size_t)row * D, lane, xv, p.in[6] + (size_t)(0 * 6 + 0) * D, mod + 0 * D, mod + 1 * D);
    }
}

__device__ __forceinline__ void phase_post(const PX& p, int layer, int s) {
    unsigned char* wsb = opq_p(p.ws);
    layer = opq_s(layer);
    const int tid = tid_opaque(p.wv), lane = tid & 63, wave = tid >> 6, G = gridDim.x, blk = blockIdx.x;
    const int gw = wave * G + blk, NGW = NW * G;
    float* X = (float*)(wsb + WS_X); bf16* H = (bf16*)(wsb + WS_H); const bf16* Y = (const bf16*)(wsb + WS_Y); const float* MOD = (const float*)(wsb + WS_MOD);
    const bool last = layer == DEPTH - 1, final = last && s == 2, split = !(last && s >= 1);
    const float wgt = (s == 1) ? 1.0f : 0.5f;
    const int l2 = (s < 2) ? layer : layer + 1, s2 = (s < 2) ? s + 1 : 0;
    for (int row = gw; row < M; row += NGW) {
        const int b = row / PB, pp = row % PB; const bool isctx = pp < CTX; const int v = isctx ? 4 : b;
        if (last && s >= 1 && isctx) continue;
        f32x4 yv[8], xv[8];
        if (split && row >= 8192) { const bf16* yp = (const bf16*)(wsb + WS_YP) + (size_t)(row - 8192) * D;
#pragma unroll
            for (int j = 0; j < 8; ++j) { f32x4 a = (f32x4){0.f, 0.f, 0.f, 0.f};
#pragma unroll
                for (int sl = 0; sl < 8; ++sl) { const v2u w = ((const v2u*)(yp + (size_t)sl * 1024 * 2048))[lane + 64 * j]; a += (f32x4){bflo(w.x), bfhi(w.x), bflo(w.y), bfhi(w.y)}; }
                yv[j] = a; } }
        else {
#pragma unroll
            for (int j = 0; j < 8; ++j) { const v2u w = ((const v2u*)(Y + (size_t)row * D))[lane + 64 * j]; yv[j] = (f32x4){bflo(w.x), bfhi(w.x), bflo(w.y), bfhi(w.y)}; } }
#pragma unroll
        for (int j = 0; j < 8; ++j) xv[j] = ((const f32x4*)(X + (size_t)row * D))[lane + 64 * j];
        const float rstd = row_rstd(yv);
        const float* gate = MOD + ((size_t)layer * 5 + v) * NMODC + (size_t)(3 * s + 2) * D;
        const float* gpost = p.in[6] + (size_t)(layer * 6 + 2 * s + 1) * D;
        float* dst = final ? p.out + ((size_t)b * SEQ + (pp - CTX)) * D : X + (size_t)row * D;
#pragma unroll
        for (int j = 0; j < 8; ++j) { const int idx = lane + 64 * j; const f32x4 ga = ((const f32x4*)gate)[idx], gp = ((const f32x4*)gpost)[idx];
            xv[j] = xv[j] + (ga * wgt) * ((yv[j] * rstd) * gp);
            ((f32x4*)dst)[idx] = xv[j]; }
        if (!final) { const float* mod = MOD + ((size_t)l2 * 5 + v) * NMODC;
            store_prenorm(H + (size_t)row * D, lane, xv, p.in[6] + (size_t)(l2 * 6 + 2 * s2) * D, mod + (size_t)(3 * s2) * D, mod + (size_t)(3 * s2 + 1) * D); }
    }
}

template <class Epi>
__device__ __forceinline__ void run_gemm(int wv, LAS unsigned char* lds, const bf16* A, const bf16* Bt, int nMt, int N, int K, int latonly, int coff, const Epi& E) {
    pg8::Gemm g{A, Bt, M, N, K, K, wv};
    TileOrder S; S.init(nMt, N, (int)gridDim.x, (int)((blockIdx.x + coff) % gridDim.x), latonly);
    pg8::gemm_phase<Epi, TileOrder, true, true>(lds, g, S, E);
}
struct OneUnit { int pm, pn;
    __device__ __forceinline__ bool next(int i, pg8::Unit& u) const { if (i != 0) return false; u.pm = pm; u.pn = pn; return true; }
    __device__ __forceinline__ void a_ready(const pg8::Unit&) const {}
    __device__ __forceinline__ void done(const pg8::Unit&) const {}
};
__device__ __forceinline__ void run_gemm_n2048_split(int wv, LAS unsigned char* lds, const bf16* A, const bf16* Bt, int K, bf16* Y, bf16* YP) {
    { EpiB16 E{Y, D}; run_gemm(wv, lds, A, Bt, 32, D, K, 0, 0, E); }
    __syncthreads();
    const int nkt = K / 64;
    for (int L = blockIdx.x; L < 256; L += gridDim.x) {
        const int s = L & 7, tile = L >> 3, pm = 32 + (tile >> 3), pn = tile & 7;
        const int per = nkt >> 3, odd = per & 1;
        const int kt0 = per * s + (odd ? (s & 1) : 0), nk = odd ? per + 1 - 2 * (s & 1) : per;
        pg8::Gemm g{A + (size_t)kt0 * 64, Bt + (size_t)kt0 * 64, M, D, nk * 64, K, wv};
        OneUnit S{pm, pn};
        EpiB16 E{YP + (ptrdiff_t)s * (1024 * 2048) - (ptrdiff_t)(32 * 256) * 2048, D};
        pg8::gemm_phase<EpiB16, OneUnit, true, true>(lds, g, S, E);
        __syncthreads();
    }
}
__device__ __forceinline__ void phase_ffn_in(const PX& p, LAS unsigned char* lds, int layer, int which) {
    unsigned char* wsb = opq_p(p.ws);
    layer = opq_s(layer);
    const bool lat = (layer == DEPTH - 1) && which == 1;
    EpiSwiglu E{(bf16*)(wsb + WS_ACT), DFF};
    run_gemm(p.wv, lds, (const bf16*)(wsb + WS_H), (const bf16*)(wsb + WS_WFFI) + (size_t)(layer * 2 + which) * (2 * DFF) * D, lat ? 32 : 36, 2 * DFF, D, lat, 0, E);
}
__device__ __forceinline__ void phase_ffn_out(const PX& p, LAS unsigned char* lds, int layer, int which) {
    unsigned char* wsb = opq_p(p.ws);
    layer = opq_s(layer);
    const bool lat = (layer == DEPTH - 1) && which == 1;
    const bf16* A = (const bf16*)(wsb + WS_ACT); const bf16* Bt = (const bf16*)(wsb + WS_WFFO) + (size_t)(layer * 2 + which) * D * DFF;
    if (lat) { EpiB16 E{(bf16*)(wsb + WS_Y), D}; run_gemm(p.wv, lds, A, Bt, 32, D, DFF, 1, 0, E); }
    else run_gemm_n2048_split(p.wv, lds, A, Bt, DFF, (bf16*)(wsb + WS_Y), (bf16*)(wsb + WS_YP));
}
__device__ __forceinline__ void phase_inproj(const PX& p, LAS unsigned char* lds, int layer) {
    unsigned char* wsb = opq_p(p.ws);
    layer = opq_s(layer);
    EpiB16 E{(bf16*)(wsb + WS_COLS), NINP};
    run_gemm(p.wv, lds, (const bf16*)(wsb + WS_H), (const bf16*)(wsb + WS_WIN) + (size_t)layer * NINP * D, 36, NINP, D, 0, 0, E);
}
__device__ __forceinline__ void phase_outproj(const PX& p, LAS unsigned char* lds, int layer) {
    unsigned char* wsb = opq_p(p.ws);
    layer = opq_s(layer);
    const bool lat = (layer == DEPTH - 1);
    const bf16* A = (const bf16*)(wsb + WS_YMIX); const bf16* Bt = (const bf16*)(wsb + WS_WOUT) + (size_t)layer * D * D;
    if (lat) { EpiB16 E{(bf16*)(wsb + WS_Y), D}; run_gemm(p.wv, lds, A, Bt, 32, D, D, 1, 0, E); }
    else run_gemm_n2048_split(p.wv, lds, A, Bt, D, (bf16*)(wsb + WS_Y), (bf16*)(wsb + WS_YP));
}

struct EpiLru {
    static constexpr bool PERM = false, AFTER_DRAIN = false;
    f32x2* AB; const bf16* U; const float* bg; const float* lam;
    __device__ __forceinline__ void operator()(const f32x4 (&acc)[2][2][4][2], const pg8::Unit& u, int wr, int wc, int fr, int fq) const {
        { const int ln = lane_fresh(); fr = ln & 15; fq = ln >> 4; }
        const int dir = u.pn >> 2, ch0 = (u.pn & 3) * 128 + wc * 32 + 4 * fq, row0 = u.pm * 256 + wr * 64 + fr;
        float br[2][4], bi[2][4], sp8[2][4];
#pragma unroll
        for (int n = 0; n < 2; ++n)
#pragma unroll
            for (int e = 0; e < 4; ++e) { const int ch = ch0 + 16 * n + e; br[n][e] = bg[(dir * 2 + 0) * 512 + ch]; bi[n][e] = bg[(dir * 2 + 1) * 512 + ch]; const float ee = __expf(-lam[dir * 512 + ch]); sp8[n][e] = 8.0f * (ee < 0.03f ? ee * (1.0f - ee * (0.5f - ee * 0.33333333f)) : __logf(1.0f + ee)); }
#pragma unroll
        for (int ai = 0; ai < 2; ++ai)
#pragma unroll
            for (int m = 0; m < 4; ++m) { const size_t row = (size_t)(row0 + ai * 128 + m * 16);
#pragma unroll
                for (int n = 0; n < 2; ++n) { const v2u uw = *(const v2u*)(U + row * 512 + ch0 + 16 * n);
                    const float uu[4] = {bflo(uw.x), bfhi(uw.x), bflo(uw.y), bfhi(uw.y)};
                    float o[8];
#pragma unroll
                    for (int e = 0; e < 4; ++e) { const float gr = acc[ai][0][m][n][e] + br[n][e], gi = acc[ai][1][m][n][e] + bi[n][e];
                        const float r = __builtin_amdgcn_rcpf(1.f + __expf(-gr)), ig = __builtin_amdgcn_rcpf(1.f + __expf(-gi));
                        const float log_a = -r * sp8[n][e], x2 = 2.0f * log_a;
                        const float om = x2 > -0.1f ? -x2 * (1.0f + x2 * (0.5f + x2 * (0.16666667f + x2 * 0.041666667f))) : 1.0f - __expf(x2);
                        o[2 * e] = __expf(log_a); o[2 * e + 1] = __builtin_amdgcn_sqrtf(om) * (ig * uu[e]); }
                    f32x4* dst = (f32x4*)(AB + ((size_t)dir * M + row) * 512 + ch0 + 16 * n);
                    dst[0] = (f32x4){o[0], o[1], o[2], o[3]}; dst[1] = (f32x4){o[4], o[5], o[6], o[7]}; } }
    }
};
struct EpiKvup {
    static constexpr bool PERM = true, AFTER_DRAIN = false;
    bf16* KMN; bf16* VTM;
    __device__ __forceinline__ void operator()(const f32x4 (&acc)[2][2][4][2], const pg8::Unit& u, int wr, int wc, int fr, int fq) const {
        { const int ln = lane_fresh(); fr = ln & 15; fq = ln >> 4; }
        const int row0 = u.pm * 256 + wr * 64 + fr, b = u.pm / 9, p0 = (u.pm % 9) * 256 + wr * 64 + fr;
#pragma unroll
        for (int ai = 0; ai < 2; ++ai)
#pragma unroll
            for (int m = 0; m < 4; ++m) { const size_t row = (size_t)(row0 + ai * 128 + m * 16); const int pp = p0 + ai * 128 + m * 16;
#pragma unroll
                for (int bj = 0; bj < 2; ++bj) { const int h = 2 * u.pn + bj; const f32x4 v0 = acc[ai][bj][m][0], v1 = acc[ai][bj][m][1];
                    if (wc < 2) { v4u w; w.x = pg8::cvt_pk_bf16(v0[0], v0[1]); w.y = pg8::cvt_pk_bf16(v0[2], v0[3]); w.z = pg8::cvt_pk_bf16(v1[0], v1[1]); w.w = pg8::cvt_pk_bf16(v1[2], v1[3]);
                        *(v4u*)(KMN + row * 512 + h * 64 + wc * 32 + 8 * fq) = w; }
                    else { bf16* vt = VTM + ((size_t)b * 512 + h * 64 + (wc - 2) * 32 + 8 * fq) * PB + pp;
                        vt[0 * (size_t)PB] = (bf16)f2bf(v0[0]); vt[1 * (size_t)PB] = (bf16)f2bf(v0[1]); vt[2 * (size_t)PB] = (bf16)f2bf(v0[2]); vt[3 * (size_t)PB] = (bf16)f2bf(v0[3]);
                        vt[4 * (size_t)PB] = (bf16)f2bf(v1[0]); vt[5 * (size_t)PB] = (bf16)f2bf(v1[1]); vt[6 * (size_t)PB] = (bf16)f2bf(v1[2]); vt[7 * (size_t)PB] = (bf16)f2bf(v1[3]); } } }
    }
};
__device__ __forceinline__ void phase_mgemm(const PX& p, LAS unsigned char* lds, int layer) {
    unsigned char* wsb = opq_p(p.ws);
    layer = opq_s(layer);
    { EpiB16 E{(bf16*)(wsb + WS_QUP), 768};
      run_gemm(p.wv, lds, (const bf16*)(wsb + WS_QN), (const bf16*)(wsb + WS_WQB) + (size_t)layer * 768 * 384, 36, 768, 384, 0, 0, E); }
    __syncthreads();
    { EpiKvup E{(bf16*)(wsb + WS_KMN), (bf16*)(wsb + WS_VTM)};
      run_gemm(p.wv, lds, (const bf16*)(wsb + WS_KVN), (const bf16*)(wsb + WS_WKVB) + (size_t)layer * 1024 * 256, 36, 1024, 256, 0, 148, E); }
    __syncthreads();
    { EpiLru E{(f32x2*)(wsb + WS_AB), (const bf16*)(wsb + WS_U), p.in[14] + (size_t)layer * 2 * 2 * 512, p.in[15] + (size_t)layer * 2 * 512};
      run_gemm(p.wv, lds, (const bf16*)(wsb + WS_U), (const bf16*)(wsb + WS_WG) + (size_t)layer * 2048 * 512, 36, 2048, 512, 0, 0, E); }
}


__device__ __forceinline__ void transpose_tok_item(const bf16* src, int ss, bf16* dst, LAS unsigned short* scr, int lane) {
#pragma unroll
    for (int i = 0; i < 8; ++i) { const int id = lane + 64 * i, row = id >> 3, ch = id & 7;
        const v4u w = *(const v4u*)(src + (size_t)row * ss + ch * 8);
        LAS unsigned* d = (LAS unsigned*)(scr + row * 66 + ch * 8);
        d[0] = w.x; d[1] = w.y; d[2] = w.z; d[3] = w.w; }
    LDS_WAIT(); asm volatile("" ::: "memory");
#pragma unroll
    for (int i = 0; i < 8; ++i) { const int id = lane + 64 * i, e = id >> 3, ch = id & 7;
        unsigned v[8];
#pragma unroll
        for (int k = 0; k < 8; ++k) v[k] = scr[(ch * 8 + k) * 66 + e];
        v4u w; w.x = v[0] | (v[1] << 16); w.y = v[2] | (v[3] << 16); w.z = v[4] | (v[5] << 16); w.w = v[6] | (v[7] << 16);
        *(v4u*)(dst + (size_t)e * PB + ch * 8) = w; }
    LDS_WAIT(); asm volatile("" ::: "memory");
}
__device__ __forceinline__ void phase_prep(const PX& p, LAS unsigned char* lds, int layer) {
    unsigned char* wsb = opq_p(p.ws);
    layer = opq_s(layer);
    const int tid = tid_opaque(p.wv), lane = tid & 63, wave = tid >> 6, G = gridDim.x, blk = blockIdx.x;
    const int gw = wave * G + blk, NGW = NW * G;
    bf16* COLS = (bf16*)(wsb + WS_COLS); bf16* U = (bf16*)(wsb + WS_U); bf16* QN = (bf16*)(wsb + WS_QN); bf16* KVN = (bf16*)(wsb + WS_KVN);
    const float* rope = (const float*)(wsb + WS_ROPE);
    const float* cw = p.in[11] + (size_t)layer * 4 * 512; const float* cb = p.in[12] + (size_t)layer * 512;
    const float* qg = p.in[16] + (size_t)layer * 384; const float* kvg = p.in[18] + (size_t)layer * 256;
    auto unpack8 = [](const v4u& w, float (&f)[8]) { f[0] = bflo(w.x); f[1] = bfhi(w.x); f[2] = bflo(w.y); f[3] = bfhi(w.y); f[4] = bflo(w.z); f[5] = bfhi(w.z); f[6] = bflo(w.w); f[7] = bfhi(w.w); };
    auto pack8 = [](const float (&f)[8]) { v4u w; w.x = pk2(f[0], f[1]); w.y = pk2(f[2], f[3]); w.z = pk2(f[4], f[5]); w.w = pk2(f[6], f[7]); return w; };
    for (int row = gw; row < M; row += NGW) {
        const int pp = row % PB; const bool isctx = pp < CTX;
        const int lo = isctx ? 0 : CTX, hi = isctx ? CTX : PB;
        bf16* crow = COLS + (size_t)row * NINP;
        { float acc[8];
          { const f32x4 b0 = *(const f32x4*)(cb + 8 * lane), b1 = *(const f32x4*)(cb + 8 * lane + 4);
            acc[0] = b0[0]; acc[1] = b0[1]; acc[2] = b0[2]; acc[3] = b0[3]; acc[4] = b1[0]; acc[5] = b1[1]; acc[6] = b1[2]; acc[7] = b1[3]; }
#pragma unroll
          for (int j = 0; j < 4; ++j) { const int q = pp + j - 2;
              if (q >= lo && q < hi) { float xv[8]; unpack8(*(const v4u*)(crow + (ptrdiff_t)(j - 2) * NINP + C_XB + 8 * lane), xv);
                  const f32x4 w0 = *(const f32x4*)(cw + j * 512 + 8 * lane), w1 = *(const f32x4*)(cw + j * 512 + 8 * lane + 4);
#pragma unroll
                  for (int e = 0; e < 4; ++e) { acc[e] += w0[e] * xv[e]; acc[4 + e] += w1[e] * xv[4 + e]; } } }
          *(v4u*)(U + (size_t)row * 512 + 8 * lane) = pack8(acc); }
        { float v[8]; float s = 0.f; const int l8 = lane < 48 ? lane : 47;
          unpack8(*(const v4u*)(crow + C_MQ + 8 * l8), v);
          if (lane < 48) {
#pragma unroll
              for (int e = 0; e < 8; ++e) s += v[e] * v[e]; }
          s = wave_sum(s); const float rstd = 1.0f / sqrtf(s * (1.0f / 384.f) + 1e-6f);
          const f32x4 g0 = *(const f32x4*)(qg + 8 * l8), g1 = *(const f32x4*)(qg + 8 * l8 + 4);
#pragma unroll
          for (int e = 0; e < 4; ++e) { v[e] = v[e] * rstd * g0[e]; v[4 + e] = v[4 + e] * rstd * g1[e]; }
          if (lane < 48) *(v4u*)(QN + (size_t)row * 384 + 8 * lane) = pack8(v); }
        { float v[8]; float s = 0.f; const int l8 = lane & 31;
          unpack8(*(const v4u*)(crow + C_MKV + 8 * l8), v);
          if (lane < 32) {
#pragma unroll
              for (int e = 0; e < 8; ++e) s += v[e] * v[e]; }
          s = wave_sum(s); const float rstd = 1.0f / sqrtf(s * (1.0f / 256.f) + 1e-6f);
          const f32x4 g0 = *(const f32x4*)(kvg + 8 * l8), g1 = *(const f32x4*)(kvg + 8 * l8 + 4);
#pragma unroll
          for (int e = 0; e < 4; ++e) { v[e] = v[e] * rstd * g0[e]; v[4 + e] = v[4 + e] * rstd * g1[e]; }
          if (lane < 32) *(v4u*)(KVN + (size_t)row * 256 + 8 * lane) = pack8(v); }
        if (!isctx) { const int t = pp - CTX; const int c = lane & 3, hsub = lane >> 2;
            const float* ct = rope + (size_t)t * 32 + 8 * c; const float* st = ct + SEQ * 32;
            const f32x4 c0 = *(const f32x4*)ct, c1 = *(const f32x4*)(ct + 4), s0 = *(const f32x4*)st, s1 = *(const f32x4*)(st + 4);
            const float cs[8] = {c0[0], c0[1], c0[2], c0[3], c1[0], c1[1], c1[2], c1[3]}, sn[8] = {s0[0], s0[1], s0[2], s0[3], s1[0], s1[1], s1[2], s1[3]};
#pragma unroll
            for (int k = 0; k < 2; ++k) { const int hd = 16 * k + hsub;
                if (hd < 26) { bf16* hp = crow + (hd < 16 ? C_DQ + hd * 64 : C_GQ + (hd - 16) * 64) + 8 * c;
                    float a[8], b[8], o1[8], o2[8]; unpack8(*(const v4u*)hp, a); unpack8(*(const v4u*)(hp + 32), b);
#pragma unroll
                    for (int e = 0; e < 8; ++e) { o1[e] = a[e] * cs[e] - b[e] * sn[e]; o2[e] = a[e] * sn[e] + b[e] * cs[e]; }
                    *(v4u*)hp = pack8(o1); *(v4u*)(hp + 32) = pack8(o2); } }
            if (lane < 2) { const float* ct2 = rope + SEQ * 64 + (size_t)t * 16 + 8 * lane; const float* st2 = ct2 + SEQ * 16;
                const f32x4 d0 = *(const f32x4*)ct2, d1 = *(const f32x4*)(ct2 + 4), e0 = *(const f32x4*)st2, e1 = *(const f32x4*)(st2 + 4);
                const float cs2[8] = {d0[0], d0[1], d0[2], d0[3], d1[0], d1[1], d1[2], d1[3]}, sn2[8] = {e0[0], e0[1], e0[2], e0[3], e1[0], e1[1], e1[2], e1[3]};
                bf16* hp = crow + C_MKR + 8 * lane;
                float a[8], b[8], o1[8], o2[8]; unpack8(*(const v4u*)hp, a); unpack8(*(const v4u*)(hp + 16), b);
#pragma unroll
                for (int e = 0; e < 8; ++e) { o1[e] = a[e] * cs2[e] - b[e] * sn2[e]; o2[e] = a[e] * sn2[e] + b[e] * cs2[e]; }
                *(v4u*)hp = pack8(o1); *(v4u*)(hp + 16) = pack8(o2); }
        }
    }
    { LAS unsigned short* scr = (LAS unsigned short*)(lds + wave * 16384);
      bf16* VTD = (bf16*)(wsb + WS_VTD); bf16* VTG = (bf16*)(wsb + WS_VTG);
      for (int it = gw; it < NB * 36 * 10; it += NGW) { const int b = it / 360, r = it % 360, tb = r / 10, cb = r % 10;
          const bf16* s = COLS + ((size_t)b * PB + tb * 64) * NINP + (cb < 8 ? C_DV + cb * 64 : C_GV + (cb - 8) * 64);
          bf16* d = cb < 8 ? VTD + ((size_t)b * 512 + cb * 64) * PB + tb * 64 : VTG + ((size_t)b * 128 + (cb - 8) * 64) * PB + tb * 64;
          transpose_tok_item(s, NINP, d, scr, lane); } }
}

__device__ __forceinline__ void phase_prep2(const PX& p, LAS unsigned char* lds, int layer) {
    unsigned char* wsb = opq_p(p.ws);
    layer = opq_s(layer);
    const int tid = tid_opaque(p.wv), lane = tid & 63, wave = tid >> 6, G = gridDim.x, blk = blockIdx.x;
    const int gw = wave * G + blk, NGW = NW * G;
    const bf16* COLS = (const bf16*)(wsb + WS_COLS); const bf16* U = (const bf16*)(wsb + WS_U);
    const bf16* QUP = (const bf16*)(wsb + WS_QUP); const bf16* KVUP = (const bf16*)(wsb + WS_KVUP);
    bf16* QM = (bf16*)(wsb + WS_QM); bf16* KM = (bf16*)(wsb + WS_KM);
    const float* GATES = (const float*)(wsb + WS_GATES); f32x2* AB = (f32x2*)(wsb + WS_AB);
    const float* rope = (const float*)(wsb + WS_ROPE);
    const float* bg = p.in[14] + (size_t)layer * 2 * 2 * 512; const float* lam = p.in[15] + (size_t)layer * 2 * 512;
    for (int row = gw; row < M; row += NGW) {
        const int pp = row % PB; const bool isctx = pp < CTX; const int t = pp - CTX;
#pragma unroll
        for (int j = 0; j < 12; ++j) { const int e = lane + 64 * j, h = e / 96, d = e % 96;
            float qv = bf2f(QUP[(size_t)row * 768 + e]);
            if (d >= 64 && !isctx) { const int i = (d - 64) & 15; const bool second = (d - 64) >= 16;
                const float c = rope[SEQ * 64 + t * 16 + i], sn = rope[SEQ * 64 + SEQ * 16 + t * 16 + i];
                const float x1 = bf2f(QUP[(size_t)row * 768 + h * 96 + 64 + i]), x2 = bf2f(QUP[(size_t)row * 768 + h * 96 + 80 + i]);
                qv = second ? (x1 * sn + x2 * c) : (x1 * c - x2 * sn); }
            QM[(size_t)row * 768 + e] = (bf16)f2bf(qv);
            KM[(size_t)row * 768 + e] = d < 64 ? KVUP[(size_t)row * 1024 + h * 128 + d] : COLS[(size_t)row * NINP + C_MKR + (d - 64)]; }
#pragma unroll
        for (int dir = 0; dir < 2; ++dir)
#pragma unroll
            for (int cblk = 0; cblk < 8; ++cblk) { const int ch = cblk * 64 + lane;
                const float* gp = GATES + (size_t)row * 2048 + ((dir * 4 + (ch >> 7)) * 2) * 128 + (ch & 127);
                const float gr = gp[0] + bg[(dir * 2 + 0) * 512 + ch], gi = gp[128] + bg[(dir * 2 + 1) * 512 + ch];
                const float r = 1.f / (1.f + expf(-gr)), ig = 1.f / (1.f + expf(-gi));
                const float sp = log1pf(expf(-lam[dir * 512 + ch]));
                const float log_a = -8.0f * r * sp, a = expf(log_a);
                const float u = bf2f(U[(size_t)row * 512 + ch]);
                const float bco = sqrtf(-expm1f(2.0f * log_a)) * (ig * u);
                AB[((size_t)dir * M + row) * 512 + ch] = (f32x2){a, bco}; }
    }
    { LAS unsigned short* scr = (LAS unsigned short*)(lds + wave * 16384);
      bf16* VTM = (bf16*)(wsb + WS_VTM);
      for (int it = gw; it < NB * 36 * 8; it += NGW) { const int b = it / 288, r = it % 288, tb = r / 8, hh = r % 8;
          transpose_tok_item(KVUP + ((size_t)b * PB + tb * 64) * 1024 + hh * 128 + 64, 1024, VTM + ((size_t)b * 512 + hh * 64) * PB + tb * 64, scr, lane); } }
}

template <int DQK, int DV, int MODE, bool OUTF32>
__device__ __forceinline__ void naive_attn(const bf16* Q, int qs, const bf16* K, int ks, const bf16* V, int vs, void* O, int os,
                                           int b, int pp0, int lane, float scale, float sink) {
    const size_t rowbase = (size_t)b * PB; const int pp = pp0 + lane;
    float q[DQK], o[DV];
    { const bf16* qr = Q + (rowbase + pp) * qs;
#pragma unroll
      for (int c = 0; c < DQK / 8; ++c) { const v4u w = *(const v4u*)(qr + 8 * c);
          q[8 * c + 0] = bflo(w.x); q[8 * c + 1] = bfhi(w.x); q[8 * c + 2] = bflo(w.y); q[8 * c + 3] = bfhi(w.y);
          q[8 * c + 4] = bflo(w.z); q[8 * c + 5] = bfhi(w.z); q[8 * c + 6] = bflo(w.w); q[8 * c + 7] = bfhi(w.w); } }
    const float sl2 = scale * 1.4426950408889634f;
#pragma unroll
    for (int d = 0; d < DQK; ++d) q[d] *= sl2;
#pragma unroll
    for (int e = 0; e < DV; ++e) o[e] = 0.f;
    float m = (MODE == 1) ? sink * 1.4426950408889634f : -1e30f, l = (MODE == 1) ? 1.f : 0.f;
    const bool isctx = pp0 < CTX; const int t = pp - CTX, t0 = pp0 - CTX;
    for (int seg = 0; seg < 2; ++seg) {
        int k0, k1;
        if (seg == 0) { k0 = 0; k1 = CTX; }
        else { if (isctx) break;
            if (MODE == 0) { k0 = CTX; k1 = PB; }
            else { const int a0 = t0 - 128 < 0 ? 0 : t0 - 128, a1 = t0 + 63 + 128 > SEQ - 1 ? SEQ - 1 : t0 + 63 + 128; k0 = CTX + a0; k1 = CTX + a1 + 1; } }
        for (int key = k0; key < k1; ++key) {
            const bf16* kr = K + (rowbase + key) * ks; const bf16* vr = V + (rowbase + key) * vs;
            asm volatile("" : "+v"(kr)); asm volatile("" : "+v"(vr));
            float s = 0.f;
#pragma unroll
            for (int c = 0; c < DQK / 8; ++c) { const v4u w = *(const v4u*)(kr + 8 * c);
                s += q[8 * c + 0] * bflo(w.x); s += q[8 * c + 1] * bfhi(w.x); s += q[8 * c + 2] * bflo(w.y); s += q[8 * c + 3] * bfhi(w.y);
                s += q[8 * c + 4] * bflo(w.z); s += q[8 * c + 5] * bfhi(w.z); s += q[8 * c + 6] * bflo(w.w); s += q[8 * c + 7] * bfhi(w.w); }
            bool valid = true;
            if (MODE == 1 && seg == 1) { const int rel = (key - CTX) - t; valid = (rel <= 128) && (rel >= -128); }
            if (valid) {
                const float mn = fmaxf(m, s), alpha = exp2f(m - mn), pr = exp2f(s - mn);
                l = l * alpha + pr; m = mn;
#pragma unroll
                for (int c = 0; c < DV / 8; ++c) { const v4u w = *(const v4u*)(vr + 8 * c);
                    o[8 * c + 0] = o[8 * c + 0] * alpha + pr * bflo(w.x); o[8 * c + 1] = o[8 * c + 1] * alpha + pr * bfhi(w.x);
                    o[8 * c + 2] = o[8 * c + 2] * alpha + pr * bflo(w.y); o[8 * c + 3] = o[8 * c + 3] * alpha + pr * bfhi(w.y);
                    o[8 * c + 4] = o[8 * c + 4] * alpha + pr * bflo(w.z); o[8 * c + 5] = o[8 * c + 5] * alpha + pr * bfhi(w.z);
                    o[8 * c + 6] = o[8 * c + 6] * alpha + pr * bflo(w.w); o[8 * c + 7] = o[8 * c + 7] * alpha + pr * bfhi(w.w); }
            }
        }
    }
    const float il = 1.f / l;
    if (OUTF32) { float* orow = (float*)O + (rowbase + pp) * os;
#pragma unroll
        for (int e = 0; e < DV; e += 4) *(f32x4*)(orow + e) = (f32x4){o[e] * il, o[e + 1] * il, o[e + 2] * il, o[e + 3] * il}; }
    else { bf16* orow = (bf16*)O + (rowbase + pp) * os;
#pragma unroll
        for (int e = 0; e < DV; e += 8) { v4u w; w.x = pk2(o[e] * il, o[e + 1] * il); w.y = pk2(o[e + 2] * il, o[e + 3] * il); w.z = pk2(o[e + 4] * il, o[e + 5] * il); w.w = pk2(o[e + 6] * il, o[e + 7] * il);
            *(v4u*)(orow + e) = w; } }
}


typedef short bf16x8 __attribute__((ext_vector_type(8)));
typedef float f32x16 __attribute__((ext_vector_type(16)));
__device__ __forceinline__ int crow16(int r, int hi) { return (r & 3) + 8 * (r >> 2) + 4 * hi; }

typedef __bf16 bf16x2_t __attribute__((ext_vector_type(2)));
__device__ __forceinline__ unsigned cvtpk_s(float lo, float hi) { const f32x2 v = {lo, hi}; const bf16x2_t b = __builtin_convertvector(v, bf16x2_t); return __builtin_bit_cast(unsigned, b); }
template <int DQK, int DV, int MODE, bool OUTF32>
__device__ __forceinline__ void attn_unit(LAS unsigned char* lds, const bf16* Qb, int qs, const bf16* Kb, int ks, const bf16* Kb2, int ks2, const float* ropeq, const bf16* VTb, void* Ob, int os,
                                          int q0, int ntd, float scale, float sink, int tid_in) {
    int tid = tid_in; asm volatile("" : "+v"(tid));
    constexpr int RSK = DQK * 2 + 16, RSV = 136, KBUF = 64 * RSK, VBUF = DV * RSV, CPR = DQK / 8, NKC = 64 * CPR, NVC = DV * 8;
    constexpr int NKI = (NKC + NT - 1) / NT, NVI = NVC / NT, ND0 = DQK / 16, NDB = DV / 32;
    const int lane = tid & 63, wave = __builtin_amdgcn_readfirstlane(tid >> 6), r32 = lane & 31, hi = lane >> 5;
    int ta = 4, ntiles = ntd;
    if (MODE == 1) { if (q0 < CTX) ntiles = 4; else { const int t0 = q0 - CTX; const int lo = t0 - 128 < 0 ? 0 : t0 - 128, hh = t0 + 383 > SEQ - 1 ? SEQ - 1 : t0 + 383; ta = 4 + (lo >> 6); ntiles = 4 + ((hh >> 6) - (lo >> 6) + 1); } }
#define TILE_OF(i) ((MODE == 1 && (i) >= 4) ? ta + (i) - 4 : (i))
    const int qrow = q0 + wave * 32 + r32;
    bf16x8 qf[ND0];
#pragma unroll
    for (int d0 = 0; d0 < ND0; ++d0) qf[d0] = *(const bf16x8*)(Qb + (size_t)qrow * qs + 16 * d0 + 8 * hi);
    if (DQK == 96 && ropeq != nullptr) {
        const float* cs = ropeq + (size_t)(qrow - CTX) * 16 + 8 * hi; const float* sn = cs + SEQ * 16;
        const f32x4 c0 = *(const f32x4*)cs, c1 = *(const f32x4*)(cs + 4), s0 = *(const f32x4*)sn, s1 = *(const f32x4*)(sn + 4);
        float y1[8], y2[8];
#pragma unroll
        for (int j = 0; j < 8; ++j) { const float x1 = bf2f((unsigned short)qf[ND0 - 2][j]), x2 = bf2f((unsigned short)qf[ND0 - 1][j]);
            const float cc = j < 4 ? c0[j] : c1[j - 4], ss = j < 4 ? s0[j] : s1[j - 4];
            y1[j] = x1 * cc - x2 * ss; y2[j] = x1 * ss + x2 * cc; }
        qf[ND0 - 2] = __builtin_bit_cast(bf16x8, (v4u){cvtpk_s(y1[0], y1[1]), cvtpk_s(y1[2], y1[3]), cvtpk_s(y1[4], y1[5]), cvtpk_s(y1[6], y1[7])});
        qf[ND0 - 1] = __builtin_bit_cast(bf16x8, (v4u){cvtpk_s(y2[0], y2[1]), cvtpk_s(y2[2], y2[3]), cvtpk_s(y2[4], y2[5]), cvtpk_s(y2[6], y2[7])});
    }
    f32x16 o[NDB];
#pragma unroll
    for (int db = 0; db < NDB; ++db)
#pragma unroll
        for (int r = 0; r < 16; ++r) o[db][r] = 0.f;
    const float c = scale * 1.4426950408889634f;
    float m = (MODE == 1) ? sink / scale : -1e30f, l = (MODE == 1 && hi == 0) ? 1.f : 0.f;
    v4u kreg[NKI], vreg[NVI];
#pragma unroll
    for (int i_ = 0; i_ < NKI; ++i_) kreg[i_] = (v4u){0u, 0u, 0u, 0u};
#pragma unroll
    for (int i_ = 0; i_ < NVI; ++i_) vreg[i_] = (v4u){0u, 0u, 0u, 0u};
#define LOAD_TILE(tile) do { const int kb_ = (tile) * 64; \
        _Pragma("unroll") for (int i_ = 0; i_ < NKI; ++i_) { const int id_ = tid + NT * i_; if (id_ < NKC) { const int row_ = id_ / CPR, ch_ = id_ % CPR; kreg[i_] = (DQK == 96 && ch_ >= 8) ? *(const v4u*)(Kb2 + (size_t)(kb_ + row_) * ks2 + (ch_ - 8) * 8) : *(const v4u*)(Kb + (size_t)(kb_ + row_) * ks + ch_ * 8); } } \
        _Pragma("unroll") for (int i_ = 0; i_ < NVI; ++i_) { const int id_ = tid + NT * i_, d_ = id_ >> 3, ch_ = id_ & 7; vreg[i_] = *(const v4u*)(VTb + (size_t)d_ * PB + kb_ + ch_ * 8); } } while (0)
#define STORE_TILE(buf) do { \
        _Pragma("unroll") for (int i_ = 0; i_ < NKI; ++i_) { const int id_ = tid + NT * i_; if (id_ < NKC) { const int row_ = id_ / CPR, ch_ = id_ % CPR; *(LAS v4u*)(lds + (buf) * KBUF + row_ * RSK + ch_ * 16) = kreg[i_]; } } \
        _Pragma("unroll") for (int i_ = 0; i_ < NVI; ++i_) { const int id_ = tid + NT * i_, d_ = id_ >> 3, ch_ = id_ & 7; LAS v2u* w_ = (LAS v2u*)(lds + 2 * KBUF + (buf) * VBUF + d_ * RSV + ch_ * 16); \
            w_[0] = (v2u){vreg[i_].x, vreg[i_].y}; w_[1] = (v2u){vreg[i_].z, vreg[i_].w}; } } while (0)
    LOAD_TILE(TILE_OF(0)); STORE_TILE(0); __syncthreads();
    for (int i = 0; i < ntiles; ++i) {
        const int cur = i & 1, tile = TILE_OF(i);
        if (i + 1 < ntiles) LOAD_TILE(TILE_OF(i + 1));
        bool active = true;
        if (MODE == 1 && i >= 4) { const int kt0 = tile * 64 - CTX, qt0 = q0 - CTX + wave * 32; active = (kt0 + 63 >= qt0 - 128) && (kt0 <= qt0 + 31 + 128); }
        if (active) {
            f32x16 p0, p1;
#pragma unroll
            for (int r = 0; r < 16; ++r) { p0[r] = 0.f; p1[r] = 0.f; }
            const LAS unsigned char* kb = lds + cur * KBUF + r32 * RSK + hi * 16;
#pragma unroll
            for (int d0 = 0; d0 < ND0; ++d0) { const bf16x8 k0 = *(const LAS bf16x8*)(kb + d0 * 32), k1 = *(const LAS bf16x8*)(kb + 32 * RSK + d0 * 32);
                p0 = __builtin_amdgcn_mfma_f32_32x32x16_bf16(k0, qf[d0], p0, 0, 0, 0); p1 = __builtin_amdgcn_mfma_f32_32x32x16_bf16(k1, qf[d0], p1, 0, 0, 0); }
            if (MODE == 1 && i >= 4) { const int rel0 = (tile * 64 - CTX) - (qrow - CTX);
#pragma unroll
                for (int r = 0; r < 16; ++r) { const int ra = rel0 + crow16(r, hi), rb = ra + 32;
                    if (ra > 128 || ra < -128) p0[r] = -1e30f; if (rb > 128 || rb < -128) p1[r] = -1e30f; } }
            float mx = fmaxf(p0[0], p1[0]);
#pragma unroll
            for (int r = 1; r < 16; ++r) mx = fmaxf(mx, fmaxf(p0[r], p1[r]));
            mx = xhalf_max(mx);
            const float mn = fmaxf(m, mx), alpha = __builtin_amdgcn_exp2f((m - mn) * c), nmc = -mn * c; m = mn;
            float sum = 0.f;
#pragma unroll
            for (int r = 0; r < 16; ++r) { p0[r] = __builtin_amdgcn_exp2f(fmaf(p0[r], c, nmc)); p1[r] = __builtin_amdgcn_exp2f(fmaf(p1[r], c, nmc)); sum += p0[r] + p1[r]; }
            l = l * alpha + sum;
            if (!__all(alpha == 1.f)) {
#pragma unroll
                for (int db = 0; db < NDB; ++db)
#pragma unroll
                    for (int r = 0; r < 16; ++r) o[db][r] *= alpha; }
            const LAS unsigned char* vb = lds + 2 * KBUF + cur * VBUF + r32 * RSV + hi * 8;
#pragma unroll
            for (int s = 0; s < 4; ++s) { const int rb = (s & 1) * 8;
                v4u pw;
                if (s < 2) { pw.x = cvtpk_s(p0[rb + 0], p0[rb + 1]); pw.y = cvtpk_s(p0[rb + 2], p0[rb + 3]); pw.z = cvtpk_s(p0[rb + 4], p0[rb + 5]); pw.w = cvtpk_s(p0[rb + 6], p0[rb + 7]); }
                else       { pw.x = cvtpk_s(p1[rb + 0], p1[rb + 1]); pw.y = cvtpk_s(p1[rb + 2], p1[rb + 3]); pw.z = cvtpk_s(p1[rb + 4], p1[rb + 5]); pw.w = cvtpk_s(p1[rb + 6], p1[rb + 7]); }
                const bf16x8 pf = __builtin_bit_cast(bf16x8, pw);
#pragma unroll
                for (int db = 0; db < NDB; ++db) { const LAS unsigned char* vp = vb + db * 32 * RSV + s * 32;
                    const v2u a0 = *(const LAS v2u*)(vp), a1 = *(const LAS v2u*)(vp + 16);
                    const bf16x8 vf = __builtin_bit_cast(bf16x8, (v4u){a0.x, a0.y, a1.x, a1.y});
                    o[db] = __builtin_amdgcn_mfma_f32_32x32x16_bf16(vf, pf, o[db], 0, 0, 0); }
                __builtin_amdgcn_sched_barrier(0); }
        }
        if (i + 1 < ntiles) STORE_TILE(cur ^ 1);
        __syncthreads();
    }
#undef LOAD_TILE
#undef STORE_TILE
#undef TILE_OF
    l = xhalf_sum(l);
    const float il = 1.f / l;
#pragma unroll
    for (int db = 0; db < NDB; ++db)
#pragma unroll
        for (int rr = 0; rr < 4; ++rr) { const int d = 32 * db + 8 * rr + 4 * hi;
            const float a = o[db][4 * rr] * il, b = o[db][4 * rr + 1] * il, cc = o[db][4 * rr + 2] * il, dd = o[db][4 * rr + 3] * il;
            if (OUTF32) *(f32x4*)((float*)Ob + (size_t)qrow * os + d) = (f32x4){a, b, cc, dd};
            else *(v2u*)((bf16*)Ob + (size_t)qrow * os + d) = (v2u){cvtpk_s(a, b), cvtpk_s(cc, dd)}; }
}

__device__ __forceinline__ void phase_att(const PX& p, LAS unsigned char* lds, int layer) {
    unsigned char* wsb = opq_p(p.ws);
    layer = opq_s(layer);
    const int tid = tid_opaque(p.wv), lane = tid & 63, wave = __builtin_amdgcn_readfirstlane(tid >> 6), G = gridDim.x, blk = blockIdx.x;
    const int gw = wave * G + blk;
    const bool last = layer == DEPTH - 1;
    const bf16* COLS = (const bf16*)(wsb + WS_COLS);
    const bf16* QUP = (const bf16*)(wsb + WS_QUP); const bf16* KMN = (const bf16*)(wsb + WS_KMN);
    const bf16* VTD = (const bf16*)(wsb + WS_VTD); const bf16* VTG = (const bf16*)(wsb + WS_VTG); const bf16* VTM = (const bf16*)(wsb + WS_VTM);
    bf16* YMIX = (bf16*)(wsb + WS_YMIX); float* DIFFO = (float*)(wsb + WS_DIFFO);
    const f32x2* AB = (const f32x2*)(wsb + WS_AB);
    { f32x2* SUM = (f32x2*)(wsb + WS_SUM);
      for (int it = gw; it < NB * 2 * 36 * 8; it += NW * G) { const int g = it & 7, c = (it >> 3) % 36, dir = (it / 288) & 1, b = it / 576, ch = g * 64 + lane;
          const f32x2* ab = AB + ((size_t)dir * M + (size_t)b * PB + c * 64) * 512 + ch;
          float A = 1.f, H = 0.f;
          if (dir == 0) {
#pragma unroll 16
              for (int q = 0; q < 64; ++q) { const f32x2 cf = ab[(size_t)q * 512]; H = cf.x * H + cf.y; A *= cf.x; }
          } else {
#pragma unroll 16
              for (int q = 63; q >= 0; --q) { const f32x2 cf = ab[(size_t)q * 512]; H = cf.x * H + cf.y; A *= cf.x; }
          }
          const int ord = dir == 0 ? c : (c <= 3 ? 3 - c : 39 - c);
          SUM[(((size_t)dir * NB + b) * 40 + ord) * 512 + ch] = (f32x2){A, H}; } }
    for (int u = blk; u < 256; u += G) {
        const int xcd = u & 7, j = u >> 3, grp = xcd * 4 + (j >> 3), qb = j & 7, b = grp >> 3, hh = grp & 7, q0 = CTX + qb * 256;
        const size_t rb = (size_t)b * PB;
        attn_unit<96, 64, 0, false>(lds, QUP + rb * 768 + hh * 96, 768, KMN + rb * 512 + hh * 64, 512, COLS + rb * NINP + C_MKR, NINP, (const float*)(wsb + WS_ROPE) + SEQ * 64, VTM + ((size_t)b * 512 + hh * 64) * PB, YMIX + rb * 2048 + 512 + hh * 64, 2048, q0, 36, 0.10206207261596575f, 0.f, tid);
        attn_unit<64, 128, 0, true>(lds, COLS + rb * NINP + C_DQ + hh * 64, NINP, COLS + rb * NINP + C_DK + hh * 64, NINP, nullptr, 0, nullptr, VTD + ((size_t)b * 512 + (hh >> 1) * 128) * PB, DIFFO + rb * 1024 + hh * 128, 1024, q0, 36, 0.125f, 0.f, tid);
        attn_unit<64, 64, 1, false>(lds, COLS + rb * NINP + C_GQ + hh * 64, NINP, COLS + rb * NINP + C_GK + (hh >> 2) * 64, NINP, nullptr, 0, nullptr, VTG + ((size_t)b * 128 + (hh >> 2) * 64) * PB, YMIX + rb * 2048 + 1536 + hh * 64, 2048, q0, 0, 0.125f, p.in[22][layer * 8 + hh], tid);
    }
    if (!last) {
        for (int u = blk; u < 96; u += G) { const int kind = u >> 5, b = (u >> 3) & 3, hh = u & 7; const size_t rb = (size_t)b * PB;
            if (kind == 0) attn_unit<96, 64, 0, false>(lds, QUP + rb * 768 + hh * 96, 768, KMN + rb * 512 + hh * 64, 512, COLS + rb * NINP + C_MKR, NINP, nullptr, VTM + ((size_t)b * 512 + hh * 64) * PB, YMIX + rb * 2048 + 512 + hh * 64, 2048, 0, 4, 0.10206207261596575f, 0.f, tid);
            else if (kind == 1) attn_unit<64, 128, 0, true>(lds, COLS + rb * NINP + C_DQ + hh * 64, NINP, COLS + rb * NINP + C_DK + hh * 64, NINP, nullptr, 0, nullptr, VTD + ((size_t)b * 512 + (hh >> 1) * 128) * PB, DIFFO + rb * 1024 + hh * 128, 1024, 0, 4, 0.125f, 0.f, tid);
            else attn_unit<64, 64, 1, false>(lds, COLS + rb * NINP + C_GQ + hh * 64, NINP, COLS + rb * NINP + C_GK + (hh >> 2) * 64, NINP, nullptr, 0, nullptr, VTG + ((size_t)b * 128 + (hh >> 2) * 64) * PB, YMIX + rb * 2048 + 1536 + hh * 64, 2048, 0, 0, 0.125f, p.in[22][layer * 8 + hh], tid);
        }
    }
}

__device__ __forceinline__ void phase_mixfin(const PX& p, LAS unsigned char* lds, int layer) {
    layer = opq_s(layer);
    unsigned char* wsb = opq_p(p.ws);
    const int tid = tid_opaque(p.wv), lane = tid & 63, wave = tid >> 6, G = gridDim.x, blk = blockIdx.x;
    const int gw = wave * G + blk, NGW = NW * G;
    const bool last = layer == DEPTH - 1;
    const bf16* COLS = (const bf16*)(wsb + WS_COLS); bf16* YMIX = (bf16*)(wsb + WS_YMIX); const float* DIFFO = (const float*)(wsb + WS_DIFFO);
    { const f32x2* AB = (const f32x2*)(wsb + WS_AB); const f32x2* SUM = (const f32x2*)(wsb + WS_SUM);
      LAS float* hf = (LAS float*)(lds + wave * 16384);
      for (int it = gw; it < NB * 36 * 8; it += NGW) { const int g = it & 7, c = (it >> 3) % 36, b = it / 288, ch = g * 64 + lane;
          if (last && c < 4) continue;
          { const f32x2* sm = SUM + (((size_t)0 * NB + b) * 40) * 512 + ch; float h = 0.f;
            for (int o = 0; o < c; ++o) { const f32x2 s = sm[(size_t)o * 512]; h = s.x * h + s.y; }
            const f32x2* ab = AB + ((size_t)0 * M + (size_t)b * PB + c * 64) * 512 + ch;
#pragma unroll 16
            for (int q = 0; q < 64; ++q) { const f32x2 cf = ab[(size_t)q * 512]; h = cf.x * h + cf.y; hf[q * 64 + lane] = h; } }
          { const int ord = c <= 3 ? 3 - c : 39 - c;
            const f32x2* sm = SUM + (((size_t)1 * NB + b) * 40) * 512 + ch; float h = 0.f;
            for (int o = 0; o < ord; ++o) { const f32x2 s = sm[(size_t)o * 512]; h = s.x * h + s.y; }
            const f32x2* ab = AB + ((size_t)1 * M + (size_t)b * PB + c * 64) * 512 + ch;
            LDS_WAIT();
#pragma unroll 8
            for (int q = 63; q >= 0; --q) { const f32x2 cf = ab[(size_t)q * 512]; h = cf.x * h + cf.y; const size_t row = (size_t)b * PB + c * 64 + q;
                const float gt = bf2f(COLS[row * NINP + C_GATE + ch]);
                YMIX[row * 2048 + ch] = (bf16)f2bf((hf[q * 64 + lane] + h) * gelu_tanh(gt)); } }
          LDS_WAIT(); } }
    const float* lv = p.in[20] + (size_t)layer * 4 * 64; const float* dg = p.in[21] + (size_t)layer * 128;
    const float lam_init = 0.8f - 0.6f * expf(-0.3f * (float)layer);
    const float lam = expf(wave_sum(lv[lane] * lv[64 + lane])) - expf(wave_sum(lv[128 + lane] * lv[192 + lane])) + lam_init;
    for (int row = gw; row < M; row += NGW) {
        const int pp = row % PB; if (last && pp < CTX) continue;
#pragma unroll
        for (int hh = 0; hh < 4; ++hh) { float o[2]; float s = 0.f;
#pragma unroll
            for (int j = 0; j < 2; ++j) { const int e = lane + 64 * j;
                o[j] = DIFFO[(size_t)row * 1024 + (2 * hh) * 128 + e] - lam * DIFFO[(size_t)row * 1024 + (2 * hh + 1) * 128 + e]; s += o[j] * o[j]; }
            s = wave_sum(s); const float rstd = 1.0f / sqrtf(s * (1.0f / 128.f) + 1e-6f);
#pragma unroll
            for (int j = 0; j < 2; ++j) { const int e = lane + 64 * j; YMIX[(size_t)row * 2048 + 1024 + hh * 128 + e] = (bf16)f2bf(o[j] * rstd * dg[e] * (1.0f - lam_init)); } }
    }
}

#define XB_TMO      128
#define XB_XCNT(j)  (256  + 64 * (j))
#define XB_XSUB(j)  (1280 + 64 * (j))
#define XB_XGEN(j)  (2304 + 64 * (j))
#define XB_TOP      3328
#define XB_TOPGEN   3392
#define XCD_BAR_WORDS 3456
#define XB_SPIN_CAP (1u << 18)

__device__ __forceinline__ unsigned xb_ld(unsigned* p)              { return __hip_atomic_load(p, __ATOMIC_RELAXED, __HIP_MEMORY_SCOPE_AGENT); }
__device__ __forceinline__ unsigned xb_add(unsigned* p, unsigned v) { return __hip_atomic_fetch_add(p, v, __ATOMIC_RELAXED, __HIP_MEMORY_SCOPE_AGENT); }
__device__ __forceinline__ unsigned xb_xcc_id() { return (unsigned)__builtin_amdgcn_s_getreg((3 << 11) | 20) & 0xFu; }
#define XB_SPIN(cond, bar) do { unsigned _sp = 0; while (cond) { __builtin_amdgcn_s_sleep(1); \
    if ((++_sp & 255u) == 0u) { if (xb_ld(&(bar)[XB_TMO])) break; if (_sp > XB_SPIN_CAP) { atomicAdd(&(bar)[XB_TMO], 1u); break; } } } } while (0)

struct XcdBarrier {
    int wv;
    unsigned* bar; unsigned x;
    volatile LAS unsigned* st;
};

__device__ __forceinline__ XcdBarrier xcd_barrier_post(unsigned* bar, volatile LAS unsigned* st) {
    XcdBarrier b; b.bar = bar; b.x = xb_xcc_id(); b.st = st;
    if (threadIdx.x == 0) (void)xb_add(&bar[XB_XCNT(b.x)], 1u);
    return b;
}
__device__ __forceinline__ void xcd_barrier_complete(unsigned* bar, unsigned x, unsigned& nloc, unsigned& nx) {
    const unsigned G = gridDim.x * gridDim.y * gridDim.z;
    unsigned sum, cnt, mine, sp = 0u;
    for (;;) {
        sum = 0u; cnt = 0u; mine = 0u;
#pragma unroll
        for (unsigned j = 0; j < 16; ++j) { const unsigned c = xb_ld(&bar[XB_XCNT(j)]); sum += c; cnt += (c > 0u) ? 1u : 0u; mine = (j == x) ? c : mine; }
        if (sum == G) break;
        __builtin_amdgcn_s_sleep(1);
        if ((++sp & 255u) == 0u) { if (xb_ld(&bar[XB_TMO])) break; if (sp > XB_SPIN_CAP) { atomicAdd(&bar[XB_TMO], 1u); break; } }
    }
    nloc = mine > 0u ? mine : 1u; nx = cnt > 0u ? cnt : 1u;
}

__device__ __forceinline__ void xcd_barrier(const XcdBarrier& b) {
    asm volatile("s_waitcnt vmcnt(0)" ::: "memory");
    __syncthreads();
    if (b.wv == 0 && lane_fresh() == 0) {
        unsigned* bar = b.bar; const unsigned bx = xb_xcc_id();
        __builtin_amdgcn_s_waitcnt(0);
        unsigned nloc = b.st[0], nx = b.st[1];
        if (nloc == 0u) { xcd_barrier_complete(bar, bx, nloc, nx); b.st[0] = nloc; b.st[1] = nx; }
        const unsigned old = xb_add(&bar[XB_XSUB(bx)], 1u);
        const unsigned gen = old / nloc;
        if (old + 1u == (gen + 1u) * nloc) {
            __builtin_amdgcn_fence(__ATOMIC_RELEASE, "agent");
            asm volatile("s_waitcnt vmcnt(0)" ::: "memory");
            const unsigned og = xb_add(&bar[XB_TOP], 1u);
            const unsigned tg = og / nx;
            if (og + 1u == (tg + 1u) * nx) xb_add(&bar[XB_TOPGEN], 1u);
            else XB_SPIN(xb_ld(&bar[XB_TOPGEN]) == tg, bar);
            __builtin_amdgcn_fence(__ATOMIC_ACQUIRE, "agent");
            xb_add(&bar[XB_XGEN(bx)], 1u);
            asm volatile("s_waitcnt vmcnt(0)" ::: "memory");
        } else {
            XB_SPIN(xb_ld(&bar[XB_XGEN(bx)]) == gen, bar);
            __builtin_amdgcn_fence(__ATOMIC_ACQUIRE, "agent");
            asm volatile("s_waitcnt vmcnt(0)" ::: "memory");
        }
    }
    __syncthreads();
}

constexpr int CW_BAR = 4096;
constexpr size_t CTL_ZERO_BYTES = 1 * MiB;
constexpr int LDSCTL_OFF = 131072, MISC_OFF = LDSCTL_OFF + 320;

__global__ void __launch_bounds__(NT, 2) k_mega(P p) {
    extern __shared__ __attribute__((aligned(16))) unsigned char lds_raw[];
    LAS unsigned char* lds = (LAS unsigned char*)lds_raw;
    const int wv = __builtin_amdgcn_readfirstlane((int)threadIdx.x >> 6);
    const KP kp = (KP)__builtin_amdgcn_kernarg_segment_ptr();
    for (int u = threadIdx.x; u < (LDS_BYTES - LDSCTL_OFF) / 4; u += NT) ((LAS unsigned*)(lds + LDSCTL_OFF))[u] = 0u;
    __syncthreads();
    unsigned* barw = (unsigned*)(p.ws + WS_CTL) + CW_BAR;
    XcdBarrier bar = xcd_barrier_post(barw, (volatile LAS unsigned*)(lds + MISC_OFF) + 8);
    bar.wv = wv;
#define GB() xcd_barrier(bar)
    phase_pro1(load_P(kp, wv), lds); GB();
    phase_pro2(load_P(kp, wv)); GB();
    for (int l = 0; l < DEPTH; ++l) {
        for (int which = 0; which < 2; ++which) {
            phase_ffn_in(load_P(kp, wv), lds, l, which); GB();
            phase_ffn_out(load_P(kp, wv), lds, l, which); GB();
            phase_post(load_P(kp, wv), l, which == 0 ? 0 : 2); GB();
            if (which == 0) {
                phase_inproj(load_P(kp, wv), lds, l); GB();
                phase_prep(load_P(kp, wv), lds, l); GB();
                phase_mgemm(load_P(kp, wv), lds, l); GB();
                phase_att(load_P(kp, wv), lds, l); GB();
                phase_mixfin(load_P(kp, wv), lds, l); GB();
                phase_outproj(load_P(kp, wv), lds, l); GB();
                phase_post(load_P(kp, wv), l, 1); GB();
            }
        }
    }
#undef GB
    if (__hip_atomic_load(barw + XB_TMO, __ATOMIC_RELAXED, __HIP_MEMORY_SCOPE_AGENT) != 0u) {
        const float q = __builtin_nanf("");
        for (size_t i = (size_t)blockIdx.x * NT + tid_opaque(wv); i < (size_t)NB * SEQ * D; i += (size_t)gridDim.x * NT) p.out[i] = q;
    }
}

extern "C" void kernel_launch(void* const* d_in, const int* in_sizes, int n_in, void* d_out, int out_size, void* d_ws, size_t ws_size, hipStream_t stream) {
    static int grid = 0;
    if (grid == 0) {
        if (n_in != 23 || out_size != NB * SEQ * D || ws_size < WS_END) { fprintf(stderr, "kernel_launch: unexpected shapes (n_in %d out %d ws %zu need %zu)\n", n_in, out_size, ws_size, (size_t)WS_END); grid = -1; return; }
        int dev = 0, cus = 0, per_cu = 0;
        if (hipGetDevice(&dev) != hipSuccess || hipDeviceGetAttribute(&cus, hipDeviceAttributeMultiprocessorCount, dev) != hipSuccess) { grid = -1; return; }
        if (hipFuncSetAttribute((const void*)k_mega, hipFuncAttributeMaxDynamicSharedMemorySize, LDS_BYTES) != hipSuccess) { fprintf(stderr, "kernel_launch: hipFuncSetAttribute failed\n"); grid = -1; return; }
        if (hipOccupancyMaxActiveBlocksPerMultiprocessor(&per_cu, (const void*)k_mega, NT, LDS_BYTES) != hipSuccess || per_cu < 1)
            fprintf(stderr, "kernel_launch: note: occupancy query reports %d workgroups per CU\n", per_cu);
        (void)hipGetLastError();
        grid = cus;
    }
    if (grid < 0) return;
    if (hipMemsetAsync((char*)d_ws + WS_CTL, 0, CTL_ZERO_BYTES, stream) != hipSuccess) { fprintf(stderr, "kernel_launch: memset failed\n"); return; }
    P p{};
    for (int i = 0; i < 23; ++i) p.in[i] = (const float*)d_in[i];
    p.out = (float*)d_out; p.ws = (unsigned char*)d_ws;
    hipLaunchKernelGGL(k_mega, dim3(grid), dim3(NT), LDS_BYTES, stream, p);
}
```
